# Optimizing an MI355X kernel written in HIP

```python
import jax, jax.numpy as jnp
from jax import lax
import numpy as np

D_MODEL = 1024
BATCH = 1
SEQ = 16384
DEPTH = 4

N_A = DEPTH // 2
N_B = DEPTH - N_A
M_HEADS = 4
M_DQK = 128
M_DV = D_MODEL // M_HEADS
M_CHUNK = 64
M_SPLITS = [M_HEADS * M_DQK, 2 * M_HEADS * M_DQK, 2 * M_HEADS * M_DQK + M_HEADS * M_DV,
            2 * M_HEADS * M_DQK + 2 * M_HEADS * M_DV, 2 * M_HEADS * M_DQK + 2 * M_HEADS * M_DV + M_HEADS]
M_IN = 2 * M_HEADS * M_DQK + 2 * M_HEADS * M_DV + 2 * M_HEADS
A_HEADS = 8
A_DH = D_MODEL // A_HEADS
ROT_DIM = A_DH // 4
ROPE_THETA = 500000.0
MOBA_BLOCK = 256
MOBA_TOPK = 3
Q_BLOCK = 128
D_FF = 2816
CONV_W = 3
EPS = 1e-6

kernel_name = 'yoco_mlstm_moba_convffn'


def rmsnorm(x, g):
    xf = x.astype(jnp.float32)
    y = xf * lax.rsqrt(jnp.mean(xf * xf, axis=-1, keepdims=True) + EPS)
    return (y * g.astype(jnp.float32)).astype(x.dtype)


def rope_tables(s_len):
    pos = jnp.arange(s_len, dtype=jnp.float32)
    inv = ROPE_THETA ** (-jnp.arange(0, ROT_DIM, 2, dtype=jnp.float32) / ROT_DIM)
    ang = pos[:, None] * inv[None, :]
    return jnp.cos(ang), jnp.sin(ang)


def apply_partial_rope(t, cos, sin):
    half = ROT_DIM // 2
    t1, t2, rest = t[..., :half], t[..., half:ROT_DIM], t[..., ROT_DIM:]
    c = cos[None, :, None, :].astype(t.dtype)
    s = sin[None, :, None, :].astype(t.dtype)
    return jnp.concatenate([t1 * c - t2 * s, t2 * c + t1 * s, rest], axis=-1)


def mlstm_chunkwise(q, k, v, i_pre, f_pre):
    b_, s_, h_, dk = q.shape
    nc = s_ // M_CHUNK

    def to_chunks(t):
        t = t.astype(jnp.float32).reshape((b_, nc, M_CHUNK, h_) + t.shape[3:])
        return jnp.moveaxis(jnp.moveaxis(t, 1, 0), 3, 2)

    qc, kc, vc = to_chunks(q), to_chunks(k), to_chunks(v)
    ic = to_chunks(i_pre)
    lfc = to_chunks(jax.nn.log_sigmoid(f_pre.astype(jnp.float32)))
    tri = jnp.tril(jnp.ones((M_CHUNK, M_CHUNK), dtype=bool))

    def step(carry, inp):
        c_st, n_st, m_st = carry
        qb, kb, vb, ib, lfb = inp
        bcum = jnp.cumsum(lfb, axis=-1)
        dmat = jnp.where(tri, bcum[..., :, None] - bcum[..., None, :] + ib[..., None, :], -jnp.inf)
        inter = bcum + m_st[..., None]
        m_t = jnp.maximum(inter, jnp.max(dmat, axis=-1))
        w_inter = jnp.exp(inter - m_t)
        s = jnp.einsum('bhtd,bhsd->bhts', qb, kb) * jnp.exp(dmat - m_t[..., None])
        num = w_inter[..., None] * jnp.einsum('bhtd,bhde->bhte', qb, c_st) + jnp.einsum('bhts,bhse->bhte', s, vb)
        den = w_inter * jnp.einsum('bhtd,bhd->bht', qb, n_st) + jnp.sum(s, axis=-1)
        h = num / jnp.maximum(jnp.abs(den), jnp.exp(-m_t))[..., None]
        b_last = bcum[..., -1]
        g = b_last[..., None] - bcum + ib
        m_new = jnp.maximum(b_last + m_st, jnp.max(g, axis=-1))
        decay = jnp.exp(b_last + m_st - m_new)
        wk = jnp.exp(g - m_new[..., None])[..., None] * kb
        c_new = decay[..., None, None] * c_st + jnp.einsum('bhsd,bhse->bhde', wk, vb)
        n_new = decay[..., None] * n_st + jnp.sum(wk, axis=-2)
        return (c_new, n_new, m_new), h

    dv = v.shape[-1]
    init = (jnp.zeros((b_, h_, dk, dv), jnp.float32), jnp.zeros((b_, h_, dk), jnp.float32),
            jnp.zeros((b_, h_), jnp.float32))
    _, hs = lax.scan(step, init, (qc, kc, vc, ic, lfc))
    return jnp.transpose(hs, (1, 0, 3, 2, 4)).reshape(b_, s_, h_, dv)


def mlstm_mixer(x, norm_g, w_in, b_gates, h_norm_g, w_out):
    b_, s_, _ = x.shape
    u = rmsnorm(x, norm_g) @ w_in
    q, k, v, o, gi, gf = jnp.split(u, M_SPLITS, axis=-1)
    q = q.reshape(b_, s_, M_HEADS, M_DQK) * (M_DQK ** -0.5)
    k = k.reshape(b_, s_, M_HEADS, M_DQK)
    v = v.reshape(b_, s_, M_HEADS, M_DV)
    i_pre = gi.astype(jnp.float32) + b_gates[0]
    f_pre = gf.astype(jnp.float32) + b_gates[1]
    h = mlstm_chunkwise(q, k, v, i_pre, f_pre)
    h = rmsnorm(h, h_norm_g.reshape(M_HEADS, M_DV)).reshape(b_, s_, M_HEADS * M_DV)
    h = h * jax.nn.sigmoid(o.astype(jnp.float32))
    return h.astype(x.dtype) @ w_out


def conv_ffn(x, norm_g, w_up, conv_w, conv_b, w_down):
    s_ = x.shape[1]
    u = rmsnorm(x, norm_g) @ w_up
    up = jnp.pad(u, ((0, 0), (CONV_W - 1, 0), (0, 0)))
    c = conv_b + up[:, 0:s_] * conv_w[0]
    for j in range(1, CONV_W):
        c = c + up[:, j:j + s_] * conv_w[j]
    val, gate = jnp.split(c, 2, axis=-1)
    return (jax.nn.silu(gate) * val) @ w_down


def shared_kv(x, norm_g, w_kv, k_norm_g, cos, sin):
    b_, s_, _ = x.shape
    kv = rmsnorm(x, norm_g) @ w_kv
    k, v = jnp.split(kv, 2, axis=-1)
    k = apply_partial_rope(rmsnorm(k.reshape(b_, s_, A_HEADS, A_DH), k_norm_g), cos, sin)
    v = v.reshape(b_, s_, A_HEADS, A_DH)
    nb = -(-s_ // MOBA_BLOCK)
    pad = nb * MOBA_BLOCK - s_
    k = jnp.pad(k, ((0, 0), (0, pad), (0, 0), (0, 0)))
    v = jnp.pad(v, ((0, 0), (0, pad), (0, 0), (0, 0)))
    kb = k.reshape(b_, nb, MOBA_BLOCK, A_HEADS, A_DH).transpose(0, 3, 1, 2, 4)
    vb = v.reshape(b_, nb, MOBA_BLOCK, A_HEADS, A_DH).transpose(0, 3, 1, 2, 4)
    kmean = jnp.mean(kb.astype(jnp.float32), axis=3).astype(kb.dtype)
    return kb, vb, kmean


def moba_mixer(x, norm_g, w_q, q_norm_g, w_o, kb, vb, kmean, cos, sin):
    b_, s_, _ = x.shape
    q = (rmsnorm(x, norm_g) @ w_q).reshape(b_, s_, A_HEADS, A_DH)
    q = apply_partial_rope(rmsnorm(q, q_norm_g), cos, sin) * (A_DH ** -0.5)
    q = q.transpose(0, 2, 1, 3)
    nb = kb.shape[2]
    n_topk = min(MOBA_TOPK, nb)
    bidx = jnp.arange(b_)[:, None, None, None]
    hidx = jnp.arange(A_HEADS)[None, :, None, None]
    n_sel = n_topk * MOBA_BLOCK

    def attend_block(qi):
        start = qi * Q_BLOCK
        cur = start // MOBA_BLOCK
        qb = lax.dynamic_slice_in_dim(q, start, Q_BLOCK, axis=2)
        gate = jnp.einsum('bhqd,bhnd->bhqn', qb, kmean).astype(jnp.float32)
        gate = jnp.where(jnp.arange(nb) < cur, gate, -jnp.inf)
        _, sel = lax.top_k(gate, n_topk)
        sel_valid = jnp.arange(n_topk) < cur
        kg = kb[bidx, hidx, sel]
        vg = vb[bidx, hidx, sel]
        l_sel = jnp.einsum('bhqd,bhqjkd->bhqjk', qb, kg).astype(jnp.float32)
        l_sel = jnp.where(sel_valid[:, None], l_sel, -jnp.inf).reshape(b_, A_HEADS, Q_BLOCK, n_sel)
        ko = lax.dynamic_index_in_dim(kb, cur, axis=2, keepdims=False)
        vo = lax.dynamic_index_in_dim(vb, cur, axis=2, keepdims=False)
        l_own = jnp.einsum('bhqd,bhkd->bhqk', qb, ko).astype(jnp.float32)
        qpos = start + jnp.arange(Q_BLOCK)
        kpos = cur * MOBA_BLOCK + jnp.arange(MOBA_BLOCK)
        l_own = jnp.where(kpos[None, :] <= qpos[:, None], l_own, -jnp.inf)
        p = jax.nn.softmax(jnp.concatenate([l_sel, l_own], axis=-1), axis=-1).astype(vb.dtype)
        p_sel = p[..., :n_sel].reshape(b_, A_HEADS, Q_BLOCK, n_topk, MOBA_BLOCK)
        p_own = p[..., n_sel:]
        return jnp.einsum('bhqjk,bhqjkd->bhqd', p_sel, vg) + jnp.einsum('bhqk,bhkd->bhqd', p_own, vo)

    o = lax.map(attend_block, jnp.arange(s_ // Q_BLOCK))
    o = o.transpose(1, 0, 3, 2, 4).reshape(b_, s_, A_HEADS * A_DH)
    return o @ w_o


def setup_inputs(seed: int = 0) -> dict:
    key = jax.random.key(seed)
    ks = jax.random.split(key, 20)
    f32 = jnp.float32

    def w(k, shape, fan_in, scale=1.0):
        return jax.random.normal(k, shape, f32) * (scale * fan_in ** -0.5)

    def gain(k, shape):
        return 1.0 + 0.05 * jax.random.normal(k, shape, f32)

    res_scale = (2 * DEPTH) ** -0.5
    gate_base = jnp.stack([jnp.zeros((M_HEADS,), f32), jnp.linspace(3.0, 6.0, M_HEADS, dtype=f32)])
    return {
        'x': jax.random.normal(ks[0], (BATCH, SEQ, D_MODEL), f32),
        'a_norm': gain(ks[1], (N_A, D_MODEL)),
        'a_w_in': w(ks[2], (N_A, D_MODEL, M_IN), D_MODEL),
        'a_b_gates': gate_base[None] + 0.1 * jax.random.normal(ks[3], (N_A, 2, M_HEADS), f32),
        'a_h_norm': gain(ks[4], (N_A, M_HEADS * M_DV)),
        'a_w_out': w(ks[5], (N_A, D_MODEL, D_MODEL), D_MODEL, res_scale),
        'kv_norm': gain(ks[6], (D_MODEL,)),
        'w_kv': w(ks[7], (D_MODEL, 2 * D_MODEL), D_MODEL),
        'k_norm': gain(ks[8], (A_DH,)),
        'b_norm': gain(ks[9], (N_B, D_MODEL)),
        'b_w_q': w(ks[10], (N_B, D_MODEL, D_MODEL), D_MODEL),
        'b_q_norm': gain(ks[11], (N_B, A_DH)),
        'b_w_o': w(ks[12], (N_B, D_MODEL, D_MODEL), D_MODEL, res_scale),
        'f_norm': gain(ks[13], (DEPTH, D_MODEL)),
        'f_w_up': w(ks[14], (DEPTH, D_MODEL, 2 * D_FF), D_MODEL),
        'f_conv_w': w(ks[15], (DEPTH, CONV_W, 2 * D_FF), CONV_W),
        'f_conv_b': 0.02 * jax.random.normal(ks[16], (DEPTH, 2 * D_FF), f32),
        'f_w_down': w(ks[17], (DEPTH, D_FF, D_MODEL), D_FF, res_scale),
    }


def reference(x, a_norm, a_w_in, a_b_gates, a_h_norm, a_w_out, kv_norm, w_kv, k_norm,
              b_norm, b_w_q, b_q_norm, b_w_o, f_norm, f_w_up, f_conv_w, f_conv_b, f_w_down):
    cos, sin = rope_tables(x.shape[1])
    h = x
    kb = vb = kmean = None
    for l in range(DEPTH):
        if l < N_A:
            h = h + mlstm_mixer(h, a_norm[l], a_w_in[l], a_b_gates[l], a_h_norm[l], a_w_out[l])
        else:
            j = l - N_A
            h = h + moba_mixer(h, b_norm[j], b_w_q[j], b_q_norm[j], b_w_o[j], kb, vb, kmean, cos, sin)
        h = h + conv_ffn(h, f_norm[l], f_w_up[l], f_conv_w[l], f_conv_b[l], f_w_down[l])
        if l == N_A - 1:
            kb, vb, kmean = shared_kv(h, kv_norm, w_kv, k_norm, cos, sin)
    return h
```

```cpp
#include <hip/hip_runtime.h>
#include <cstdio>
#include <cstdint>

#define MIXERS 2
#define DUP 0
#define REPS(k) ((DUP) == (k) ? 2 : 1)
#ifndef PROBE
#define PROBE 0
#endif

namespace pg8 {
#define PG8_LAS __attribute__((address_space(3)))
typedef unsigned short bf16_t;
typedef short bf16x8 __attribute__((ext_vector_type(8)));
typedef float f32x4 __attribute__((ext_vector_type(4)));
typedef unsigned u32x4 __attribute__((ext_vector_type(4)));
typedef unsigned u32x2 __attribute__((ext_vector_type(2)));
constexpr int BM = 256, BK = 64, HALF = 128, HTB = HALF * BK * 2, STAGE_BYTES = 8 * HTB, NXCD = 8, WGM = 8;

__host__ __device__ __forceinline__ int lds_byte(int r, int c) { const int st = (r >> 4) * 2 + (c >> 5), rr = r & 15, cc = c & 31, ob = rr * 64 + cc * 2; return st * 1024 + (ob ^ (((ob >> 9) & 1) << 5)); }
__host__ __device__ __forceinline__ void stage_rc(int b, int& R, int& C) { const int st = b / 1024, sb = b % 1024, swz = sb ^ (((sb >> 9) & 1) << 5); R = (st >> 1) * 16 + swz / 64; C = (st & 1) * 32 + (swz % 64) / 2; }
__host__ __device__ __forceinline__ int perm32(int rho) { const int n = rho >> 4, i = rho & 15; return 8 * (i >> 2) + 4 * n + (i & 3); }

struct Unit { int pm, pn; };
struct Gemm { const bf16_t* A; const bf16_t* Bt; int M, N, K, a_rows; };

struct StaticOrder {
    int nM, nN, nwg, G, c;
    __host__ __device__ void init(int M, int N, int G_, int c_) { nM = M / BM; nN = N / BM; nwg = nM * nN; G = G_; c = c_; }
    __host__ __device__ bool next(int i, Unit& u) const {
        const long L = (long)i * G + c; if (L >= nwg) return false;
        int wgid = (int)L; { const int q = nwg / NXCD, r = nwg % NXCD, xcd = wgid % NXCD, off = wgid / NXCD; wgid = (xcd < r ? xcd * (q + 1) : r * (q + 1) + (xcd - r) * q) + off; }
        const int nig = WGM * nN, gid = wgid / nig, fm = gid * WGM, gsz = (nM - fm) < WGM ? (nM - fm) : WGM;
        u.pm = fm + ((wgid % nig) % gsz); u.pn = (wgid % nig) / gsz; return true;
    }
    __device__ __forceinline__ void a_ready(const Unit&) const {}
    __device__ __forceinline__ void done(const Unit&) const {}
};

__device__ __forceinline__ float sh_idx(float v, int src) { return __builtin_bit_cast(float, __builtin_amdgcn_ds_bpermute(src << 2, __builtin_bit_cast(int, v))); }
__device__ __forceinline__ float sh_xor(float v, int o, int lane) { return sh_idx(v, lane ^ o); }
template <int CTRL, int ROWMASK = 0xf> __device__ __forceinline__ float dpp_add(float v) { return v + __builtin_bit_cast(float, __builtin_amdgcn_update_dpp(0, __builtin_bit_cast(int, v), CTRL, ROWMASK, 0xf, true)); }
__device__ __forceinline__ float half_sum_hi(float v) { v = dpp_add<0xB1>(v); v = dpp_add<0x4E>(v); v = dpp_add<0x141>(v); v = dpp_add<0x140>(v); return dpp_add<0x142, 0xA>(v); }
__device__ __forceinline__ float oct_sum(float v) { v = dpp_add<0xB1>(v); v = dpp_add<0x4E>(v); return dpp_add<0x141>(v); }
__device__ __forceinline__ unsigned cvt_pk_bf16(float lo, float hi) { unsigned r; asm volatile("v_cvt_pk_bf16_f32 %0, %1, %2" : "=v"(r) : "v"(lo), "v"(hi)); return r; }
__device__ __forceinline__ float rstd4(const float* ss4, int row) { const f32x4 p = *(const f32x4*)(ss4 + (size_t)row * 4); return rsqrtf(((p[0] + p[1]) + (p[2] + p[3])) * (1.0f / 1024.0f) + 1e-6f); }
#define EPI_BAR() do { asm volatile("s_waitcnt lgkmcnt(0)" ::: "memory"); __builtin_amdgcn_s_barrier(); asm volatile("" ::: "memory"); } while (0)

constexpr int TT = 16384, DD = 1024;
constexpr float NEPS = 1e-6f;

struct EpiRes {
    static constexpr bool PERM = true;
    bf16_t* hb; float* ss; float* fout;
    __device__ __forceinline__ void operator()(f32x4 (&acc)[2][2][4][2], const Unit& u, int wr, int wc, int fr_, int fq_, PG8_LAS unsigned char* el, int wid, int lane_) const {
        int ln_ = lane_; asm volatile("" : "+v"(ln_)); const int lane = ln_, fr = ln_ & 15, fq = ln_ >> 4; (void)fr_; (void)fq_;
        u32x4 pre[2][4][2];
#pragma unroll
        for (int ai = 0; ai < 2; ++ai)
#pragma unroll
            for (int m = 0; m < 4; ++m)
#pragma unroll
                for (int bj = 0; bj < 2; ++bj) pre[ai][m][bj] = *(const u32x4*)(hb + (size_t)(u.pm * BM + ai * HALF + wr * 64 + m * 16 + fr) * DD + u.pn * BM + bj * HALF + wc * 32 + 8 * fq);
#pragma unroll
        for (int ai = 0; ai < 2; ++ai)
#pragma unroll
            for (int m = 0; m < 4; ++m) {
                const int row = u.pm * BM + ai * HALF + wr * 64 + m * 16 + fr; float s = 0.f;
#pragma unroll
                for (int bj = 0; bj < 2; ++bj) {
                    const size_t off = (size_t)row * DD + u.pn * BM + bj * HALF + wc * 32 + 8 * fq;
                    const u32x4 p = pre[ai][m][bj];
                    f32x4 v0 = acc[ai][bj][m][0], v1 = acc[ai][bj][m][1];
                    v0[0] += __builtin_bit_cast(float, p[0] << 16); v0[1] += __builtin_bit_cast(float, p[0] & 0xffff0000u); v0[2] += __builtin_bit_cast(float, p[1] << 16); v0[3] += __builtin_bit_cast(float, p[1] & 0xffff0000u);
                    v1[0] += __builtin_bit_cast(float, p[2] << 16); v1[1] += __builtin_bit_cast(float, p[2] & 0xffff0000u); v1[2] += __builtin_bit_cast(float, p[3] << 16); v1[3] += __builtin_bit_cast(float, p[3] & 0xffff0000u);
                    if (fout) { *(f32x4*)(fout + off) = v0; *(f32x4*)(fout + off + 4) = v1; }
                    u32x4 w; w.x = cvt_pk_bf16(v0[0], v0[1]); w.y = cvt_pk_bf16(v0[2], v0[3]); w.z = cvt_pk_bf16(v1[0], v1[1]); w.w = cvt_pk_bf16(v1[2], v1[3]);
                    *(u32x4*)(hb + off) = w;
                    s += (v0[0] * v0[0] + v0[1] * v0[1]) + (v0[2] * v0[2] + v0[3] * v0[3]) + (v1[0] * v1[0] + v1[1] * v1[1]) + (v1[2] * v1[2] + v1[3] * v1[3]);
                }
                s += sh_xor(s, 16, lane); s += sh_xor(s, 32, lane);
                if (fq == 0) ((PG8_LAS float*)el)[(ai * HALF + wr * 64 + m * 16 + fr) * 4 + wc] = s;
            }
        EPI_BAR();
        { const int tid2 = wid * 64 + lane;
          if (ss && tid2 < 256) { const f32x4 p = *(const PG8_LAS f32x4*)((PG8_LAS float*)el + tid2 * 4); ss[(size_t)(u.pm * BM + tid2) * 4 + u.pn] = (p[0] + p[1]) + (p[2] + p[3]); } }
        EPI_BAR();
    }
};

struct EpiConv {
    static constexpr bool PERM = true;
    bf16_t* act; const float* ss; const float* cw; const float* cb;
    static __device__ __forceinline__ float ror1(float v) { return __builtin_bit_cast(float, __builtin_amdgcn_update_dpp(0, __builtin_bit_cast(int, v), 0x121, 0xf, 0xf, false)); }
    static __device__ __forceinline__ float ror2(float v) { return __builtin_bit_cast(float, __builtin_amdgcn_update_dpp(0, __builtin_bit_cast(int, v), 0x122, 0xf, 0xf, false)); }
    __device__ __forceinline__ void operator()(f32x4 (&acc)[2][2][4][2], const Unit& u, int wr, int wc, int fr_, int fq_, PG8_LAS unsigned char* el, int wid, int lane_) const {
        int ln_ = lane_; asm volatile("" : "+v"(ln_)); const int lane = ln_, fr = ln_ & 15, fq = ln_ >> 4; (void)lane; (void)fr_; (void)fq_;
        const int t0 = u.pm * 254 - 2;
        const int cl = wc * 32 + 8 * fq;
        float rs[2][4]; f32x4 cp[2][2][4];
#pragma unroll
        for (int ai = 0; ai < 2; ++ai)
#pragma unroll
            for (int m = 0; m < 4; ++m) { const int t = t0 + ai * HALF + wr * 64 + m * 16 + fr; rs[ai][m] = (t >= 0 && t < TT) ? rstd4(ss, t) : 0.f; }
#pragma unroll
        for (int n = 0; n < 2; ++n)
#pragma unroll
            for (int bj = 0; bj < 2; ++bj) { const int scol = (bj ? 2816 : 0) + u.pn * HALF + cl + 4 * n;
                cp[n][bj][0] = *(const f32x4*)(cw + scol); cp[n][bj][1] = *(const f32x4*)(cw + 5632 + scol); cp[n][bj][2] = *(const f32x4*)(cw + 2 * 5632 + scol); cp[n][bj][3] = *(const f32x4*)(cb + scol); }
#pragma unroll
        for (int ai = 0; ai < 2; ++ai)
#pragma unroll
            for (int m = 0; m < 4; ++m)
#pragma unroll
                for (int bj = 0; bj < 2; ++bj)
#pragma unroll
                    for (int n = 0; n < 2; ++n) acc[ai][bj][m][n] = acc[ai][bj][m][n] * rs[ai][m];
        PG8_LAS float* X = (PG8_LAS float*)el;
#pragma unroll
        for (int ai = 0; ai < 2; ++ai) { const int B = 2 * ai + wr;
            if (B < 3 && fr >= 14) {
#pragma unroll
                for (int bj = 0; bj < 2; ++bj)
#pragma unroll
                    for (int n = 0; n < 2; ++n) *(PG8_LAS f32x4*)(X + (B * 2 + (fr - 14)) * 256 + bj * HALF + cl + 4 * n) = acc[ai][bj][3][n];
            } }
        EPI_BAR();
#pragma unroll
        for (int n = 0; n < 2; ++n) {
#pragma unroll
            for (int bj = 0; bj < 2; ++bj) {
                const f32x4 w0 = cp[n][bj][0], w1 = cp[n][bj][1], w2 = cp[n][bj][2], bb = cp[n][bj][3];
#pragma unroll
                for (int ai = 0; ai < 2; ++ai) {
                    const int B = 2 * ai + wr;
                    f32x4 p1 = (f32x4){0.f, 0.f, 0.f, 0.f}, p2 = p1;
                    if (B > 0) { const f32x4 e0 = *(const PG8_LAS f32x4*)(X + ((B - 1) * 2 + 0) * 256 + bj * HALF + cl + 4 * n), e1 = *(const PG8_LAS f32x4*)(X + ((B - 1) * 2 + 1) * 256 + bj * HALF + cl + 4 * n);
                        p1 = e1; p2 = (fr == 0) ? e0 : e1; }
#pragma unroll
                    for (int m = 0; m < 4; ++m) {
                        f32x4 cur = acc[ai][bj][m][n]; f32x4 s1, s2;
                        asm volatile("" : "+v"(cur));
#pragma unroll
                        for (int i = 0; i < 4; ++i) { s1[i] = ror1(cur[i]); s2[i] = ror2(cur[i]); }
                        const f32x4 q1 = (fr >= 1) ? s1 : p1, q2 = (fr >= 2) ? s2 : p2;
                        f32x4 res = bb + w0 * q2 + w1 * q1 + w2 * cur;
                        asm volatile("" : "+v"(res), "+v"(s1), "+v"(s2));
                        acc[ai][bj][m][n] = res;
                        p1 = s1; p2 = s2;
                    }
                }
            }
        }
#pragma unroll
        for (int ai = 0; ai < 2; ++ai)
#pragma unroll
            for (int m = 0; m < 4; ++m) {
                const int r = ai * HALF + wr * 64 + m * 16 + fr, t = t0 + r;
                u32x4 w; float a[8];
#pragma unroll
                for (int n = 0; n < 2; ++n)
#pragma unroll
                    for (int i = 0; i < 4; ++i) { const float v = acc[ai][0][m][n][i], g = acc[ai][1][m][n][i]; a[4 * n + i] = v * g * __builtin_amdgcn_rcpf(1.0f + __builtin_amdgcn_exp2f(-1.4426950408889634f * g)); }
                w.x = cvt_pk_bf16(a[0], a[1]); w.y = cvt_pk_bf16(a[2], a[3]); w.z = cvt_pk_bf16(a[4], a[5]); w.w = cvt_pk_bf16(a[6], a[7]);
                if (r >= 2 && t < TT) *(u32x4*)(act + (size_t)t * 2816 + u.pn * HALF + cl) = w;
            }
        EPI_BAR();
    }
};


struct EpiIn {
    static constexpr bool PERM = true;
    bf16_t* q; bf16_t* k; bf16_t* og; const float* ss;
    __device__ __forceinline__ void operator()(f32x4 (&acc)[2][2][4][2], const Unit& u, int wr, int wc, int fr_, int fq_, PG8_LAS unsigned char* el, int wid, int lane_) const {
        int ln_ = lane_; asm volatile("" : "+v"(ln_)); const int lane = ln_, fr = ln_ & 15, fq = ln_ >> 4; (void)lane; (void)fr_; (void)fq_;
        bf16_t* dst; int ldc, c0; float sc;
        if (u.pn < 2) { dst = q; ldc = 512; c0 = 256 * u.pn; sc = 0.08838834764831845f; }
        else { dst = og; ldc = 1024; c0 = 256 * (u.pn - 2); sc = 1.f; }
#pragma unroll
        for (int ai = 0; ai < 2; ++ai)
#pragma unroll
            for (int m = 0; m < 4; ++m) {
                const int row = u.pm * BM + ai * HALF + wr * 64 + m * 16 + fr;
                const float rs = rstd4(ss, row) * sc;
#pragma unroll
                for (int bj = 0; bj < 2; ++bj) {
                    const f32x4 v0 = acc[ai][bj][m][0] * rs, v1 = acc[ai][bj][m][1] * rs;
                    u32x4 w; w.x = cvt_pk_bf16(v0[0], v0[1]); w.y = cvt_pk_bf16(v0[2], v0[3]); w.z = cvt_pk_bf16(v1[0], v1[1]); w.w = cvt_pk_bf16(v1[2], v1[3]);
                    *(u32x4*)(dst + (size_t)row * ldc + c0 + bj * HALF + wc * 32 + 8 * fq) = w;
                }
            }
    }
};
struct EpiInT {
    static constexpr bool PERM = true;
    bf16_t* o; const float* ss; int nrows, ch; const float* wgt;
    __device__ __forceinline__ void operator()(f32x4 (&acc)[2][2][4][2], const Unit& u, int wr, int wc, int fr_, int fq_, PG8_LAS unsigned char* el, int wid, int lane_) const {
        int ln_ = lane_; asm volatile("" : "+v"(ln_)); const int lane = ln_, fr = ln_ & 15, fq = ln_ >> 4; (void)lane; (void)fr_; (void)fq_;
#pragma unroll
        for (int bj = 0; bj < 2; ++bj) {
            const int t = u.pn * BM + bj * HALF + wc * 32 + 8 * fq;
            f32x4 r0, r1;
#pragma unroll
            for (int i = 0; i < 4; ++i) { r0[i] = rstd4(ss, t + i); r1[i] = rstd4(ss, t + 4 + i); }
            if (wgt && u.pm >= 2) { const float* wp = wgt + (size_t)(u.pm - 2) * TT + t; r0 = r0 * *(const f32x4*)wp; r1 = r1 * *(const f32x4*)(wp + 4); }
#pragma unroll
            for (int ai = 0; ai < 2; ++ai)
#pragma unroll
                for (int m = 0; m < 4; ++m) {
                    const int row = u.pm * BM + ai * HALF + wr * 64 + m * 16 + fr;
                    const f32x4 v0 = acc[ai][bj][m][0] * r0, v1 = acc[ai][bj][m][1] * r1;
                    u32x4 w; w.x = cvt_pk_bf16(v0[0], v0[1]); w.y = cvt_pk_bf16(v0[2], v0[3]); w.z = cvt_pk_bf16(v1[0], v1[1]); w.w = cvt_pk_bf16(v1[2], v1[3]);
                    if (ch) {
                        *(u32x4*)(o + ((((size_t)(t >> 6) * 96 + (row >> 4)) * 2 + ((t >> 5) & 1)) * 512 + (((t >> 3) & 3) * 16 + (row & 15)) * 8)) = w; }
                    else {
                        const int kb = t >> 8, key = t & 255;
                        *(u32x4*)(o + ((((size_t)(kb * 8 + (row >> 7)) * 4 + ((row >> 5) & 3)) * 16 + (key >> 4)) * 512 + (((key >> 3) & 1) * 32 + (row & 31)) * 8)) = w; }
                }
        }
    }
};


struct EpiQK {
    static constexpr bool PERM = false;
    bf16_t* o; const float* ss; const float* gain; const float* rope; float* kmean; float oscale; int kfrag;
    __device__ __forceinline__ void operator()(f32x4 (&acc)[2][2][4][2], const Unit& u, int wr, int wc, int fr_, int fq_, PG8_LAS unsigned char* el, int wid, int lane_) const {
        int ln_ = lane_; asm volatile("" : "+v"(ln_)); const int lane = ln_, fr = ln_ & 15, fq = ln_ >> 4; (void)lane; (void)fr_; (void)fq_;
        PG8_LAS float* P = (PG8_LAS float*)el;
        PG8_LAS float* KS = (PG8_LAS float*)(el + 8192);
#pragma unroll
        for (int ai = 0; ai < 2; ++ai)
#pragma unroll
            for (int m = 0; m < 4; ++m) {
                const int rl = ai * HALF + wr * 64 + m * 16 + fr;
                const float rs = rstd4(ss, u.pm * BM + rl);
#pragma unroll
                for (int bj = 0; bj < 2; ++bj) {
                    const f32x4 x0 = acc[ai][bj][m][0] * rs, x1 = acc[ai][bj][m][1] * rs;
                    acc[ai][bj][m][0] = x0; acc[ai][bj][m][1] = x1;
                    float s = (x0[0] * x0[0] + x0[1] * x0[1]) + (x0[2] * x0[2] + x0[3] * x0[3]) + (x1[0] * x1[0] + x1[1] * x1[1]) + (x1[2] * x1[2] + x1[3] * x1[3]);
                    s += sh_xor(s, 16, lane); s += sh_xor(s, 32, lane);
                    if (fq == 0) P[(rl * 2 + bj) * 4 + wc] = s;
                }
            }
        EPI_BAR();
#pragma unroll
        for (int bj = 0; bj < 2; ++bj) {
            const f32x4 g0 = *(const f32x4*)(gain + 32 * wc + 4 * fq), g1 = *(const f32x4*)(gain + 32 * wc + 16 + 4 * fq);
            f32x4 cs0 = (f32x4){0.f, 0.f, 0.f, 0.f}, cs1 = cs0;
            const int head = 2 * u.pn + bj;
#pragma unroll
            for (int ai = 0; ai < 2; ++ai)
#pragma unroll
                for (int m = 0; m < 4; ++m) {
                    const int rl = ai * HALF + wr * 64 + m * 16 + fr, row = u.pm * BM + rl;
                    const f32x4 p = *(const PG8_LAS f32x4*)(P + (rl * 2 + bj) * 4);
                    const float rn = rsqrtf(((p[0] + p[1]) + (p[2] + p[3])) * (1.0f / 128.0f) + NEPS);
                    f32x4 y0 = acc[ai][bj][m][0] * rn * g0, y1 = acc[ai][bj][m][1] * rn * g1;
                    if (wc == 0) { const f32x4 c = *(const f32x4*)(rope + (size_t)row * 16 + 4 * fq), sn = *(const f32x4*)(rope + (size_t)TT * 16 + (size_t)row * 16 + 4 * fq);
                        const f32x4 t0 = y0 * c - y1 * sn, t1 = y1 * c + y0 * sn; y0 = t0; y1 = t1; }
                    cs0 += y0; cs1 += y1;
                    y0 = y0 * oscale; y1 = y1 * oscale;
                    u32x2 w0, w1; w0.x = cvt_pk_bf16(y0[0], y0[1]); w0.y = cvt_pk_bf16(y0[2], y0[3]); w1.x = cvt_pk_bf16(y1[0], y1[1]); w1.y = cvt_pk_bf16(y1[2], y1[3]);
                    if (!kfrag) { bf16_t* op = o + (size_t)row * DD + head * 128 + 32 * wc + 4 * fq; *(u32x2*)op = w0; *(u32x2*)(op + 16) = w1; }
                    else {
                        bf16_t* op = o + ((((size_t)((row >> 8) * 8 + head) * 8 + ((row >> 5) & 7)) * 8 + 2 * wc) * 512 + ((fq >> 1) * 32 + (row & 31)) * 8 + 4 * (fq & 1));
                        *(u32x2*)op = w0; *(u32x2*)(op + 512) = w1; }
                    asm volatile("" ::: "memory");
                }
            if (kmean) {
#pragma unroll
                for (int i = 0; i < 4; ++i) {
#pragma unroll
                    for (int o2 = 1; o2 < 16; o2 <<= 1) { cs0[i] += sh_xor(cs0[i], o2, lane); cs1[i] += sh_xor(cs1[i], o2, lane); }
                }
                if (fr == 0) { *(PG8_LAS f32x4*)(KS + (wr * 2 + bj) * 128 + 32 * wc + 4 * fq) = cs0; *(PG8_LAS f32x4*)(KS + (wr * 2 + bj) * 128 + 32 * wc + 16 + 4 * fq) = cs1; }
            }
        }
        EPI_BAR();
        if (kmean) {
            const int tid2 = wid * 64 + lane;
            if (tid2 < 256) { const int bj = tid2 >> 7, d = tid2 & 127;
                kmean[((size_t)(2 * u.pn + bj) * 64 + u.pm) * 128 + d] = (KS[bj * 128 + d] + KS[(2 + bj) * 128 + d]) * (1.0f / 256.0f); }
            EPI_BAR();
        }
    }
};

template <class Epi, class Sched, bool ALIGN_EPI = false, bool SP2 = false>
__device__ __forceinline__ void gemm_phase(PG8_LAS unsigned char* lds, PG8_LAS unsigned char* elds, const Gemm g, const Sched& S, const Epi& E) {
    int tid_ = threadIdx.x; asm volatile("" : "+v"(tid_)); const int tid = tid_, wid = __builtin_amdgcn_readfirstlane(tid >> 6), lane = tid & 63, wr = wid >> 2, wc = wid & 3, fr = lane & 15, fq = lane >> 4;
    const int K = g.K, nt = K / BK;
    float zf_ = 0.f; asm volatile("" : "+v"(zf_)); const f32x4 z4_ = {zf_, zf_, zf_, zf_};
    unsigned voffA[2], voffB[2];
#pragma unroll
    for (int i = 0; i < 2; ++i) { int R, C; stage_rc(tid * 16 + i * 8192, R, C); const int Rb = Epi::PERM ? ((R & ~31) + perm32(R & 31)) : R;
        voffA[i] = (unsigned)(R * K + C) * 2u; voffB[i] = (unsigned)(Rb * K + C) * 2u; }
    const size_t kstep = (size_t)(BK * 2);
    const size_t hstep = (size_t)HALF * K * 2;
    const size_t tstep = 2 * hstep; const size_t tstepA = (size_t)g.a_rows * K * 2;
    const unsigned ldsw = (unsigned)wid * 1024u;
    const int aoff = lds_byte(wr * 64 + fr, fq * 8), boff = lds_byte(wc * 32 + fr, fq * 8);
#define PG8_SA(b, h) (((b) * 2 + (h)) * HTB)
#define PG8_SB(b, h) ((4 + (b) * 2 + (h)) * HTB)
#define PG8_STAGE(bufoff, gbase, voff) do { _Pragma("unroll") for (int _i = 0; _i < 2; ++_i) \
        __builtin_amdgcn_global_load_lds((const unsigned*)((const char*)(gbase) + (voff)[_i]), (PG8_LAS unsigned*)(lds + (bufoff) + ldsw + _i * 8192), 16, 0, 0); } while (0)
#define PG8_LDA(dst, b, h) do { _Pragma("unroll") for (int m = 0; m < 4; ++m) _Pragma("unroll") for (int k = 0; k < 2; ++k) dst[m][k] = *(const PG8_LAS bf16x8*)(lds + PG8_SA(b, h) + aoff + m * 2048 + k * 1024); } while (0)
#define PG8_LDB(dst, b, h) do { _Pragma("unroll") for (int n = 0; n < 2; ++n) _Pragma("unroll") for (int k = 0; k < 2; ++k) dst[n][k] = *(const PG8_LAS bf16x8*)(lds + PG8_SB(b, h) + boff + n * 2048 + k * 1024); } while (0)
#define PG8_MMA(ai, bj, At, Bt) do { __builtin_amdgcn_s_setprio(1); _Pragma("unroll") for (int m = 0; m < 4; ++m) _Pragma("unroll") for (int n = 0; n < 2; ++n) _Pragma("unroll") for (int k = 0; k < 2; ++k) \
        acc[ai][bj][m][n] = __builtin_amdgcn_mfma_f32_16x16x32_bf16(Bt[n][k], At[m][k], acc[ai][bj][m][n], 0, 0, 0); __builtin_amdgcn_s_setprio(0); } while (0)
#define PG8_WAIT_V(n) asm volatile("s_waitcnt vmcnt(" #n ")" ::: "memory")
#define PG8_WAIT_L(n) asm volatile("s_waitcnt lgkmcnt(" #n ")" ::: "memory")
#define PG8_BAR __builtin_amdgcn_s_barrier()
#define PG8_SCHED __builtin_amdgcn_sched_barrier(0)
    Unit cur, nxt; int ui = 0;
    if (!S.next(0, cur)) return;
    f32x4 acc[2][2][4][2];
#pragma unroll
    for (int a = 0; a < 2; ++a)
#pragma unroll
        for (int b = 0; b < 2; ++b)
#pragma unroll
            for (int m = 0; m < 4; ++m)
#pragma unroll
                for (int n = 0; n < 2; ++n) acc[a][b][m][n] = z4_;
    bf16x8 At[4][2], B0[2][2], B1[2][2];
    const char* cA = (const char*)g.A + (size_t)cur.pm * tstepA; const char* cB = (const char*)g.Bt + (size_t)cur.pn * tstep;
    S.a_ready(cur);
    if constexpr (SP2) {
        PG8_STAGE(PG8_SB(0, 0), cB, voffB); PG8_STAGE(PG8_SB(0, 1), cB + hstep, voffB); PG8_STAGE(PG8_SA(0, 0), cA, voffA); PG8_STAGE(PG8_SA(0, 1), cA + hstep, voffA);
        if (wr == 1) PG8_BAR;
        PG8_WAIT_V(2); PG8_BAR;
        PG8_STAGE(PG8_SB(1, 0), cB + kstep, voffB); PG8_STAGE(PG8_SA(1, 0), cA + kstep, voffA); PG8_STAGE(PG8_SB(1, 1), cB + hstep + kstep, voffB);
        PG8_WAIT_V(6); PG8_BAR;
    } else {
        PG8_STAGE(PG8_SB(0, 0), cB, voffB); PG8_STAGE(PG8_SA(0, 0), cA, voffA); PG8_STAGE(PG8_SB(0, 1), cB + hstep, voffB); PG8_STAGE(PG8_SA(0, 1), cA + hstep, voffA);
        if (wr == 1) PG8_BAR;
        PG8_WAIT_V(4); PG8_BAR;
        PG8_STAGE(PG8_SB(1, 0), cB + kstep, voffB); PG8_STAGE(PG8_SA(1, 0), cA + kstep, voffA); PG8_STAGE(PG8_SB(1, 1), cB + hstep + kstep, voffB);
        PG8_WAIT_V(6); PG8_BAR;
    }
    for (;;) {
        const bool has_next = S.next(ui + 1, nxt);
        const char* nA = has_next ? (const char*)g.A + (size_t)nxt.pm * tstepA : cA; const char* nB = has_next ? (const char*)g.Bt + (size_t)nxt.pn * tstep : cB;
        for (int t = 0; t < nt; t += 2) {
            const bool last = (t == nt - 2);
            const char* a1 = cA + (size_t)(t + 1) * kstep;
            const char* a2 = last ? nA : cA + (size_t)(t + 2) * kstep; const char* b2 = last ? nB : cB + (size_t)(t + 2) * kstep;
            const char* a3 = a2 + kstep; const char* b3 = b2 + kstep;
            if (last && has_next) S.a_ready(nxt);
            if constexpr (SP2) {
            PG8_LDB(B0, 0, 0); PG8_LDB(B1, 0, 1); PG8_SCHED; PG8_LDA(At, 0, 0); PG8_STAGE(PG8_SA(1, 1), a1 + hstep, voffA);
            PG8_WAIT_V(8); PG8_WAIT_L(0); PG8_BAR; PG8_MMA(0, 0, At, B0); PG8_MMA(0, 1, At, B1); PG8_BAR; PG8_SCHED;
            PG8_LDA(At, 0, 1); PG8_STAGE(PG8_SB(0, 0), b2, voffB); PG8_STAGE(PG8_SB(0, 1), b2 + hstep, voffB); PG8_STAGE(PG8_SA(0, 0), a2, voffA);
            PG8_WAIT_V(8); PG8_WAIT_L(0); PG8_BAR; PG8_MMA(1, 0, At, B0); PG8_MMA(1, 1, At, B1); PG8_BAR; PG8_SCHED;
            PG8_LDB(B0, 1, 0); PG8_LDB(B1, 1, 1); PG8_SCHED; PG8_LDA(At, 1, 0); PG8_STAGE(PG8_SA(0, 1), a2 + hstep, voffA);
            PG8_WAIT_V(8); PG8_WAIT_L(0); PG8_BAR; PG8_MMA(0, 0, At, B0); PG8_MMA(0, 1, At, B1); PG8_BAR; PG8_SCHED;
            PG8_LDA(At, 1, 1); PG8_STAGE(PG8_SB(1, 0), b3, voffB); PG8_STAGE(PG8_SB(1, 1), b3 + hstep, voffB); PG8_STAGE(PG8_SA(1, 0), a3, voffA);
            PG8_WAIT_V(8); PG8_WAIT_L(0); PG8_BAR; PG8_MMA(1, 0, At, B0); PG8_MMA(1, 1, At, B1); PG8_BAR; PG8_SCHED;
            } else {
            PG8_LDB(B0, 0, 0); PG8_SCHED; PG8_LDA(At, 0, 0); PG8_STAGE(PG8_SA(1, 1), a1 + hstep, voffA);
            PG8_WAIT_L(8); PG8_BAR; PG8_WAIT_L(0); PG8_MMA(0, 0, At, B0); PG8_BAR; PG8_SCHED;
            PG8_LDB(B1, 0, 1); PG8_STAGE(PG8_SB(0, 0), b2, voffB);
            PG8_BAR; PG8_WAIT_L(0); PG8_MMA(0, 1, At, B1); PG8_BAR;
            PG8_LDA(At, 0, 1); PG8_STAGE(PG8_SA(0, 0), a2, voffA);
            PG8_BAR; PG8_WAIT_L(0); PG8_MMA(1, 0, At, B0); PG8_BAR; PG8_SCHED;
            PG8_STAGE(PG8_SB(0, 1), b2 + hstep, voffB);
            PG8_WAIT_V(6); PG8_BAR; PG8_MMA(1, 1, At, B1); PG8_BAR;
            PG8_LDB(B0, 1, 0); PG8_SCHED; PG8_LDA(At, 1, 0); PG8_STAGE(PG8_SA(0, 1), a2 + hstep, voffA);
            PG8_WAIT_L(8); PG8_BAR; PG8_WAIT_L(0); PG8_MMA(0, 0, At, B0); PG8_BAR; PG8_SCHED;
            PG8_LDB(B1, 1, 1); PG8_STAGE(PG8_SB(1, 0), b3, voffB);
            PG8_BAR; PG8_WAIT_L(0); PG8_MMA(0, 1, At, B1); PG8_BAR;
            PG8_LDA(At, 1, 1); PG8_STAGE(PG8_SA(1, 0), a3, voffA);
            PG8_BAR; PG8_WAIT_L(0); PG8_MMA(1, 0, At, B0); PG8_BAR; PG8_SCHED;
            PG8_STAGE(PG8_SB(1, 1), b3 + hstep, voffB);
            PG8_WAIT_V(6); PG8_BAR; PG8_MMA(1, 1, At, B1); PG8_BAR;
            }
        }
        if constexpr (ALIGN_EPI) { if (wr == 0) PG8_BAR; }
        { E(acc, cur, wr, wc, fr, fq, elds, wid, lane); S.done(cur); }
        if (!has_next) break;
#pragma unroll
        for (int a = 0; a < 2; ++a)
#pragma unroll
            for (int b = 0; b < 2; ++b)
#pragma unroll
                for (int m = 0; m < 4; ++m)
#pragma unroll
                    for (int n = 0; n < 2; ++n) acc[a][b][m][n] = z4_;
        cur = nxt; cA = nA; cB = nB; ++ui;
        if constexpr (ALIGN_EPI) { if (wr == 1) PG8_BAR; }
    }
    PG8_WAIT_V(0);
    if constexpr (!ALIGN_EPI) { if (wr == 0) PG8_BAR; }
    PG8_BAR;
#undef PG8_SA
#undef PG8_SB
#undef PG8_STAGE
#undef PG8_LDA
#undef PG8_LDB
#undef PG8_MMA
#undef PG8_WAIT_V
#undef PG8_WAIT_L
#undef PG8_BAR
#undef PG8_SCHED
}
}


#define GAS __attribute__((address_space(1)))
#define LAS __attribute__((address_space(3)))
typedef unsigned short bf16;
typedef unsigned v4u __attribute__((ext_vector_type(4)));
typedef float f32x4 __attribute__((ext_vector_type(4)));
typedef short bf16x8 __attribute__((ext_vector_type(8)));

constexpr int NWAVES = 8;
constexpr int T = 16384, D = 1024, FF = 2816, FF2 = 5632, MIN_ = 3080;
constexpr size_t MiB = 1u << 20;
constexpr size_t WS_CTL = 0, CTL_ZERO_BYTES = 2 * MiB;
constexpr size_t WS_SS = 64 * 1024;
constexpr size_t WS_WINR = 2 * MiB;
constexpr size_t WS_WINT = 10 * MiB;
constexpr size_t WS_WOUT = 16 * MiB;
constexpr size_t WS_WK = 20 * MiB, WS_WV = 22 * MiB;
constexpr size_t WS_WQ = 24 * MiB;
constexpr size_t WS_WO = 28 * MiB;
constexpr size_t WS_WUP = 32 * MiB;
constexpr size_t WS_WDN = 76 * MiB;
constexpr size_t WS_WG = 98 * MiB;
constexpr size_t WS_ROPE = 99 * MiB;
constexpr size_t WS_HB = 101 * MiB;
constexpr size_t HB_ROW0 = 2 * 2048;
constexpr size_t WS_ACT = 135 * MiB;
constexpr size_t WS_CT = 135 * MiB;
constexpr size_t WS_MQ = 199 * MiB;
constexpr size_t WS_BCUM = 215 * MiB, WS_IG = WS_BCUM + 256 * 1024, WS_WGT = WS_IG + 256 * 1024, WS_DECAY = WS_WGT + 256 * 1024;
constexpr size_t WS_NCT = 217 * MiB;
constexpr size_t WS_ONES = 221 * MiB;
constexpr size_t WS_MK = 223 * MiB;
constexpr size_t WS_OG = 239 * MiB;
constexpr size_t WS_KVT = 271 * MiB;
constexpr size_t WS_HG = 319 * MiB;
constexpr size_t WS_XK = 223 * MiB;
constexpr size_t WS_XVT = 255 * MiB;
constexpr size_t WS_KMEAN = 287 * MiB;
constexpr size_t WS_AQ = 288 * MiB;
constexpr size_t WS_LIST = 320 * MiB;
constexpr size_t WS_ML = 337 * MiB;
constexpr size_t WS_PO = 135 * MiB, WS_PO2 = 340 * MiB;
constexpr int PO_SPLIT = 14336;
constexpr int TRI = 516096;
constexpr size_t WS_GCNT = 1536 * 1024;
constexpr size_t WS_END = 352 * MiB;
constexpr int CW_BAR = 4096;
constexpr int RING_BYTES = 131072, EPI_OFF = RING_BYTES + 1024, LDS_BYTES = 163840, MISC_OFF = LDS_BYTES - 256;

#define LDS_WAIT() asm volatile("s_waitcnt lgkmcnt(0)" ::: "memory")
__device__ __forceinline__ unsigned f2bf(float f) { unsigned u = __builtin_bit_cast(unsigned, f); return (u + 0x7fffu + ((u >> 16) & 1u)) >> 16; }
__device__ __forceinline__ unsigned pk2(float lo, float hi) { return f2bf(lo) | (f2bf(hi) << 16); }

#define XB_TMO      128
#define XB_XCNT(j)  (256  + 64 * (j))
#define XB_XSUB(j)  (1280 + 64 * (j))
#define XB_XGEN(j)  (2304 + 64 * (j))
#define XB_TOP      3328
#define XB_TOPGEN   3392
#define XCD_BAR_WORDS 3456
#define XB_SPIN_CAP (1u << 18)
__device__ __forceinline__ unsigned xb_ld(unsigned* p)              { return __hip_atomic_load(p, __ATOMIC_RELAXED, __HIP_MEMORY_SCOPE_AGENT); }
__device__ __forceinline__ unsigned xb_add(unsigned* p, unsigned v) { return __hip_atomic_fetch_add(p, v, __ATOMIC_RELAXED, __HIP_MEMORY_SCOPE_AGENT); }
__device__ __forceinline__ unsigned xb_xcc_id() { return (unsigned)__builtin_amdgcn_s_getreg((3 << 11) | 20) & 0xFu; }
#define XB_SPIN(cond, bar) do { unsigned _sp = 0; while (cond) { __builtin_amdgcn_s_sleep(1); \
    if ((++_sp & 255u) == 0u) { if (xb_ld(&(bar)[XB_TMO])) break; if (_sp > XB_SPIN_CAP) { atomicAdd(&(bar)[XB_TMO], 1u); break; } } } } while (0)
struct XcdBarrier { unsigned* bar; unsigned x; volatile LAS unsigned* st; };
__device__ __forceinline__ XcdBarrier xcd_barrier_post(unsigned* bar, volatile LAS unsigned* st) {
    XcdBarrier b; b.bar = bar; b.x = xb_xcc_id(); b.st = st;
    if (threadIdx.x == 0) (void)xb_add(&bar[XB_XCNT(b.x)], 1u);
    return b;
}
__device__ __forceinline__ void xcd_barrier_complete(unsigned* bar, unsigned x, unsigned& nloc, unsigned& nx) {
    const unsigned G = gridDim.x * gridDim.y * gridDim.z;
    unsigned sum, cnt, mine, sp = 0u;
    for (;;) {
        sum = 0u; cnt = 0u; mine = 0u;
#pragma unroll
        for (unsigned j = 0; j < 16; ++j) { const unsigned c = xb_ld(&bar[XB_XCNT(j)]); sum += c; cnt += (c > 0u) ? 1u : 0u; mine = (j == x) ? c : mine; }
        if (sum == G) break;
        __builtin_amdgcn_s_sleep(1);
        if ((++sp & 255u) == 0u) { if (xb_ld(&bar[XB_TMO])) break; if (sp > XB_SPIN_CAP) { atomicAdd(&bar[XB_TMO], 1u); break; } }
    }
    nloc = mine > 0u ? mine : 1u; nx = cnt > 0u ? cnt : 1u;
}
__device__ __forceinline__ void xcd_barrier(const XcdBarrier& b) {
    asm volatile("s_waitcnt vmcnt(0)" ::: "memory");
    __syncthreads();
    if (threadIdx.x == 0) {
        unsigned* bar = b.bar;
        __builtin_amdgcn_s_waitcnt(0);
        unsigned nloc = b.st[0], nx = b.st[1];
        if (nloc == 0u) { xcd_barrier_complete(bar, b.x, nloc, nx); b.st[0] = nloc; b.st[1] = nx; }
        const unsigned old = xb_add(&bar[XB_XSUB(b.x)], 1u);
        const unsigned gen = old / nloc;
        if (old + 1u == (gen + 1u) * nloc) {
            __builtin_amdgcn_fence(__ATOMIC_RELEASE, "agent");
            asm volatile("s_waitcnt vmcnt(0)" ::: "memory");
            const unsigned og = xb_add(&bar[XB_TOP], 1u);
            const unsigned tg = og / nx;
            if (og + 1u == (tg + 1u) * nx) xb_add(&bar[XB_TOPGEN], 1u);
            else XB_SPIN(xb_ld(&bar[XB_TOPGEN]) == tg, bar);
            __builtin_amdgcn_fence(__ATOMIC_ACQUIRE, "agent");
            xb_add(&bar[XB_XGEN(b.x)], 1u);
            asm volatile("s_waitcnt vmcnt(0)" ::: "memory");
        } else {
            XB_SPIN(xb_ld(&bar[XB_XGEN(b.x)]) == gen, bar);
            __builtin_amdgcn_fence(__ATOMIC_ACQUIRE, "agent");
            asm volatile("s_waitcnt vmcnt(0)" ::: "memory");
        }
    }
    __syncthreads();
}

using pg8::sh_idx; using pg8::sh_xor; using pg8::half_sum_hi; using pg8::oct_sum;
__device__ __forceinline__ float wave_sum(float v, int lane) {
#pragma unroll
    for (int o = 1; o < 64; o <<= 1) v += sh_xor(v, o, lane);
    return v;
}
__device__ __forceinline__ void transpose_item(const float* W, int ldw, int k0, int n0, const float* gain, bf16* WT, int Kd, int d0, bf16* WT2, int d1, LAS float* scr, int lane) {
    float v_[32], g_[32];
#pragma unroll
    for (int i = 0; i < 32; ++i) { const int kk = 2 * i + (lane >> 5); v_[i] = W[(size_t)(k0 + kk) * ldw + n0 + (lane & 31)]; g_[i] = gain ? gain[k0 + kk] : 1.0f; }
#pragma unroll
    for (int i = 0; i < 32; ++i) { const int kk = 2 * i + (lane >> 5); scr[kk * 33 + (lane & 31)] = v_[i] * g_[i]; }
    LDS_WAIT(); asm volatile("" ::: "memory");
    const int c = lane & 7;
#pragma unroll
    for (int j = 0; j < 4; ++j) { const int n = (lane >> 3) + 8 * j; const LAS float* s = scr + (8 * c) * 33 + n;
        v4u o; o.x = pk2(s[0 * 33], s[1 * 33]); o.y = pk2(s[2 * 33], s[3 * 33]); o.z = pk2(s[4 * 33], s[5 * 33]); o.w = pk2(s[6 * 33], s[7 * 33]);
        *(GAS v4u*)(WT + (size_t)(d0 + n) * Kd + k0 + 8 * c) = o;
        if (WT2) *(GAS v4u*)(WT2 + (size_t)(d1 + n) * Kd + k0 + 8 * c) = o; }
    LDS_WAIT(); asm volatile("" ::: "memory");
}


typedef float f32x16 __attribute__((ext_vector_type(16)));
__device__ __forceinline__ float bf2f(unsigned short v) { return __builtin_bit_cast(float, (unsigned)v << 16); }
__device__ __forceinline__ float log_sigmoidf(float f) { return fminf(f, 0.f) - log1pf(expf(-fabsf(f))); }

__device__ __forceinline__ void mlstm_gates_item(LAS unsigned char* L, int c, const bf16* hbr, const float* wg, const float* ssn, const float* bg,
                                                 float* BCUM, float* IG, float* WGT, float* DECAY, bf16* WROW) {
    int tid_ = threadIdx.x; asm volatile("" : "+v"(tid_)); const int tid = tid_, lane = tid & 63, wave = __builtin_amdgcn_readfirstlane(tid >> 6); (void)tid; (void)lane; (void)wave;
    LAS float* Gs = (LAS float*)L;
    float w[16][8];
#pragma unroll
    for (int j = 0; j < 2; ++j)
#pragma unroll
        for (int i = 0; i < 8; ++i) { const int k = 8 * lane + 512 * j + i; const f32x4 a = *(const f32x4*)(wg + k * 8), b = *(const f32x4*)(wg + k * 8 + 4);
            w[8 * j + i][0] = a[0]; w[8 * j + i][1] = a[1]; w[8 * j + i][2] = a[2]; w[8 * j + i][3] = a[3]; w[8 * j + i][4] = b[0]; w[8 * j + i][5] = b[1]; w[8 * j + i][6] = b[2]; w[8 * j + i][7] = b[3]; }
    for (int tt = 0; tt < 8; ++tt) {
        const int tl = wave * 8 + tt, t = 64 * c + tl;
        const GAS v4u* xr = (const GAS v4u*)(hbr + (size_t)t * D) + lane;
        float a8[8] = {0.f, 0.f, 0.f, 0.f, 0.f, 0.f, 0.f, 0.f};
#pragma unroll
        for (int j = 0; j < 2; ++j) { const v4u xv = xr[64 * j];
#pragma unroll
            for (int i = 0; i < 8; ++i) { const float xf = (i & 1) ? __builtin_bit_cast(float, xv[i >> 1] & 0xffff0000u) : __builtin_bit_cast(float, xv[i >> 1] << 16);
#pragma unroll
                for (int q = 0; q < 8; ++q) a8[q] += xf * w[8 * j + i][q]; } }
        const float rs = pg8::rstd4(ssn, t);
#pragma unroll
        for (int q = 0; q < 8; ++q) { const float v = wave_sum(a8[q], lane); if (lane == 0) Gs[tl * 8 + q] = v * rs; }
    }
    LDS_WAIT(); __syncthreads();
    if (wave < 4) {
        const int h = wave, t = 64 * c + lane;
        const float gi = Gs[lane * 8 + h] + bg[h], gf = Gs[lane * 8 + 4 + h] + bg[4 + h];
        float b = log_sigmoidf(gf);
#pragma unroll
        for (int o = 1; o < 64; o <<= 1) { const float v = sh_idx(b, lane - o); if (lane >= o) b += v; }
        const float bl = sh_idx(b, 63);
        BCUM[(size_t)h * T + t] = b; IG[(size_t)h * T + t] = gi; { const float wv_ = expf(bl - b + gi); WGT[(size_t)h * T + t] = wv_; WROW[(size_t)(c * 4 + h) * 64 + lane] = (bf16)f2bf(wv_); }
        if (lane == 63) DECAY[c * 4 + h] = expf(bl);
    }
    LDS_WAIT(); __syncthreads();
}

__device__ __forceinline__ bf16x8 scale_bf16x8(bf16x8 v, bf16x8 wv) {
    typedef unsigned u4 __attribute__((ext_vector_type(4)));
    const u4 u = __builtin_bit_cast(u4, v), w = __builtin_bit_cast(u4, wv); u4 o;
#pragma unroll
    for (int i = 0; i < 4; ++i)
        o[i] = pg8::cvt_pk_bf16(__builtin_bit_cast(float, u[i] << 16) * __builtin_bit_cast(float, w[i] << 16), __builtin_bit_cast(float, u[i] & 0xffff0000u) * __builtin_bit_cast(float, w[i] & 0xffff0000u));
    return __builtin_bit_cast(bf16x8, o);
}
__device__ __forceinline__ void mlstm_scan(const bf16* KVT, const float* DECAY, bf16* CT, bf16* NCT, const bf16* WROW, const bf16* ZROW, int G, bool probe_same = false) {
    int tid_ = threadIdx.x; asm volatile("" : "+v"(tid_)); const int tid = tid_, lane = tid & 63, wave = __builtin_amdgcn_readfirstlane(tid >> 6); (void)tid;
    bool active, ntask; int h, e0, d0;
    if (G == 256) { const int x = (int)blockIdx.x & 7, cu = (int)blockIdx.x >> 3; h = x >> 1;
        if (wave < 2) { const int k = wave * 32 + cu; active = true; ntask = false; e0 = (x & 1) * 128 + (k >> 3) * 16; d0 = (k & 7) * 16; }
        else { active = (wave == 2) && ((x & 1) == 0) && (cu < 8); ntask = true; e0 = 0; d0 = (cu & 7) * 16; }
    } else { const int gw = wave * G + (int)blockIdx.x; active = gw < 544; ntask = gw >= 512;
        if (!ntask) { h = gw >> 7; e0 = ((gw >> 3) & 15) * 16; d0 = (gw & 7) * 16; } else { const int q = gw - 512; h = (q >> 3) & 3; e0 = 0; d0 = (q & 7) * 16; } }
    if (probe_same) { h = 0; e0 = 0; d0 = 0; }
    if (active) {
        const int fr = lane & 15, fq = lane >> 4;
        const bf16* arow = KVT + (size_t)((h * 8 + (d0 >> 4)) * 2) * 512 + lane * 8;
        const bf16* brow = ntask ? ((fr == 0 ? WROW + h * 64 : ZROW) + 8 * fq) : (KVT + (size_t)((32 + h * 16 + (e0 >> 4)) * 2) * 512 + lane * 8);
        bf16* crow = ntask ? (NCT + ((size_t)h * 16 + fr) * 128 + d0 + 4 * fq) : (CT + ((size_t)(h * 8 + (e0 >> 5)) * 8 + (d0 >> 4)) * 512 + ((fq >> 1) * 32 + (e0 & 16) + fr) * 8 + 4 * (fq & 1));
        const size_t cstep = probe_same ? (size_t)0 : (ntask ? (size_t)4 * 16 * 128 : (size_t)4 * 256 * 128);
        const float* drow = DECAY + h;
        const size_t bstep = ntask ? (fr == 0 ? (size_t)256 : (size_t)0) : (size_t)1536 * 64;
        constexpr int P = 8;
        bf16x8 sa[P][2], sb[P][2]; float sd[P];
        const char* pa = (const char*)arow; const char* pb = (const char*)brow; const size_t b2off = ntask ? 64 : 1024;     const char* pd = (const char*)(DECAY + h); char* pc = (char*)crow;
        const size_t astep = (size_t)1536 * 64 * 2, bstepb = bstep * 2, cstepb = cstep * 2;
#define SC_LD16(dst, ptr, OFF) asm volatile("global_load_dwordx4 %0, %1, off offset:" #OFF : "=&v"(dst) : "v"(ptr) : "memory")
#define SC_LD4(dst, ptr) asm volatile("global_load_dword %0, %1, off" : "=&v"(dst) : "v"(ptr) : "memory")
#define SC_LOADS(j) do { SC_LD16(sa[j][0], pa, 0); SC_LD16(sa[j][1], pa, 1024); { const char* pb2_ = pb + b2off; SC_LD16(sb[j][0], pb, 0); SC_LD16(sb[j][1], pb2_, 0); } SC_LD4(sd[j], pd); pa += astep; pb += bstepb; pd += 16; } while (0)
#pragma unroll
        for (int j = 0; j < P; ++j) { float dm_; SC_LD4(dm_, pd); SC_LOADS(j); }
        f32x4 acc = (f32x4){0.f, 0.f, 0.f, 0.f};
        for (int c0 = 0; c0 < 256; c0 += P) {
#pragma unroll
            for (int j = 0; j < P; ++j) {
                asm volatile("s_waitcnt vmcnt(42)" : "+v"(sa[j][0]), "+v"(sa[j][1]), "+v"(sb[j][0]), "+v"(sb[j][1]), "+v"(sd[j]) :: "memory");
                { typedef unsigned u2 __attribute__((ext_vector_type(2))); u2 o; o.x = pg8::cvt_pk_bf16(acc[0], acc[1]); o.y = pg8::cvt_pk_bf16(acc[2], acc[3]);
                  if (!probe_same) asm volatile("global_store_dwordx2 %0, %1, off" :: "v"(pc), "v"(o) : "memory"); else { float dm2_; asm volatile("global_load_dword %0, %1, off" : "=&v"(dm2_) : "v"(pd), "v"(o) : "memory"); }
                  pc += cstepb; }
                acc = acc * sd[j];
                acc = __builtin_amdgcn_mfma_f32_16x16x32_bf16(sa[j][0], sb[j][0], acc, 0, 0, 0);
                acc = __builtin_amdgcn_mfma_f32_16x16x32_bf16(sa[j][1], sb[j][1], acc, 0, 0, 0);
                asm volatile("" : "+v"(acc));
                SC_LOADS(j);
            }
        }
        asm volatile("s_waitcnt vmcnt(0)" ::: "memory");
#undef SC_LD16
#undef SC_LD4
#undef SC_LOADS
    }
}

constexpr int M3_BUF = 36864;
constexpr int M3_QS = 0, M3_KS = 17408, M3_BC = 35840, M3_IG = 36096, M3_NV = 36352;
constexpr int M3_SS = 73728, M3_DQ = 82944, M3_DSP = 83200, M3_OS = 83968  ;
__device__ __forceinline__ void mlstm_out_phase(LAS unsigned char* L, int G, const bf16* Q, const bf16* K, const bf16* KVT, const bf16* CT, const bf16* NCT,
                                                const float* BCUM, const float* WGT, const bf16* OG, const float* hn, bf16* HG) {
    int tid_ = threadIdx.x; asm volatile("" : "+v"(tid_)); const int tid = tid_, lane = tid & 63, wave = __builtin_amdgcn_readfirstlane(tid >> 6);
    const int r = lane & 31, hh = lane >> 5;
    LAS float* dq = (LAS float*)(L + M3_DQ); LAS float* dsp = (LAS float*)(L + M3_DSP); LAS float* OS = (LAS float*)(L + M3_OS);
    int it = (int)blockIdx.x; if (it >= 1024) return;
    bf16x8 ctf[8], vtf[4]; v4u ogf[4]; v4u qk[4]; float sm = 0.f;
#define M3_LD_CT(c_, h_) do { const bf16* ctp = CT + (((size_t)((c_) * 4 + (h_)) * 8 + wave) * 8) * 512 + lane * 8; _Pragma("unroll") for (int kk = 0; kk < 8; ++kk) ctf[kk] = *(const bf16x8*)(ctp + 512 * kk); } while (0)
#define M3_LD_VT(c_, h_) do { const bf16* vtp = KVT + (((size_t)(c_) * 96 + 32 + (h_) * 16 + 2 * wave + (r >> 4)) * 2) * 512 + (hh * 16 + (r & 15)) * 8; _Pragma("unroll") for (int kk = 0; kk < 4; ++kk) vtf[kk] = *(const bf16x8*)(vtp + (kk >> 1) * 512 + (kk & 1) * 256); } while (0)
#define M3_LD_OG(c_, h_) do { const bf16* ogp = OG + (size_t)(64 * (c_) + (tid >> 3)) * 1024 + (h_) * 256 + 8 * (tid & 7); _Pragma("unroll") for (int k = 0; k < 4; ++k) ogf[k] = *(const GAS v4u*)(ogp + 64 * k); } while (0)
#define M3_LD_QK(c_, h_) do { _Pragma("unroll") for (int j = 0; j < 4; ++j) { const int i = tid + 512 * j, which = i >> 10, idx = i & 1023, row = idx >> 4, ch = idx & 15; \
            qk[j] = which ? *(const GAS v4u*)(KVT + (((size_t)(c_) * 96 + (h_) * 8) * 2) * 512 + idx * 8) : *(const GAS v4u*)(Q + (size_t)(64 * (c_) + row) * 512 + (h_) * 128 + ch * 8); } \
        if (tid < 64) sm = BCUM[(size_t)(h_) * T + 64 * (c_) + tid]; else if (tid < 128) sm = WGT[(size_t)(h_) * T + 64 * (c_) + tid - 64]; else if (tid < 256) sm = bf2f(NCT[(size_t)((c_) * 4 + (h_)) * 16 * 128 + tid - 128]); } while (0)
#define M3_ST_QK(B_) do { _Pragma("unroll") for (int j = 0; j < 4; ++j) { const int i = tid + 512 * j, which = i >> 10, idx = i & 1023, row = idx >> 4, ch = idx & 15; if (which) { const int bi_ = idx >> 6, lp_ = idx & 63; *(LAS v4u*)((B_) + M3_KS + (16 * (bi_ >> 1) + (lp_ & 15)) * 144 + (32 * (bi_ & 1) + 8 * (lp_ >> 4)) * 2) = qk[j]; } \
            else *(LAS v4u*)((B_) + row * 272 + ch * 16) = qk[j]; } \
        if (tid < 256) ((LAS float*)((B_) + M3_BC))[tid] = sm; } while (0)
    { const int c = it >> 2, h = it & 3; M3_LD_CT(c, h); M3_LD_VT(c, h); M3_LD_OG(c, h); M3_LD_QK(c, h); M3_ST_QK(L); }
    LDS_WAIT(); __syncthreads();
    int pb = 0;
    for (;;) {
        const int c = it >> 2, h = it & 3, t0 = 64 * c, itn = it + G; const bool has_next = itn < 1024; const int cn = itn >> 2, hn_ = itn & 3;
        LAS unsigned char* B = L + pb * M3_BUF; LAS unsigned char* Bn = L + (pb ^ 1) * M3_BUF;
        LAS float* bc = (LAS float*)(B + M3_BC); LAS float* ig = (LAS float*)(B + M3_IG); LAS float* nv = (LAS float*)(B + M3_NV);
        if (has_next) M3_LD_QK(cn, hn_);
        f32x16 O[2];
#pragma unroll
        for (int i = 0; i < 16; ++i) { O[0][i] = 0.f; O[1][i] = 0.f; }
#pragma unroll
        for (int kk = 0; kk < 8; ++kk) {
            const bf16x8 a0 = *(const LAS bf16x8*)(B + M3_QS + r * 272 + (16 * kk + 8 * hh) * 2), a1 = *(const LAS bf16x8*)(B + M3_QS + (32 + r) * 272 + (16 * kk + 8 * hh) * 2);
            O[0] = __builtin_amdgcn_mfma_f32_32x32x16_bf16(a0, ctf[kk], O[0], 0, 0, 0); O[1] = __builtin_amdgcn_mfma_f32_32x32x16_bf16(a1, ctf[kk], O[1], 0, 0, 0);
        }
        if (has_next) M3_LD_CT(cn, hn_);
        if (wave < 4) {
            const int tt = wave >> 1, s2 = wave & 1; f32x16 S;
#pragma unroll
            for (int i = 0; i < 16; ++i) S[i] = 0.f;
#pragma unroll
            for (int kk = 0; kk < 8; ++kk) {
                const bf16x8 a = *(const LAS bf16x8*)(B + M3_QS + (32 * tt + r) * 272 + (16 * kk + 8 * hh) * 2);
                typedef short v4i16_t __attribute__((ext_vector_type(4)));
                const int i16 = lane & 15, q4 = i16 >> 2, p4 = i16 & 3, blk = (lane >> 4) & 1;
                LAS unsigned char* tb = B + M3_KS + (16 * kk + 8 * hh + q4) * 144 + (32 * s2 + 16 * blk + 4 * p4) * 2;
                const v4i16_t lo = __builtin_amdgcn_ds_read_tr16_b64_v4i16((LAS v4i16_t*)tb), hi = __builtin_amdgcn_ds_read_tr16_b64_v4i16((LAS v4i16_t*)(tb + 4 * 144));
                const bf16x8 b = __builtin_shufflevector(lo, hi, 0, 1, 2, 3, 4, 5, 6, 7);
                S = __builtin_amdgcn_mfma_f32_32x32x16_bf16(a, b, S, 0, 0, 0);
            }
            const int s = 32 * s2 + r; const float ws = ig[s], bl = bc[63];
#pragma unroll
            for (int i = 0; i < 16; ++i) {
                const int t = 32 * tt + (i & 3) + 8 * (i >> 2) + 4 * hh;
                const float v = (s <= t) ? S[i] * __expf(bc[t] - bl) : 0.f;
                const float rsum = half_sum_hi(v * ws);
                if (r == 16) dsp[s2 * 64 + t] = rsum;
                *(LAS unsigned short*)(L + M3_SS + t * 144 + s * 2) = (unsigned short)f2bf(v);
            }
        } else {
            const int th = tid - 256, t = th >> 2, part = th & 3; float sum = 0.f;
#pragma unroll 8
            for (int d = 0; d < 32; ++d) sum += bf2f(*(const LAS unsigned short*)(B + M3_QS + t * 272 + (32 * part + d) * 2)) * nv[32 * part + d];
            sum = pg8::dpp_add<0xB1>(sum); sum = pg8::dpp_add<0x4E>(sum);
            if (part == 0) dq[t] = sum;
        }
        LDS_WAIT(); __syncthreads();
#pragma unroll
        for (int tt = 0; tt < 2; ++tt)
#pragma unroll
            for (int i = 0; i < 16; ++i) O[tt][i] *= __expf(bc[32 * tt + (i & 3) + 8 * (i >> 2) + 4 * hh]);
#pragma unroll
        for (int kk = 0; kk < 4; ++kk) {
            const bf16x8 a0 = *(const LAS bf16x8*)(L + M3_SS + r * 144 + (16 * kk + 8 * hh) * 2), a1 = *(const LAS bf16x8*)(L + M3_SS + (32 + r) * 144 + (16 * kk + 8 * hh) * 2);
            O[0] = __builtin_amdgcn_mfma_f32_32x32x16_bf16(a0, vtf[kk], O[0], 0, 0, 0); O[1] = __builtin_amdgcn_mfma_f32_32x32x16_bf16(a1, vtf[kk], O[1], 0, 0, 0);
        }
        if (has_next) M3_LD_VT(cn, hn_);
#pragma unroll
        for (int tt = 0; tt < 2; ++tt)
#pragma unroll
            for (int i = 0; i < 16; ++i) OS[(32 * tt + (i & 3) + 8 * (i >> 2) + 4 * hh) * 260 + 32 * wave + r] = O[tt][i];
        LDS_WAIT(); __syncthreads();
        {
            const int t = tid >> 3, part = tid & 7;
            const float den = __expf(bc[t]) * dq[t] + dsp[t] + dsp[64 + t];
            const float inv = __builtin_amdgcn_rcpf(fmaxf(fabsf(den), 1.0f));
            f32x4 v[8]; float ssq = 0.f;
#pragma unroll
            for (int k = 0; k < 8; ++k) { v[k] = *(const LAS f32x4*)(OS + t * 260 + 64 * (k >> 1) + 8 * part + 4 * (k & 1)) * inv; ssq += (v[k][0] * v[k][0] + v[k][1] * v[k][1]) + (v[k][2] * v[k][2] + v[k][3] * v[k][3]); }
            ssq = oct_sum(ssq);
            const float rsn = rsqrtf(ssq * (1.0f / 256.0f) + 1e-6f);
            const float* gp = hn + h * 256 + 8 * part;
            bf16* op = HG + (size_t)(t0 + t) * 1024 + h * 256 + 8 * part;
#pragma unroll
            for (int k = 0; k < 4; ++k) {
                const f32x4 g0 = *(const f32x4*)(gp + 64 * k), g1 = *(const f32x4*)(gp + 64 * k + 4);
                float o8[8];
#pragma unroll
                for (int x2 = 0; x2 < 4; ++x2) {
                    const float og0 = __builtin_bit_cast(float, ogf[k][x2] << 16), og1 = __builtin_bit_cast(float, ogf[k][x2] & 0xffff0000u);
                    const float a0 = (2 * x2 < 4) ? v[2 * k][2 * x2] : v[2 * k + 1][2 * x2 - 4], a1 = (2 * x2 + 1 < 4) ? v[2 * k][2 * x2 + 1] : v[2 * k + 1][2 * x2 + 1 - 4];
                    const float gg0 = (2 * x2 < 4) ? g0[2 * x2] : g1[2 * x2 - 4], gg1 = (2 * x2 + 1 < 4) ? g0[2 * x2 + 1] : g1[2 * x2 + 1 - 4];
                    o8[2 * x2] = a0 * rsn * gg0 * __builtin_amdgcn_rcpf(1.0f + __builtin_amdgcn_exp2f(-1.4426950408889634f * og0)); o8[2 * x2 + 1] = a1 * rsn * gg1 * __builtin_amdgcn_rcpf(1.0f + __builtin_amdgcn_exp2f(-1.4426950408889634f * og1)); }
                v4u w; w.x = pg8::cvt_pk_bf16(o8[0], o8[1]); w.y = pg8::cvt_pk_bf16(o8[2], o8[3]); w.z = pg8::cvt_pk_bf16(o8[4], o8[5]); w.w = pg8::cvt_pk_bf16(o8[6], o8[7]);
                *(GAS v4u*)(op + 64 * k) = w; }
        }
        if (has_next) { M3_LD_OG(cn, hn_); M3_ST_QK(Bn); }
        LDS_WAIT(); __syncthreads();
        if (!has_next) break;
        it = itn; pb ^= 1;
    }
#undef M3_LD_CT
#undef M3_LD_VT
#undef M3_LD_OG
#undef M3_LD_QK
#undef M3_ST_QK
}

constexpr int AT_QS = 0, AT_PS = 34816, AT_PM = 102400, AT_PSUM = 106496, AT_ENT = 110592, AT_W = 111104, AT_MX = 113152, AT_PRE = 113664  , AT_WT = 115744;
constexpr int GT_KH = 34816, GT_KL = 52224, GT_SC = 69632, GT_LCNT = 102912, GT_BASE = 103168;
__device__ __forceinline__ int list_off(int h, int b) { return h * TRI + b * T - 128 * b * (b + 1); }
__device__ __forceinline__ void moba_gate_phase(LAS unsigned char* L, int G, const bf16* AQ, const float* KMEAN, int* gcnt, int* LIST) {
    int tid_ = threadIdx.x; asm volatile("" : "+v"(tid_)); const int tid = tid_, lane = tid & 63, wave = __builtin_amdgcn_readfirstlane(tid >> 6);
    const int r = lane & 31, hh = lane >> 5;
    LAS int* LCNT = (LAS int*)(L + GT_LCNT); LAS int* BASE = (LAS int*)(L + GT_BASE); LAS float* SC = (LAS float*)(L + GT_SC);
    int h_loaded = -1;
    int it = (int)blockIdx.x;
    while (it < 1024 && (it >> 4) == 0) it += G;
    if (it >= 1024) return;
    v4u qn[4];
#pragma unroll
    for (int j = 0; j < 4; ++j) { const int i = tid + 512 * j, rl = i >> 4, ch = i & 15; qn[j] = *(const GAS v4u*)(AQ + (size_t)(128 * (it >> 3) + rl) * 1024 + (it & 7) * 128 + ch * 8); }
    for (;;) {
        const int qi = it >> 3, h = it & 7, cur = qi >> 1;
        int itn = it + G; const bool has_next = itn < 1024;
        if (h != h_loaded) {
            for (int i = tid; i < 64 * 128; i += 512) { const int bb = i >> 7, d = i & 127; const float v = KMEAN[((size_t)h * 64 + bb) * 128 + d];
                const unsigned hi = f2bf(v), lo = f2bf(v - bf2f((unsigned short)hi));
                *(LAS unsigned short*)(L + GT_KH + bb * 272 + d * 2) = (unsigned short)hi; *(LAS unsigned short*)(L + GT_KL + bb * 272 + d * 2) = (unsigned short)lo; }
            h_loaded = h; }
#pragma unroll
        for (int j = 0; j < 4; ++j) { const int i = tid + 512 * j, rl = i >> 4, ch = i & 15; *(LAS v4u*)(L + AT_QS + rl * 272 + ch * 16) = qn[j]; }
        if (tid < 64) LCNT[tid] = 0;
        LDS_WAIT(); __syncthreads();
        if (has_next) {
#pragma unroll
            for (int j = 0; j < 4; ++j) { const int i = tid + 512 * j, rl = i >> 4, ch = i & 15; qn[j] = *(const GAS v4u*)(AQ + (size_t)(128 * (itn >> 3) + rl) * 1024 + (itn & 7) * 128 + ch * 8); }
        }
        {   const int tt = wave >> 1, bt = wave & 1; f32x16 S;
#pragma unroll
            for (int i = 0; i < 16; ++i) S[i] = 0.f;
#pragma unroll
            for (int kk = 0; kk < 8; ++kk) {
                const bf16x8 a = *(const LAS bf16x8*)(L + AT_QS + (32 * tt + r) * 272 + (16 * kk + 8 * hh) * 2);
                const bf16x8 bh = *(const LAS bf16x8*)(L + GT_KH + (32 * bt + r) * 272 + (16 * kk + 8 * hh) * 2), bl = *(const LAS bf16x8*)(L + GT_KL + (32 * bt + r) * 272 + (16 * kk + 8 * hh) * 2);
                S = __builtin_amdgcn_mfma_f32_32x32x16_bf16(a, bh, S, 0, 0, 0); S = __builtin_amdgcn_mfma_f32_32x32x16_bf16(a, bl, S, 0, 0, 0);
            }
#pragma unroll
            for (int i = 0; i < 16; ++i) SC[(32 * tt + (i & 3) + 8 * (i >> 2) + 4 * hh) * 65 + 32 * bt + r] = S[i];
        }
        LDS_WAIT(); __syncthreads();
        int p0 = -1, p1 = -1, p2 = -1, l0 = 0, l1 = 0, l2 = 0; const int nsel = cur < 3 ? cur : 3;
        if (tid < 128) {
            float v0 = -INFINITY, v1 = -INFINITY, v2 = -INFINITY;
            for (int b = 0; b < cur; ++b) { const float sc = SC[tid * 65 + b];
                if (sc > v0) { v2 = v1; p2 = p1; v1 = v0; p1 = p0; v0 = sc; p0 = b; }
                else if (sc > v1) { v2 = v1; p2 = p1; v1 = sc; p1 = b; }
                else if (sc > v2) { v2 = sc; p2 = b; } }
            if (nsel > 0 && p0 >= 0) l0 = __hip_atomic_fetch_add(LCNT + p0, 1, __ATOMIC_RELAXED, __HIP_MEMORY_SCOPE_WORKGROUP);
            if (nsel > 1 && p1 >= 0) l1 = __hip_atomic_fetch_add(LCNT + p1, 1, __ATOMIC_RELAXED, __HIP_MEMORY_SCOPE_WORKGROUP);
            if (nsel > 2 && p2 >= 0) l2 = __hip_atomic_fetch_add(LCNT + p2, 1, __ATOMIC_RELAXED, __HIP_MEMORY_SCOPE_WORKGROUP);
        }
        LDS_WAIT(); __syncthreads();
        if (tid < cur) { const int n = LCNT[tid]; if (n > 0) BASE[tid] = __hip_atomic_fetch_add(gcnt + h * 64 + tid, n, __ATOMIC_RELAXED, __HIP_MEMORY_SCOPE_AGENT); }
        LDS_WAIT(); __syncthreads();
        if (tid < 128) { const int tg = (128 * qi + tid) << 2;
            if (nsel > 0 && p0 >= 0) LIST[list_off(h, p0) + BASE[p0] + l0] = tg | 0;
            if (nsel > 1 && p1 >= 0) LIST[list_off(h, p1) + BASE[p1] + l1] = tg | 1;
            if (nsel > 2 && p2 >= 0) LIST[list_off(h, p2) + BASE[p2] + l2] = tg | 2; }
        LDS_WAIT(); __syncthreads();
        if (!has_next) break;
        it = itn;
    }
}

constexpr int AP_QS0 = 0, AP_QS1 = 34816, AP_PS = 69632, AP_PM = 137216, AP_PSUM = 141312, AP_ENT0 = 145408, AP_ENT1 = 145920, AP_W = 146432, AP_MX = 148480, AP_PRE = 148992  , AP_WT = 151072;
struct AItem { int h, b, row0, nrows, qi; const int* list; bool valid; };
template <bool OWN>
__device__ __forceinline__ AItem attn_get(int k, int G, const LAS int* PRE, int total, const int* gcnt, const int* LIST) {
    AItem it; const int idx = (int)blockIdx.x + k * G;
    if (OWN) { it.valid = idx < 1024; it.qi = idx >> 3; it.h = idx & 7; it.b = it.qi >> 1; it.row0 = 128 * it.qi; it.nrows = 128; it.list = nullptr; }
    else {
        it.valid = idx < total; it.qi = 0; int lo = 0, hi = 512;
        if (it.valid) { while (hi - lo > 1) { const int mid = (lo + hi) >> 1; if (PRE[mid] <= idx) lo = mid; else hi = mid; } }
        const int hb = lo; it.h = hb >> 6; it.b = hb & 63; const int i = it.valid ? idx - PRE[hb] : 0, n = it.valid ? gcnt[hb] : 0;
        it.row0 = 128 * i; it.nrows = (n - 128 * i) < 128 ? (n - 128 * i) : 128; it.list = LIST + list_off(it.h, it.b);
    }
    return it;
}
template <bool OWN>
__device__ __forceinline__ void attn_phase(LAS unsigned char* L, int G, const int* gcnt, const int* LIST, const bf16* AQ, const bf16* XK, const bf16* XVT, bf16* PO, float* ML, bf16* AOUT, int tmask, int probe = 0) {
    int tid_ = threadIdx.x; asm volatile("" : "+v"(tid_)); const int tid = tid_, lane = tid & 63, wave = __builtin_amdgcn_readfirstlane(tid >> 6);
    const int r = lane & 31, hh = lane >> 5;
    LAS int* PRE = (LAS int*)(L + AP_PRE); LAS int* WT = (LAS int*)(L + AP_WT);
    LAS float* PM = (LAS float*)(L + AP_PM); LAS float* PSUM = (LAS float*)(L + AP_PSUM); LAS float* MX = (LAS float*)(L + AP_MX); LAS float* W = (LAS float*)(L + AP_W);
    int total = 0;
    if (!OWN) {
        int v = (gcnt[tid] + 127) >> 7;
#pragma unroll
        for (int o = 1; o < 64; o <<= 1) { const int u = __builtin_amdgcn_ds_bpermute((lane - o) << 2, v); if (lane >= o) v += u; }
        if (lane == 63) WT[wave] = v;
        LDS_WAIT(); __syncthreads();
        int add = 0;
#pragma unroll
        for (int w8 = 0; w8 < 8; ++w8) if (w8 < wave) add += WT[w8];
        PRE[tid + 1] = v + add; if (tid == 0) PRE[0] = 0;
        LDS_WAIT(); __syncthreads();
        total = PRE[512];
    }
    AItem cur = attn_get<OWN>(0, G, PRE, total, gcnt, LIST);
    if (!cur.valid) return;
    int pb = 0;
    {   LAS int* ENT = (LAS int*)(L + AP_ENT0);
        if (!OWN) { if (tid < 128) ENT[tid] = (tid < cur.nrows) ? cur.list[cur.row0 + tid] : -1; LDS_WAIT(); __syncthreads(); }
        for (int i = tid; i < 2048; i += 512) { const int rl = i >> 4, ch = i & 15; int t;
            if (OWN) t = cur.row0 + rl; else { const int e = ENT[rl]; t = e >= 0 ? (e >> 2) : 0; }
            const v4u v = *(const GAS v4u*)(AQ + (size_t)t * 1024 + cur.h * 128 + ch * 8); *(LAS v4u*)(L + AP_QS0 + rl * 272 + ch * 16) = v; }
        LDS_WAIT(); __syncthreads();
    }
    for (int k = 0; ; ++k) {
        const AItem nxt = attn_get<OWN>(k + 1, G, PRE, total, gcnt, LIST);
        const int h = (probe & 2) ? 0 : cur.h, b = (probe & 2) ? 0 : cur.b, qi = cur.qi, row0 = cur.row0;
        LAS unsigned char* Qc = L + (pb ? AP_QS1 : AP_QS0); LAS unsigned char* Qn = L + (pb ? AP_QS0 : AP_QS1);
        LAS int* ENT = (LAS int*)(L + (pb ? AP_ENT1 : AP_ENT0)); LAS int* ENTn = (LAS int*)(L + (pb ? AP_ENT0 : AP_ENT1));
        const int dt = wave & 3, tp = wave >> 2;
        bf16x8 kf[8], vf[16];
        {   const bf16* kp = XK + (((size_t)(b * 8 + h) * 8 + wave) * 8) * 512 + lane * 8;
#pragma unroll
            for (int kk = 0; kk < 8; ++kk) kf[kk] = *(const bf16x8*)(kp + 512 * kk);
            const bf16* vp = XVT + (((size_t)(b * 8 + h) * 4 + dt) * 16) * 512 + lane * 8;
#pragma unroll
            for (int kk = 0; kk < 16; ++kk) vf[kk] = *(const bf16x8*)(vp + 512 * kk);
        }
        int e_n = -1;
        if (!OWN && nxt.valid && tid < 128 && tid < nxt.nrows) e_n = nxt.list[nxt.row0 + tid];
        f32x16 S[4];
#pragma unroll
        for (int tq = 0; tq < 4; ++tq) {
#pragma unroll
            for (int i = 0; i < 16; ++i) S[tq][i] = 0.f;
#pragma unroll
            for (int kk = 0; kk < 8; ++kk) { const bf16x8 bq = *(const LAS bf16x8*)(Qc + (32 * tq + r) * 272 + (16 * kk + 8 * hh) * 2);
                S[tq] = __builtin_amdgcn_mfma_f32_32x32x16_bf16(kf[kk], bq, S[tq], 0, 0, 0); }
        }
#pragma unroll
        for (int tq = 0; tq < 4; ++tq) {
            const int t = 32 * tq + r; float ps = 0.f;
#pragma unroll
            for (int i = 0; i < 16; ++i) {
                float sv = S[tq][i];
                if (OWN) { const int key = 32 * wave + (i & 3) + 8 * (i >> 2) + 4 * hh, lim = (qi & 1) * 128 + t; if (key > lim) sv = -INFINITY; }
                const float p = __builtin_amdgcn_exp2f(sv); S[tq][i] = p; ps += p; }
            ps += sh_xor(ps, 32, lane);
            if (hh == 0) PSUM[wave * 128 + t] = ps;
#pragma unroll
            for (int g = 0; g < 4; ++g) { pg8::u32x2 w2; w2.x = pg8::cvt_pk_bf16(S[tq][4 * g], S[tq][4 * g + 1]); w2.y = pg8::cvt_pk_bf16(S[tq][4 * g + 2], S[tq][4 * g + 3]);
                *(LAS pg8::u32x2*)(L + AP_PS + t * 528 + (32 * wave + 8 * g + 4 * hh) * 2) = w2; }
        }
        if (!OWN && tid < 128) ENTn[tid] = e_n;
        LDS_WAIT(); __syncthreads();
        v4u qn[4];
        if (nxt.valid) {
#pragma unroll
            for (int j = 0; j < 4; ++j) { const int i = tid + 512 * j, rl = i >> 4, ch = i & 15; int t;
                if (OWN) t = nxt.row0 + rl; else { const int e = ENTn[rl]; t = e >= 0 ? (e >> 2) : 0; if (probe & 4) t = rl; }
                qn[j] = *(const GAS v4u*)(AQ + (size_t)t * 1024 + nxt.h * 128 + ch * 8); }
        }
        f32x16 O[2];
#pragma unroll
        for (int i = 0; i < 16; ++i) { O[0][i] = 0.f; O[1][i] = 0.f; }
#pragma unroll
        for (int kk = 0; kk < 16; ++kk) {
            const bf16x8 a0 = *(const LAS bf16x8*)(L + AP_PS + (64 * tp + r) * 528 + (16 * kk + 8 * hh) * 2), a1 = *(const LAS bf16x8*)(L + AP_PS + (64 * tp + 32 + r) * 528 + (16 * kk + 8 * hh) * 2);
            O[0] = __builtin_amdgcn_mfma_f32_32x32x16_bf16(a0, vf[kk], O[0], 0, 0, 0); O[1] = __builtin_amdgcn_mfma_f32_32x32x16_bf16(a1, vf[kk], O[1], 0, 0, 0);
        }
        const int curb = qi >> 1, nsel = curb < 3 ? curb : 3;
        if (OWN) {
            if (tid < 128) { const int t = row0 + tid; float Lo = 0.f;
#pragma unroll
                for (int w8 = 0; w8 < 8; ++w8) Lo += PSUM[w8 * 128 + tid];
                float den = Lo;
#pragma unroll
                for (int j = 0; j < 3; ++j) if (j < nsel) den += ML[((size_t)(t * 8 + h) * 3 + j) * 2 + 1];
                const float inv = 1.0f / den;
                W[tid * 4 + 0] = inv; W[tid * 4 + 1] = nsel > 0 ? inv : 0.f; W[tid * 4 + 2] = nsel > 1 ? inv : 0.f; W[tid * 4 + 3] = nsel > 2 ? inv : 0.f; }
        }
        LDS_WAIT(); __syncthreads();
        {   LAS float* OS = (LAS float*)(L + AP_PS);
#pragma unroll
            for (int q = 0; q < 2; ++q)
#pragma unroll
                for (int i = 0; i < 16; ++i) OS[(64 * tp + 32 * q + (i & 3) + 8 * (i >> 2) + 4 * hh) * 132 + 32 * dt + r] = O[q][i];
        }
        LDS_WAIT(); __syncthreads();
        {   const LAS float* OS = (const LAS float*)(L + AP_PS);
            const int rl = tid >> 2, c4 = tid & 3;
            if (!OWN) {
                const int e = (probe & 1) ? -1 : ENT[rl];
                if (e >= 0) {
                    const int te = e >> 2; bf16* dst = (te < PO_SPLIT ? PO : PO + (WS_PO2 - WS_PO) / 2 - (size_t)PO_SPLIT * 3072) + ((size_t)(te * 8 + h) * 3 + (e & 3)) * 128;
#pragma unroll
                    for (int kq = 0; kq < 4; ++kq) { const int ch = c4 + 4 * kq; const f32x4 a = *(const LAS f32x4*)(OS + rl * 132 + ch * 8), b2 = *(const LAS f32x4*)(OS + rl * 132 + ch * 8 + 4);
                        v4u w; w.x = pg8::cvt_pk_bf16(a[0], a[1]); w.y = pg8::cvt_pk_bf16(a[2], a[3]); w.z = pg8::cvt_pk_bf16(b2[0], b2[1]); w.w = pg8::cvt_pk_bf16(b2[2], b2[3]);
                        *(GAS v4u*)(dst + ch * 8) = w; }
                    if (c4 == 0) { float Ls = 0.f;
#pragma unroll
                        for (int w8 = 0; w8 < 8; ++w8) Ls += PSUM[w8 * 128 + rl];
                        float* ml = ML + ((size_t)((e >> 2) * 8 + h) * 3 + (e & 3)) * 2; ml[0] = 0.f; ml[1] = Ls; }
                }
            } else {
                const int t = row0 + rl; const f32x4 w4 = *(const LAS f32x4*)(W + rl * 4);
                const bf16* po = (t < PO_SPLIT ? PO : PO + (WS_PO2 - WS_PO) / 2 - (size_t)PO_SPLIT * 3072) + ((size_t)(t * 8 + h) * 3) * 128;
                const unsigned m0 = nsel > 0 ? 0xffffffffu : 0u, m1 = nsel > 1 ? 0xffffffffu : 0u, m2 = nsel > 2 ? 0xffffffffu : 0u;
#pragma unroll
                for (int kq = 0; kq < 4; ++kq) { const int ch = c4 + 4 * kq;
                    const f32x4 a = *(const LAS f32x4*)(OS + rl * 132 + ch * 8), b2 = *(const LAS f32x4*)(OS + rl * 132 + ch * 8 + 4);
                    v4u p0 = *(const GAS v4u*)(po + ch * 8), p1 = *(const GAS v4u*)(po + 128 + ch * 8), p2 = *(const GAS v4u*)(po + 256 + ch * 8);
                    p0 = p0 & m0; p1 = p1 & m1; p2 = p2 & m2;
                    float o8[8] = {a[0] * w4[0], a[1] * w4[0], a[2] * w4[0], a[3] * w4[0], b2[0] * w4[0], b2[1] * w4[0], b2[2] * w4[0], b2[3] * w4[0]};
#pragma unroll
                    for (int x2 = 0; x2 < 4; ++x2) {
                        o8[2 * x2] += w4[1] * __builtin_bit_cast(float, p0[x2] << 16) + w4[2] * __builtin_bit_cast(float, p1[x2] << 16) + w4[3] * __builtin_bit_cast(float, p2[x2] << 16);
                        o8[2 * x2 + 1] += w4[1] * __builtin_bit_cast(float, p0[x2] & 0xffff0000u) + w4[2] * __builtin_bit_cast(float, p1[x2] & 0xffff0000u) + w4[3] * __builtin_bit_cast(float, p2[x2] & 0xffff0000u); }
                    v4u w; w.x = pg8::cvt_pk_bf16(o8[0], o8[1]); w.y = pg8::cvt_pk_bf16(o8[2], o8[3]); w.z = pg8::cvt_pk_bf16(o8[4], o8[5]); w.w = pg8::cvt_pk_bf16(o8[6], o8[7]);
                    *(GAS v4u*)(AOUT + (size_t)(t & tmask) * 1024 + h * 128 + ch * 8) = w; }
            }
        }
        if (nxt.valid) {
#pragma unroll
            for (int j = 0; j < 4; ++j) { const int i = tid + 512 * j, rl = i >> 4, ch = i & 15; *(LAS v4u*)(Qn + rl * 272 + ch * 16) = qn[j]; }
        }
        LDS_WAIT(); __syncthreads();
        if (!nxt.valid) break;
        cur = nxt; pb ^= 1;
    }
}


struct Args { const float* in[18]; float* out; unsigned char* ws; unsigned long long ws_size; };

typedef const __attribute__((address_space(4))) Args* KArgsP;
#define KA() ({ KArgsP p_ = (KArgsP)__builtin_amdgcn_kernarg_segment_ptr(); asm volatile("" : "+s"(p_)); p_; })
#define AIN(i) ((const float*)KA()->in[i])
#define WSB ((unsigned char*)KA()->ws)
#define XIN AIN(0)
#define OUTP ((float*)KA()->out)
#define SS ((float*)(WSB + WS_SS))
#define HBP ((bf16*)(WSB + WS_HB))
#define HB ((bf16*)(WSB + WS_HB + HB_ROW0))
#define ACT ((bf16*)(WSB + WS_ACT))
enum { WK_IN = 0, WK_OUT, WK_KV, WK_Q, WK_O, WK_UP, WK_DN };
constexpr int I_IN = 16 * 96, I_SQ = 16 * 32, I_KV = 16 * 64, I_UP = 16 * 176, I_DN = 44 * 32;
#define AIN2(i) AIN(i)
#define WSB2 WSB
__device__ __forceinline__ void weight_item(int kind, int l, int r, LAS float* scr, int lane) {
    if (kind == WK_IN) { const int kb = r / 96, nb = r % 96, c0 = nb * 32;
        const float* W = AIN2(2) + (size_t)l * D * MIN_; const float* g = AIN2(1) + l * D;
        bf16* WR = (bf16*)(WSB2 + WS_WINR) + (size_t)l * 1536 * D; bf16* WTt = (bf16*)(WSB2 + WS_WINT) + (size_t)l * 1536 * D;
        if (c0 < 512) transpose_item(W, MIN_, kb * 64, c0, g, WR, D, c0, nullptr, 0, scr, lane);
        else if (c0 < 1024) transpose_item(W, MIN_, kb * 64, c0, g, WTt, D, c0 - 512, nullptr, 0, scr, lane);
        else if (c0 < 2048) transpose_item(W, MIN_, kb * 64, c0, g, WTt, D, 512 + c0 - 1024, nullptr, 0, scr, lane);
        else transpose_item(W, MIN_, kb * 64, c0, g, WR, D, 512 + c0 - 2048, nullptr, 0, scr, lane);
    } else if (kind == WK_OUT) { const int kb = r / 32, nb = r % 32;
        transpose_item(AIN2(5) + (size_t)l * D * D, D, kb * 64, nb * 32, nullptr, (bf16*)(WSB2 + WS_WOUT) + (size_t)l * D * D, D, nb * 32, nullptr, 0, scr, lane);
    } else if (kind == WK_KV) { const int kb = r / 64, nb = r % 64, c0 = nb * 32;
        if (c0 < 1024) transpose_item(AIN2(7), 2048, kb * 64, c0, AIN2(6), (bf16*)(WSB2 + WS_WK), D, c0, nullptr, 0, scr, lane);
        else transpose_item(AIN2(7), 2048, kb * 64, c0, AIN2(6), (bf16*)(WSB2 + WS_WV), D, c0 - 1024, nullptr, 0, scr, lane);
    } else if (kind == WK_Q) { const int kb = r / 32, nb = r % 32;
        transpose_item(AIN2(10) + (size_t)l * D * D, D, kb * 64, nb * 32, AIN2(9) + l * D, (bf16*)(WSB2 + WS_WQ) + (size_t)l * D * D, D, nb * 32, nullptr, 0, scr, lane);
    } else if (kind == WK_O) { const int kb = r / 32, nb = r % 32;
        transpose_item(AIN2(12) + (size_t)l * D * D, D, kb * 64, nb * 32, nullptr, (bf16*)(WSB2 + WS_WO) + (size_t)l * D * D, D, nb * 32, nullptr, 0, scr, lane);
    } else if (kind == WK_UP) { const int kb = r / 176, nb = r % 176, c0 = nb * 32;
        const int bj = c0 >= FF, cp = c0 - bj * FF, d0 = (cp / 128) * 256 + bj * 128 + (cp % 128);
        transpose_item(AIN2(14) + (size_t)l * D * FF2, FF2, kb * 64, c0, AIN2(13) + l * D, (bf16*)(WSB2 + WS_WUP) + (size_t)l * FF2 * D, D, d0, nullptr, 0, scr, lane);
    } else { const int kb = r / 32, nb = r % 32;
        transpose_item(AIN2(17) + (size_t)l * FF * D, D, kb * 64, nb * 32, nullptr, (bf16*)(WSB2 + WS_WDN) + (size_t)l * D * FF, FF, nb * 32, nullptr, 0, scr, lane); }
}
__device__ __forceinline__ void weight_set(int set, int widx, int nw, LAS float* scr, int lane) {
    if (set == 0) {
        for (int it = widx; it < I_IN; it += nw) weight_item(WK_IN, 0, it, scr, lane);
    } else if (set == 1) {
        constexpr int N = (I_SQ + I_UP + I_DN) + (I_IN + I_SQ + I_UP + I_DN);
        for (int it = widx; it < N; it += nw) { int r = it;
            if (r < I_SQ) { weight_item(WK_OUT, 0, r, scr, lane); continue; } r -= I_SQ;
            if (r < I_UP) { weight_item(WK_UP, 0, r, scr, lane); continue; } r -= I_UP;
            if (r < I_DN) { weight_item(WK_DN, 0, r, scr, lane); continue; } r -= I_DN;
            if (r < I_IN) { weight_item(WK_IN, 1, r, scr, lane); continue; } r -= I_IN;
            if (r < I_SQ) { weight_item(WK_OUT, 1, r, scr, lane); continue; } r -= I_SQ;
            if (r < I_UP) { weight_item(WK_UP, 1, r, scr, lane); continue; } r -= I_UP;
            weight_item(WK_DN, 1, r, scr, lane); }
    } else {
        constexpr int N = I_KV + 4 * I_SQ + 2 * I_UP + 2 * I_DN;
        for (int it = widx; it < N; it += nw) { int r = it;
            if (r < I_KV) { weight_item(WK_KV, 0, r, scr, lane); continue; } r -= I_KV;
            if (r < 2 * I_SQ) { weight_item(WK_Q, r / I_SQ, r % I_SQ, scr, lane); continue; } r -= 2 * I_SQ;
            if (r < 2 * I_SQ) { weight_item(WK_O, r / I_SQ, r % I_SQ, scr, lane); continue; } r -= 2 * I_SQ;
            if (r < 2 * I_UP) { weight_item(WK_UP, 2 + r / I_UP, r % I_UP, scr, lane); continue; } r -= 2 * I_UP;
            weight_item(WK_DN, 2 + r / I_DN, r % I_DN, scr, lane); }
    }
}

__global__ void __launch_bounds__(NWAVES * 64, 2) yoco_fwd(Args args) {
    extern __shared__ __attribute__((aligned(16))) unsigned char lds[];
    LAS unsigned char* L = (LAS unsigned char*)lds;
    volatile LAS unsigned* MISC = (volatile LAS unsigned*)(L + MISC_OFF);
    const int tid = threadIdx.x, lane = tid & 63, wave = __builtin_amdgcn_readfirstlane(tid >> 6);
    const int G = gridDim.x;
    for (int u = tid; u < (LDS_BYTES - RING_BYTES) / 4; u += NWAVES * 64) ((LAS unsigned*)(L + RING_BYTES))[u] = 0u;
    __syncthreads();
    (void)xcd_barrier_post((unsigned*)(WSB + WS_CTL) + CW_BAR, MISC + 8);
#define GRID_BAR() do { XcdBarrier b_; b_.bar = (unsigned*)(WSB + WS_CTL) + CW_BAR; b_.x = xb_xcc_id(); b_.st = (volatile LAS unsigned*)(L + MISC_OFF) + 8; xcd_barrier(b_); } while (0)

    for (int rp_ = 0; rp_ < REPS(1); ++rp_) {
        LAS float* scr = (LAS float*)(L + wave * 16384);
        const int gw = blockIdx.x * NWAVES + wave, NGW = G * NWAVES;
        weight_set(0, gw, NGW, scr, lane);
        { const int gt = blockIdx.x * (NWAVES * 64) + tid, NTH = G * NWAVES * 64;
          for (int i = gt; i < 2 * D * 8; i += NTH) { const int l = i / (D * 8), k = (i / 8) % D, j = i & 7;
              ((float*)(WSB + WS_WG))[i] = AIN(2)[(size_t)l * D * MIN_ + (size_t)k * MIN_ + 3072 + j] * AIN(1)[l * D + k]; } }
        { const int gt = blockIdx.x * (NWAVES * 64) + tid, NTH = G * NWAVES * 64; bf16* ON = (bf16*)(WSB + WS_ONES);
          for (int i = gt; i < 128; i += NTH) ON[128 * 1024 + i] = (bf16)0; }
        { const int gt = blockIdx.x * (NWAVES * 64) + tid, NTH = G * NWAVES * 64; float* RP = (float*)(WSB + WS_ROPE);
          for (int i = gt; i < T * 16; i += NTH) { const int pos = i >> 4, k = i & 15; const double inv = pow(500000.0, -(double)(2 * k) / 32.0), ang = (double)pos * inv;
              RP[i] = (float)cos(ang); RP[T * 16 + i] = (float)sin(ang); } }
        for (int m = gw; m < T; m += NGW) {
            const GAS f32x4* xr = (const GAS f32x4*)(XIN + (size_t)m * D) + lane; f32x4 v[4]; float s = 0.f;
#pragma unroll
            for (int j = 0; j < 4; ++j) { v[j] = xr[64 * j]; s += (v[j].x * v[j].x + v[j].y * v[j].y) + (v[j].z * v[j].z + v[j].w * v[j].w); }
            s = wave_sum(s, lane);
            GAS unsigned long long* o8 = (GAS unsigned long long*)(HB + (size_t)m * D) + lane;
#pragma unroll
            for (int j = 0; j < 4; ++j) o8[64 * j] = (unsigned long long)pk2(v[j].x, v[j].y) | ((unsigned long long)pk2(v[j].z, v[j].w) << 32);
            if (lane == 0) *(f32x4*)(SS + (size_t)m * 4) = (f32x4){s, 0.f, 0.f, 0.f};
        }
        { const int gt = blockIdx.x * (NWAVES * 64) + tid, NTH = G * NWAVES * 64;
          for (int i = gt; i < 2 * 1024 / 8; i += NTH) ((GAS v4u*)HBP)[i] = (v4u){0u, 0u, 0u, 0u};
          for (int i = gt; i < 128 * 1024 / 8; i += NTH) ((GAS v4u*)(HB + (size_t)T * D))[i] = (v4u){0u, 0u, 0u, 0u}; }
    GRID_BAR();
    }
    if (DUP == 8) { for (int rp_ = 0; rp_ < 8; ++rp_) GRID_BAR(); }

#define GRIDN() ({ int g_ = gridDim.x; asm volatile("" : "+s"(g_)); g_; })
#define BLK() ({ int b_ = blockIdx.x; asm volatile("" : "+s"(b_)); b_; })
    LAS unsigned char* ring = L; LAS unsigned char* el = L + EPI_OFF;
#pragma unroll
    for (int l = 0; l < 4; ++l) {
#if MIXERS
        if (l < 2) {
            bf16* MQ = (bf16*)(WSB + WS_MQ); bf16* MK = (bf16*)(WSB + WS_MK); bf16* OGB = (bf16*)(WSB + WS_OG); bf16* KVT = (bf16*)(WSB + WS_KVT);
            bf16* CT = (bf16*)(WSB + WS_CT); bf16* HG = (bf16*)(WSB + WS_HG);
            float* BCUM = (float*)(WSB + WS_BCUM); float* IG = (float*)(WSB + WS_IG); float* WGT = (float*)(WSB + WS_WGT); float* DECAY = (float*)(WSB + WS_DECAY); bf16* NCT = (bf16*)(WSB + WS_NCT); bf16* WROW = (bf16*)(WSB + WS_ONES); const bf16* ZROW = (const bf16*)(WSB + WS_ONES + 256 * 1024);
            const float* ssm = SS + (size_t)((2 * l) & 3) * T * 4;
            for (int rp_ = 0; rp_ < REPS(2); ++rp_) {
            for (int c = BLK(); c < 256; c += GRIDN())
                mlstm_gates_item(L, c, HB, (const float*)(WSB + WS_WG) + (size_t)l * D * 8, ssm, AIN(3) + l * 8, BCUM, IG, WGT, DECAY, WROW);
            GRID_BAR();
            {
                pg8::Gemm g{HB, (const bf16*)(WSB + WS_WINR) + (size_t)l * 1536 * D, T, 1536, D, 256};
                pg8::StaticOrder S; S.init(T, 1536, GRIDN(), BLK());
                pg8::EpiIn E{MQ, MK, OGB, ssm};
                pg8::gemm_phase<pg8::EpiIn, pg8::StaticOrder, true, true>(ring, el, g, S, E);
            }
            {
                pg8::Gemm g{(const bf16*)(WSB + WS_WINT) + (size_t)l * 1536 * D, HB, 1536, T, D, 256};
                pg8::StaticOrder S; S.init(1536, T, GRIDN(), BLK());
                pg8::EpiInT E{KVT, ssm, 1536, 64, WGT};
                pg8::gemm_phase<pg8::EpiInT, pg8::StaticOrder, true, true>(ring, el, g, S, E);
            }
            GRID_BAR();
            }
            for (int rp_ = 0; rp_ < REPS(3); ++rp_) {
            { int t4 = threadIdx.x; asm volatile("" : "+v"(t4)); const int wv4 = __builtin_amdgcn_readfirstlane(t4 >> 6);
              if (wv4 >= 3 && rp_ == 0) weight_set(l + 1, BLK() * 5 + (wv4 - 3), GRIDN() * 5, (LAS float*)(L + (wv4 - 3) * 16384), t4 & 63); }
            mlstm_scan(KVT, DECAY, CT, NCT, WROW, ZROW, GRIDN());
            GRID_BAR();
            }
            if (DUP == 13) { mlstm_scan(KVT, DECAY, HG, HG, WROW, ZROW, GRIDN(), true); GRID_BAR(); }
            for (int rp_ = 0; rp_ < REPS(4); ++rp_) {
            mlstm_out_phase(L, GRIDN(), MQ, MK, KVT, CT, NCT, BCUM, WGT, OGB, AIN(4) + l * D, HG);
            GRID_BAR();
            }
            for (int rp_ = 0; rp_ < REPS(10); ++rp_) {
                const bool dummy = (DUP == 10) && rp_ == 0;
                pg8::Gemm g{HG, (const bf16*)(WSB + WS_WOUT) + (size_t)l * D * D, T, D, D, 256};
                pg8::StaticOrder S; S.init(T, D, GRIDN(), BLK());
                pg8::EpiRes E{HB, SS + (size_t)((2 * l + 1) & 3) * T * 4, nullptr}; (void)dummy;
                pg8::gemm_phase<pg8::EpiRes, pg8::StaticOrder, true, true>(ring, el, g, S, E);
                if (dummy) GRID_BAR();
            }
            if (0) {
                pg8::Gemm g{HG, (const bf16*)(WSB + WS_WOUT) + (size_t)l * D * D, T, D, D, 256};
                pg8::StaticOrder S; S.init(T, D, GRIDN(), BLK());
                pg8::EpiRes E{HB, SS + (size_t)((2 * l + 1) & 3) * T * 4, nullptr};
                pg8::gemm_phase<pg8::EpiRes, pg8::StaticOrder, true, true>(ring, el, g, S, E);
            }
            GRID_BAR();
        }
#if MIXERS >= 2
        else {
            const int j = l - 2;
            bf16* XK = (bf16*)(WSB + WS_XK); bf16* XVT = (bf16*)(WSB + WS_XVT); bf16* AQ = (bf16*)(WSB + WS_AQ); bf16* PO = (bf16*)(WSB + WS_PO);
            float* KMEAN = (float*)(WSB + WS_KMEAN); float* ML = (float*)(WSB + WS_ML); int* LIST = (int*)(WSB + WS_LIST); int* gcnt = (int*)(WSB + WS_GCNT) + j * 512;
            const float* ssm = SS + (size_t)((2 * l) & 3) * T * 4; const float* RP = (const float*)(WSB + WS_ROPE);
            for (int rp_ = 0; rp_ < REPS(5); ++rp_) {
            if (l == 2) {
                { pg8::Gemm g{HB, (const bf16*)(WSB + WS_WK), T, D, D, 256}; pg8::StaticOrder S; S.init(T, D, GRIDN(), BLK());
                  pg8::EpiQK E{XK, ssm, AIN(8), RP, KMEAN, 1.0f, 1};
                  pg8::gemm_phase<pg8::EpiQK, pg8::StaticOrder, true, true>(ring, el, g, S, E); }
                { pg8::Gemm g{(const bf16*)(WSB + WS_WV), HB, D, T, D, 256}; pg8::StaticOrder S; S.init(D, T, GRIDN(), BLK());
                  pg8::EpiInT E{XVT, ssm, 1024, 0, nullptr};
                  pg8::gemm_phase<pg8::EpiInT, pg8::StaticOrder, true, true>(ring, el, g, S, E); }
            }
            { pg8::Gemm g{HB, (const bf16*)(WSB + WS_WQ) + (size_t)j * D * D, T, D, D, 256}; pg8::StaticOrder S; S.init(T, D, GRIDN(), BLK());
              pg8::EpiQK E{AQ, ssm, AIN(11) + j * 128, RP, nullptr, 0.08838834764831845f * 1.4426950408889634f, 0};
              pg8::gemm_phase<pg8::EpiQK, pg8::StaticOrder, true, true>(ring, el, g, S, E); }
            GRID_BAR();
            }
            for (int rp_ = 0; rp_ < REPS(11); ++rp_) {
            const bool dummy = (DUP == 11) && rp_ == 0;
            moba_gate_phase(L, GRIDN(), AQ, KMEAN, dummy ? gcnt + 2048 : gcnt, dummy ? (int*)(WSB + WS_WINR) : LIST);
            GRID_BAR();
            }
            for (int rp_ = 0; rp_ < REPS(6); ++rp_) {
            attn_phase<false>(L, GRIDN(), gcnt, LIST, AQ, XK, XVT, PO, ML, nullptr, 0, (DUP == 6 && rp_ == 0) ? PROBE : 0);
            GRID_BAR();
            }
            for (int rp_ = 0; rp_ < REPS(12); ++rp_) {
            const bool dummy = (DUP == 12) && rp_ == 0;
            attn_phase<true>(L, GRIDN(), gcnt, LIST, AQ, XK, XVT, PO, ML, dummy ? HB : AQ, dummy ? 8191 : 0x7fffffff);
            GRID_BAR();
            }
            { int t2 = threadIdx.x; asm volatile("" : "+v"(t2)); const int gt = BLK() * (NWAVES * 64) + t2, NTH = GRIDN() * NWAVES * 64;
              unsigned zu = 0u; asm volatile("" : "+v"(zu));
              for (int i = gt; i < 128 * 1024 / 8; i += NTH) ((GAS v4u*)(HB + (size_t)T * D))[i] = (v4u){zu, zu, zu, zu}; }
            { pg8::Gemm g{AQ, (const bf16*)(WSB + WS_WO) + (size_t)j * D * D, T, D, D, 256}; pg8::StaticOrder S; S.init(T, D, GRIDN(), BLK());
              pg8::EpiRes E{HB, SS + (size_t)((2 * l + 1) & 3) * T * 4, nullptr};
              pg8::gemm_phase<pg8::EpiRes, pg8::StaticOrder, true, true>(ring, el, g, S, E); }
            GRID_BAR();
        }
#endif
#endif
        const bool mix_on = (MIXERS >= 2) || (MIXERS == 1 && l < 2);
        const int ssf = mix_on ? 2 * l + 1 : 2 * l;
#ifndef SKIP_UP
        for (int rp_ = 0; rp_ < REPS(7); ++rp_) {
            pg8::Gemm g{HBP, (const bf16*)(WSB + WS_WUP) + (size_t)l * FF2 * D, 65 * 256, FF2, D, 254};
            pg8::StaticOrder S; S.init(65 * 256, FF2, GRIDN(), BLK());
            pg8::EpiConv E{ACT, SS + (size_t)(ssf & 3) * T * 4, AIN(15) + (size_t)l * 3 * FF2, AIN(16) + (size_t)l * FF2};
            pg8::gemm_phase<pg8::EpiConv, pg8::StaticOrder, true, true>(ring, el, g, S, E);
            GRID_BAR();
        }
#endif
#ifndef SKIP_DN
        for (int rp_ = 0; rp_ < REPS(9); ++rp_) {
            const bool dummy = (DUP == 9) && rp_ == 0;
            pg8::Gemm g{ACT, (const bf16*)(WSB + WS_WDN) + (size_t)l * D * FF, T, D, FF, 256};
            pg8::StaticOrder S; S.init(T, D, GRIDN(), BLK());
            pg8::EpiRes E{HB, (l < 3) ? SS + (size_t)((2 * l + 2) & 3) * T * 4 : nullptr, (l == 3) ? OUTP : nullptr}; (void)dummy;
            pg8::gemm_phase<pg8::EpiRes, pg8::StaticOrder, true, true>(ring, el, g, S, E);
            GRID_BAR();
        }
#endif
    }
    { int t3 = threadIdx.x; asm volatile("" : "+v"(t3)); if (BLK() == 0 && t3 == 0) if (xb_ld((unsigned*)(WSB + WS_CTL) + CW_BAR + XB_TMO)) OUTP[0] = 1.0e6f; }
}

#undef WSB
#undef XIN
#undef OUTP
#undef SS
#undef HBP
#undef HB
#undef ACT
extern "C" void kernel_launch(void* const* d_in, const int* in_sizes, int n_in, void* d_out, int out_size, void* d_ws, size_t ws_size, hipStream_t stream) {
    static int grid = 0;
    if (grid == 0) {
        int dev = 0, cus = 0;
        if (n_in != 18 || out_size != T * D || ws_size < WS_END) { fprintf(stderr, "kernel_launch: unexpected problem geometry (n_in %d out %d ws %zu)\n", n_in, out_size, ws_size); grid = -1; return; }
        if (hipGetDevice(&dev) != hipSuccess || hipDeviceGetAttribute(&cus, hipDeviceAttributeMultiprocessorCount, dev) != hipSuccess) { grid = -1; return; }
        if (hipFuncSetAttribute((const void*)yoco_fwd, hipFuncAttributeMaxDynamicSharedMemorySize, LDS_BYTES) != hipSuccess) { fprintf(stderr, "hipFuncSetAttribute failed\n"); grid = -1; return; }
        (void)hipGetLastError();
        grid = cus;
    }
    if (grid < 0) return;
    (void)hipMemsetAsync((char*)d_ws + WS_CTL, 0, CTL_ZERO_BYTES, stream);
    Args a{};
    for (int i = 0; i < 18; ++i) a.in[i] = (const float*)d_in[i];
    a.out = (float*)d_out; a.ws = (unsigned char*)d_ws; a.ws_size = (unsigned long long)ws_size;
    hipLaunchKernelGGL(yoco_fwd, dim3(grid), dim3(NWAVES * 64), LDS_BYTES, stream, a);
}
```

```cpp
#include <hip/hip_runtime.h>
#include <cstdio>
#include <cstdint>

#define MIXERS 2
#define DUP 0
#define REPS(k) ((DUP) == (k) ? 2 : 1)
#ifndef PROBE
#define PROBE 0
#endif

namespace pg8 {
#define PG8_LAS __attribute__((address_space(3)))
typedef unsigned short bf16_t;
typedef short bf16x8 __attribute__((ext_vector_type(8)));
typedef float f32x4 __attribute__((ext_vector_type(4)));
typedef unsigned u32x4 __attribute__((ext_vector_type(4)));
typedef unsigned u32x2 __attribute__((ext_vector_type(2)));
constexpr int BM = 256, BK = 64, HALF = 128, HTB = HALF * BK * 2, STAGE_BYTES = 8 * HTB, NXCD = 8, WGM = 8;

__host__ __device__ __forceinline__ int lds_byte(int r, int c) { const int st = (r >> 4) * 2 + (c >> 5), rr = r & 15, cc = c & 31, ob = rr * 64 + cc * 2; return st * 1024 + (ob ^ (((ob >> 9) & 1) << 5)); }
__host__ __device__ __forceinline__ void stage_rc(int b, int& R, int& C) { const int st = b / 1024, sb = b % 1024, swz = sb ^ (((sb >> 9) & 1) << 5); R = (st >> 1) * 16 + swz / 64; C = (st & 1) * 32 + (swz % 64) / 2; }
__host__ __device__ __forceinline__ int perm32(int rho) { const int n = rho >> 4, i = rho & 15; return 8 * (i >> 2) + 4 * n + (i & 3); }

struct Unit { int pm, pn; };
struct Gemm { const bf16_t* A; const bf16_t* Bt; int M, N, K, a_rows; };

struct StaticOrder {
    int nM, nN, nwg, G, c;
    __host__ __device__ void init(int M, int N, int G_, int c_) { nM = M / BM; nN = N / BM; nwg = nM * nN; G = G_; c = c_; }
    __host__ __device__ bool next(int i, Unit& u) const {
        const long L = (long)i * G + c; if (L >= nwg) return false;
        int wgid = (int)L; { const int q = nwg / NXCD, r = nwg % NXCD, xcd = wgid % NXCD, off = wgid / NXCD; wgid = (xcd < r ? xcd * (q + 1) : r * (q + 1) + (xcd - r) * q) + off; }
        const int nig = WGM * nN, gid = wgid / nig, fm = gid * WGM, gsz = (nM - fm) < WGM ? (nM - fm) : WGM;
        u.pm = fm + ((wgid % nig) % gsz); u.pn = (wgid % nig) / gsz; return true;
    }
    __device__ __forceinline__ void a_ready(const Unit&) const {}
    __device__ __forceinline__ void done(const Unit&) const {}
};

__device__ __forceinline__ float sh_idx(float v, int src) { return __builtin_bit_cast(float, __builtin_amdgcn_ds_bpermute(src << 2, __builtin_bit_cast(int, v))); }
__device__ __forceinline__ float sh_xor(float v, int o, int lane) { return sh_idx(v, lane ^ o); }
template <int CTRL, int ROWMASK = 0xf> __device__ __forceinline__ float dpp_add(float v) { return v + __builtin_bit_cast(float, __builtin_amdgcn_update_dpp(0, __builtin_bit_cast(int, v), CTRL, ROWMASK, 0xf, true)); }
__device__ __forceinline__ float half_sum_hi(float v) { v = dpp_add<0xB1>(v); v = dpp_add<0x4E>(v); v = dpp_add<0x141>(v); v = dpp_add<0x140>(v); return dpp_add<0x142, 0xA>(v); }
__device__ __forceinline__ float oct_sum(float v) { v = dpp_add<0xB1>(v); v = dpp_add<0x4E>(v); return dpp_add<0x141>(v); }
__device__ __forceinline__ unsigned cvt_pk_bf16(float lo, float hi) { unsigned r; asm volatile("v_cvt_pk_bf16_f32 %0, %1, %2" : "=v"(r) : "v"(lo), "v"(hi)); return r; }
__device__ __forceinline__ float rstd4(const float* ss4, int row) { const f32x4 p = *(const f32x4*)(ss4 + (size_t)row * 4); return rsqrtf(((p[0] + p[1]) + (p[2] + p[3])) * (1.0f / 1024.0f) + 1e-6f); }
#define EPI_BAR() do { asm volatile("s_waitcnt lgkmcnt(0)" ::: "memory"); __builtin_amdgcn_s_barrier(); asm volatile("" ::: "memory"); } while (0)

constexpr int TT = 16384, DD = 1024;
constexpr float NEPS = 1e-6f;

struct EpiRes {
    static constexpr bool PERM = true;
    bf16_t* hb; float* ss; float* fout;
    __device__ __forceinline__ void operator()(f32x4 (&acc)[2][2][4][2], const Unit& u, int wr, int wc, int fr_, int fq_, PG8_LAS unsigned char* el, int wid, int lane_) const {
        int ln_ = lane_; asm volatile("" : "+v"(ln_)); const int lane = ln_, fr = ln_ & 15, fq = ln_ >> 4; (void)fr_; (void)fq_;
        u32x4 pre[2][4][2];
#pragma unroll
        for (int ai = 0; ai < 2; ++ai)
#pragma unroll
            for (int m = 0; m < 4; ++m)
#pragma unroll
                for (int bj = 0; bj < 2; ++bj) pre[ai][m][bj] = *(const u32x4*)(hb + (size_t)(u.pm * BM + ai * HALF + wr * 64 + m * 16 + fr) * DD + u.pn * BM + bj * HALF + wc * 32 + 8 * fq);
#pragma unroll
        for (int ai = 0; ai < 2; ++ai)
#pragma unroll
            for (int m = 0; m < 4; ++m) {
                const int row = u.pm * BM + ai * HALF + wr * 64 + m * 16 + fr; float s = 0.f;
#pragma unroll
                for (int bj = 0; bj < 2; ++bj) {
                    const size_t off = (size_t)row * DD + u.pn * BM + bj * HALF + wc * 32 + 8 * fq;
                    const u32x4 p = pre[ai][m][bj];
                    f32x4 v0 = acc[ai][bj][m][0], v1 = acc[ai][bj][m][1];
                    v0[0] += __builtin_bit_cast(float, p[0] << 16); v0[1] += __builtin_bit_cast(float, p[0] & 0xffff0000u); v0[2] += __builtin_bit_cast(float, p[1] << 16); v0[3] += __builtin_bit_cast(float, p[1] & 0xffff0000u);
                    v1[0] += __builtin_bit_cast(float, p[2] << 16); v1[1] += __builtin_bit_cast(float, p[2] & 0xffff0000u); v1[2] += __builtin_bit_cast(float, p[3] << 16); v1[3] += __builtin_bit_cast(float, p[3] & 0xffff0000u);
                    if (fout) { *(f32x4*)(fout + off) = v0; *(f32x4*)(fout + off + 4) = v1; }
                    u32x4 w; w.x = cvt_pk_bf16(v0[0], v0[1]); w.y = cvt_pk_bf16(v0[2], v0[3]); w.z = cvt_pk_bf16(v1[0], v1[1]); w.w = cvt_pk_bf16(v1[2], v1[3]);
                    *(u32x4*)(hb + off) = w;
                    s += (v0[0] * v0[0] + v0[1] * v0[1]) + (v0[2] * v0[2] + v0[3] * v0[3]) + (v1[0] * v1[0] + v1[1] * v1[1]) + (v1[2] * v1[2] + v1[3] * v1[3]);
                }
                s += sh_xor(s, 16, lane); s += sh_xor(s, 32, lane);
                if (fq == 0) ((PG8_LAS float*)el)[(ai * HALF + wr * 64 + m * 16 + fr) * 4 + wc] = s;
            }
        EPI_BAR();
        { const int tid2 = wid * 64 + lane;
          if (ss && tid2 < 256) { const f32x4 p = *(const PG8_LAS f32x4*)((PG8_LAS float*)el + tid2 * 4); ss[(size_t)(u.pm * BM + tid2) * 4 + u.pn] = (p[0] + p[1]) + (p[2] + p[3]); } }
        EPI_BAR();
    }
};

struct EpiConv {
    static constexpr bool PERM = true;
    bf16_t* act; const float* ss; const float* cw; const float* cb;
    static __device__ __forceinline__ float ror1(float v) { const int iv = __builtin_bit_cast(int, v); return __builtin_bit_cast(float, __builtin_amdgcn_update_dpp(iv, iv, 0x121, 0xf, 0xf, false)); }
    static __device__ __forceinline__ float ror2(float v) { const int iv = __builtin_bit_cast(int, v); return __builtin_bit_cast(float, __builtin_amdgcn_update_dpp(iv, iv, 0x122, 0xf, 0xf, false)); }
    __device__ __forceinline__ void operator()(f32x4 (&acc)[2][2][4][2], const Unit& u, int wr, int wc, int fr_, int fq_, PG8_LAS unsigned char* el, int wid, int lane_) const {
        int ln_ = lane_; asm volatile("" : "+v"(ln_)); const int lane = ln_, fr = ln_ & 15, fq = ln_ >> 4; (void)lane; (void)fr_; (void)fq_;
        const int t0 = u.pm * 254 - 2;
        const int cl = wc * 32 + 8 * fq;
        float rs[2][4]; f32x4 cp[2][2][4];
#pragma unroll
        for (int ai = 0; ai < 2; ++ai)
#pragma unroll
            for (int m = 0; m < 4; ++m) { const int t = t0 + ai * HALF + wr * 64 + m * 16 + fr; rs[ai][m] = (t >= 0 && t < TT) ? rstd4(ss, t) : 0.f; }
#pragma unroll
        for (int n = 0; n < 2; ++n)
#pragma unroll
            for (int bj = 0; bj < 2; ++bj) { const int scol = (bj ? 2816 : 0) + u.pn * HALF + cl + 4 * n;
                cp[n][bj][0] = *(const f32x4*)(cw + scol); cp[n][bj][1] = *(const f32x4*)(cw + 5632 + scol); cp[n][bj][2] = *(const f32x4*)(cw + 2 * 5632 + scol); cp[n][bj][3] = *(const f32x4*)(cb + scol); }
#pragma unroll
        for (int ai = 0; ai < 2; ++ai)
#pragma unroll
            for (int m = 0; m < 4; ++m)
#pragma unroll
                for (int bj = 0; bj < 2; ++bj)
#pragma unroll
                    for (int n = 0; n < 2; ++n) acc[ai][bj][m][n] = acc[ai][bj][m][n] * rs[ai][m];
        PG8_LAS float* X = (PG8_LAS float*)el;
#pragma unroll
        for (int ai = 0; ai < 2; ++ai) { const int B = 2 * ai + wr;
            if (B < 3 && fr >= 14) {
#pragma unroll
                for (int bj = 0; bj < 2; ++bj)
#pragma unroll
                    for (int n = 0; n < 2; ++n) *(PG8_LAS f32x4*)(X + (B * 2 + (fr - 14)) * 256 + bj * HALF + cl + 4 * n) = acc[ai][bj][3][n];
            } }
        EPI_BAR();
#pragma unroll
        for (int n = 0; n < 2; ++n) {
#pragma unroll
            for (int bj = 0; bj < 2; ++bj) {
                const f32x4 w0 = cp[n][bj][0], w1 = cp[n][bj][1], w2 = cp[n][bj][2], bb = cp[n][bj][3];
#pragma unroll
                for (int ai = 0; ai < 2; ++ai) {
                    const int B = 2 * ai + wr;
                    f32x4 p1 = (f32x4){0.f, 0.f, 0.f, 0.f}, p2 = p1;
                    if (B > 0) { const f32x4 e0 = *(const PG8_LAS f32x4*)(X + ((B - 1) * 2 + 0) * 256 + bj * HALF + cl + 4 * n), e1 = *(const PG8_LAS f32x4*)(X + ((B - 1) * 2 + 1) * 256 + bj * HALF + cl + 4 * n);
                        p1 = e1; p2 = (fr == 0) ? e0 : e1; }
#pragma unroll
                    for (int m = 0; m < 4; ++m) {
                        f32x4 cur = acc[ai][bj][m][n]; f32x4 s1, s2;
                        asm volatile("" : "+v"(cur));
#pragma unroll
                        for (int i = 0; i < 4; ++i) { s1[i] = ror1(cur[i]); s2[i] = ror2(cur[i]); }
                        const f32x4 q1 = (fr >= 1) ? s1 : p1, q2 = (fr >= 2) ? s2 : p2;
                        f32x4 res = bb + w0 * q2 + w1 * q1 + w2 * cur;
                        asm volatile("" : "+v"(res), "+v"(s1), "+v"(s2));
                        acc[ai][bj][m][n] = res;
                        p1 = s1; p2 = s2;
                    }
                }
            }
        }
#pragma unroll
        for (int ai = 0; ai < 2; ++ai)
#pragma unroll
            for (int m = 0; m < 4; ++m) {
                const int r = ai * HALF + wr * 64 + m * 16 + fr, t = t0 + r;
                u32x4 w; float a[8];
#pragma unroll
                for (int n = 0; n < 2; ++n)
#pragma unroll
                    for (int i = 0; i < 4; ++i) { const float v = acc[ai][0][m][n][i], g = acc[ai][1][m][n][i]; a[4 * n + i] = v * g * __builtin_amdgcn_rcpf(1.0f + __builtin_amdgcn_exp2f(-1.4426950408889634f * g)); }
                w.x = cvt_pk_bf16(a[0], a[1]); w.y = cvt_pk_bf16(a[2], a[3]); w.z = cvt_pk_bf16(a[4], a[5]); w.w = cvt_pk_bf16(a[6], a[7]);
                if (r >= 2 && t < TT) *(u32x4*)(act + (size_t)t * 2816 + u.pn * HALF + cl) = w;
            }
        EPI_BAR();
    }
};


struct EpiIn {
    static constexpr bool PERM = true;
    bf16_t* q; bf16_t* k; bf16_t* og; const float* ss;
    __device__ __forceinline__ void operator()(f32x4 (&acc)[2][2][4][2], const Unit& u, int wr, int wc, int fr_, int fq_, PG8_LAS unsigned char* el, int wid, int lane_) const {
        int ln_ = lane_; asm volatile("" : "+v"(ln_)); const int lane = ln_, fr = ln_ & 15, fq = ln_ >> 4; (void)lane; (void)fr_; (void)fq_;
        bf16_t* dst; int ldc, c0; float sc;
        if (u.pn < 2) { dst = q; ldc = 512; c0 = 256 * u.pn; sc = 0.08838834764831845f; }
        else { dst = og; ldc = 1024; c0 = 256 * (u.pn - 2); sc = 1.f; }
#pragma unroll
        for (int ai = 0; ai < 2; ++ai)
#pragma unroll
            for (int m = 0; m < 4; ++m) {
                const int row = u.pm * BM + ai * HALF + wr * 64 + m * 16 + fr;
                const float rs = rstd4(ss, row) * sc;
#pragma unroll
                for (int bj = 0; bj < 2; ++bj) {
                    const f32x4 v0 = acc[ai][bj][m][0] * rs, v1 = acc[ai][bj][m][1] * rs;
                    u32x4 w; w.x = cvt_pk_bf16(v0[0], v0[1]); w.y = cvt_pk_bf16(v0[2], v0[3]); w.z = cvt_pk_bf16(v1[0], v1[1]); w.w = cvt_pk_bf16(v1[2], v1[3]);
                    *(u32x4*)(dst + (size_t)row * ldc + c0 + bj * HALF + wc * 32 + 8 * fq) = w;
                }
            }
    }
};
struct EpiInT {
    static constexpr bool PERM = true;
    bf16_t* o; const float* ss; int nrows, ch; const float* wgt;
    __device__ __forceinline__ void operator()(f32x4 (&acc)[2][2][4][2], const Unit& u, int wr, int wc, int fr_, int fq_, PG8_LAS unsigned char* el, int wid, int lane_) const {
        int ln_ = lane_; asm volatile("" : "+v"(ln_)); const int lane = ln_, fr = ln_ & 15, fq = ln_ >> 4; (void)lane; (void)fr_; (void)fq_;
#pragma unroll
        for (int bj = 0; bj < 2; ++bj) {
            const int t = u.pn * BM + bj * HALF + wc * 32 + 8 * fq;
            f32x4 r0, r1;
#pragma unroll
            for (int i = 0; i < 4; ++i) { r0[i] = rstd4(ss, t + i); r1[i] = rstd4(ss, t + 4 + i); }
            if (wgt && u.pm >= 2) { const float* wp = wgt + (size_t)(u.pm - 2) * TT + t; r0 = r0 * *(const f32x4*)wp; r1 = r1 * *(const f32x4*)(wp + 4); }
#pragma unroll
            for (int ai = 0; ai < 2; ++ai)
#pragma unroll
                for (int m = 0; m < 4; ++m) {
                    const int row = u.pm * BM + ai * HALF + wr * 64 + m * 16 + fr;
                    const f32x4 v0 = acc[ai][bj][m][0] * r0, v1 = acc[ai][bj][m][1] * r1;
                    u32x4 w; w.x = cvt_pk_bf16(v0[0], v0[1]); w.y = cvt_pk_bf16(v0[2], v0[3]); w.z = cvt_pk_bf16(v1[0], v1[1]); w.w = cvt_pk_bf16(v1[2], v1[3]);
                    if (ch) {
                        *(u32x4*)(o + ((((size_t)(t >> 6) * 96 + (row >> 4)) * 2 + ((t >> 5) & 1)) * 512 + (((t >> 3) & 3) * 16 + (row & 15)) * 8)) = w; }
                    else {
                        const int kb = t >> 8, key = t & 255;
                        *(u32x4*)(o + ((((size_t)(kb * 8 + (row >> 7)) * 4 + ((row >> 5) & 3)) * 16 + (key >> 4)) * 512 + (((key >> 3) & 1) * 32 + (row & 31)) * 8)) = w; }
                }
        }
    }
};


struct EpiQK {
    static constexpr bool PERM = false;
    bf16_t* o; const float* ss; const float* gain; const float* rope; float* kmean; float oscale; int kfrag;
    __device__ __forceinline__ void operator()(f32x4 (&acc)[2][2][4][2], const Unit& u, int wr, int wc, int fr_, int fq_, PG8_LAS unsigned char* el, int wid, int lane_) const {
        int ln_ = lane_; asm volatile("" : "+v"(ln_)); const int lane = ln_, fr = ln_ & 15, fq = ln_ >> 4; (void)lane; (void)fr_; (void)fq_;
        PG8_LAS float* P = (PG8_LAS float*)el;
        PG8_LAS float* KS = (PG8_LAS float*)(el + 8192);
#pragma unroll
        for (int ai = 0; ai < 2; ++ai)
#pragma unroll
            for (int m = 0; m < 4; ++m) {
                const int rl = ai * HALF + wr * 64 + m * 16 + fr;
                const float rs = rstd4(ss, u.pm * BM + rl);
#pragma unroll
                for (int bj = 0; bj < 2; ++bj) {
                    const f32x4 x0 = acc[ai][bj][m][0] * rs, x1 = acc[ai][bj][m][1] * rs;
                    acc[ai][bj][m][0] = x0; acc[ai][bj][m][1] = x1;
                    float s = (x0[0] * x0[0] + x0[1] * x0[1]) + (x0[2] * x0[2] + x0[3] * x0[3]) + (x1[0] * x1[0] + x1[1] * x1[1]) + (x1[2] * x1[2] + x1[3] * x1[3]);
                    s += sh_xor(s, 16, lane); s += sh_xor(s, 32, lane);
                    if (fq == 0) P[(rl * 2 + bj) * 4 + wc] = s;
                }
            }
        EPI_BAR();
#pragma unroll
        for (int bj = 0; bj < 2; ++bj) {
            const f32x4 g0 = *(const f32x4*)(gain + 32 * wc + 4 * fq), g1 = *(const f32x4*)(gain + 32 * wc + 16 + 4 * fq);
            f32x4 cs0 = (f32x4){0.f, 0.f, 0.f, 0.f}, cs1 = cs0;
            const int head = 2 * u.pn + bj;
#pragma unroll
            for (int ai = 0; ai < 2; ++ai)
#pragma unroll
                for (int m = 0; m < 4; ++m) {
                    const int rl = ai * HALF + wr * 64 + m * 16 + fr, row = u.pm * BM + rl;
                    const f32x4 p = *(const PG8_LAS f32x4*)(P + (rl * 2 + bj) * 4);
                    const float rn = rsqrtf(((p[0] + p[1]) + (p[2] + p[3])) * (1.0f / 128.0f) + NEPS);
                    f32x4 y0 = acc[ai][bj][m][0] * rn * g0, y1 = acc[ai][bj][m][1] * rn * g1;
                    if (wc == 0) { const f32x4 c = *(const f32x4*)(rope + (size_t)row * 16 + 4 * fq), sn = *(const f32x4*)(rope + (size_t)TT * 16 + (size_t)row * 16 + 4 * fq);
                        const f32x4 t0 = y0 * c - y1 * sn, t1 = y1 * c + y0 * sn; y0 = t0; y1 = t1; }
                    cs0 += y0; cs1 += y1;
                    y0 = y0 * oscale; y1 = y1 * oscale;
                    u32x2 w0, w1; w0.x = cvt_pk_bf16(y0[0], y0[1]); w0.y = cvt_pk_bf16(y0[2], y0[3]); w1.x = cvt_pk_bf16(y1[0], y1[1]); w1.y = cvt_pk_bf16(y1[2], y1[3]);
                    if (!kfrag) { bf16_t* op = o + (size_t)row * DD + head * 128 + 32 * wc + 4 * fq; *(u32x2*)op = w0; *(u32x2*)(op + 16) = w1; }
                    else {
                        bf16_t* op = o + ((((size_t)((row >> 8) * 8 + head) * 8 + ((row >> 5) & 7)) * 8 + 2 * wc) * 512 + ((fq >> 1) * 32 + (row & 31)) * 8 + 4 * (fq & 1));
                        *(u32x2*)op = w0; *(u32x2*)(op + 512) = w1; }
                    asm volatile("" ::: "memory");
                }
            if (kmean) {
#pragma unroll
                for (int i = 0; i < 4; ++i) {
#pragma unroll
                    for (int o2 = 1; o2 < 16; o2 <<= 1) { cs0[i] += sh_xor(cs0[i], o2, lane); cs1[i] += sh_xor(cs1[i], o2, lane); }
                }
                if (fr == 0) { *(PG8_LAS f32x4*)(KS + (wr * 2 + bj) * 128 + 32 * wc + 4 * fq) = cs0; *(PG8_LAS f32x4*)(KS + (wr * 2 + bj) * 128 + 32 * wc + 16 + 4 * fq) = cs1; }
            }
        }
        EPI_BAR();
        if (kmean) {
            const int tid2 = wid * 64 + lane;
            if (tid2 < 256) { const int bj = tid2 >> 7, d = tid2 & 127;
                kmean[((size_t)(2 * u.pn + bj) * 64 + u.pm) * 128 + d] = (KS[bj * 128 + d] + KS[(2 + bj) * 128 + d]) * (1.0f / 256.0f); }
            EPI_BAR();
        }
    }
};

template <class Epi, class Sched, bool ALIGN_EPI = false, bool SP2 = false>
__device__ __forceinline__ void gemm_phase(PG8_LAS unsigned char* lds, PG8_LAS unsigned char* elds, const Gemm g, const Sched& S, const Epi& E) {
    int tid_ = threadIdx.x; asm volatile("" : "+v"(tid_)); const int tid = tid_, wid = __builtin_amdgcn_readfirstlane(tid >> 6), lane = tid & 63, wr = wid >> 2, wc = wid & 3, fr = lane & 15, fq = lane >> 4;
    const int K = g.K, nt = K / BK;
    float zf_ = 0.f; asm volatile("" : "+v"(zf_)); const f32x4 z4_ = {zf_, zf_, zf_, zf_};
    unsigned voffA[2], voffB[2];
#pragma unroll
    for (int i = 0; i < 2; ++i) { int R, C; stage_rc(tid * 16 + i * 8192, R, C); const int Rb = Epi::PERM ? ((R & ~31) + perm32(R & 31)) : R;
        voffA[i] = (unsigned)(R * K + C) * 2u; voffB[i] = (unsigned)(Rb * K + C) * 2u; }
    const size_t kstep = (size_t)(BK * 2);
    const size_t hstep = (size_t)HALF * K * 2;
    const size_t tstep = 2 * hstep; const size_t tstepA = (size_t)g.a_rows * K * 2;
    const unsigned ldsw = (unsigned)wid * 1024u;
    const int aoff = lds_byte(wr * 64 + fr, fq * 8), boff = lds_byte(wc * 32 + fr, fq * 8);
#define PG8_SA(b, h) (((b) * 2 + (h)) * HTB)
#define PG8_SB(b, h) ((4 + (b) * 2 + (h)) * HTB)
#define PG8_STAGE(bufoff, gbase, voff) do { _Pragma("unroll") for (int _i = 0; _i < 2; ++_i) \
        __builtin_amdgcn_global_load_lds((const unsigned*)((const char*)(gbase) + (voff)[_i]), (PG8_LAS unsigned*)(lds + (bufoff) + ldsw + _i * 8192), 16, 0, 0); } while (0)
#define PG8_LDA(dst, b, h) do { _Pragma("unroll") for (int m = 0; m < 4; ++m) _Pragma("unroll") for (int k = 0; k < 2; ++k) dst[m][k] = *(const PG8_LAS bf16x8*)(lds + PG8_SA(b, h) + aoff + m * 2048 + k * 1024); } while (0)
#define PG8_LDB(dst, b, h) do { _Pragma("unroll") for (int n = 0; n < 2; ++n) _Pragma("unroll") for (int k = 0; k < 2; ++k) dst[n][k] = *(const PG8_LAS bf16x8*)(lds + PG8_SB(b, h) + boff + n * 2048 + k * 1024); } while (0)
#define PG8_MMA(ai, bj, At, Bt) do { __builtin_amdgcn_s_setprio(1); _Pragma("unroll") for (int m = 0; m < 4; ++m) _Pragma("unroll") for (int n = 0; n < 2; ++n) _Pragma("unroll") for (int k = 0; k < 2; ++k) \
        acc[ai][bj][m][n] = __builtin_amdgcn_mfma_f32_16x16x32_bf16(Bt[n][k], At[m][k], acc[ai][bj][m][n], 0, 0, 0); __builtin_amdgcn_s_setprio(0); } while (0)
#define PG8_WAIT_V(n) asm volatile("s_waitcnt vmcnt(" #n ")" ::: "memory")
#define PG8_WAIT_L(n) asm volatile("s_waitcnt lgkmcnt(" #n ")" ::: "memory")
#define PG8_BAR __builtin_amdgcn_s_barrier()
#define PG8_SCHED __builtin_amdgcn_sched_barrier(0)
    Unit cur, nxt; int ui = 0;
    if (!S.next(0, cur)) return;
    f32x4 acc[2][2][4][2];
#pragma unroll
    for (int a = 0; a < 2; ++a)
#pragma unroll
        for (int b = 0; b < 2; ++b)
#pragma unroll
            for (int m = 0; m < 4; ++m)
#pragma unroll
                for (int n = 0; n < 2; ++n) acc[a][b][m][n] = z4_;
    bf16x8 At[4][2], B0[2][2], B1[2][2];
    const char* cA = (const char*)g.A + (size_t)cur.pm * tstepA; const char* cB = (const char*)g.Bt + (size_t)cur.pn * tstep;
    S.a_ready(cur);
    if constexpr (SP2) {
        PG8_STAGE(PG8_SB(0, 0), cB, voffB); PG8_STAGE(PG8_SB(0, 1), cB + hstep, voffB); PG8_STAGE(PG8_SA(0, 0), cA, voffA); PG8_STAGE(PG8_SA(0, 1), cA + hstep, voffA);
        if (wr == 1) PG8_BAR;
        PG8_WAIT_V(2); PG8_BAR;
        PG8_STAGE(PG8_SB(1, 0), cB + kstep, voffB); PG8_STAGE(PG8_SA(1, 0), cA + kstep, voffA); PG8_STAGE(PG8_SB(1, 1), cB + hstep + kstep, voffB);
        PG8_WAIT_V(6); PG8_BAR;
    } else {
        PG8_STAGE(PG8_SB(0, 0), cB, voffB); PG8_STAGE(PG8_SA(0, 0), cA, voffA); PG8_STAGE(PG8_SB(0, 1), cB + hstep, voffB); PG8_STAGE(PG8_SA(0, 1), cA + hstep, voffA);
        if (wr == 1) PG8_BAR;
        PG8_WAIT_V(4); PG8_BAR;
        PG8_STAGE(PG8_SB(1, 0), cB + kstep, voffB); PG8_STAGE(PG8_SA(1, 0), cA + kstep, voffA); PG8_STAGE(PG8_SB(1, 1), cB + hstep + kstep, voffB);
        PG8_WAIT_V(6); PG8_BAR;
    }
    for (;;) {
        const bool has_next = S.next(ui + 1, nxt);
        const char* nA = has_next ? (const char*)g.A + (size_t)nxt.pm * tstepA : cA; const char* nB = has_next ? (const char*)g.Bt + (size_t)nxt.pn * tstep : cB;
        for (int t = 0; t < nt; t += 2) {
            const bool last = (t == nt - 2);
            const char* a1 = cA + (size_t)(t + 1) * kstep;
            const char* a2 = last ? nA : cA + (size_t)(t + 2) * kstep; const char* b2 = last ? nB : cB + (size_t)(t + 2) * kstep;
            const char* a3 = a2 + kstep; const char* b3 = b2 + kstep;
            if (last && has_next) S.a_ready(nxt);
            if constexpr (SP2) {
            PG8_LDB(B0, 0, 0); PG8_LDB(B1, 0, 1); PG8_SCHED; PG8_LDA(At, 0, 0); PG8_STAGE(PG8_SA(1, 1), a1 + hstep, voffA);
            PG8_WAIT_V(8); PG8_WAIT_L(0); PG8_BAR; PG8_MMA(0, 0, At, B0); PG8_MMA(0, 1, At, B1); PG8_BAR; PG8_SCHED;
            PG8_LDA(At, 0, 1); PG8_STAGE(PG8_SB(0, 0), b2, voffB); PG8_STAGE(PG8_SB(0, 1), b2 + hstep, voffB); PG8_STAGE(PG8_SA(0, 0), a2, voffA);
            PG8_WAIT_V(8); PG8_WAIT_L(0); PG8_BAR; PG8_MMA(1, 0, At, B0); PG8_MMA(1, 1, At, B1); PG8_BAR; PG8_SCHED;
            PG8_LDB(B0, 1, 0); PG8_LDB(B1, 1, 1); PG8_SCHED; PG8_LDA(At, 1, 0); PG8_STAGE(PG8_SA(0, 1), a2 + hstep, voffA);
            PG8_WAIT_V(8); PG8_WAIT_L(0); PG8_BAR; PG8_MMA(0, 0, At, B0); PG8_MMA(0, 1, At, B1); PG8_BAR; PG8_SCHED;
            PG8_LDA(At, 1, 1); PG8_STAGE(PG8_SB(1, 0), b3, voffB); PG8_STAGE(PG8_SB(1, 1), b3 + hstep, voffB); PG8_STAGE(PG8_SA(1, 0), a3, voffA);
            PG8_WAIT_V(8); PG8_WAIT_L(0); PG8_BAR; PG8_MMA(1, 0, At, B0); PG8_MMA(1, 1, At, B1); PG8_BAR; PG8_SCHED;
            } else {
            PG8_LDB(B0, 0, 0); PG8_SCHED; PG8_LDA(At, 0, 0); PG8_STAGE(PG8_SA(1, 1), a1 + hstep, voffA);
            PG8_WAIT_L(8); PG8_BAR; PG8_WAIT_L(0); PG8_MMA(0, 0, At, B0); PG8_BAR; PG8_SCHED;
            PG8_LDB(B1, 0, 1); PG8_STAGE(PG8_SB(0, 0), b2, voffB);
            PG8_BAR; PG8_WAIT_L(0); PG8_MMA(0, 1, At, B1); PG8_BAR;
            PG8_LDA(At, 0, 1); PG8_STAGE(PG8_SA(0, 0), a2, voffA);
            PG8_BAR; PG8_WAIT_L(0); PG8_MMA(1, 0, At, B0); PG8_BAR; PG8_SCHED;
            PG8_STAGE(PG8_SB(0, 1), b2 + hstep, voffB);
            PG8_WAIT_V(6); PG8_BAR; PG8_MMA(1, 1, At, B1); PG8_BAR;
            PG8_LDB(B0, 1, 0); PG8_SCHED; PG8_LDA(At, 1, 0); PG8_STAGE(PG8_SA(0, 1), a2 + hstep, voffA);
            PG8_WAIT_L(8); PG8_BAR; PG8_WAIT_L(0); PG8_MMA(0, 0, At, B0); PG8_BAR; PG8_SCHED;
            PG8_LDB(B1, 1, 1); PG8_STAGE(PG8_SB(1, 0), b3, voffB);
            PG8_BAR; PG8_WAIT_L(0); PG8_MMA(0, 1, At, B1); PG8_BAR;
            PG8_LDA(At, 1, 1); PG8_STAGE(PG8_SA(1, 0), a3, voffA);
            PG8_BAR; PG8_WAIT_L(0); PG8_MMA(1, 0, At, B0); PG8_BAR; PG8_SCHED;
            PG8_STAGE(PG8_SB(1, 1), b3 + hstep, voffB);
            PG8_WAIT_V(6); PG8_BAR; PG8_MMA(1, 1, At, B1); PG8_BAR;
            }
        }
        if constexpr (ALIGN_EPI) { if (wr == 0) PG8_BAR; }
        { E(acc, cur, wr, wc, fr, fq, elds, wid, lane); S.done(cur); }
        if (!has_next) break;
#pragma unroll
        for (int a = 0; a < 2; ++a)
#pragma unroll
            for (int b = 0; b < 2; ++b)
#pragma unroll
                for (int m = 0; m < 4; ++m)
#pragma unroll
                    for (int n = 0; n < 2; ++n) acc[a][b][m][n] = z4_;
        cur = nxt; cA = nA; cB = nB; ++ui;
        if constexpr (ALIGN_EPI) { if (wr == 1) PG8_BAR; }
    }
    PG8_WAIT_V(0);
    if constexpr (!ALIGN_EPI) { if (wr == 0) PG8_BAR; }
    PG8_BAR;
#undef PG8_SA
#undef PG8_SB
#undef PG8_STAGE
#undef PG8_LDA
#undef PG8_LDB
#undef PG8_MMA
#undef PG8_WAIT_V
#undef PG8_WAIT_L
#undef PG8_BAR
#undef PG8_SCHED
}
}


#define GAS __attribute__((address_space(1)))
#define LAS __attribute__((address_space(3)))
typedef unsigned short bf16;
typedef unsigned v4u __attribute__((ext_vector_type(4)));
typedef float f32x4 __attribute__((ext_vector_type(4)));
typedef short bf16x8 __attribute__((ext_vector_type(8)));

constexpr int NWAVES = 8;
constexpr int T = 16384, D = 1024, FF = 2816, FF2 = 5632, MIN_ = 3080;
constexpr size_t MiB = 1u << 20;
constexpr size_t WS_CTL = 0, CTL_ZERO_BYTES = 2 * MiB;
constexpr size_t WS_SS = 64 * 1024;
constexpr size_t WS_WINR = 2 * MiB;
constexpr size_t WS_WINT = 10 * MiB;
constexpr size_t WS_WOUT = 16 * MiB;
constexpr size_t WS_WK = 20 * MiB, WS_WV = 22 * MiB;
constexpr size_t WS_WQ = 24 * MiB;
constexpr size_t WS_WO = 28 * MiB;
constexpr size_t WS_WUP = 32 * MiB;
constexpr size_t WS_WDN = 76 * MiB;
constexpr size_t WS_WG = 98 * MiB;
constexpr size_t WS_ROPE = 99 * MiB;
constexpr size_t WS_HB = 101 * MiB;
constexpr size_t HB_ROW0 = 2 * 2048;
constexpr size_t WS_ACT = 135 * MiB;
constexpr size_t WS_CT = 135 * MiB;
constexpr size_t WS_MQ = 199 * MiB;
constexpr size_t WS_BCUM = 215 * MiB, WS_IG = WS_BCUM + 256 * 1024, WS_WGT = WS_IG + 256 * 1024, WS_DECAY = WS_WGT + 256 * 1024;
constexpr size_t WS_NCT = 217 * MiB;
constexpr size_t WS_ONES = 221 * MiB;
constexpr size_t WS_MK = 223 * MiB;
constexpr size_t WS_OG = 239 * MiB;
constexpr size_t WS_KVT = 271 * MiB;
constexpr size_t WS_HG = 319 * MiB;
constexpr size_t WS_XK = 223 * MiB;
constexpr size_t WS_XVT = 255 * MiB;
constexpr size_t WS_KMEAN = 287 * MiB;
constexpr size_t WS_AQ = 288 * MiB;
constexpr size_t WS_LIST = 320 * MiB;
constexpr size_t WS_ML = 337 * MiB;
constexpr size_t WS_PO = 135 * MiB, WS_PO2 = 340 * MiB;
constexpr int PO_SPLIT = 14336;
constexpr int TRI = 516096;
constexpr size_t WS_GCNT = 1536 * 1024;
constexpr size_t WS_END = 352 * MiB;
constexpr int CW_BAR = 4096;
constexpr int RING_BYTES = 131072, EPI_OFF = RING_BYTES + 1024, LDS_BYTES = 163840, MISC_OFF = LDS_BYTES - 256;

#define LDS_WAIT() asm volatile("s_waitcnt lgkmcnt(0)" ::: "memory")
__device__ __forceinline__ unsigned f2bf(float f) { unsigned u = __builtin_bit_cast(unsigned, f); return (u + 0x7fffu + ((u >> 16) & 1u)) >> 16; }
__device__ __forceinline__ unsigned pk2(float lo, float hi) { return f2bf(lo) | (f2bf(hi) << 16); }

#define XB_TMO      128
#define XB_XCNT(j)  (256  + 64 * (j))
#define XB_XSUB(j)  (1280 + 64 * (j))
#define XB_XGEN(j)  (2304 + 64 * (j))
#define XB_TOP      3328
#define XB_TOPGEN   3392
#define XCD_BAR_WORDS 3456
#define XB_SPIN_CAP (1u << 18)
__device__ __forceinline__ unsigned xb_ld(unsigned* p)              { return __hip_atomic_load(p, __ATOMIC_RELAXED, __HIP_MEMORY_SCOPE_AGENT); }
__device__ __forceinline__ unsigned xb_add(unsigned* p, unsigned v) { return __hip_atomic_fetch_add(p, v, __ATOMIC_RELAXED, __HIP_MEMORY_SCOPE_AGENT); }
__device__ __forceinline__ unsigned xb_xcc_id() { return (unsigned)__builtin_amdgcn_s_getreg((3 << 11) | 20) & 0xFu; }
#define XB_SPIN(cond, bar) do { unsigned _sp = 0; while (cond) { __builtin_amdgcn_s_sleep(1); \
    if ((++_sp & 255u) == 0u) { if (xb_ld(&(bar)[XB_TMO])) break; if (_sp > XB_SPIN_CAP) { atomicAdd(&(bar)[XB_TMO], 1u); break; } } } } while (0)
struct XcdBarrier { unsigned* bar; unsigned x; volatile LAS unsigned* st; };
__device__ __forceinline__ XcdBarrier xcd_barrier_post(unsigned* bar, volatile LAS unsigned* st) {
    XcdBarrier b; b.bar = bar; b.x = xb_xcc_id(); b.st = st;
    if (threadIdx.x == 0) (void)xb_add(&bar[XB_XCNT(b.x)], 1u);
    return b;
}
__device__ __forceinline__ void xcd_barrier_complete(unsigned* bar, unsigned x, unsigned& nloc, unsigned& nx) {
    const unsigned G = gridDim.x * gridDim.y * gridDim.z;
    unsigned sum, cnt, mine, sp = 0u;
    for (;;) {
        sum = 0u; cnt = 0u; mine = 0u;
#pragma unroll
        for (unsigned j = 0; j < 16; ++j) { const unsigned c = xb_ld(&bar[XB_XCNT(j)]); sum += c; cnt += (c > 0u) ? 1u : 0u; mine = (j == x) ? c : mine; }
        if (sum == G) break;
        __builtin_amdgcn_s_sleep(1);
        if ((++sp & 255u) == 0u) { if (xb_ld(&bar[XB_TMO])) break; if (sp > XB_SPIN_CAP) { atomicAdd(&bar[XB_TMO], 1u); break; } }
    }
    nloc = mine > 0u ? mine : 1u; nx = cnt > 0u ? cnt : 1u;
}
__device__ __forceinline__ void xcd_barrier(const XcdBarrier& b) {
    asm volatile("s_waitcnt vmcnt(0)" ::: "memory");
    __syncthreads();
    if (threadIdx.x == 0) {
        unsigned* bar = b.bar;
        __builtin_amdgcn_s_waitcnt(0);
        unsigned nloc = b.st[0], nx = b.st[1];
        if (nloc == 0u) { xcd_barrier_complete(bar, b.x, nloc, nx); b.st[0] = nloc; b.st[1] = nx; }
        const unsigned old = xb_add(&bar[XB_XSUB(b.x)], 1u);
        const unsigned gen = old / nloc;
        if (old + 1u == (gen + 1u) * nloc) {
            __builtin_amdgcn_fence(__ATOMIC_RELEASE, "agent");
            asm volatile("s_waitcnt vmcnt(0)" ::: "memory");
            const unsigned og = xb_add(&bar[XB_TOP], 1u);
            const unsigned tg = og / nx;
            if (og + 1u == (tg + 1u) * nx) xb_add(&bar[XB_TOPGEN], 1u);
            else XB_SPIN(xb_ld(&bar[XB_TOPGEN]) == tg, bar);
            __builtin_amdgcn_fence(__ATOMIC_ACQUIRE, "agent");
            xb_add(&bar[XB_XGEN(b.x)], 1u);
            asm volatile("s_waitcnt vmcnt(0)" ::: "memory");
        } else {
            XB_SPIN(xb_ld(&bar[XB_XGEN(b.x)]) == gen, bar);
            __builtin_amdgcn_fence(__ATOMIC_ACQUIRE, "agent");
            asm volatile("s_waitcnt vmcnt(0)" ::: "memory");
        }
    }
    __syncthreads();
}

using pg8::sh_idx; using pg8::sh_xor; using pg8::half_sum_hi; using pg8::oct_sum;
__device__ __forceinline__ float wave_sum(float v, int lane) {
#pragma unroll
    for (int o = 1; o < 64; o <<= 1) v += sh_xor(v, o, lane);
    return v;
}
__device__ __forceinline__ void transpose_item(const float* W, int ldw, int k0, int n0, const float* gain, bf16* WT, int Kd, int d0, bf16* WT2, int d1, LAS float* scr, int lane) {
    float v_[32], g_[32];
#pragma unroll
    for (int i = 0; i < 32; ++i) { const int kk = 2 * i + (lane >> 5); v_[i] = W[(size_t)(k0 + kk) * ldw + n0 + (lane & 31)]; g_[i] = gain ? gain[k0 + kk] : 1.0f; }
#pragma unroll
    for (int i = 0; i < 32; ++i) { const int kk = 2 * i + (lane >> 5); scr[kk * 33 + (lane & 31)] = v_[i] * g_[i]; }
    LDS_WAIT(); asm volatile("" ::: "memory");
    const int c = lane & 7;
#pragma unroll
    for (int j = 0; j < 4; ++j) { const int n = (lane >> 3) + 8 * j; const LAS float* s = scr + (8 * c) * 33 + n;
        v4u o; o.x = pk2(s[0 * 33], s[1 * 33]); o.y = pk2(s[2 * 33], s[3 * 33]); o.z = pk2(s[4 * 33], s[5 * 33]); o.w = pk2(s[6 * 33], s[7 * 33]);
        *(GAS v4u*)(WT + (size_t)(d0 + n) * Kd + k0 + 8 * c) = o;
        if (WT2) *(GAS v4u*)(WT2 + (size_t)(d1 + n) * Kd + k0 + 8 * c) = o; }
    LDS_WAIT(); asm volatile("" ::: "memory");
}


typedef float f32x16 __attribute__((ext_vector_type(16)));
__device__ __forceinline__ float bf2f(unsigned short v) { return __builtin_bit_cast(float, (unsigned)v << 16); }
__device__ __forceinline__ float log_sigmoidf(float f) { return fminf(f, 0.f) - log1pf(expf(-fabsf(f))); }

__device__ __forceinline__ void mlstm_gates_item(LAS unsigned char* L, int c, const bf16* hbr, const float* wg, const float* ssn, const float* bg,
                                                 float* BCUM, float* IG, float* WGT, float* DECAY, bf16* WROW) {
    int tid_ = threadIdx.x; asm volatile("" : "+v"(tid_)); const int tid = tid_, lane = tid & 63, wave = __builtin_amdgcn_readfirstlane(tid >> 6); (void)tid; (void)lane; (void)wave;
    LAS float* Gs = (LAS float*)L;
    float w[16][8];
#pragma unroll
    for (int j = 0; j < 2; ++j)
#pragma unroll
        for (int i = 0; i < 8; ++i) { const int k = 8 * lane + 512 * j + i; const f32x4 a = *(const f32x4*)(wg + k * 8), b = *(const f32x4*)(wg + k * 8 + 4);
            w[8 * j + i][0] = a[0]; w[8 * j + i][1] = a[1]; w[8 * j + i][2] = a[2]; w[8 * j + i][3] = a[3]; w[8 * j + i][4] = b[0]; w[8 * j + i][5] = b[1]; w[8 * j + i][6] = b[2]; w[8 * j + i][7] = b[3]; }
    for (int tt = 0; tt < 8; ++tt) {
        const int tl = wave * 8 + tt, t = 64 * c + tl;
        const GAS v4u* xr = (const GAS v4u*)(hbr + (size_t)t * D) + lane;
        float a8[8] = {0.f, 0.f, 0.f, 0.f, 0.f, 0.f, 0.f, 0.f};
#pragma unroll
        for (int j = 0; j < 2; ++j) { const v4u xv = xr[64 * j];
#pragma unroll
            for (int i = 0; i < 8; ++i) { const float xf = (i & 1) ? __builtin_bit_cast(float, xv[i >> 1] & 0xffff0000u) : __builtin_bit_cast(float, xv[i >> 1] << 16);
#pragma unroll
                for (int q = 0; q < 8; ++q) a8[q] += xf * w[8 * j + i][q]; } }
        const float rs = pg8::rstd4(ssn, t);
#pragma unroll
        for (int q = 0; q < 8; ++q) { const float v = wave_sum(a8[q], lane); if (lane == 0) Gs[tl * 8 + q] = v * rs; }
    }
    LDS_WAIT(); __syncthreads();
    if (wave < 4) {
        const int h = wave, t = 64 * c + lane;
        const float gi = Gs[lane * 8 + h] + bg[h], gf = Gs[lane * 8 + 4 + h] + bg[4 + h];
        float b = log_sigmoidf(gf);
#pragma unroll
        for (int o = 1; o < 64; o <<= 1) { const float v = sh_idx(b, lane - o); if (lane >= o) b += v; }
        const float bl = sh_idx(b, 63);
        BCUM[(size_t)h * T + t] = b; IG[(size_t)h * T + t] = gi; { const float wv_ = expf(bl - b + gi); WGT[(size_t)h * T + t] = wv_; WROW[(size_t)(c * 4 + h) * 64 + lane] = (bf16)f2bf(wv_); }
        if (lane == 63) DECAY[c * 4 + h] = expf(bl);
    }
    LDS_WAIT(); __syncthreads();
}

__device__ __forceinline__ bf16x8 scale_bf16x8(bf16x8 v, bf16x8 wv) {
    typedef unsigned u4 __attribute__((ext_vector_type(4)));
    const u4 u = __builtin_bit_cast(u4, v), w = __builtin_bit_cast(u4, wv); u4 o;
#pragma unroll
    for (int i = 0; i < 4; ++i)
        o[i] = pg8::cvt_pk_bf16(__builtin_bit_cast(float, u[i] << 16) * __builtin_bit_cast(float, w[i] << 16), __builtin_bit_cast(float, u[i] & 0xffff0000u) * __builtin_bit_cast(float, w[i] & 0xffff0000u));
    return __builtin_bit_cast(bf16x8, o);
}
__device__ __forceinline__ void mlstm_scan(const bf16* KVT, const float* DECAY, bf16* CT, bf16* NCT, const bf16* WROW, const bf16* ZROW, int G, bool probe_same = false) {
    int tid_ = threadIdx.x; asm volatile("" : "+v"(tid_)); const int tid = tid_, lane = tid & 63, wave = __builtin_amdgcn_readfirstlane(tid >> 6); (void)tid;
    bool active, ntask; int h, e0, d0;
    if (G == 256) { const int x = (int)blockIdx.x & 7, cu = (int)blockIdx.x >> 3; h = x >> 1;
        if (wave < 2) { const int k = wave * 32 + cu; active = true; ntask = false; e0 = (x & 1) * 128 + (k >> 3) * 16; d0 = (k & 7) * 16; }
        else { active = (wave == 2) && ((x & 1) == 0) && (cu < 8); ntask = true; e0 = 0; d0 = (cu & 7) * 16; }
    } else { const int gw = wave * G + (int)blockIdx.x; active = gw < 544; ntask = gw >= 512;
        if (!ntask) { h = gw >> 7; e0 = ((gw >> 3) & 15) * 16; d0 = (gw & 7) * 16; } else { const int q = gw - 512; h = (q >> 3) & 3; e0 = 0; d0 = (q & 7) * 16; } }
    if (probe_same) { h = 0; e0 = 0; d0 = 0; }
    if (active) {
        const int fr = lane & 15, fq = lane >> 4;
        const bf16* arow = KVT + (size_t)((h * 8 + (d0 >> 4)) * 2) * 512 + lane * 8;
        const bf16* brow = ntask ? ((fr == 0 ? WROW + h * 64 : ZROW) + 8 * fq) : (KVT + (size_t)((32 + h * 16 + (e0 >> 4)) * 2) * 512 + lane * 8);
        bf16* crow = ntask ? (NCT + ((size_t)h * 16 + fr) * 128 + d0 + 4 * fq) : (CT + ((size_t)(h * 8 + (e0 >> 5)) * 8 + (d0 >> 4)) * 512 + ((fq >> 1) * 32 + (e0 & 16) + fr) * 8 + 4 * (fq & 1));
        const size_t cstep = probe_same ? (size_t)0 : (ntask ? (size_t)4 * 16 * 128 : (size_t)4 * 256 * 128);
        const float* drow = DECAY + h;
        const size_t bstep = ntask ? (fr == 0 ? (size_t)256 : (size_t)0) : (size_t)1536 * 64;
        constexpr int P = 8;
        bf16x8 sa[P][2], sb[P][2]; float sd[P];
        const char* pa = (const char*)arow; const char* pb = (const char*)brow; const size_t b2off = ntask ? 64 : 1024;     const char* pd = (const char*)(DECAY + h); char* pc = (char*)crow;
        const size_t astep = (size_t)1536 * 64 * 2, bstepb = bstep * 2, cstepb = cstep * 2;
#define SC_LD16(dst, ptr, OFF) asm volatile("global_load_dwordx4 %0, %1, off offset:" #OFF : "=&v"(dst) : "v"(ptr) : "memory")
#define SC_LD4(dst, ptr) asm volatile("global_load_dword %0, %1, off" : "=&v"(dst) : "v"(ptr) : "memory")
#define SC_LOADS(j) do { SC_LD16(sa[j][0], pa, 0); SC_LD16(sa[j][1], pa, 1024); { const char* pb2_ = pb + b2off; SC_LD16(sb[j][0], pb, 0); SC_LD16(sb[j][1], pb2_, 0); } SC_LD4(sd[j], pd); pa += astep; pb += bstepb; pd += 16; } while (0)
#pragma unroll
        for (int j = 0; j < P; ++j) { float dm_; SC_LD4(dm_, pd); SC_LOADS(j); }
        f32x4 acc = (f32x4){0.f, 0.f, 0.f, 0.f};
        for (int c0 = 0; c0 < 256; c0 += P) {
#pragma unroll
            for (int j = 0; j < P; ++j) {
                asm volatile("s_waitcnt vmcnt(42)" : "+v"(sa[j][0]), "+v"(sa[j][1]), "+v"(sb[j][0]), "+v"(sb[j][1]), "+v"(sd[j]) :: "memory");
                { typedef unsigned u2 __attribute__((ext_vector_type(2))); u2 o; o.x = pg8::cvt_pk_bf16(acc[0], acc[1]); o.y = pg8::cvt_pk_bf16(acc[2], acc[3]);
                  if (!probe_same) asm volatile("global_store_dwordx2 %0, %1, off" :: "v"(pc), "v"(o) : "memory"); else { float dm2_; asm volatile("global_load_dword %0, %1, off" : "=&v"(dm2_) : "v"(pd), "v"(o) : "memory"); }
                  pc += cstepb; }
                acc = acc * sd[j];
                acc = __builtin_amdgcn_mfma_f32_16x16x32_bf16(sa[j][0], sb[j][0], acc, 0, 0, 0);
                acc = __builtin_amdgcn_mfma_f32_16x16x32_bf16(sa[j][1], sb[j][1], acc, 0, 0, 0);
                asm volatile("" : "+v"(acc));
                SC_LOADS(j);
            }
        }
        asm volatile("s_waitcnt vmcnt(0)" ::: "memory");
#undef SC_LD16
#undef SC_LD4
#undef SC_LOADS
    }
}

constexpr int M3_BUF = 36864;
constexpr int M3_QS = 0, M3_KS = 17408, M3_BC = 35840, M3_IG = 36096, M3_NV = 36352;
constexpr int M3_SS = 73728, M3_DQ = 82944, M3_DSP = 83200, M3_OS = 83968  ;
__device__ __forceinline__ void mlstm_out_phase(LAS unsigned char* L, int G, const bf16* Q, const bf16* K, const bf16* KVT, const bf16* CT, const bf16* NCT,
                                                const float* BCUM, const float* WGT, const bf16* OG, const float* hn, bf16* HG) {
    int tid_ = threadIdx.x; asm volatile("" : "+v"(tid_)); const int tid = tid_, lane = tid & 63, wave = __builtin_amdgcn_readfirstlane(tid >> 6);
    const int r = lane & 31, hh = lane >> 5;
    LAS float* dq = (LAS float*)(L + M3_DQ); LAS float* dsp = (LAS float*)(L + M3_DSP); LAS float* OS = (LAS float*)(L + M3_OS);
    int it = (int)blockIdx.x; if (it >= 1024) return;
    bf16x8 ctf[8], vtf[4]; v4u ogf[4]; v4u qk[4]; float sm = 0.f;
#define M3_LD_CT(c_, h_) do { const bf16* ctp = CT + (((size_t)((c_) * 4 + (h_)) * 8 + wave) * 8) * 512 + lane * 8; _Pragma("unroll") for (int kk = 0; kk < 8; ++kk) ctf[kk] = *(const bf16x8*)(ctp + 512 * kk); } while (0)
#define M3_LD_VT(c_, h_) do { const bf16* vtp = KVT + (((size_t)(c_) * 96 + 32 + (h_) * 16 + 2 * wave + (r >> 4)) * 2) * 512 + (hh * 16 + (r & 15)) * 8; _Pragma("unroll") for (int kk = 0; kk < 4; ++kk) vtf[kk] = *(const bf16x8*)(vtp + (kk >> 1) * 512 + (kk & 1) * 256); } while (0)
#define M3_LD_OG(c_, h_) do { const bf16* ogp = OG + (size_t)(64 * (c_) + (tid >> 3)) * 1024 + (h_) * 256 + 8 * (tid & 7); _Pragma("unroll") for (int k = 0; k < 4; ++k) ogf[k] = *(const GAS v4u*)(ogp + 64 * k); } while (0)
#define M3_LD_QK(c_, h_) do { _Pragma("unroll") for (int j = 0; j < 4; ++j) { const int i = tid + 512 * j, which = i >> 10, idx = i & 1023, row = idx >> 4, ch = idx & 15; \
            qk[j] = which ? *(const GAS v4u*)(KVT + (((size_t)(c_) * 96 + (h_) * 8) * 2) * 512 + idx * 8) : *(const GAS v4u*)(Q + (size_t)(64 * (c_) + row) * 512 + (h_) * 128 + ch * 8); } \
        if (tid < 64) sm = BCUM[(size_t)(h_) * T + 64 * (c_) + tid]; else if (tid < 128) sm = WGT[(size_t)(h_) * T + 64 * (c_) + tid - 64]; else if (tid < 256) sm = bf2f(NCT[(size_t)((c_) * 4 + (h_)) * 16 * 128 + tid - 128]); } while (0)
#define M3_ST_QK(B_) do { _Pragma("unroll") for (int j = 0; j < 4; ++j) { const int i = tid + 512 * j, which = i >> 10, idx = i & 1023, row = idx >> 4, ch = idx & 15; if (which) { const int bi_ = idx >> 6, lp_ = idx & 63; *(LAS v4u*)((B_) + M3_KS + (16 * (bi_ >> 1) + (lp_ & 15)) * 144 + (32 * (bi_ & 1) + 8 * (lp_ >> 4)) * 2) = qk[j]; } \
            else *(LAS v4u*)((B_) + row * 272 + ch * 16) = qk[j]; } \
        if (tid < 256) ((LAS float*)((B_) + M3_BC))[tid] = sm; } while (0)
    { const int c = it >> 2, h = it & 3; M3_LD_CT(c, h); M3_LD_VT(c, h); M3_LD_OG(c, h); M3_LD_QK(c, h); M3_ST_QK(L); }
    LDS_WAIT(); __syncthreads();
    int pb = 0;
    for (;;) {
        const int c = it >> 2, h = it & 3, t0 = 64 * c, itn = it + G; const bool has_next = itn < 1024; const int cn = itn >> 2, hn_ = itn & 3;
        LAS unsigned char* B = L + pb * M3_BUF; LAS unsigned char* Bn = L + (pb ^ 1) * M3_BUF;
        LAS float* bc = (LAS float*)(B + M3_BC); LAS float* ig = (LAS float*)(B + M3_IG); LAS float* nv = (LAS float*)(B + M3_NV);
        if (has_next) M3_LD_QK(cn, hn_);
        f32x16 O[2];
#pragma unroll
        for (int i = 0; i < 16; ++i) { O[0][i] = 0.f; O[1][i] = 0.f; }
#pragma unroll
        for (int kk = 0; kk < 8; ++kk) {
            const bf16x8 a0 = *(const LAS bf16x8*)(B + M3_QS + r * 272 + (16 * kk + 8 * hh) * 2), a1 = *(const LAS bf16x8*)(B + M3_QS + (32 + r) * 272 + (16 * kk + 8 * hh) * 2);
            O[0] = __builtin_amdgcn_mfma_f32_32x32x16_bf16(a0, ctf[kk], O[0], 0, 0, 0); O[1] = __builtin_amdgcn_mfma_f32_32x32x16_bf16(a1, ctf[kk], O[1], 0, 0, 0);
        }
        if (has_next) M3_LD_CT(cn, hn_);
        if (wave < 4) {
            const int tt = wave >> 1, s2 = wave & 1; f32x16 S;
#pragma unroll
            for (int i = 0; i < 16; ++i) S[i] = 0.f;
#pragma unroll
            for (int kk = 0; kk < 8; ++kk) {
                const bf16x8 a = *(const LAS bf16x8*)(B + M3_QS + (32 * tt + r) * 272 + (16 * kk + 8 * hh) * 2);
                typedef short v4i16_t __attribute__((ext_vector_type(4)));
                const int i16 = lane & 15, q4 = i16 >> 2, p4 = i16 & 3, blk = (lane >> 4) & 1;
                LAS unsigned char* tb = B + M3_KS + (16 * kk + 8 * hh + q4) * 144 + (32 * s2 + 16 * blk + 4 * p4) * 2;
                const v4i16_t lo = __builtin_amdgcn_ds_read_tr16_b64_v4i16((LAS v4i16_t*)tb), hi = __builtin_amdgcn_ds_read_tr16_b64_v4i16((LAS v4i16_t*)(tb + 4 * 144));
                const bf16x8 b = __builtin_shufflevector(lo, hi, 0, 1, 2, 3, 4, 5, 6, 7);
                S = __builtin_amdgcn_mfma_f32_32x32x16_bf16(a, b, S, 0, 0, 0);
            }
            const int s = 32 * s2 + r; const float ws = ig[s], bl = bc[63];
#pragma unroll
            for (int i = 0; i < 16; ++i) {
                const int t = 32 * tt + (i & 3) + 8 * (i >> 2) + 4 * hh;
                const float v = (s <= t) ? S[i] * __expf(bc[t] - bl) : 0.f;
                const float rsum = half_sum_hi(v * ws);
                if (r == 16) dsp[s2 * 64 + t] = rsum;
                *(LAS unsigned short*)(L + M3_SS + t * 144 + s * 2) = (unsigned short)f2bf(v);
            }
        } else {
            const int th = tid - 256, t = th >> 2, part = th & 3; float sum = 0.f;
#pragma unroll 8
            for (int d = 0; d < 32; ++d) sum += bf2f(*(const LAS unsigned short*)(B + M3_QS + t * 272 + (32 * part + d) * 2)) * nv[32 * part + d];
            sum = pg8::dpp_add<0xB1>(sum); sum = pg8::dpp_add<0x4E>(sum);
            if (part == 0) dq[t] = sum;
        }
        LDS_WAIT(); __syncthreads();
#pragma unroll
        for (int tt = 0; tt < 2; ++tt)
#pragma unroll
            for (int i = 0; i < 16; ++i) O[tt][i] *= __expf(bc[32 * tt + (i & 3) + 8 * (i >> 2) + 4 * hh]);
#pragma unroll
        for (int kk = 0; kk < 4; ++kk) {
            const bf16x8 a0 = *(const LAS bf16x8*)(L + M3_SS + r * 144 + (16 * kk + 8 * hh) * 2), a1 = *(const LAS bf16x8*)(L + M3_SS + (32 + r) * 144 + (16 * kk + 8 * hh) * 2);
            O[0] = __builtin_amdgcn_mfma_f32_32x32x16_bf16(a0, vtf[kk], O[0], 0, 0, 0); O[1] = __builtin_amdgcn_mfma_f32_32x32x16_bf16(a1, vtf[kk], O[1], 0, 0, 0);
        }
        if (has_next) M3_LD_VT(cn, hn_);
#pragma unroll
        for (int tt = 0; tt < 2; ++tt)
#pragma unroll
            for (int i = 0; i < 16; ++i) OS[(32 * tt + (i & 3) + 8 * (i >> 2) + 4 * hh) * 260 + 32 * wave + r] = O[tt][i];
        LDS_WAIT(); __syncthreads();
        {
            const int t = tid >> 3, part = tid & 7;
            const float den = __expf(bc[t]) * dq[t] + dsp[t] + dsp[64 + t];
            const float inv = __builtin_amdgcn_rcpf(fmaxf(fabsf(den), 1.0f));
            f32x4 v[8]; float ssq = 0.f;
#pragma unroll
            for (int k = 0; k < 8; ++k) { v[k] = *(const LAS f32x4*)(OS + t * 260 + 64 * (k >> 1) + 8 * part + 4 * (k & 1)) * inv; ssq += (v[k][0] * v[k][0] + v[k][1] * v[k][1]) + (v[k][2] * v[k][2] + v[k][3] * v[k][3]); }
            ssq = oct_sum(ssq);
            const float rsn = rsqrtf(ssq * (1.0f / 256.0f) + 1e-6f);
            const float* gp = hn + h * 256 + 8 * part;
            bf16* op = HG + (size_t)(t0 + t) * 1024 + h * 256 + 8 * part;
#pragma unroll
            for (int k = 0; k < 4; ++k) {
                const f32x4 g0 = *(const f32x4*)(gp + 64 * k), g1 = *(const f32x4*)(gp + 64 * k + 4);
                float o8[8];
#pragma unroll
                for (int x2 = 0; x2 < 4; ++x2) {
                    const float og0 = __builtin_bit_cast(float, ogf[k][x2] << 16), og1 = __builtin_bit_cast(float, ogf[k][x2] & 0xffff0000u);
                    const float a0 = (2 * x2 < 4) ? v[2 * k][2 * x2] : v[2 * k + 1][2 * x2 - 4], a1 = (2 * x2 + 1 < 4) ? v[2 * k][2 * x2 + 1] : v[2 * k + 1][2 * x2 + 1 - 4];
                    const float gg0 = (2 * x2 < 4) ? g0[2 * x2] : g1[2 * x2 - 4], gg1 = (2 * x2 + 1 < 4) ? g0[2 * x2 + 1] : g1[2 * x2 + 1 - 4];
                    o8[2 * x2] = a0 * rsn * gg0 * __builtin_amdgcn_rcpf(1.0f + __builtin_amdgcn_exp2f(-1.4426950408889634f * og0)); o8[2 * x2 + 1] = a1 * rsn * gg1 * __builtin_amdgcn_rcpf(1.0f + __builtin_amdgcn_exp2f(-1.4426950408889634f * og1)); }
                v4u w; w.x = pg8::cvt_pk_bf16(o8[0], o8[1]); w.y = pg8::cvt_pk_bf16(o8[2], o8[3]); w.z = pg8::cvt_pk_bf16(o8[4], o8[5]); w.w = pg8::cvt_pk_bf16(o8[6], o8[7]);
                *(GAS v4u*)(op + 64 * k) = w; }
        }
        if (has_next) { M3_LD_OG(cn, hn_); M3_ST_QK(Bn); }
        LDS_WAIT(); __syncthreads();
        if (!has_next) break;
        it = itn; pb ^= 1;
    }
#undef M3_LD_CT
#undef M3_LD_VT
#undef M3_LD_OG
#undef M3_LD_QK
#undef M3_ST_QK
}

constexpr int AT_QS = 0, AT_PS = 34816, AT_PM = 102400, AT_PSUM = 106496, AT_ENT = 110592, AT_W = 111104, AT_MX = 113152, AT_PRE = 113664  , AT_WT = 115744;
constexpr int GT_KH = 34816, GT_KL = 52224, GT_SC = 69632, GT_LCNT = 102912, GT_BASE = 103168;
__device__ __forceinline__ int list_off(int h, int b) { return h * TRI + b * T - 128 * b * (b + 1); }
__device__ __forceinline__ void moba_gate_phase(LAS unsigned char* L, int G, const bf16* AQ, const float* KMEAN, int* gcnt, int* LIST) {
    int tid_ = threadIdx.x; asm volatile("" : "+v"(tid_)); const int tid = tid_, lane = tid & 63, wave = __builtin_amdgcn_readfirstlane(tid >> 6);
    const int r = lane & 31, hh = lane >> 5;
    LAS int* LCNT = (LAS int*)(L + GT_LCNT); LAS int* BASE = (LAS int*)(L + GT_BASE); LAS float* SC = (LAS float*)(L + GT_SC);
    int h_loaded = -1;
    int it = (int)blockIdx.x;
    while (it < 1024 && (it >> 4) == 0) it += G;
    if (it >= 1024) return;
    v4u qn[4];
#pragma unroll
    for (int j = 0; j < 4; ++j) { const int i = tid + 512 * j, rl = i >> 4, ch = i & 15; qn[j] = *(const GAS v4u*)(AQ + (size_t)(128 * (it >> 3) + rl) * 1024 + (it & 7) * 128 + ch * 8); }
    for (;;) {
        const int qi = it >> 3, h = it & 7, cur = qi >> 1;
        int itn = it + G; const bool has_next = itn < 1024;
        if (h != h_loaded) {
            for (int i = tid; i < 64 * 128; i += 512) { const int bb = i >> 7, d = i & 127; const float v = KMEAN[((size_t)h * 64 + bb) * 128 + d];
                const unsigned hi = f2bf(v), lo = f2bf(v - bf2f((unsigned short)hi));
                *(LAS unsigned short*)(L + GT_KH + bb * 272 + d * 2) = (unsigned short)hi; *(LAS unsigned short*)(L + GT_KL + bb * 272 + d * 2) = (unsigned short)lo; }
            h_loaded = h; }
#pragma unroll
        for (int j = 0; j < 4; ++j) { const int i = tid + 512 * j, rl = i >> 4, ch = i & 15; *(LAS v4u*)(L + AT_QS + rl * 272 + ch * 16) = qn[j]; }
        if (tid < 64) LCNT[tid] = 0;
        LDS_WAIT(); __syncthreads();
        if (has_next) {
#pragma unroll
            for (int j = 0; j < 4; ++j) { const int i = tid + 512 * j, rl = i >> 4, ch = i & 15; qn[j] = *(const GAS v4u*)(AQ + (size_t)(128 * (itn >> 3) + rl) * 1024 + (itn & 7) * 128 + ch * 8); }
        }
        {   const int tt = wave >> 1, bt = wave & 1; f32x16 S;
#pragma unroll
            for (int i = 0; i < 16; ++i) S[i] = 0.f;
#pragma unroll
            for (int kk = 0; kk < 8; ++kk) {
                const bf16x8 a = *(const LAS bf16x8*)(L + AT_QS + (32 * tt + r) * 272 + (16 * kk + 8 * hh) * 2);
                const bf16x8 bh = *(const LAS bf16x8*)(L + GT_KH + (32 * bt + r) * 272 + (16 * kk + 8 * hh) * 2), bl = *(const LAS bf16x8*)(L + GT_KL + (32 * bt + r) * 272 + (16 * kk + 8 * hh) * 2);
                S = __builtin_amdgcn_mfma_f32_32x32x16_bf16(a, bh, S, 0, 0, 0); S = __builtin_amdgcn_mfma_f32_32x32x16_bf16(a, bl, S, 0, 0, 0);
            }
#pragma unroll
            for (int i = 0; i < 16; ++i) SC[(32 * tt + (i & 3) + 8 * (i >> 2) + 4 * hh) * 65 + 32 * bt + r] = S[i];
        }
        LDS_WAIT(); __syncthreads();
        int p0 = -1, p1 = -1, p2 = -1, l0 = 0, l1 = 0, l2 = 0; const int nsel = cur < 3 ? cur : 3;
        if (tid < 128) {
            float v0 = -INFINITY, v1 = -INFINITY, v2 = -INFINITY;
            for (int b = 0; b < cur; ++b) { const float sc = SC[tid * 65 + b];
                if (sc > v0) { v2 = v1; p2 = p1; v1 = v0; p1 = p0; v0 = sc; p0 = b; }
                else if (sc > v1) { v2 = v1; p2 = p1; v1 = sc; p1 = b; }
                else if (sc > v2) { v2 = sc; p2 = b; } }
            if (nsel > 0 && p0 >= 0) l0 = __hip_atomic_fetch_add(LCNT + p0, 1, __ATOMIC_RELAXED, __HIP_MEMORY_SCOPE_WORKGROUP);
            if (nsel > 1 && p1 >= 0) l1 = __hip_atomic_fetch_add(LCNT + p1, 1, __ATOMIC_RELAXED, __HIP_MEMORY_SCOPE_WORKGROUP);
            if (nsel > 2 && p2 >= 0) l2 = __hip_atomic_fetch_add(LCNT + p2, 1, __ATOMIC_RELAXED, __HIP_MEMORY_SCOPE_WORKGROUP);
        }
        LDS_WAIT(); __syncthreads();
        if (tid < cur) { const int n = LCNT[tid]; if (n > 0) BASE[tid] = __hip_atomic_fetch_add(gcnt + h * 64 + tid, n, __ATOMIC_RELAXED, __HIP_MEMORY_SCOPE_AGENT); }
        LDS_WAIT(); __syncthreads();
        if (tid < 128) { const int tg = (128 * qi + tid) << 2;
            if (nsel > 0 && p0 >= 0) LIST[list_off(h, p0) + BASE[p0] + l0] = tg | 0;
            if (nsel > 1 && p1 >= 0) LIST[list_off(h, p1) + BASE[p1] + l1] = tg | 1;
            if (nsel > 2 && p2 >= 0) LIST[list_off(h, p2) + BASE[p2] + l2] = tg | 2; }
        LDS_WAIT(); __syncthreads();
        if (!has_next) break;
        it = itn;
    }
}

constexpr int AP_QS0 = 0, AP_QS1 = 34816, AP_PS = 69632, AP_PM = 137216, AP_PSUM = 141312, AP_ENT0 = 145408, AP_ENT1 = 145920, AP_W = 146432, AP_MX = 148480, AP_PRE = 148992  , AP_WT = 151072;
struct AItem { int h, b, row0, nrows, qi; const int* list; bool valid; };
template <bool OWN>
__device__ __forceinline__ AItem attn_get(int k, int G, const LAS int* PRE, int total, const int* gcnt, const int* LIST) {
    AItem it; const int idx = (int)blockIdx.x + k * G;
    if (OWN) { it.valid = idx < 1024; it.qi = idx >> 3; it.h = idx & 7; it.b = it.qi >> 1; it.row0 = 128 * it.qi; it.nrows = 128; it.list = nullptr; }
    else {
        it.valid = idx < total; it.qi = 0; int lo = 0, hi = 512;
        if (it.valid) { while (hi - lo > 1) { const int mid = (lo + hi) >> 1; if (PRE[mid] <= idx) lo = mid; else hi = mid; } }
        const int hb = lo; it.h = hb >> 6; it.b = hb & 63; const int i = it.valid ? idx - PRE[hb] : 0, n = it.valid ? gcnt[hb] : 0;
        it.row0 = 128 * i; it.nrows = (n - 128 * i) < 128 ? (n - 128 * i) : 128; it.list = LIST + list_off(it.h, it.b);
    }
    return it;
}
template <bool OWN>
__device__ __forceinline__ void attn_phase(LAS unsigned char* L, int G, const int* gcnt, const int* LIST, const bf16* AQ, const bf16* XK, const bf16* XVT, bf16* PO, float* ML, bf16* AOUT, int tmask, int probe = 0) {
    int tid_ = threadIdx.x; asm volatile("" : "+v"(tid_)); const int tid = tid_, lane = tid & 63, wave = __builtin_amdgcn_readfirstlane(tid >> 6);
    const int r = lane & 31, hh = lane >> 5;
    LAS int* PRE = (LAS int*)(L + AP_PRE); LAS int* WT = (LAS int*)(L + AP_WT);
    LAS float* PM = (LAS float*)(L + AP_PM); LAS float* PSUM = (LAS float*)(L + AP_PSUM); LAS float* MX = (LAS float*)(L + AP_MX); LAS float* W = (LAS float*)(L + AP_W);
    int total = 0;
    if (!OWN) {
        int v = (gcnt[tid] + 127) >> 7;
#pragma unroll
        for (int o = 1; o < 64; o <<= 1) { const int u = __builtin_amdgcn_ds_bpermute((lane - o) << 2, v); if (lane >= o) v += u; }
        if (lane == 63) WT[wave] = v;
        LDS_WAIT(); __syncthreads();
        int add = 0;
#pragma unroll
        for (int w8 = 0; w8 < 8; ++w8) if (w8 < wave) add += WT[w8];
        PRE[tid + 1] = v + add; if (tid == 0) PRE[0] = 0;
        LDS_WAIT(); __syncthreads();
        total = PRE[512];
    }
    AItem cur = attn_get<OWN>(0, G, PRE, total, gcnt, LIST);
    if (!cur.valid) return;
    int pb = 0;
    {   LAS int* ENT = (LAS int*)(L + AP_ENT0);
        if (!OWN) { if (tid < 128) ENT[tid] = (tid < cur.nrows) ? cur.list[cur.row0 + tid] : -1; LDS_WAIT(); __syncthreads(); }
        for (int i = tid; i < 2048; i += 512) { const int rl = i >> 4, ch = i & 15; int t;
            if (OWN) t = cur.row0 + rl; else { const int e = ENT[rl]; t = e >= 0 ? (e >> 2) : 0; }
            const v4u v = *(const GAS v4u*)(AQ + (size_t)t * 1024 + cur.h * 128 + ch * 8); *(LAS v4u*)(L + AP_QS0 + rl * 272 + ch * 16) = v; }
        LDS_WAIT(); __syncthreads();
    }
    for (int k = 0; ; ++k) {
        const AItem nxt = attn_get<OWN>(k + 1, G, PRE, total, gcnt, LIST);
        const int h = (probe & 2) ? 0 : cur.h, b = (probe & 2) ? 0 : cur.b, qi = cur.qi, row0 = cur.row0;
        LAS unsigned char* Qc = L + (pb ? AP_QS1 : AP_QS0); LAS unsigned char* Qn = L + (pb ? AP_QS0 : AP_QS1);
        LAS int* ENT = (LAS int*)(L + (pb ? AP_ENT1 : AP_ENT0)); LAS int* ENTn = (LAS int*)(L + (pb ? AP_ENT0 : AP_ENT1));
        const int dt = wave & 3, tp = wave >> 2;
        bf16x8 kf[8], vf[16];
        {   const bf16* kp = XK + (((size_t)(b * 8 + h) * 8 + wave) * 8) * 512 + lane * 8;
#pragma unroll
            for (int kk = 0; kk < 8; ++kk) kf[kk] = *(const bf16x8*)(kp + 512 * kk);
            const bf16* vp = XVT + (((size_t)(b * 8 + h) * 4 + dt) * 16) * 512 + lane * 8;
#pragma unroll
            for (int kk = 0; kk < 16; ++kk) vf[kk] = *(const bf16x8*)(vp + 512 * kk);
        }
        int e_n = -1;
        if (!OWN && nxt.valid && tid < 128 && tid < nxt.nrows) e_n = nxt.list[nxt.row0 + tid];
        f32x16 S[4];
#pragma unroll
        for (int tq = 0; tq < 4; ++tq) {
#pragma unroll
            for (int i = 0; i < 16; ++i) S[tq][i] = 0.f;
#pragma unroll
            for (int kk = 0; kk < 8; ++kk) { const bf16x8 bq = *(const LAS bf16x8*)(Qc + (32 * tq + r) * 272 + (16 * kk + 8 * hh) * 2);
                S[tq] = __builtin_amdgcn_mfma_f32_32x32x16_bf16(kf[kk], bq, S[tq], 0, 0, 0); }
        }
#pragma unroll
        for (int tq = 0; tq < 4; ++tq) {
            const int t = 32 * tq + r; float ps = 0.f;
#pragma unroll
            for (int i = 0; i < 16; ++i) {
                float sv = S[tq][i];
                if (OWN) { const int key = 32 * wave + (i & 3) + 8 * (i >> 2) + 4 * hh, lim = (qi & 1) * 128 + t; if (key > lim) sv = -INFINITY; }
                const float p = __builtin_amdgcn_exp2f(sv); S[tq][i] = p; ps += p; }
            ps += sh_xor(ps, 32, lane);
            if (hh == 0) PSUM[wave * 128 + t] = ps;
#pragma unroll
            for (int g = 0; g < 4; ++g) { pg8::u32x2 w2; w2.x = pg8::cvt_pk_bf16(S[tq][4 * g], S[tq][4 * g + 1]); w2.y = pg8::cvt_pk_bf16(S[tq][4 * g + 2], S[tq][4 * g + 3]);
                *(LAS pg8::u32x2*)(L + AP_PS + t * 528 + (32 * wave + 8 * g + 4 * hh) * 2) = w2; }
        }
        if (!OWN && tid < 128) ENTn[tid] = e_n;
        LDS_WAIT(); __syncthreads();
        v4u qn[4];
        if (nxt.valid) {
#pragma unroll
            for (int j = 0; j < 4; ++j) { const int i = tid + 512 * j, rl = i >> 4, ch = i & 15; int t;
                if (OWN) t = nxt.row0 + rl; else { const int e = ENTn[rl]; t = e >= 0 ? (e >> 2) : 0; if (probe & 4) t = rl; }
                qn[j] = *(const GAS v4u*)(AQ + (size_t)t * 1024 + nxt.h * 128 + ch * 8); }
        }
        f32x16 O[2];
#pragma unroll
        for (int i = 0; i < 16; ++i) { O[0][i] = 0.f; O[1][i] = 0.f; }
#pragma unroll
        for (int kk = 0; kk < 16; ++kk) {
            const bf16x8 a0 = *(const LAS bf16x8*)(L + AP_PS + (64 * tp + r) * 528 + (16 * kk + 8 * hh) * 2), a1 = *(const LAS bf16x8*)(L + AP_PS + (64 * tp + 32 + r) * 528 + (16 * kk + 8 * hh) * 2);
            O[0] = __builtin_amdgcn_mfma_f32_32x32x16_bf16(a0, vf[kk], O[0], 0, 0, 0); O[1] = __builtin_amdgcn_mfma_f32_32x32x16_bf16(a1, vf[kk], O[1], 0, 0, 0);
        }
        const int curb = qi >> 1, nsel = curb < 3 ? curb : 3;
        if (OWN) {
            if (tid < 128) { const int t = row0 + tid; float Lo = 0.f;
#pragma unroll
                for (int w8 = 0; w8 < 8; ++w8) Lo += PSUM[w8 * 128 + tid];
                float den = Lo;
#pragma unroll
                for (int j = 0; j < 3; ++j) if (j < nsel) den += ML[((size_t)(t * 8 + h) * 3 + j) * 2 + 1];
                const float inv = 1.0f / den;
                W[tid * 4 + 0] = inv; W[tid * 4 + 1] = nsel > 0 ? inv : 0.f; W[tid * 4 + 2] = nsel > 1 ? inv : 0.f; W[tid * 4 + 3] = nsel > 2 ? inv : 0.f; }
        }
        LDS_WAIT(); __syncthreads();
        {   LAS float* OS = (LAS float*)(L + AP_PS);
#pragma unroll
            for (int q = 0; q < 2; ++q)
#pragma unroll
                for (int i = 0; i < 16; ++i) OS[(64 * tp + 32 * q + (i & 3) + 8 * (i >> 2) + 4 * hh) * 132 + 32 * dt + r] = O[q][i];
        }
        LDS_WAIT(); __syncthreads();
        {   const LAS float* OS = (const LAS float*)(L + AP_PS);
            const int rl = tid >> 2, c4 = tid & 3;
            if (!OWN) {
                const int e = (probe & 1) ? -1 : ENT[rl];
                if (e >= 0) {
                    const int te = e >> 2; bf16* dst = (te < PO_SPLIT ? PO : PO + (WS_PO2 - WS_PO) / 2 - (size_t)PO_SPLIT * 3072) + ((size_t)(te * 8 + h) * 3 + (e & 3)) * 128;
#pragma unroll
                    for (int kq = 0; kq < 4; ++kq) { const int ch = c4 + 4 * kq; const f32x4 a = *(const LAS f32x4*)(OS + rl * 132 + ch * 8), b2 = *(const LAS f32x4*)(OS + rl * 132 + ch * 8 + 4);
                        v4u w; w.x = pg8::cvt_pk_bf16(a[0], a[1]); w.y = pg8::cvt_pk_bf16(a[2], a[3]); w.z = pg8::cvt_pk_bf16(b2[0], b2[1]); w.w = pg8::cvt_pk_bf16(b2[2], b2[3]);
                        *(GAS v4u*)(dst + ch * 8) = w; }
                    if (c4 == 0) { float Ls = 0.f;
#pragma unroll
                        for (int w8 = 0; w8 < 8; ++w8) Ls += PSUM[w8 * 128 + rl];
                        float* ml = ML + ((size_t)((e >> 2) * 8 + h) * 3 + (e & 3)) * 2; ml[0] = 0.f; ml[1] = Ls; }
                }
            } else {
                const int t = row0 + rl; const f32x4 w4 = *(const LAS f32x4*)(W + rl * 4);
                const bf16* po = (t < PO_SPLIT ? PO : PO + (WS_PO2 - WS_PO) / 2 - (size_t)PO_SPLIT * 3072) + ((size_t)(t * 8 + h) * 3) * 128;
                const unsigned m0 = nsel > 0 ? 0xffffffffu : 0u, m1 = nsel > 1 ? 0xffffffffu : 0u, m2 = nsel > 2 ? 0xffffffffu : 0u;
#pragma unroll
                for (int kq = 0; kq < 4; ++kq) { const int ch = c4 + 4 * kq;
                    const f32x4 a = *(const LAS f32x4*)(OS + rl * 132 + ch * 8), b2 = *(const LAS f32x4*)(OS + rl * 132 + ch * 8 + 4);
                    v4u p0 = *(const GAS v4u*)(po + ch * 8), p1 = *(const GAS v4u*)(po + 128 + ch * 8), p2 = *(const GAS v4u*)(po + 256 + ch * 8);
                    p0 = p0 & m0; p1 = p1 & m1; p2 = p2 & m2;
                    float o8[8] = {a[0] * w4[0], a[1] * w4[0], a[2] * w4[0], a[3] * w4[0], b2[0] * w4[0], b2[1] * w4[0], b2[2] * w4[0], b2[3] * w4[0]};
#pragma unroll
                    for (int x2 = 0; x2 < 4; ++x2) {
                        o8[2 * x2] += w4[1] * __builtin_bit_cast(float, p0[x2] << 16) + w4[2] * __builtin_bit_cast(float, p1[x2] << 16) + w4[3] * __builtin_bit_cast(float, p2[x2] << 16);
                        o8[2 * x2 + 1] += w4[1] * __builtin_bit_cast(float, p0[x2] & 0xffff0000u) + w4[2] * __builtin_bit_cast(float, p1[x2] & 0xffff0000u) + w4[3] * __builtin_bit_cast(float, p2[x2] & 0xffff0000u); }
                    v4u w; w.x = pg8::cvt_pk_bf16(o8[0], o8[1]); w.y = pg8::cvt_pk_bf16(o8[2], o8[3]); w.z = pg8::cvt_pk_bf16(o8[4], o8[5]); w.w = pg8::cvt_pk_bf16(o8[6], o8[7]);
                    *(GAS v4u*)(AOUT + (size_t)(t & tmask) * 1024 + h * 128 + ch * 8) = w; }
            }
        }
        if (nxt.valid) {
#pragma unroll
            for (int j = 0; j < 4; ++j) { const int i = tid + 512 * j, rl = i >> 4, ch = i & 15; *(LAS v4u*)(Qn + rl * 272 + ch * 16) = qn[j]; }
        }
        LDS_WAIT(); __syncthreads();
        if (!nxt.valid) break;
        cur = nxt; pb ^= 1;
    }
}


struct Args { const float* in[18]; float* out; unsigned char* ws; unsigned long long ws_size; };

typedef const __attribute__((address_space(4))) Args* KArgsP;
#define KA() ({ KArgsP p_ = (KArgsP)__builtin_amdgcn_kernarg_segment_ptr(); asm volatile("" : "+s"(p_)); p_; })
#define AIN(i) ((const float*)KA()->in[i])
#define WSB ((unsigned char*)KA()->ws)
#define XIN AIN(0)
#define OUTP ((float*)KA()->out)
#define SS ((float*)(WSB + WS_SS))
#define HBP ((bf16*)(WSB + WS_HB))
#define HB ((bf16*)(WSB + WS_HB + HB_ROW0))
#define ACT ((bf16*)(WSB + WS_ACT))
enum { WK_IN = 0, WK_OUT, WK_KV, WK_Q, WK_O, WK_UP, WK_DN };
constexpr int I_IN = 16 * 96, I_SQ = 16 * 32, I_KV = 16 * 64, I_UP = 16 * 176, I_DN = 44 * 32;
#define AIN2(i) AIN(i)
#define WSB2 WSB
__device__ __forceinline__ void weight_item(int kind, int l, int r, LAS float* scr, int lane) {
    if (kind == WK_IN) { const int kb = r / 96, nb = r % 96, c0 = nb * 32;
        const float* W = AIN2(2) + (size_t)l * D * MIN_; const float* g = AIN2(1) + l * D;
        bf16* WR = (bf16*)(WSB2 + WS_WINR) + (size_t)l * 1536 * D; bf16* WTt = (bf16*)(WSB2 + WS_WINT) + (size_t)l * 1536 * D;
        if (c0 < 512) transpose_item(W, MIN_, kb * 64, c0, g, WR, D, c0, nullptr, 0, scr, lane);
        else if (c0 < 1024) transpose_item(W, MIN_, kb * 64, c0, g, WTt, D, c0 - 512, nullptr, 0, scr, lane);
        else if (c0 < 2048) transpose_item(W, MIN_, kb * 64, c0, g, WTt, D, 512 + c0 - 1024, nullptr, 0, scr, lane);
        else transpose_item(W, MIN_, kb * 64, c0, g, WR, D, 512 + c0 - 2048, nullptr, 0, scr, lane);
    } else if (kind == WK_OUT) { const int kb = r / 32, nb = r % 32;
        transpose_item(AIN2(5) + (size_t)l * D * D, D, kb * 64, nb * 32, nullptr, (bf16*)(WSB2 + WS_WOUT) + (size_t)l * D * D, D, nb * 32, nullptr, 0, scr, lane);
    } else if (kind == WK_KV) { const int kb = r / 64, nb = r % 64, c0 = nb * 32;
        if (c0 < 1024) transpose_item(AIN2(7), 2048, kb * 64, c0, AIN2(6), (bf16*)(WSB2 + WS_WK), D, c0, nullptr, 0, scr, lane);
        else transpose_item(AIN2(7), 2048, kb * 64, c0, AIN2(6), (bf16*)(WSB2 + WS_WV), D, c0 - 1024, nullptr, 0, scr, lane);
    } else if (kind == WK_Q) { const int kb = r / 32, nb = r % 32;
        transpose_item(AIN2(10) + (size_t)l * D * D, D, kb * 64, nb * 32, AIN2(9) + l * D, (bf16*)(WSB2 + WS_WQ) + (size_t)l * D * D, D, nb * 32, nullptr, 0, scr, lane);
    } else if (kind == WK_O) { const int kb = r / 32, nb = r % 32;
        transpose_item(AIN2(12) + (size_t)l * D * D, D, kb * 64, nb * 32, nullptr, (bf16*)(WSB2 + WS_WO) + (size_t)l * D * D, D, nb * 32, nullptr, 0, scr, lane);
    } else if (kind == WK_UP) { const int kb = r / 176, nb = r % 176, c0 = nb * 32;
        const int bj = c0 >= FF, cp = c0 - bj * FF, d0 = (cp / 128) * 256 + bj * 128 + (cp % 128);
        transpose_item(AIN2(14) + (size_t)l * D * FF2, FF2, kb * 64, c0, AIN2(13) + l * D, (bf16*)(WSB2 + WS_WUP) + (size_t)l * FF2 * D, D, d0, nullptr, 0, scr, lane);
    } else { const int kb = r / 32, nb = r % 32;
        transpose_item(AIN2(17) + (size_t)l * FF * D, D, kb * 64, nb * 32, nullptr, (bf16*)(WSB2 + WS_WDN) + (size_t)l * D * FF, FF, nb * 32, nullptr, 0, scr, lane); }
}
__device__ __forceinline__ void weight_set(int set, int widx, int nw, LAS float* scr, int lane) {
    if (set == 0) {
        for (int it = widx; it < I_IN; it += nw) weight_item(WK_IN, 0, it, scr, lane);
    } else if (set == 1) {
        constexpr int N = (I_SQ + I_UP + I_DN) + (I_IN + I_SQ + I_UP + I_DN);
        for (int it = widx; it < N; it += nw) { int r = it;
            if (r < I_SQ) { weight_item(WK_OUT, 0, r, scr, lane); continue; } r -= I_SQ;
            if (r < I_UP) { weight_item(WK_UP, 0, r, scr, lane); continue; } r -= I_UP;
            if (r < I_DN) { weight_item(WK_DN, 0, r, scr, lane); continue; } r -= I_DN;
            if (r < I_IN) { weight_item(WK_IN, 1, r, scr, lane); continue; } r -= I_IN;
            if (r < I_SQ) { weight_item(WK_OUT, 1, r, scr, lane); continue; } r -= I_SQ;
            if (r < I_UP) { weight_item(WK_UP, 1, r, scr, lane); continue; } r -= I_UP;
            weight_item(WK_DN, 1, r, scr, lane); }
    } else {
        constexpr int N = I_KV + 4 * I_SQ + 2 * I_UP + 2 * I_DN;
        for (int it = widx; it < N; it += nw) { int r = it;
            if (r < I_KV) { weight_item(WK_KV, 0, r, scr, lane); continue; } r -= I_KV;
            if (r < 2 * I_SQ) { weight_item(WK_Q, r / I_SQ, r % I_SQ, scr, lane); continue; } r -= 2 * I_SQ;
            if (r < 2 * I_SQ) { weight_item(WK_O, r / I_SQ, r % I_SQ, scr, lane); continue; } r -= 2 * I_SQ;
            if (r < 2 * I_UP) { weight_item(WK_UP, 2 + r / I_UP, r % I_UP, scr, lane); continue; } r -= 2 * I_UP;
            weight_item(WK_DN, 2 + r / I_DN, r % I_DN, scr, lane); }
    }
}

__global__ void __launch_bounds__(NWAVES * 64, 2) yoco_fwd(Args args) {
    extern __shared__ __attribute__((aligned(16))) unsigned char lds[];
    LAS unsigned char* L = (LAS unsigned char*)lds;
    volatile LAS unsigned* MISC = (volatile LAS unsigned*)(L + MISC_OFF);
    const int tid = threadIdx.x, lane = tid & 63, wave = __builtin_amdgcn_readfirstlane(tid >> 6);
    const int G = gridDim.x;
    for (int u = tid; u < (LDS_BYTES - RING_BYTES) / 4; u += NWAVES * 64) ((LAS unsigned*)(L + RING_BYTES))[u] = 0u;
    __syncthreads();
    (void)xcd_barrier_post((unsigned*)(WSB + WS_CTL) + CW_BAR, MISC + 8);
#define GRID_BAR() do { XcdBarrier b_; b_.bar = (unsigned*)(WSB + WS_CTL) + CW_BAR; b_.x = xb_xcc_id(); b_.st = (volatile LAS unsigned*)(L + MISC_OFF) + 8; xcd_barrier(b_); } while (0)

    for (int rp_ = 0; rp_ < REPS(1); ++rp_) {
        LAS float* scr = (LAS float*)(L + wave * 16384);
        const int gw = blockIdx.x * NWAVES + wave, NGW = G * NWAVES;
        weight_set(0, gw, NGW, scr, lane);
        { const int gt = blockIdx.x * (NWAVES * 64) + tid, NTH = G * NWAVES * 64;
          for (int i = gt; i < 2 * D * 8; i += NTH) { const int l = i / (D * 8), k = (i / 8) % D, j = i & 7;
              ((float*)(WSB + WS_WG))[i] = AIN(2)[(size_t)l * D * MIN_ + (size_t)k * MIN_ + 3072 + j] * AIN(1)[l * D + k]; } }
        { const int gt = blockIdx.x * (NWAVES * 64) + tid, NTH = G * NWAVES * 64; bf16* ON = (bf16*)(WSB + WS_ONES);
          for (int i = gt; i < 128; i += NTH) ON[128 * 1024 + i] = (bf16)0; }
        { const int gt = blockIdx.x * (NWAVES * 64) + tid, NTH = G * NWAVES * 64; float* RP = (float*)(WSB + WS_ROPE);
          for (int i = gt; i < T * 16; i += NTH) { const int pos = i >> 4, k = i & 15; const double inv = pow(500000.0, -(double)(2 * k) / 32.0), ang = (double)pos * inv;
              RP[i] = (float)cos(ang); RP[T * 16 + i] = (float)sin(ang); } }
        for (int m = gw; m < T; m += NGW) {
            const GAS f32x4* xr = (const GAS f32x4*)(XIN + (size_t)m * D) + lane; f32x4 v[4]; float s = 0.f;
#pragma unroll
            for (int j = 0; j < 4; ++j) { v[j] = xr[64 * j]; s += (v[j].x * v[j].x + v[j].y * v[j].y) + (v[j].z * v[j].z + v[j].w * v[j].w); }
            s = wave_sum(s, lane);
            GAS unsigned long long* o8 = (GAS unsigned long long*)(HB + (size_t)m * D) + lane;
#pragma unroll
            for (int j = 0; j < 4; ++j) o8[64 * j] = (unsigned long long)pk2(v[j].x, v[j].y) | ((unsigned long long)pk2(v[j].z, v[j].w) << 32);
            if (lane == 0) *(f32x4*)(SS + (size_t)m * 4) = (f32x4){s, 0.f, 0.f, 0.f};
        }
        { const int gt = blockIdx.x * (NWAVES * 64) + tid, NTH = G * NWAVES * 64;
          for (int i = gt; i < 2 * 1024 / 8; i += NTH) ((GAS v4u*)HBP)[i] = (v4u){0u, 0u, 0u, 0u};
          for (int i = gt; i < 128 * 1024 / 8; i += NTH) ((GAS v4u*)(HB + (size_t)T * D))[i] = (v4u){0u, 0u, 0u, 0u}; }
    GRID_BAR();
    }
    if (DUP == 8) { for (int rp_ = 0; rp_ < 8; ++rp_) GRID_BAR(); }

#define GRIDN() ({ int g_ = gridDim.x; asm volatile("" : "+s"(g_)); g_; })
#define BLK() ({ int b_ = blockIdx.x; asm volatile("" : "+s"(b_)); b_; })
    LAS unsigned char* ring = L; LAS unsigned char* el = L + EPI_OFF;
#pragma unroll
    for (int l = 0; l < 4; ++l) {
#if MIXERS
        if (l < 2) {
            bf16* MQ = (bf16*)(WSB + WS_MQ); bf16* MK = (bf16*)(WSB + WS_MK); bf16* OGB = (bf16*)(WSB + WS_OG); bf16* KVT = (bf16*)(WSB + WS_KVT);
            bf16* CT = (bf16*)(WSB + WS_CT); bf16* HG = (bf16*)(WSB + WS_HG);
            float* BCUM = (float*)(WSB + WS_BCUM); float* IG = (float*)(WSB + WS_IG); float* WGT = (float*)(WSB + WS_WGT); float* DECAY = (float*)(WSB + WS_DECAY); bf16* NCT = (bf16*)(WSB + WS_NCT); bf16* WROW = (bf16*)(WSB + WS_ONES); const bf16* ZROW = (const bf16*)(WSB + WS_ONES + 256 * 1024);
            const float* ssm = SS + (size_t)((2 * l) & 3) * T * 4;
            for (int rp_ = 0; rp_ < REPS(2); ++rp_) {
            for (int c = BLK(); c < 256; c += GRIDN())
                mlstm_gates_item(L, c, HB, (const float*)(WSB + WS_WG) + (size_t)l * D * 8, ssm, AIN(3) + l * 8, BCUM, IG, WGT, DECAY, WROW);
            GRID_BAR();
            {
                pg8::Gemm g{HB, (const bf16*)(WSB + WS_WINR) + (size_t)l * 1536 * D, T, 1536, D, 256};
                pg8::StaticOrder S; S.init(T, 1536, GRIDN(), BLK());
                pg8::EpiIn E{MQ, MK, OGB, ssm};
                pg8::gemm_phase<pg8::EpiIn, pg8::StaticOrder, true, true>(ring, el, g, S, E);
            }
            {
                pg8::Gemm g{(const bf16*)(WSB + WS_WINT) + (size_t)l * 1536 * D, HB, 1536, T, D, 256};
                pg8::StaticOrder S; S.init(1536, T, GRIDN(), BLK());
                pg8::EpiInT E{KVT, ssm, 1536, 64, WGT};
                pg8::gemm_phase<pg8::EpiInT, pg8::StaticOrder, true, true>(ring, el, g, S, E);
            }
            GRID_BAR();
            }
            for (int rp_ = 0; rp_ < REPS(3); ++rp_) {
            { int t4 = threadIdx.x; asm volatile("" : "+v"(t4)); const int wv4 = __builtin_amdgcn_readfirstlane(t4 >> 6);
              if (wv4 >= 3 && rp_ == 0) weight_set(l + 1, BLK() * 5 + (wv4 - 3), GRIDN() * 5, (LAS float*)(L + (wv4 - 3) * 16384), t4 & 63); }
            mlstm_scan(KVT, DECAY, CT, NCT, WROW, ZROW, GRIDN());
            GRID_BAR();
            }
            if (DUP == 13) { mlstm_scan(KVT, DECAY, HG, HG, WROW, ZROW, GRIDN(), true); GRID_BAR(); }
            for (int rp_ = 0; rp_ < REPS(4); ++rp_) {
            mlstm_out_phase(L, GRIDN(), MQ, MK, KVT, CT, NCT, BCUM, WGT, OGB, AIN(4) + l * D, HG);
            GRID_BAR();
            }
            for (int rp_ = 0; rp_ < REPS(10); ++rp_) {
                const bool dummy = (DUP == 10) && rp_ == 0;
                pg8::Gemm g{HG, (const bf16*)(WSB + WS_WOUT) + (size_t)l * D * D, T, D, D, 256};
                pg8::StaticOrder S; S.init(T, D, GRIDN(), BLK());
                pg8::EpiRes E{HB, SS + (size_t)((2 * l + 1) & 3) * T * 4, nullptr}; (void)dummy;
                pg8::gemm_phase<pg8::EpiRes, pg8::StaticOrder, true, true>(ring, el, g, S, E);
                if (dummy) GRID_BAR();
            }
            if (0) {
                pg8::Gemm g{HG, (const bf16*)(WSB + WS_WOUT) + (size_t)l * D * D, T, D, D, 256};
                pg8::StaticOrder S; S.init(T, D, GRIDN(), BLK());
                pg8::EpiRes E{HB, SS + (size_t)((2 * l + 1) & 3) * T * 4, nullptr};
                pg8::gemm_phase<pg8::EpiRes, pg8::StaticOrder, true, true>(ring, el, g, S, E);
            }
            GRID_BAR();
        }
#if MIXERS >= 2
        else {
            const int j = l - 2;
            bf16* XK = (bf16*)(WSB + WS_XK); bf16* XVT = (bf16*)(WSB + WS_XVT); bf16* AQ = (bf16*)(WSB + WS_AQ); bf16* PO = (bf16*)(WSB + WS_PO);
            float* KMEAN = (float*)(WSB + WS_KMEAN); float* ML = (float*)(WSB + WS_ML); int* LIST = (int*)(WSB + WS_LIST); int* gcnt = (int*)(WSB + WS_GCNT) + j * 512;
            const float* ssm = SS + (size_t)((2 * l) & 3) * T * 4; const float* RP = (const float*)(WSB + WS_ROPE);
            for (int rp_ = 0; rp_ < REPS(5); ++rp_) {
            if (l == 2) {
                { pg8::Gemm g{HB, (const bf16*)(WSB + WS_WK), T, D, D, 256}; pg8::StaticOrder S; S.init(T, D, GRIDN(), BLK());
                  pg8::EpiQK E{XK, ssm, AIN(8), RP, KMEAN, 1.0f, 1};
                  pg8::gemm_phase<pg8::EpiQK, pg8::StaticOrder, true, true>(ring, el, g, S, E); }
                { pg8::Gemm g{(const bf16*)(WSB + WS_WV), HB, D, T, D, 256}; pg8::StaticOrder S; S.init(D, T, GRIDN(), BLK());
                  pg8::EpiInT E{XVT, ssm, 1024, 0, nullptr};
                  pg8::gemm_phase<pg8::EpiInT, pg8::StaticOrder, true, true>(ring, el, g, S, E); }
            }
            { pg8::Gemm g{HB, (const bf16*)(WSB + WS_WQ) + (size_t)j * D * D, T, D, D, 256}; pg8::StaticOrder S; S.init(T, D, GRIDN(), BLK());
              pg8::EpiQK E{AQ, ssm, AIN(11) + j * 128, RP, nullptr, 0.08838834764831845f * 1.4426950408889634f, 0};
              pg8::gemm_phase<pg8::EpiQK, pg8::StaticOrder, true, true>(ring, el, g, S, E); }
            GRID_BAR();
            }
            for (int rp_ = 0; rp_ < REPS(11); ++rp_) {
            const bool dummy = (DUP == 11) && rp_ == 0;
            moba_gate_phase(L, GRIDN(), AQ, KMEAN, dummy ? gcnt + 2048 : gcnt, dummy ? (int*)(WSB + WS_WINR) : LIST);
            GRID_BAR();
            }
            for (int rp_ = 0; rp_ < REPS(6); ++rp_) {
            attn_phase<false>(L, GRIDN(), gcnt, LIST, AQ, XK, XVT, PO, ML, nullptr, 0, (DUP == 6 && rp_ == 0) ? PROBE : 0);
            GRID_BAR();
            }
            for (int rp_ = 0; rp_ < REPS(12); ++rp_) {
            const bool dummy = (DUP == 12) && rp_ == 0;
            attn_phase<true>(L, GRIDN(), gcnt, LIST, AQ, XK, XVT, PO, ML, dummy ? HB : AQ, dummy ? 8191 : 0x7fffffff);
            GRID_BAR();
            }
            { int t2 = threadIdx.x; asm volatile("" : "+v"(t2)); const int gt = BLK() * (NWAVES * 64) + t2, NTH = GRIDN() * NWAVES * 64;
              unsigned zu = 0u; asm volatile("" : "+v"(zu));
              for (int i = gt; i < 128 * 1024 / 8; i += NTH) ((GAS v4u*)(HB + (size_t)T * D))[i] = (v4u){zu, zu, zu, zu}; }
            { pg8::Gemm g{AQ, (const bf16*)(WSB + WS_WO) + (size_t)j * D * D, T, D, D, 256}; pg8::StaticOrder S; S.init(T, D, GRIDN(), BLK());
              pg8::EpiRes E{HB, SS + (size_t)((2 * l + 1) & 3) * T * 4, nullptr};
              pg8::gemm_phase<pg8::EpiRes, pg8::StaticOrder, true, true>(ring, el, g, S, E); }
            GRID_BAR();
        }
#endif
#endif
        const bool mix_on = (MIXERS >= 2) || (MIXERS == 1 && l < 2);
        const int ssf = mix_on ? 2 * l + 1 : 2 * l;
#ifndef SKIP_UP
        for (int rp_ = 0; rp_ < REPS(7); ++rp_) {
            pg8::Gemm g{HBP, (const bf16*)(WSB + WS_WUP) + (size_t)l * FF2 * D, 65 * 256, FF2, D, 254};
            pg8::StaticOrder S; S.init(65 * 256, FF2, GRIDN(), BLK());
            pg8::EpiConv E{ACT, SS + (size_t)(ssf & 3) * T * 4, AIN(15) + (size_t)l * 3 * FF2, AIN(16) + (size_t)l * FF2};
            pg8::gemm_phase<pg8::EpiConv, pg8::StaticOrder, true, true>(ring, el, g, S, E);
            GRID_BAR();
        }
#endif
#ifndef SKIP_DN
        for (int rp_ = 0; rp_ < REPS(9); ++rp_) {
            const bool dummy = (DUP == 9) && rp_ == 0;
            pg8::Gemm g{ACT, (const bf16*)(WSB + WS_WDN) + (size_t)l * D * FF, T, D, FF, 256};
            pg8::StaticOrder S; S.init(T, D, GRIDN(), BLK());
            pg8::EpiRes E{HB, (l < 3) ? SS + (size_t)((2 * l + 2) & 3) * T * 4 : nullptr, (l == 3) ? OUTP : nullptr}; (void)dummy;
            pg8::gemm_phase<pg8::EpiRes, pg8::StaticOrder, true, true>(ring, el, g, S, E);
            GRID_BAR();
        }
#endif
    }
    { int t3 = threadIdx.x; asm volatile("" : "+v"(t3)); if (BLK() == 0 && t3 == 0) if (xb_ld((unsigned*)(WSB + WS_CTL) + CW_BAR + XB_TMO)) OUTP[0] = 1.0e6f; }
}

#undef WSB
#undef XIN
#undef OUTP
#undef SS
#undef HBP
#undef HB
#undef ACT
extern "C" void kernel_launch(void* const* d_in, const int* in_sizes, int n_in, void* d_out, int out_size, void* d_ws, size_t ws_size, hipStream_t stream) {
    static int grid = 0;
    if (grid == 0) {
        int dev = 0, cus = 0;
        if (n_in != 18 || out_size != T * D || ws_size < WS_END) { fprintf(stderr, "kernel_launch: unexpected problem geometry (n_in %d out %d ws %zu)\n", n_in, out_size, ws_size); grid = -1; return; }
        if (hipGetDevice(&dev) != hipSuccess || hipDeviceGetAttribute(&cus, hipDeviceAttributeMultiprocessorCount, dev) != hipSuccess) { grid = -1; return; }
        if (hipFuncSetAttribute((const void*)yoco_fwd, hipFuncAttributeMaxDynamicSharedMemorySize, LDS_BYTES) != hipSuccess) { fprintf(stderr, "hipFuncSetAttribute failed\n"); grid = -1; return; }
        (void)hipGetLastError();
        grid = cus;
    }
    if (grid < 0) return;
    (void)hipMemsetAsync((char*)d_ws + WS_CTL, 0, CTL_ZERO_BYTES, stream);
    Args a{};
    for (int i = 0; i < 18; ++i) a.in[i] = (const float*)d_in[i];
    a.out = (float*)d_out; a.ws = (unsigned char*)d_ws; a.ws_size = (unsigned long long)ws_size;
    hipLaunchKernelGGL(yoco_fwd, dim3(grid), dim3(NWAVES * 64), LDS_BYTES, stream, a);
}
```

```cpp
#include <hip/hip_runtime.h>
#include <cstdio>
#include <cstdint>

#define MIXERS 2
#define DUP 0
#define REPS(k) ((DUP) == (k) ? 2 : 1)
#ifndef PROBE
#define PROBE 0
#endif

namespace pg8 {
#define PG8_LAS __attribute__((address_space(3)))
typedef unsigned short bf16_t;
typedef short bf16x8 __attribute__((ext_vector_type(8)));
typedef float f32x4 __attribute__((ext_vector_type(4)));
typedef unsigned u32x4 __attribute__((ext_vector_type(4)));
typedef unsigned u32x2 __attribute__((ext_vector_type(2)));
constexpr int BM = 256, BK = 64, HALF = 128, HTB = HALF * BK * 2, STAGE_BYTES = 8 * HTB, NXCD = 8, WGM = 8;

__host__ __device__ __forceinline__ int lds_byte(int r, int c) { const int st = (r >> 4) * 2 + (c >> 5), rr = r & 15, cc = c & 31, ob = rr * 64 + cc * 2; return st * 1024 + (ob ^ (((ob >> 9) & 1) << 5)); }
__host__ __device__ __forceinline__ void stage_rc(int b, int& R, int& C) { const int st = b / 1024, sb = b % 1024, swz = sb ^ (((sb >> 9) & 1) << 5); R = (st >> 1) * 16 + swz / 64; C = (st & 1) * 32 + (swz % 64) / 2; }
__host__ __device__ __forceinline__ int perm32(int rho) { const int n = rho >> 4, i = rho & 15; return 8 * (i >> 2) + 4 * n + (i & 3); }

struct Unit { int pm, pn; };
struct Gemm { const bf16_t* A; const bf16_t* Bt; int M, N, K, a_rows; };

struct StaticOrder {
    int nM, nN, nwg, G, c;
    __host__ __device__ void init(int M, int N, int G_, int c_) { nM = M / BM; nN = N / BM; nwg = nM * nN; G = G_; c = c_; }
    __host__ __device__ bool next(int i, Unit& u) const {
        const long L = (long)i * G + c; if (L >= nwg) return false;
        int wgid = (int)L; { const int q = nwg / NXCD, r = nwg % NXCD, xcd = wgid % NXCD, off = wgid / NXCD; wgid = (xcd < r ? xcd * (q + 1) : r * (q + 1) + (xcd - r) * q) + off; }
        const int nig = WGM * nN, gid = wgid / nig, fm = gid * WGM, gsz = (nM - fm) < WGM ? (nM - fm) : WGM;
        u.pm = fm + ((wgid % nig) % gsz); u.pn = (wgid % nig) / gsz; return true;
    }
    __device__ __forceinline__ void a_ready(const Unit&) const {}
    __device__ __forceinline__ void done(const Unit&) const {}
};

__device__ __forceinline__ float sh_idx(float v, int src) { return __builtin_bit_cast(float, __builtin_amdgcn_ds_bpermute(src << 2, __builtin_bit_cast(int, v))); }
__device__ __forceinline__ float sh_xor(float v, int o, int lane) { return sh_idx(v, lane ^ o); }
template <int CTRL, int ROWMASK = 0xf> __device__ __forceinline__ float dpp_add(float v) { return v + __builtin_bit_cast(float, __builtin_amdgcn_update_dpp(0, __builtin_bit_cast(int, v), CTRL, ROWMASK, 0xf, true)); }
__device__ __forceinline__ float half_sum_hi(float v) { v = dpp_add<0xB1>(v); v = dpp_add<0x4E>(v); v = dpp_add<0x141>(v); v = dpp_add<0x140>(v); return dpp_add<0x142, 0xA>(v); }
__device__ __forceinline__ float oct_sum(float v) { v = dpp_add<0xB1>(v); v = dpp_add<0x4E>(v); return dpp_add<0x141>(v); }
typedef float f32x2n __attribute__((ext_vector_type(2)));
typedef __bf16 bf16x2n __attribute__((ext_vector_type(2)));
__device__ __forceinline__ unsigned cvt_pk_bf16n(float lo, float hi) { unsigned r; asm volatile("s_nop 0\n\tv_cvt_pk_bf16_f32 %0, %1, %2" : "=v"(r) : "v"(lo), "v"(hi)); return r; }
__device__ __forceinline__ unsigned cvt_pk_bf16(float lo, float hi) { unsigned r; asm volatile("v_cvt_pk_bf16_f32 %0, %1, %2" : "=v"(r) : "v"(lo), "v"(hi)); return r; }
__device__ __forceinline__ float rstd4(const float* ss4, int row) { const f32x4 p = *(const f32x4*)(ss4 + (size_t)row * 4); return rsqrtf(((p[0] + p[1]) + (p[2] + p[3])) * (1.0f / 1024.0f) + 1e-6f); }
#define EPI_BAR() do { asm volatile("s_waitcnt lgkmcnt(0)" ::: "memory"); __builtin_amdgcn_s_barrier(); asm volatile("" ::: "memory"); } while (0)

constexpr int TT = 16384, DD = 1024;
constexpr float NEPS = 1e-6f;

struct EpiRes {
    static constexpr bool PERM = true;
    bf16_t* hb; float* ss; float* fout;
    __device__ __forceinline__ void operator()(f32x4 (&acc)[2][2][4][2], const Unit& u, int wr, int wc, int fr_, int fq_, PG8_LAS unsigned char* el, int wid, int lane_) const {
        int ln_ = lane_; asm volatile("" : "+v"(ln_)); const int lane = ln_, fr = ln_ & 15, fq = ln_ >> 4; (void)fr_; (void)fq_;
        u32x4 pre[2][4][2];
#pragma unroll
        for (int ai = 0; ai < 2; ++ai)
#pragma unroll
            for (int m = 0; m < 4; ++m)
#pragma unroll
                for (int bj = 0; bj < 2; ++bj) pre[ai][m][bj] = *(const u32x4*)(hb + (size_t)(u.pm * BM + ai * HALF + wr * 64 + m * 16 + fr) * DD + u.pn * BM + bj * HALF + wc * 32 + 8 * fq);
#pragma unroll
        for (int ai = 0; ai < 2; ++ai)
#pragma unroll
            for (int m = 0; m < 4; ++m) {
                const int row = u.pm * BM + ai * HALF + wr * 64 + m * 16 + fr; float s = 0.f;
#pragma unroll
                for (int bj = 0; bj < 2; ++bj) {
                    const size_t off = (size_t)row * DD + u.pn * BM + bj * HALF + wc * 32 + 8 * fq;
                    const u32x4 p = pre[ai][m][bj];
                    f32x4 v0 = acc[ai][bj][m][0], v1 = acc[ai][bj][m][1];
                    v0[0] += __builtin_bit_cast(float, p[0] << 16); v0[1] += __builtin_bit_cast(float, p[0] & 0xffff0000u); v0[2] += __builtin_bit_cast(float, p[1] << 16); v0[3] += __builtin_bit_cast(float, p[1] & 0xffff0000u);
                    v1[0] += __builtin_bit_cast(float, p[2] << 16); v1[1] += __builtin_bit_cast(float, p[2] & 0xffff0000u); v1[2] += __builtin_bit_cast(float, p[3] << 16); v1[3] += __builtin_bit_cast(float, p[3] & 0xffff0000u);
                    if (fout) { *(f32x4*)(fout + off) = v0; *(f32x4*)(fout + off + 4) = v1; }
                    u32x4 w; w.x = cvt_pk_bf16(v0[0], v0[1]); w.y = cvt_pk_bf16(v0[2], v0[3]); w.z = cvt_pk_bf16(v1[0], v1[1]); w.w = cvt_pk_bf16(v1[2], v1[3]);
                    *(u32x4*)(hb + off) = w;
                    s += (v0[0] * v0[0] + v0[1] * v0[1]) + (v0[2] * v0[2] + v0[3] * v0[3]) + (v1[0] * v1[0] + v1[1] * v1[1]) + (v1[2] * v1[2] + v1[3] * v1[3]);
                }
                s += sh_xor(s, 16, lane); s += sh_xor(s, 32, lane);
                if (fq == 0) ((PG8_LAS float*)el)[(ai * HALF + wr * 64 + m * 16 + fr) * 4 + wc] = s;
            }
        EPI_BAR();
        { const int tid2 = wid * 64 + lane;
          if (ss && tid2 < 256) { const f32x4 p = *(const PG8_LAS f32x4*)((PG8_LAS float*)el + tid2 * 4); ss[(size_t)(u.pm * BM + tid2) * 4 + u.pn] = (p[0] + p[1]) + (p[2] + p[3]); } }
        EPI_BAR();
    }
};

struct EpiConv {
    static constexpr bool PERM = true;
    bf16_t* act; const float* ss; const float* cw; const float* cb;
    static __device__ __forceinline__ float ror1(float v) { return __builtin_bit_cast(float, __builtin_amdgcn_update_dpp(0, __builtin_bit_cast(int, v), 0x121, 0xf, 0xf, false)); }
    static __device__ __forceinline__ float ror2(float v) { return __builtin_bit_cast(float, __builtin_amdgcn_update_dpp(0, __builtin_bit_cast(int, v), 0x122, 0xf, 0xf, false)); }
    __device__ __forceinline__ void operator()(f32x4 (&acc)[2][2][4][2], const Unit& u, int wr, int wc, int fr_, int fq_, PG8_LAS unsigned char* el, int wid, int lane_) const {
        int ln_ = lane_; asm volatile("" : "+v"(ln_)); const int lane = ln_, fr = ln_ & 15, fq = ln_ >> 4; (void)lane; (void)fr_; (void)fq_;
        const int t0 = u.pm * 254 - 2;
        const int cl = wc * 32 + 8 * fq;
        float rs[2][4]; f32x4 cp[2][2][4];
#pragma unroll
        for (int ai = 0; ai < 2; ++ai)
#pragma unroll
            for (int m = 0; m < 4; ++m) { const int t = t0 + ai * HALF + wr * 64 + m * 16 + fr; rs[ai][m] = (t >= 0 && t < TT) ? rstd4(ss, t) : 0.f; }
#pragma unroll
        for (int n = 0; n < 2; ++n)
#pragma unroll
            for (int bj = 0; bj < 2; ++bj) { const int scol = (bj ? 2816 : 0) + u.pn * HALF + cl + 4 * n;
                cp[n][bj][0] = *(const f32x4*)(cw + scol); cp[n][bj][1] = *(const f32x4*)(cw + 5632 + scol); cp[n][bj][2] = *(const f32x4*)(cw + 2 * 5632 + scol); cp[n][bj][3] = *(const f32x4*)(cb + scol); }
#pragma unroll
        for (int ai = 0; ai < 2; ++ai)
#pragma unroll
            for (int m = 0; m < 4; ++m)
#pragma unroll
                for (int bj = 0; bj < 2; ++bj)
#pragma unroll
                    for (int n = 0; n < 2; ++n) acc[ai][bj][m][n] = acc[ai][bj][m][n] * rs[ai][m];
        PG8_LAS float* X = (PG8_LAS float*)el;
#pragma unroll
        for (int ai = 0; ai < 2; ++ai) { const int B = 2 * ai + wr;
            if (B < 3 && fr >= 14) {
#pragma unroll
                for (int bj = 0; bj < 2; ++bj)
#pragma unroll
                    for (int n = 0; n < 2; ++n) *(PG8_LAS f32x4*)(X + (B * 2 + (fr - 14)) * 256 + bj * HALF + cl + 4 * n) = acc[ai][bj][3][n];
            } }
        EPI_BAR();
#pragma unroll
        for (int n = 0; n < 2; ++n) {
#pragma unroll
            for (int bj = 0; bj < 2; ++bj) {
                const f32x4 w0 = cp[n][bj][0], w1 = cp[n][bj][1], w2 = cp[n][bj][2], bb = cp[n][bj][3];
#pragma unroll
                for (int ai = 0; ai < 2; ++ai) {
                    const int B = 2 * ai + wr;
                    f32x4 p1 = (f32x4){0.f, 0.f, 0.f, 0.f}, p2 = p1;
                    if (B > 0) { const f32x4 e0 = *(const PG8_LAS f32x4*)(X + ((B - 1) * 2 + 0) * 256 + bj * HALF + cl + 4 * n), e1 = *(const PG8_LAS f32x4*)(X + ((B - 1) * 2 + 1) * 256 + bj * HALF + cl + 4 * n);
                        p1 = e1; p2 = (fr == 0) ? e0 : e1; }
#pragma unroll
                    for (int m = 0; m < 4; ++m) {
                        f32x4 cur = acc[ai][bj][m][n]; f32x4 s1, s2;
                        asm volatile("" : "+v"(cur));
#pragma unroll
                        for (int i = 0; i < 4; ++i) { s1[i] = ror1(cur[i]); s2[i] = ror2(cur[i]); }
                        const f32x4 q1 = (fr >= 1) ? s1 : p1, q2 = (fr >= 2) ? s2 : p2;
                        f32x4 res = bb + w0 * q2 + w1 * q1 + w2 * cur;
                        asm volatile("" : "+v"(res), "+v"(s1), "+v"(s2));
                        acc[ai][bj][m][n] = res;
                        p1 = s1; p2 = s2;
                    }
                }
            }
        }
#pragma unroll
        for (int ai = 0; ai < 2; ++ai)
#pragma unroll
            for (int m = 0; m < 4; ++m) {
                const int r = ai * HALF + wr * 64 + m * 16 + fr, t = t0 + r;
                u32x4 w; float a[8];
#pragma unroll
                for (int n = 0; n < 2; ++n)
#pragma unroll
                    for (int i = 0; i < 4; ++i) { const float v = acc[ai][0][m][n][i], g = acc[ai][1][m][n][i]; a[4 * n + i] = v * g * __builtin_amdgcn_rcpf(1.0f + __builtin_amdgcn_exp2f(-1.4426950408889634f * g)); }
                w.x = cvt_pk_bf16(a[0], a[1]); w.y = cvt_pk_bf16(a[2], a[3]); w.z = cvt_pk_bf16(a[4], a[5]); w.w = cvt_pk_bf16(a[6], a[7]);
                if (r >= 2 && t < TT) *(u32x4*)(act + (size_t)t * 2816 + u.pn * HALF + cl) = w;
            }
        EPI_BAR();
    }
};


struct EpiIn {
    static constexpr bool PERM = true;
    bf16_t* q; bf16_t* k; bf16_t* og; const float* ss;
    __device__ __forceinline__ void operator()(f32x4 (&acc)[2][2][4][2], const Unit& u, int wr, int wc, int fr_, int fq_, PG8_LAS unsigned char* el, int wid, int lane_) const {
        int ln_ = lane_; asm volatile("" : "+v"(ln_)); const int lane = ln_, fr = ln_ & 15, fq = ln_ >> 4; (void)lane; (void)fr_; (void)fq_;
        bf16_t* dst; int ldc, c0; float sc;
        if (u.pn < 2) { dst = q; ldc = 512; c0 = 256 * u.pn; sc = 0.08838834764831845f; }
        else { dst = og; ldc = 1024; c0 = 256 * (u.pn - 2); sc = 1.f; }
#pragma unroll
        for (int ai = 0; ai < 2; ++ai)
#pragma unroll
            for (int m = 0; m < 4; ++m) {
                const int row = u.pm * BM + ai * HALF + wr * 64 + m * 16 + fr;
                const float rs = rstd4(ss, row) * sc;
#pragma unroll
                for (int bj = 0; bj < 2; ++bj) {
                    const f32x4 v0 = acc[ai][bj][m][0] * rs, v1 = acc[ai][bj][m][1] * rs;
                    u32x4 w; w.x = cvt_pk_bf16(v0[0], v0[1]); w.y = cvt_pk_bf16(v0[2], v0[3]); w.z = cvt_pk_bf16(v1[0], v1[1]); w.w = cvt_pk_bf16(v1[2], v1[3]);
                    *(u32x4*)(dst + (size_t)row * ldc + c0 + bj * HALF + wc * 32 + 8 * fq) = w;
                }
            }
    }
};
struct EpiInT {
    static constexpr bool PERM = true;
    bf16_t* o; const float* ss; int nrows, ch; const float* wgt;
    __device__ __forceinline__ void operator()(f32x4 (&acc)[2][2][4][2], const Unit& u, int wr, int wc, int fr_, int fq_, PG8_LAS unsigned char* el, int wid, int lane_) const {
        int ln_ = lane_; asm volatile("" : "+v"(ln_)); const int lane = ln_, fr = ln_ & 15, fq = ln_ >> 4; (void)lane; (void)fr_; (void)fq_;
#pragma unroll
        for (int bj = 0; bj < 2; ++bj) {
            const int t = u.pn * BM + bj * HALF + wc * 32 + 8 * fq;
            f32x4 r0, r1;
#pragma unroll
            for (int i = 0; i < 4; ++i) { r0[i] = rstd4(ss, t + i); r1[i] = rstd4(ss, t + 4 + i); }
            if (wgt && u.pm >= 2) { const float* wp = wgt + (size_t)(u.pm - 2) * TT + t; r0 = r0 * *(const f32x4*)wp; r1 = r1 * *(const f32x4*)(wp + 4); }
#pragma unroll
            for (int ai = 0; ai < 2; ++ai)
#pragma unroll
                for (int m = 0; m < 4; ++m) {
                    const int row = u.pm * BM + ai * HALF + wr * 64 + m * 16 + fr;
                    const f32x4 v0 = acc[ai][bj][m][0] * r0, v1 = acc[ai][bj][m][1] * r1;
                    u32x4 w; w.x = cvt_pk_bf16(v0[0], v0[1]); w.y = cvt_pk_bf16(v0[2], v0[3]); w.z = cvt_pk_bf16(v1[0], v1[1]); w.w = cvt_pk_bf16(v1[2], v1[3]);
                    if (ch) {
                        *(u32x4*)(o + ((((size_t)(t >> 6) * 96 + (row >> 4)) * 2 + ((t >> 5) & 1)) * 512 + (((t >> 3) & 3) * 16 + (row & 15)) * 8)) = w; }
                    else {
                        const int kb = t >> 8, key = t & 255;
                        *(u32x4*)(o + ((((size_t)(kb * 8 + (row >> 7)) * 4 + ((row >> 5) & 3)) * 16 + (key >> 4)) * 512 + (((key >> 3) & 1) * 32 + (row & 31)) * 8)) = w; }
                }
        }
    }
};


struct EpiQK {
    static constexpr bool PERM = false;
    bf16_t* o; const float* ss; const float* gain; const float* rope; float* kmean; float oscale; int kfrag;
    __device__ __forceinline__ void operator()(f32x4 (&acc)[2][2][4][2], const Unit& u, int wr, int wc, int fr_, int fq_, PG8_LAS unsigned char* el, int wid, int lane_) const {
        int ln_ = lane_; asm volatile("" : "+v"(ln_)); const int lane = ln_, fr = ln_ & 15, fq = ln_ >> 4; (void)lane; (void)fr_; (void)fq_;
        PG8_LAS float* P = (PG8_LAS float*)el;
        PG8_LAS float* KS = (PG8_LAS float*)(el + 8192);
#pragma unroll
        for (int ai = 0; ai < 2; ++ai)
#pragma unroll
            for (int m = 0; m < 4; ++m) {
                const int rl = ai * HALF + wr * 64 + m * 16 + fr;
                const float rs = rstd4(ss, u.pm * BM + rl);
#pragma unroll
                for (int bj = 0; bj < 2; ++bj) {
                    const f32x4 x0 = acc[ai][bj][m][0] * rs, x1 = acc[ai][bj][m][1] * rs;
                    acc[ai][bj][m][0] = x0; acc[ai][bj][m][1] = x1;
                    float s = (x0[0] * x0[0] + x0[1] * x0[1]) + (x0[2] * x0[2] + x0[3] * x0[3]) + (x1[0] * x1[0] + x1[1] * x1[1]) + (x1[2] * x1[2] + x1[3] * x1[3]);
                    s += sh_xor(s, 16, lane); s += sh_xor(s, 32, lane);
                    if (fq == 0) P[(rl * 2 + bj) * 4 + wc] = s;
                }
            }
        EPI_BAR();
#pragma unroll
        for (int bj = 0; bj < 2; ++bj) {
            const f32x4 g0 = *(const f32x4*)(gain + 32 * wc + 4 * fq), g1 = *(const f32x4*)(gain + 32 * wc + 16 + 4 * fq);
            f32x4 cs0 = (f32x4){0.f, 0.f, 0.f, 0.f}, cs1 = cs0;
            const int head = 2 * u.pn + bj;
#pragma unroll
            for (int ai = 0; ai < 2; ++ai)
#pragma unroll
                for (int m = 0; m < 4; ++m) {
                    const int rl = ai * HALF + wr * 64 + m * 16 + fr, row = u.pm * BM + rl;
                    const f32x4 p = *(const PG8_LAS f32x4*)(P + (rl * 2 + bj) * 4);
                    const float rn = rsqrtf(((p[0] + p[1]) + (p[2] + p[3])) * (1.0f / 128.0f) + NEPS);
                    f32x4 y0 = acc[ai][bj][m][0] * rn * g0, y1 = acc[ai][bj][m][1] * rn * g1;
                    if (wc == 0) { const f32x4 c = *(const f32x4*)(rope + (size_t)row * 16 + 4 * fq), sn = *(const f32x4*)(rope + (size_t)TT * 16 + (size_t)row * 16 + 4 * fq);
                        const f32x4 t0 = y0 * c - y1 * sn, t1 = y1 * c + y0 * sn; y0 = t0; y1 = t1; }
                    cs0 += y0; cs1 += y1;
                    y0 = y0 * oscale; y1 = y1 * oscale;
                    u32x2 w0, w1; w0.x = cvt_pk_bf16(y0[0], y0[1]); w0.y = cvt_pk_bf16(y0[2], y0[3]); w1.x = cvt_pk_bf16(y1[0], y1[1]); w1.y = cvt_pk_bf16(y1[2], y1[3]);
                    if (!kfrag) { bf16_t* op = o + (size_t)row * DD + head * 128 + 32 * wc + 4 * fq; *(u32x2*)op = w0; *(u32x2*)(op + 16) = w1; }
                    else {
                        bf16_t* op = o + ((((size_t)((row >> 8) * 8 + head) * 8 + ((row >> 5) & 7)) * 8 + 2 * wc) * 512 + ((fq >> 1) * 32 + (row & 31)) * 8 + 4 * (fq & 1));
                        *(u32x2*)op = w0; *(u32x2*)(op + 512) = w1; }
                    asm volatile("" ::: "memory");
                }
            if (kmean) {
#pragma unroll
                for (int i = 0; i < 4; ++i) {
#pragma unroll
                    for (int o2 = 1; o2 < 16; o2 <<= 1) { cs0[i] += sh_xor(cs0[i], o2, lane); cs1[i] += sh_xor(cs1[i], o2, lane); }
                }
                if (fr == 0) { *(PG8_LAS f32x4*)(KS + (wr * 2 + bj) * 128 + 32 * wc + 4 * fq) = cs0; *(PG8_LAS f32x4*)(KS + (wr * 2 + bj) * 128 + 32 * wc + 16 + 4 * fq) = cs1; }
            }
        }
        EPI_BAR();
        if (kmean) {
            const int tid2 = wid * 64 + lane;
            if (tid2 < 256) { const int bj = tid2 >> 7, d = tid2 & 127;
                kmean[((size_t)(2 * u.pn + bj) * 64 + u.pm) * 128 + d] = (KS[bj * 128 + d] + KS[(2 + bj) * 128 + d]) * (1.0f / 256.0f); }
            EPI_BAR();
        }
    }
};

template <class Epi, class Sched, bool ALIGN_EPI = false, bool SP2 = false>
__device__ __forceinline__ void gemm_phase(PG8_LAS unsigned char* lds, PG8_LAS unsigned char* elds, const Gemm g, const Sched& S, const Epi& E) {
    int tid_ = threadIdx.x; asm volatile("" : "+v"(tid_)); const int tid = tid_, wid = __builtin_amdgcn_readfirstlane(tid >> 6), lane = tid & 63, wr = wid >> 2, wc = wid & 3, fr = lane & 15, fq = lane >> 4;
    const int K = g.K, nt = K / BK;
    float zf_ = 0.f; asm volatile("" : "+v"(zf_)); const f32x4 z4_ = {zf_, zf_, zf_, zf_};
    unsigned voffA[2], voffB[2];
#pragma unroll
    for (int i = 0; i < 2; ++i) { int R, C; stage_rc(tid * 16 + i * 8192, R, C); const int Rb = Epi::PERM ? ((R & ~31) + perm32(R & 31)) : R;
        voffA[i] = (unsigned)(R * K + C) * 2u; voffB[i] = (unsigned)(Rb * K + C) * 2u; }
    const size_t kstep = (size_t)(BK * 2);
    const size_t hstep = (size_t)HALF * K * 2;
    const size_t tstep = 2 * hstep; const size_t tstepA = (size_t)g.a_rows * K * 2;
    const unsigned ldsw = (unsigned)wid * 1024u;
    const int aoff = lds_byte(wr * 64 + fr, fq * 8), boff = lds_byte(wc * 32 + fr, fq * 8);
#define PG8_SA(b, h) (((b) * 2 + (h)) * HTB)
#define PG8_SB(b, h) ((4 + (b) * 2 + (h)) * HTB)
#define PG8_STAGE(bufoff, gbase, voff) do { _Pragma("unroll") for (int _i = 0; _i < 2; ++_i) \
        __builtin_amdgcn_global_load_lds((const unsigned*)((const char*)(gbase) + (voff)[_i]), (PG8_LAS unsigned*)(lds + (bufoff) + ldsw + _i * 8192), 16, 0, 0); } while (0)
#define PG8_LDA(dst, b, h) do { _Pragma("unroll") for (int m = 0; m < 4; ++m) _Pragma("unroll") for (int k = 0; k < 2; ++k) dst[m][k] = *(const PG8_LAS bf16x8*)(lds + PG8_SA(b, h) + aoff + m * 2048 + k * 1024); } while (0)
#define PG8_LDB(dst, b, h) do { _Pragma("unroll") for (int n = 0; n < 2; ++n) _Pragma("unroll") for (int k = 0; k < 2; ++k) dst[n][k] = *(const PG8_LAS bf16x8*)(lds + PG8_SB(b, h) + boff + n * 2048 + k * 1024); } while (0)
#define PG8_MMA(ai, bj, At, Bt) do { __builtin_amdgcn_s_setprio(1); _Pragma("unroll") for (int m = 0; m < 4; ++m) _Pragma("unroll") for (int n = 0; n < 2; ++n) _Pragma("unroll") for (int k = 0; k < 2; ++k) \
        acc[ai][bj][m][n] = __builtin_amdgcn_mfma_f32_16x16x32_bf16(Bt[n][k], At[m][k], acc[ai][bj][m][n], 0, 0, 0); __builtin_amdgcn_s_setprio(0); } while (0)
#define PG8_WAIT_V(n) asm volatile("s_waitcnt vmcnt(" #n ")" ::: "memory")
#define PG8_WAIT_L(n) asm volatile("s_waitcnt lgkmcnt(" #n ")" ::: "memory")
#define PG8_BAR __builtin_amdgcn_s_barrier()
#define PG8_SCHED __builtin_amdgcn_sched_barrier(0)
    Unit cur, nxt; int ui = 0;
    if (!S.next(0, cur)) return;
    f32x4 acc[2][2][4][2];
#pragma unroll
    for (int a = 0; a < 2; ++a)
#pragma unroll
        for (int b = 0; b < 2; ++b)
#pragma unroll
            for (int m = 0; m < 4; ++m)
#pragma unroll
                for (int n = 0; n < 2; ++n) acc[a][b][m][n] = z4_;
    bf16x8 At[4][2], B0[2][2], B1[2][2];
    const char* cA = (const char*)g.A + (size_t)cur.pm * tstepA; const char* cB = (const char*)g.Bt + (size_t)cur.pn * tstep;
    S.a_ready(cur);
    if constexpr (SP2) {
        PG8_STAGE(PG8_SB(0, 0), cB, voffB); PG8_STAGE(PG8_SB(0, 1), cB + hstep, voffB); PG8_STAGE(PG8_SA(0, 0), cA, voffA); PG8_STAGE(PG8_SA(0, 1), cA + hstep, voffA);
        if (wr == 1) PG8_BAR;
        PG8_WAIT_V(2); PG8_BAR;
        PG8_STAGE(PG8_SB(1, 0), cB + kstep, voffB); PG8_STAGE(PG8_SA(1, 0), cA + kstep, voffA); PG8_STAGE(PG8_SB(1, 1), cB + hstep + kstep, voffB);
        PG8_WAIT_V(6); PG8_BAR;
    } else {
        PG8_STAGE(PG8_SB(0, 0), cB, voffB); PG8_STAGE(PG8_SA(0, 0), cA, voffA); PG8_STAGE(PG8_SB(0, 1), cB + hstep, voffB); PG8_STAGE(PG8_SA(0, 1), cA + hstep, voffA);
        if (wr == 1) PG8_BAR;
        PG8_WAIT_V(4); PG8_BAR;
        PG8_STAGE(PG8_SB(1, 0), cB + kstep, voffB); PG8_STAGE(PG8_SA(1, 0), cA + kstep, voffA); PG8_STAGE(PG8_SB(1, 1), cB + hstep + kstep, voffB);
        PG8_WAIT_V(6); PG8_BAR;
    }
    for (;;) {
        const bool has_next = S.next(ui + 1, nxt);
        const char* nA = has_next ? (const char*)g.A + (size_t)nxt.pm * tstepA : cA; const char* nB = has_next ? (const char*)g.Bt + (size_t)nxt.pn * tstep : cB;
        for (int t = 0; t < nt; t += 2) {
            const bool last = (t == nt - 2);
            const char* a1 = cA + (size_t)(t + 1) * kstep;
            const char* a2 = last ? nA : cA + (size_t)(t + 2) * kstep; const char* b2 = last ? nB : cB + (size_t)(t + 2) * kstep;
            const char* a3 = a2 + kstep; const char* b3 = b2 + kstep;
            if (last && has_next) S.a_ready(nxt);
            if constexpr (SP2) {
            PG8_LDB(B0, 0, 0); PG8_LDB(B1, 0, 1); PG8_SCHED; PG8_LDA(At, 0, 0); PG8_STAGE(PG8_SA(1, 1), a1 + hstep, voffA);
            PG8_WAIT_V(8); PG8_WAIT_L(0); PG8_BAR; PG8_MMA(0, 0, At, B0); PG8_MMA(0, 1, At, B1); PG8_BAR; PG8_SCHED;
            PG8_LDA(At, 0, 1); PG8_STAGE(PG8_SB(0, 0), b2, voffB); PG8_STAGE(PG8_SB(0, 1), b2 + hstep, voffB); PG8_STAGE(PG8_SA(0, 0), a2, voffA);
            PG8_WAIT_V(8); PG8_WAIT_L(0); PG8_BAR; PG8_MMA(1, 0, At, B0); PG8_MMA(1, 1, At, B1); PG8_BAR; PG8_SCHED;
            PG8_LDB(B0, 1, 0); PG8_LDB(B1, 1, 1); PG8_SCHED; PG8_LDA(At, 1, 0); PG8_STAGE(PG8_SA(0, 1), a2 + hstep, voffA);
            PG8_WAIT_V(8); PG8_WAIT_L(0); PG8_BAR; PG8_MMA(0, 0, At, B0); PG8_MMA(0, 1, At, B1); PG8_BAR; PG8_SCHED;
            PG8_LDA(At, 1, 1); PG8_STAGE(PG8_SB(1, 0), b3, voffB); PG8_STAGE(PG8_SB(1, 1), b3 + hstep, voffB); PG8_STAGE(PG8_SA(1, 0), a3, voffA);
            PG8_WAIT_V(8); PG8_WAIT_L(0); PG8_BAR; PG8_MMA(1, 0, At, B0); PG8_MMA(1, 1, At, B1); PG8_BAR; PG8_SCHED;
            } else {
            PG8_LDB(B0, 0, 0); PG8_SCHED; PG8_LDA(At, 0, 0); PG8_STAGE(PG8_SA(1, 1), a1 + hstep, voffA);
            PG8_WAIT_L(8); PG8_BAR; PG8_WAIT_L(0); PG8_MMA(0, 0, At, B0); PG8_BAR; PG8_SCHED;
            PG8_LDB(B1, 0, 1); PG8_STAGE(PG8_SB(0, 0), b2, voffB);
            PG8_BAR; PG8_WAIT_L(0); PG8_MMA(0, 1, At, B1); PG8_BAR;
            PG8_LDA(At, 0, 1); PG8_STAGE(PG8_SA(0, 0), a2, voffA);
            PG8_BAR; PG8_WAIT_L(0); PG8_MMA(1, 0, At, B0); PG8_BAR; PG8_SCHED;
            PG8_STAGE(PG8_SB(0, 1), b2 + hstep, voffB);
            PG8_WAIT_V(6); PG8_BAR; PG8_MMA(1, 1, At, B1); PG8_BAR;
            PG8_LDB(B0, 1, 0); PG8_SCHED; PG8_LDA(At, 1, 0); PG8_STAGE(PG8_SA(0, 1), a2 + hstep, voffA);
            PG8_WAIT_L(8); PG8_BAR; PG8_WAIT_L(0); PG8_MMA(0, 0, At, B0); PG8_BAR; PG8_SCHED;
            PG8_LDB(B1, 1, 1); PG8_STAGE(PG8_SB(1, 0), b3, voffB);
            PG8_BAR; PG8_WAIT_L(0); PG8_MMA(0, 1, At, B1); PG8_BAR;
            PG8_LDA(At, 1, 1); PG8_STAGE(PG8_SA(1, 0), a3, voffA);
            PG8_BAR; PG8_WAIT_L(0); PG8_MMA(1, 0, At, B0); PG8_BAR; PG8_SCHED;
            PG8_STAGE(PG8_SB(1, 1), b3 + hstep, voffB);
            PG8_WAIT_V(6); PG8_BAR; PG8_MMA(1, 1, At, B1); PG8_BAR;
            }
        }
        if constexpr (ALIGN_EPI) { if (wr == 0) PG8_BAR; }
        { E(acc, cur, wr, wc, fr, fq, elds, wid, lane); S.done(cur); }
        if (!has_next) break;
#pragma unroll
        for (int a = 0; a < 2; ++a)
#pragma unroll
            for (int b = 0; b < 2; ++b)
#pragma unroll
                for (int m = 0; m < 4; ++m)
#pragma unroll
                    for (int n = 0; n < 2; ++n) acc[a][b][m][n] = z4_;
        cur = nxt; cA = nA; cB = nB; ++ui;
        if constexpr (ALIGN_EPI) { if (wr == 1) PG8_BAR; }
    }
    PG8_WAIT_V(0);
    if constexpr (!ALIGN_EPI) { if (wr == 0) PG8_BAR; }
    PG8_BAR;
#undef PG8_SA
#undef PG8_SB
#undef PG8_STAGE
#undef PG8_LDA
#undef PG8_LDB
#undef PG8_MMA
#undef PG8_WAIT_V
#undef PG8_WAIT_L
#undef PG8_BAR
#undef PG8_SCHED
}
}


#define GAS __attribute__((address_space(1)))
#define LAS __attribute__((address_space(3)))
typedef unsigned short bf16;
typedef unsigned v4u __attribute__((ext_vector_type(4)));
typedef float f32x4 __attribute__((ext_vector_type(4)));
typedef short bf16x8 __attribute__((ext_vector_type(8)));

constexpr int NWAVES = 8;
constexpr int T = 16384, D = 1024, FF = 2816, FF2 = 5632, MIN_ = 3080;
constexpr size_t MiB = 1u << 20;
constexpr size_t WS_CTL = 0, CTL_ZERO_BYTES = 2 * MiB;
constexpr size_t WS_SS = 64 * 1024;
constexpr size_t WS_WINR = 2 * MiB;
constexpr size_t WS_WINT = 10 * MiB;
constexpr size_t WS_WOUT = 16 * MiB;
constexpr size_t WS_WK = 20 * MiB, WS_WV = 22 * MiB;
constexpr size_t WS_WQ = 24 * MiB;
constexpr size_t WS_WO = 28 * MiB;
constexpr size_t WS_WUP = 32 * MiB;
constexpr size_t WS_WDN = 76 * MiB;
constexpr size_t WS_WG = 98 * MiB;
constexpr size_t WS_ROPE = 99 * MiB;
constexpr size_t WS_HB = 101 * MiB;
constexpr size_t HB_ROW0 = 2 * 2048;
constexpr size_t WS_ACT = 135 * MiB;
constexpr size_t WS_CT = 135 * MiB;
constexpr size_t WS_MQ = 199 * MiB;
constexpr size_t WS_BCUM = 215 * MiB, WS_IG = WS_BCUM + 256 * 1024, WS_WGT = WS_IG + 256 * 1024, WS_DECAY = WS_WGT + 256 * 1024;
constexpr size_t WS_NCT = 217 * MiB;
constexpr size_t WS_ONES = 221 * MiB;
constexpr size_t WS_MK = 223 * MiB;
constexpr size_t WS_OG = 239 * MiB;
constexpr size_t WS_KVT = 271 * MiB;
constexpr size_t WS_HG = 319 * MiB;
constexpr size_t WS_XK = 223 * MiB;
constexpr size_t WS_XVT = 255 * MiB;
constexpr size_t WS_KMEAN = 287 * MiB;
constexpr size_t WS_AQ = 288 * MiB;
constexpr size_t WS_LIST = 320 * MiB;
constexpr size_t WS_ML = 337 * MiB;
constexpr size_t WS_PO = 135 * MiB, WS_PO2 = 340 * MiB;
constexpr int PO_SPLIT = 14336;
constexpr int TRI = 516096;
constexpr size_t WS_GCNT = 1536 * 1024;
constexpr size_t WS_END = 352 * MiB;
constexpr int CW_BAR = 4096;
constexpr int RING_BYTES = 131072, EPI_OFF = RING_BYTES + 1024, LDS_BYTES = 163840, MISC_OFF = LDS_BYTES - 256;

#define LDS_WAIT() asm volatile("s_waitcnt lgkmcnt(0)" ::: "memory")
__device__ __forceinline__ unsigned f2bf(float f) { unsigned u = __builtin_bit_cast(unsigned, f); return (u + 0x7fffu + ((u >> 16) & 1u)) >> 16; }
__device__ __forceinline__ unsigned pk2(float lo, float hi) { return f2bf(lo) | (f2bf(hi) << 16); }

#define XB_TMO      128
#define XB_XCNT(j)  (256  + 64 * (j))
#define XB_XSUB(j)  (1280 + 64 * (j))
#define XB_XGEN(j)  (2304 + 64 * (j))
#define XB_TOP      3328
#define XB_TOPGEN   3392
#define XCD_BAR_WORDS 3456
#define XB_SPIN_CAP (1u << 18)
__device__ __forceinline__ unsigned xb_ld(unsigned* p)              { return __hip_atomic_load(p, __ATOMIC_RELAXED, __HIP_MEMORY_SCOPE_AGENT); }
__device__ __forceinline__ unsigned xb_add(unsigned* p, unsigned v) { return __hip_atomic_fetch_add(p, v, __ATOMIC_RELAXED, __HIP_MEMORY_SCOPE_AGENT); }
__device__ __forceinline__ unsigned xb_xcc_id() { return (unsigned)__builtin_amdgcn_s_getreg((3 << 11) | 20) & 0xFu; }
#define XB_SPIN(cond, bar) do { unsigned _sp = 0; while (cond) { __builtin_amdgcn_s_sleep(1); \
    if ((++_sp & 255u) == 0u) { if (xb_ld(&(bar)[XB_TMO])) break; if (_sp > XB_SPIN_CAP) { atomicAdd(&(bar)[XB_TMO], 1u); break; } } } } while (0)
struct XcdBarrier { unsigned* bar; unsigned x; volatile LAS unsigned* st; };
__device__ __forceinline__ XcdBarrier xcd_barrier_post(unsigned* bar, volatile LAS unsigned* st) {
    XcdBarrier b; b.bar = bar; b.x = xb_xcc_id(); b.st = st;
    if (threadIdx.x == 0) (void)xb_add(&bar[XB_XCNT(b.x)], 1u);
    return b;
}
__device__ __forceinline__ void xcd_barrier_complete(unsigned* bar, unsigned x, unsigned& nloc, unsigned& nx) {
    const unsigned G = gridDim.x * gridDim.y * gridDim.z;
    unsigned sum, cnt, mine, sp = 0u;
    for (;;) {
        sum = 0u; cnt = 0u; mine = 0u;
#pragma unroll
        for (unsigned j = 0; j < 16; ++j) { const unsigned c = xb_ld(&bar[XB_XCNT(j)]); sum += c; cnt += (c > 0u) ? 1u : 0u; mine = (j == x) ? c : mine; }
        if (sum == G) break;
        __builtin_amdgcn_s_sleep(1);
        if ((++sp & 255u) == 0u) { if (xb_ld(&bar[XB_TMO])) break; if (sp > XB_SPIN_CAP) { atomicAdd(&bar[XB_TMO], 1u); break; } }
    }
    nloc = mine > 0u ? mine : 1u; nx = cnt > 0u ? cnt : 1u;
}
__device__ __forceinline__ void xcd_barrier(const XcdBarrier& b) {
    asm volatile("s_waitcnt vmcnt(0)" ::: "memory");
    __syncthreads();
    if (threadIdx.x == 0) {
        unsigned* bar = b.bar;
        __builtin_amdgcn_s_waitcnt(0);
        unsigned nloc = b.st[0], nx = b.st[1];
        if (nloc == 0u) { xcd_barrier_complete(bar, b.x, nloc, nx); b.st[0] = nloc; b.st[1] = nx; }
        const unsigned old = xb_add(&bar[XB_XSUB(b.x)], 1u);
        const unsigned gen = old / nloc;
        if (old + 1u == (gen + 1u) * nloc) {
            __builtin_amdgcn_fence(__ATOMIC_RELEASE, "agent");
            asm volatile("s_waitcnt vmcnt(0)" ::: "memory");
            const unsigned og = xb_add(&bar[XB_TOP], 1u);
            const unsigned tg = og / nx;
            if (og + 1u == (tg + 1u) * nx) xb_add(&bar[XB_TOPGEN], 1u);
            else XB_SPIN(xb_ld(&bar[XB_TOPGEN]) == tg, bar);
            __builtin_amdgcn_fence(__ATOMIC_ACQUIRE, "agent");
            xb_add(&bar[XB_XGEN(b.x)], 1u);
            asm volatile("s_waitcnt vmcnt(0)" ::: "memory");
        } else {
            XB_SPIN(xb_ld(&bar[XB_XGEN(b.x)]) == gen, bar);
            __builtin_amdgcn_fence(__ATOMIC_ACQUIRE, "agent");
            asm volatile("s_waitcnt vmcnt(0)" ::: "memory");
        }
    }
    __syncthreads();
}

using pg8::sh_idx; using pg8::sh_xor; using pg8::half_sum_hi; using pg8::oct_sum;
__device__ __forceinline__ float wave_sum(float v, int lane) {
#pragma unroll
    for (int o = 1; o < 64; o <<= 1) v += sh_xor(v, o, lane);
    return v;
}
__device__ __forceinline__ void transpose_item(const float* W, int ldw, int k0, int n0, const float* gain, bf16* WT, int Kd, int d0, bf16* WT2, int d1, LAS float* scr, int lane) {
    float v_[32], g_[32];
#pragma unroll
    for (int i = 0; i < 32; ++i) { const int kk = 2 * i + (lane >> 5); v_[i] = W[(size_t)(k0 + kk) * ldw + n0 + (lane & 31)]; g_[i] = gain ? gain[k0 + kk] : 1.0f; }
#pragma unroll
    for (int i = 0; i < 32; ++i) { const int kk = 2 * i + (lane >> 5); scr[kk * 33 + (lane & 31)] = v_[i] * g_[i]; }
    LDS_WAIT(); asm volatile("" ::: "memory");
    const int c = lane & 7;
#pragma unroll
    for (int j = 0; j < 4; ++j) { const int n = (lane >> 3) + 8 * j; const LAS float* s = scr + (8 * c) * 33 + n;
        v4u o; o.x = pk2(s[0 * 33], s[1 * 33]); o.y = pk2(s[2 * 33], s[3 * 33]); o.z = pk2(s[4 * 33], s[5 * 33]); o.w = pk2(s[6 * 33], s[7 * 33]);
        *(GAS v4u*)(WT + (size_t)(d0 + n) * Kd + k0 + 8 * c) = o;
        if (WT2) *(GAS v4u*)(WT2 + (size_t)(d1 + n) * Kd + k0 + 8 * c) = o; }
    LDS_WAIT(); asm volatile("" ::: "memory");
}


typedef float f32x16 __attribute__((ext_vector_type(16)));
__device__ __forceinline__ float bf2f(unsigned short v) { return __builtin_bit_cast(float, (unsigned)v << 16); }
__device__ __forceinline__ float log_sigmoidf(float f) { return fminf(f, 0.f) - log1pf(expf(-fabsf(f))); }

__device__ __forceinline__ void mlstm_gates_item(LAS unsigned char* L, int c, const bf16* hbr, const float* wg, const float* ssn, const float* bg,
                                                 float* BCUM, float* IG, float* WGT, float* DECAY, bf16* WROW) {
    int tid_ = threadIdx.x; asm volatile("" : "+v"(tid_)); const int tid = tid_, lane = tid & 63, wave = __builtin_amdgcn_readfirstlane(tid >> 6); (void)tid; (void)lane; (void)wave;
    LAS float* Gs = (LAS float*)L;
    float w[16][8];
#pragma unroll
    for (int j = 0; j < 2; ++j)
#pragma unroll
        for (int i = 0; i < 8; ++i) { const int k = 8 * lane + 512 * j + i; const f32x4 a = *(const f32x4*)(wg + k * 8), b = *(const f32x4*)(wg + k * 8 + 4);
            w[8 * j + i][0] = a[0]; w[8 * j + i][1] = a[1]; w[8 * j + i][2] = a[2]; w[8 * j + i][3] = a[3]; w[8 * j + i][4] = b[0]; w[8 * j + i][5] = b[1]; w[8 * j + i][6] = b[2]; w[8 * j + i][7] = b[3]; }
    for (int tt = 0; tt < 8; ++tt) {
        const int tl = wave * 8 + tt, t = 64 * c + tl;
        const GAS v4u* xr = (const GAS v4u*)(hbr + (size_t)t * D) + lane;
        float a8[8] = {0.f, 0.f, 0.f, 0.f, 0.f, 0.f, 0.f, 0.f};
#pragma unroll
        for (int j = 0; j < 2; ++j) { const v4u xv = xr[64 * j];
#pragma unroll
            for (int i = 0; i < 8; ++i) { const float xf = (i & 1) ? __builtin_bit_cast(float, xv[i >> 1] & 0xffff0000u) : __builtin_bit_cast(float, xv[i >> 1] << 16);
#pragma unroll
                for (int q = 0; q < 8; ++q) a8[q] += xf * w[8 * j + i][q]; } }
        const float rs = pg8::rstd4(ssn, t);
#pragma unroll
        for (int q = 0; q < 8; ++q) { const float v = wave_sum(a8[q], lane); if (lane == 0) Gs[tl * 8 + q] = v * rs; }
    }
    LDS_WAIT(); __syncthreads();
    if (wave < 4) {
        const int h = wave, t = 64 * c + lane;
        const float gi = Gs[lane * 8 + h] + bg[h], gf = Gs[lane * 8 + 4 + h] + bg[4 + h];
        float b = log_sigmoidf(gf);
#pragma unroll
        for (int o = 1; o < 64; o <<= 1) { const float v = sh_idx(b, lane - o); if (lane >= o) b += v; }
        const float bl = sh_idx(b, 63);
        BCUM[(size_t)h * T + t] = b; IG[(size_t)h * T + t] = gi; { const float wv_ = expf(bl - b + gi); WGT[(size_t)h * T + t] = wv_; WROW[(size_t)(c * 4 + h) * 64 + lane] = (bf16)f2bf(wv_); }
        if (lane == 63) DECAY[c * 4 + h] = expf(bl);
    }
    LDS_WAIT(); __syncthreads();
}

__device__ __forceinline__ bf16x8 scale_bf16x8(bf16x8 v, bf16x8 wv) {
    typedef unsigned u4 __attribute__((ext_vector_type(4)));
    const u4 u = __builtin_bit_cast(u4, v), w = __builtin_bit_cast(u4, wv); u4 o;
#pragma unroll
    for (int i = 0; i < 4; ++i)
        o[i] = pg8::cvt_pk_bf16(__builtin_bit_cast(float, u[i] << 16) * __builtin_bit_cast(float, w[i] << 16), __builtin_bit_cast(float, u[i] & 0xffff0000u) * __builtin_bit_cast(float, w[i] & 0xffff0000u));
    return __builtin_bit_cast(bf16x8, o);
}
__device__ __forceinline__ void mlstm_scan(const bf16* KVT, const float* DECAY, bf16* CT, bf16* NCT, const bf16* WROW, const bf16* ZROW, int G, bool probe_same = false) {
    int tid_ = threadIdx.x; asm volatile("" : "+v"(tid_)); const int tid = tid_, lane = tid & 63, wave = __builtin_amdgcn_readfirstlane(tid >> 6); (void)tid;
    bool active, ntask; int h, e0, d0;
    if (G == 256) { const int x = (int)blockIdx.x & 7, cu = (int)blockIdx.x >> 3; h = x >> 1;
        if (wave < 2) { const int k = wave * 32 + cu; active = true; ntask = false; e0 = (x & 1) * 128 + (k >> 3) * 16; d0 = (k & 7) * 16; }
        else { active = (wave == 2) && ((x & 1) == 0) && (cu < 8); ntask = true; e0 = 0; d0 = (cu & 7) * 16; }
    } else { const int gw = wave * G + (int)blockIdx.x; active = gw < 544; ntask = gw >= 512;
        if (!ntask) { h = gw >> 7; e0 = ((gw >> 3) & 15) * 16; d0 = (gw & 7) * 16; } else { const int q = gw - 512; h = (q >> 3) & 3; e0 = 0; d0 = (q & 7) * 16; } }
    if (probe_same) { h = 0; e0 = 0; d0 = 0; }
    if (active) {
        const int fr = lane & 15, fq = lane >> 4;
        const bf16* arow = KVT + (size_t)((h * 8 + (d0 >> 4)) * 2) * 512 + lane * 8;
        const bf16* brow = ntask ? ((fr == 0 ? WROW + h * 64 : ZROW) + 8 * fq) : (KVT + (size_t)((32 + h * 16 + (e0 >> 4)) * 2) * 512 + lane * 8);
        bf16* crow = ntask ? (NCT + ((size_t)h * 16 + fr) * 128 + d0 + 4 * fq) : (CT + ((size_t)(h * 8 + (e0 >> 5)) * 8 + (d0 >> 4)) * 512 + ((fq >> 1) * 32 + (e0 & 16) + fr) * 8 + 4 * (fq & 1));
        const size_t cstep = probe_same ? (size_t)0 : (ntask ? (size_t)4 * 16 * 128 : (size_t)4 * 256 * 128);
        const float* drow = DECAY + h;
        const size_t bstep = ntask ? (fr == 0 ? (size_t)256 : (size_t)0) : (size_t)1536 * 64;
        constexpr int P = 8;
        bf16x8 sa[P][2], sb[P][2]; float sd[P];
        const char* pa = (const char*)arow; const char* pb = (const char*)brow; const size_t b2off = ntask ? 64 : 1024;     const char* pd = (const char*)(DECAY + h); char* pc = (char*)crow;
        const size_t astep = (size_t)1536 * 64 * 2, bstepb = bstep * 2, cstepb = cstep * 2;
#define SC_LD16(dst, ptr, OFF) asm volatile("global_load_dwordx4 %0, %1, off offset:" #OFF : "=&v"(dst) : "v"(ptr) : "memory")
#define SC_LD4(dst, ptr) asm volatile("global_load_dword %0, %1, off" : "=&v"(dst) : "v"(ptr) : "memory")
#define SC_LOADS(j) do { SC_LD16(sa[j][0], pa, 0); SC_LD16(sa[j][1], pa, 1024); { const char* pb2_ = pb + b2off; SC_LD16(sb[j][0], pb, 0); SC_LD16(sb[j][1], pb2_, 0); } SC_LD4(sd[j], pd); pa += astep; pb += bstepb; pd += 16; } while (0)
#pragma unroll
        for (int j = 0; j < P; ++j) { float dm_; SC_LD4(dm_, pd); SC_LOADS(j); }
        f32x4 acc = (f32x4){0.f, 0.f, 0.f, 0.f};
        for (int c0 = 0; c0 < 256; c0 += P) {
#pragma unroll
            for (int j = 0; j < P; ++j) {
                asm volatile("s_waitcnt vmcnt(42)" : "+v"(sa[j][0]), "+v"(sa[j][1]), "+v"(sb[j][0]), "+v"(sb[j][1]), "+v"(sd[j]) :: "memory");
                { typedef unsigned u2 __attribute__((ext_vector_type(2))); u2 o; o.x = pg8::cvt_pk_bf16(acc[0], acc[1]); o.y = pg8::cvt_pk_bf16(acc[2], acc[3]);
                  if (!probe_same) asm volatile("global_store_dwordx2 %0, %1, off" :: "v"(pc), "v"(o) : "memory"); else { float dm2_; asm volatile("global_load_dword %0, %1, off" : "=&v"(dm2_) : "v"(pd), "v"(o) : "memory"); }
                  pc += cstepb; }
                acc = acc * sd[j];
                acc = __builtin_amdgcn_mfma_f32_16x16x32_bf16(sa[j][0], sb[j][0], acc, 0, 0, 0);
                acc = __builtin_amdgcn_mfma_f32_16x16x32_bf16(sa[j][1], sb[j][1], acc, 0, 0, 0);
                asm volatile("" : "+v"(acc));
                SC_LOADS(j);
            }
        }
        asm volatile("s_waitcnt vmcnt(0)" ::: "memory");
#undef SC_LD16
#undef SC_LD4
#undef SC_LOADS
    }
}

constexpr int M3_BUF = 36864;
constexpr int M3_QS = 0, M3_KS = 17408, M3_BC = 35840, M3_IG = 36096, M3_NV = 36352;
constexpr int M3_SS = 73728, M3_DQ = 82944, M3_DSP = 83200, M3_OS = 83968  ;
__device__ __forceinline__ void mlstm_out_phase(LAS unsigned char* L, int G, const bf16* Q, const bf16* K, const bf16* KVT, const bf16* CT, const bf16* NCT,
                                                const float* BCUM, const float* WGT, const bf16* OG, const float* hn, bf16* HG) {
    int tid_ = threadIdx.x; asm volatile("" : "+v"(tid_)); const int tid = tid_, lane = tid & 63, wave = __builtin_amdgcn_readfirstlane(tid >> 6);
    const int r = lane & 31, hh = lane >> 5;
    LAS float* dq = (LAS float*)(L + M3_DQ); LAS float* dsp = (LAS float*)(L + M3_DSP); LAS float* OS = (LAS float*)(L + M3_OS);
    int it = (int)blockIdx.x; if (it >= 1024) return;
    bf16x8 ctf[8], vtf[4]; v4u ogf[4]; v4u qk[4]; float sm = 0.f;
#define M3_LD_CT(c_, h_) do { const bf16* ctp = CT + (((size_t)((c_) * 4 + (h_)) * 8 + wave) * 8) * 512 + lane * 8; _Pragma("unroll") for (int kk = 0; kk < 8; ++kk) ctf[kk] = *(const bf16x8*)(ctp + 512 * kk); } while (0)
#define M3_LD_VT(c_, h_) do { const bf16* vtp = KVT + (((size_t)(c_) * 96 + 32 + (h_) * 16 + 2 * wave + (r >> 4)) * 2) * 512 + (hh * 16 + (r & 15)) * 8; _Pragma("unroll") for (int kk = 0; kk < 4; ++kk) vtf[kk] = *(const bf16x8*)(vtp + (kk >> 1) * 512 + (kk & 1) * 256); } while (0)
#define M3_LD_OG(c_, h_) do { const bf16* ogp = OG + (size_t)(64 * (c_) + (tid >> 3)) * 1024 + (h_) * 256 + 8 * (tid & 7); _Pragma("unroll") for (int k = 0; k < 4; ++k) ogf[k] = *(const GAS v4u*)(ogp + 64 * k); } while (0)
#define M3_LD_QK(c_, h_) do { _Pragma("unroll") for (int j = 0; j < 4; ++j) { const int i = tid + 512 * j, which = i >> 10, idx = i & 1023, row = idx >> 4, ch = idx & 15; \
            qk[j] = which ? *(const GAS v4u*)(KVT + (((size_t)(c_) * 96 + (h_) * 8) * 2) * 512 + idx * 8) : *(const GAS v4u*)(Q + (size_t)(64 * (c_) + row) * 512 + (h_) * 128 + ch * 8); } \
        if (tid < 64) sm = BCUM[(size_t)(h_) * T + 64 * (c_) + tid]; else if (tid < 128) sm = WGT[(size_t)(h_) * T + 64 * (c_) + tid - 64]; else if (tid < 256) sm = bf2f(NCT[(size_t)((c_) * 4 + (h_)) * 16 * 128 + tid - 128]); } while (0)
#define M3_ST_QK(B_) do { _Pragma("unroll") for (int j = 0; j < 4; ++j) { const int i = tid + 512 * j, which = i >> 10, idx = i & 1023, row = idx >> 4, ch = idx & 15; if (which) { const int bi_ = idx >> 6, lp_ = idx & 63; *(LAS v4u*)((B_) + M3_KS + (16 * (bi_ >> 1) + (lp_ & 15)) * 144 + (32 * (bi_ & 1) + 8 * (lp_ >> 4)) * 2) = qk[j]; } \
            else *(LAS v4u*)((B_) + row * 272 + ch * 16) = qk[j]; } \
        if (tid < 256) ((LAS float*)((B_) + M3_BC))[tid] = sm; } while (0)
    { const int c = it >> 2, h = it & 3; M3_LD_CT(c, h); M3_LD_VT(c, h); M3_LD_OG(c, h); M3_LD_QK(c, h); M3_ST_QK(L); }
    LDS_WAIT(); __syncthreads();
    int pb = 0;
    for (;;) {
        const int c = it >> 2, h = it & 3, t0 = 64 * c, itn = it + G; const bool has_next = itn < 1024; const int cn = itn >> 2, hn_ = itn & 3;
        LAS unsigned char* B = L + pb * M3_BUF; LAS unsigned char* Bn = L + (pb ^ 1) * M3_BUF;
        LAS float* bc = (LAS float*)(B + M3_BC); LAS float* ig = (LAS float*)(B + M3_IG); LAS float* nv = (LAS float*)(B + M3_NV);
        if (has_next) M3_LD_QK(cn, hn_);
        f32x16 O[2];
#pragma unroll
        for (int i = 0; i < 16; ++i) { O[0][i] = 0.f; O[1][i] = 0.f; }
#pragma unroll
        for (int kk = 0; kk < 8; ++kk) {
            const bf16x8 a0 = *(const LAS bf16x8*)(B + M3_QS + r * 272 + (16 * kk + 8 * hh) * 2), a1 = *(const LAS bf16x8*)(B + M3_QS + (32 + r) * 272 + (16 * kk + 8 * hh) * 2);
            O[0] = __builtin_amdgcn_mfma_f32_32x32x16_bf16(a0, ctf[kk], O[0], 0, 0, 0); O[1] = __builtin_amdgcn_mfma_f32_32x32x16_bf16(a1, ctf[kk], O[1], 0, 0, 0);
        }
        if (has_next) M3_LD_CT(cn, hn_);
        if (wave < 4) {
            const int tt = wave >> 1, s2 = wave & 1; f32x16 S;
#pragma unroll
            for (int i = 0; i < 16; ++i) S[i] = 0.f;
#pragma unroll
            for (int kk = 0; kk < 8; ++kk) {
                const bf16x8 a = *(const LAS bf16x8*)(B + M3_QS + (32 * tt + r) * 272 + (16 * kk + 8 * hh) * 2);
                typedef short v4i16_t __attribute__((ext_vector_type(4)));
                const int i16 = lane & 15, q4 = i16 >> 2, p4 = i16 & 3, blk = (lane >> 4) & 1;
                LAS unsigned char* tb = B + M3_KS + (16 * kk + 8 * hh + q4) * 144 + (32 * s2 + 16 * blk + 4 * p4) * 2;
                const v4i16_t lo = __builtin_amdgcn_ds_read_tr16_b64_v4i16((LAS v4i16_t*)tb), hi = __builtin_amdgcn_ds_read_tr16_b64_v4i16((LAS v4i16_t*)(tb + 4 * 144));
                const bf16x8 b = __builtin_shufflevector(lo, hi, 0, 1, 2, 3, 4, 5, 6, 7);
                S = __builtin_amdgcn_mfma_f32_32x32x16_bf16(a, b, S, 0, 0, 0);
            }
            const int s = 32 * s2 + r; const float ws = ig[s], bl = bc[63];
#pragma unroll
            for (int i = 0; i < 16; ++i) {
                const int t = 32 * tt + (i & 3) + 8 * (i >> 2) + 4 * hh;
                const float v = (s <= t) ? S[i] * __expf(bc[t] - bl) : 0.f;
                const float rsum = half_sum_hi(v * ws);
                if (r == 16) dsp[s2 * 64 + t] = rsum;
                *(LAS unsigned short*)(L + M3_SS + t * 144 + s * 2) = (unsigned short)f2bf(v);
            }
        } else {
            const int th = tid - 256, t = th >> 2, part = th & 3; float sum = 0.f;
#pragma unroll 8
            for (int d = 0; d < 32; ++d) sum += bf2f(*(const LAS unsigned short*)(B + M3_QS + t * 272 + (32 * part + d) * 2)) * nv[32 * part + d];
            sum = pg8::dpp_add<0xB1>(sum); sum = pg8::dpp_add<0x4E>(sum);
            if (part == 0) dq[t] = sum;
        }
        LDS_WAIT(); __syncthreads();
#pragma unroll
        for (int tt = 0; tt < 2; ++tt)
#pragma unroll
            for (int i = 0; i < 16; ++i) O[tt][i] *= __expf(bc[32 * tt + (i & 3) + 8 * (i >> 2) + 4 * hh]);
#pragma unroll
        for (int kk = 0; kk < 4; ++kk) {
            const bf16x8 a0 = *(const LAS bf16x8*)(L + M3_SS + r * 144 + (16 * kk + 8 * hh) * 2), a1 = *(const LAS bf16x8*)(L + M3_SS + (32 + r) * 144 + (16 * kk + 8 * hh) * 2);
            O[0] = __builtin_amdgcn_mfma_f32_32x32x16_bf16(a0, vtf[kk], O[0], 0, 0, 0); O[1] = __builtin_amdgcn_mfma_f32_32x32x16_bf16(a1, vtf[kk], O[1], 0, 0, 0);
        }
        if (has_next) M3_LD_VT(cn, hn_);
#pragma unroll
        for (int tt = 0; tt < 2; ++tt)
#pragma unroll
            for (int i = 0; i < 16; ++i) OS[(32 * tt + (i & 3) + 8 * (i >> 2) + 4 * hh) * 260 + 32 * wave + r] = O[tt][i];
        LDS_WAIT(); __syncthreads();
        {
            const int t = tid >> 3, part = tid & 7;
            const float den = __expf(bc[t]) * dq[t] + dsp[t] + dsp[64 + t];
            const float inv = __builtin_amdgcn_rcpf(fmaxf(fabsf(den), 1.0f));
            f32x4 v[8]; float ssq = 0.f;
#pragma unroll
            for (int k = 0; k < 8; ++k) { v[k] = *(const LAS f32x4*)(OS + t * 260 + 64 * (k >> 1) + 8 * part + 4 * (k & 1)) * inv; ssq += (v[k][0] * v[k][0] + v[k][1] * v[k][1]) + (v[k][2] * v[k][2] + v[k][3] * v[k][3]); }
            ssq = oct_sum(ssq);
            const float rsn = rsqrtf(ssq * (1.0f / 256.0f) + 1e-6f);
            const float* gp = hn + h * 256 + 8 * part;
            bf16* op = HG + (size_t)(t0 + t) * 1024 + h * 256 + 8 * part;
#pragma unroll
            for (int k = 0; k < 4; ++k) {
                const f32x4 g0 = *(const f32x4*)(gp + 64 * k), g1 = *(const f32x4*)(gp + 64 * k + 4);
                float o8[8];
#pragma unroll
                for (int x2 = 0; x2 < 4; ++x2) {
                    const float og0 = __builtin_bit_cast(float, ogf[k][x2] << 16), og1 = __builtin_bit_cast(float, ogf[k][x2] & 0xffff0000u);
                    const float a0 = (2 * x2 < 4) ? v[2 * k][2 * x2] : v[2 * k + 1][2 * x2 - 4], a1 = (2 * x2 + 1 < 4) ? v[2 * k][2 * x2 + 1] : v[2 * k + 1][2 * x2 + 1 - 4];
                    const float gg0 = (2 * x2 < 4) ? g0[2 * x2] : g1[2 * x2 - 4], gg1 = (2 * x2 + 1 < 4) ? g0[2 * x2 + 1] : g1[2 * x2 + 1 - 4];
                    o8[2 * x2] = a0 * rsn * gg0 * __builtin_amdgcn_rcpf(1.0f + __builtin_amdgcn_exp2f(-1.4426950408889634f * og0)); o8[2 * x2 + 1] = a1 * rsn * gg1 * __builtin_amdgcn_rcpf(1.0f + __builtin_amdgcn_exp2f(-1.4426950408889634f * og1)); }
                v4u w; w.x = pg8::cvt_pk_bf16(o8[0], o8[1]); w.y = pg8::cvt_pk_bf16(o8[2], o8[3]); w.z = pg8::cvt_pk_bf16(o8[4], o8[5]); w.w = pg8::cvt_pk_bf16(o8[6], o8[7]);
                *(GAS v4u*)(op + 64 * k) = w; }
        }
        if (has_next) { M3_LD_OG(cn, hn_); M3_ST_QK(Bn); }
        LDS_WAIT(); __syncthreads();
        if (!has_next) break;
        it = itn; pb ^= 1;
    }
#undef M3_LD_CT
#undef M3_LD_VT
#undef M3_LD_OG
#undef M3_LD_QK
#undef M3_ST_QK
}

constexpr int AT_QS = 0, AT_PS = 34816, AT_PM = 102400, AT_PSUM = 106496, AT_ENT = 110592, AT_W = 111104, AT_MX = 113152, AT_PRE = 113664  , AT_WT = 115744;
constexpr int GT_KH = 34816, GT_KL = 52224, GT_SC = 69632, GT_LCNT = 102912, GT_BASE = 103168;
__device__ __forceinline__ int list_off(int h, int b) { return h * TRI + b * T - 128 * b * (b + 1); }
__device__ __forceinline__ void moba_gate_phase(LAS unsigned char* L, int G, const bf16* AQ, const float* KMEAN, int* gcnt, int* LIST) {
    int tid_ = threadIdx.x; asm volatile("" : "+v"(tid_)); const int tid = tid_, lane = tid & 63, wave = __builtin_amdgcn_readfirstlane(tid >> 6);
    const int r = lane & 31, hh = lane >> 5;
    LAS int* LCNT = (LAS int*)(L + GT_LCNT); LAS int* BASE = (LAS int*)(L + GT_BASE); LAS float* SC = (LAS float*)(L + GT_SC);
    int h_loaded = -1;
    int it = (int)blockIdx.x;
    while (it < 1024 && (it >> 4) == 0) it += G;
    if (it >= 1024) return;
    v4u qn[4];
#pragma unroll
    for (int j = 0; j < 4; ++j) { const int i = tid + 512 * j, rl = i >> 4, ch = i & 15; qn[j] = *(const GAS v4u*)(AQ + (size_t)(128 * (it >> 3) + rl) * 1024 + (it & 7) * 128 + ch * 8); }
    for (;;) {
        const int qi = it >> 3, h = it & 7, cur = qi >> 1;
        int itn = it + G; const bool has_next = itn < 1024;
        if (h != h_loaded) {
            for (int i = tid; i < 64 * 128; i += 512) { const int bb = i >> 7, d = i & 127; const float v = KMEAN[((size_t)h * 64 + bb) * 128 + d];
                const unsigned hi = f2bf(v), lo = f2bf(v - bf2f((unsigned short)hi));
                *(LAS unsigned short*)(L + GT_KH + bb * 272 + d * 2) = (unsigned short)hi; *(LAS unsigned short*)(L + GT_KL + bb * 272 + d * 2) = (unsigned short)lo; }
            h_loaded = h; }
#pragma unroll
        for (int j = 0; j < 4; ++j) { const int i = tid + 512 * j, rl = i >> 4, ch = i & 15; *(LAS v4u*)(L + AT_QS + rl * 272 + ch * 16) = qn[j]; }
        if (tid < 64) LCNT[tid] = 0;
        LDS_WAIT(); __syncthreads();
        if (has_next) {
#pragma unroll
            for (int j = 0; j < 4; ++j) { const int i = tid + 512 * j, rl = i >> 4, ch = i & 15; qn[j] = *(const GAS v4u*)(AQ + (size_t)(128 * (itn >> 3) + rl) * 1024 + (itn & 7) * 128 + ch * 8); }
        }
        {   const int tt = wave >> 1, bt = wave & 1; f32x16 S;
#pragma unroll
            for (int i = 0; i < 16; ++i) S[i] = 0.f;
#pragma unroll
            for (int kk = 0; kk < 8; ++kk) {
                const bf16x8 a = *(const LAS bf16x8*)(L + AT_QS + (32 * tt + r) * 272 + (16 * kk + 8 * hh) * 2);
                const bf16x8 bh = *(const LAS bf16x8*)(L + GT_KH + (32 * bt + r) * 272 + (16 * kk + 8 * hh) * 2), bl = *(const LAS bf16x8*)(L + GT_KL + (32 * bt + r) * 272 + (16 * kk + 8 * hh) * 2);
                S = __builtin_amdgcn_mfma_f32_32x32x16_bf16(a, bh, S, 0, 0, 0); S = __builtin_amdgcn_mfma_f32_32x32x16_bf16(a, bl, S, 0, 0, 0);
            }
#pragma unroll
            for (int i = 0; i < 16; ++i) SC[(32 * tt + (i & 3) + 8 * (i >> 2) + 4 * hh) * 65 + 32 * bt + r] = S[i];
        }
        LDS_WAIT(); __syncthreads();
        int p0 = -1, p1 = -1, p2 = -1, l0 = 0, l1 = 0, l2 = 0; const int nsel = cur < 3 ? cur : 3;
        if (tid < 128) {
            float v0 = -INFINITY, v1 = -INFINITY, v2 = -INFINITY;
            for (int b = 0; b < cur; ++b) { const float sc = SC[tid * 65 + b];
                if (sc > v0) { v2 = v1; p2 = p1; v1 = v0; p1 = p0; v0 = sc; p0 = b; }
                else if (sc > v1) { v2 = v1; p2 = p1; v1 = sc; p1 = b; }
                else if (sc > v2) { v2 = sc; p2 = b; } }
            if (nsel > 0 && p0 >= 0) l0 = __hip_atomic_fetch_add(LCNT + p0, 1, __ATOMIC_RELAXED, __HIP_MEMORY_SCOPE_WORKGROUP);
            if (nsel > 1 && p1 >= 0) l1 = __hip_atomic_fetch_add(LCNT + p1, 1, __ATOMIC_RELAXED, __HIP_MEMORY_SCOPE_WORKGROUP);
            if (nsel > 2 && p2 >= 0) l2 = __hip_atomic_fetch_add(LCNT + p2, 1, __ATOMIC_RELAXED, __HIP_MEMORY_SCOPE_WORKGROUP);
        }
        LDS_WAIT(); __syncthreads();
        if (tid < cur) { const int n = LCNT[tid]; if (n > 0) BASE[tid] = __hip_atomic_fetch_add(gcnt + h * 64 + tid, n, __ATOMIC_RELAXED, __HIP_MEMORY_SCOPE_AGENT); }
        LDS_WAIT(); __syncthreads();
        if (tid < 128) { const int tg = (128 * qi + tid) << 2;
            if (nsel > 0 && p0 >= 0) LIST[list_off(h, p0) + BASE[p0] + l0] = tg | 0;
            if (nsel > 1 && p1 >= 0) LIST[list_off(h, p1) + BASE[p1] + l1] = tg | 1;
            if (nsel > 2 && p2 >= 0) LIST[list_off(h, p2) + BASE[p2] + l2] = tg | 2; }
        LDS_WAIT(); __syncthreads();
        if (!has_next) break;
        it = itn;
    }
}

constexpr int AP_QS0 = 0, AP_QS1 = 34816, AP_PS = 69632, AP_PM = 137216, AP_PSUM = 141312, AP_ENT0 = 145408, AP_ENT1 = 145920, AP_W = 146432, AP_MX = 148480, AP_PRE = 148992  , AP_WT = 151072;
struct AItem { int h, b, row0, nrows, qi; const int* list; bool valid; };
template <bool OWN>
__device__ __forceinline__ AItem attn_get(int k, int G, const LAS int* PRE, int total, const int* gcnt, const int* LIST) {
    AItem it; const int idx = (int)blockIdx.x + k * G;
    if (OWN) { it.valid = idx < 1024; it.qi = idx >> 3; it.h = idx & 7; it.b = it.qi >> 1; it.row0 = 128 * it.qi; it.nrows = 128; it.list = nullptr; }
    else {
        it.valid = idx < total; it.qi = 0; int lo = 0, hi = 512;
        if (it.valid) { while (hi - lo > 1) { const int mid = (lo + hi) >> 1; if (PRE[mid] <= idx) lo = mid; else hi = mid; } }
        const int hb = lo; it.h = hb >> 6; it.b = hb & 63; const int i = it.valid ? idx - PRE[hb] : 0, n = it.valid ? gcnt[hb] : 0;
        it.row0 = 128 * i; it.nrows = (n - 128 * i) < 128 ? (n - 128 * i) : 128; it.list = LIST + list_off(it.h, it.b);
    }
    return it;
}
template <bool OWN>
__device__ __forceinline__ void attn_phase(LAS unsigned char* L, int G, const int* gcnt, const int* LIST, const bf16* AQ, const bf16* XK, const bf16* XVT, bf16* PO, float* ML, bf16* AOUT, int tmask, int probe = 0) {
    int tid_ = threadIdx.x; asm volatile("" : "+v"(tid_)); const int tid = tid_, lane = tid & 63, wave = __builtin_amdgcn_readfirstlane(tid >> 6);
    const int r = lane & 31, hh = lane >> 5;
    LAS int* PRE = (LAS int*)(L + AP_PRE); LAS int* WT = (LAS int*)(L + AP_WT);
    LAS float* PM = (LAS float*)(L + AP_PM); LAS float* PSUM = (LAS float*)(L + AP_PSUM); LAS float* MX = (LAS float*)(L + AP_MX); LAS float* W = (LAS float*)(L + AP_W);
    int total = 0;
    if (!OWN) {
        int v = (gcnt[tid] + 127) >> 7;
#pragma unroll
        for (int o = 1; o < 64; o <<= 1) { const int u = __builtin_amdgcn_ds_bpermute((lane - o) << 2, v); if (lane >= o) v += u; }
        if (lane == 63) WT[wave] = v;
        LDS_WAIT(); __syncthreads();
        int add = 0;
#pragma unroll
        for (int w8 = 0; w8 < 8; ++w8) if (w8 < wave) add += WT[w8];
        PRE[tid + 1] = v + add; if (tid == 0) PRE[0] = 0;
        LDS_WAIT(); __syncthreads();
        total = PRE[512];
    }
    AItem cur = attn_get<OWN>(0, G, PRE, total, gcnt, LIST);
    if (!cur.valid) return;
    int pb = 0;
    {   LAS int* ENT = (LAS int*)(L + AP_ENT0);
        if (!OWN) { if (tid < 128) ENT[tid] = (tid < cur.nrows) ? cur.list[cur.row0 + tid] : -1; LDS_WAIT(); __syncthreads(); }
        for (int i = tid; i < 2048; i += 512) { const int rl = i >> 4, ch = i & 15; int t;
            if (OWN) t = cur.row0 + rl; else { const int e = ENT[rl]; t = e >= 0 ? (e >> 2) : 0; }
            const v4u v = *(const GAS v4u*)(AQ + (size_t)t * 1024 + cur.h * 128 + ch * 8); *(LAS v4u*)(L + AP_QS0 + rl * 272 + ch * 16) = v; }
        LDS_WAIT(); __syncthreads();
    }
    for (int k = 0; ; ++k) {
        const AItem nxt = attn_get<OWN>(k + 1, G, PRE, total, gcnt, LIST);
        const int h = (probe & 2) ? 0 : cur.h, b = (probe & 2) ? 0 : cur.b, qi = cur.qi, row0 = cur.row0;
        LAS unsigned char* Qc = L + (pb ? AP_QS1 : AP_QS0); LAS unsigned char* Qn = L + (pb ? AP_QS0 : AP_QS1);
        LAS int* ENT = (LAS int*)(L + (pb ? AP_ENT1 : AP_ENT0)); LAS int* ENTn = (LAS int*)(L + (pb ? AP_ENT0 : AP_ENT1));
        const int dt = wave & 3, tp = wave >> 2;
        bf16x8 kf[8], vf[16];
        {   const bf16* kp = XK + (((size_t)(b * 8 + h) * 8 + wave) * 8) * 512 + lane * 8;
#pragma unroll
            for (int kk = 0; kk < 8; ++kk) kf[kk] = *(const bf16x8*)(kp + 512 * kk);
            const bf16* vp = XVT + (((size_t)(b * 8 + h) * 4 + dt) * 16) * 512 + lane * 8;
#pragma unroll
            for (int kk = 0; kk < 16; ++kk) vf[kk] = *(const bf16x8*)(vp + 512 * kk);
        }
        int e_n = -1;
        if (!OWN && nxt.valid && tid < 128 && tid < nxt.nrows) e_n = nxt.list[nxt.row0 + tid];
        f32x16 S[4];
#pragma unroll
        for (int tq = 0; tq < 4; ++tq) {
#pragma unroll
            for (int i = 0; i < 16; ++i) S[tq][i] = 0.f;
#pragma unroll
            for (int kk = 0; kk < 8; ++kk) { const bf16x8 bq = *(const LAS bf16x8*)(Qc + (32 * tq + r) * 272 + (16 * kk + 8 * hh) * 2);
                S[tq] = __builtin_amdgcn_mfma_f32_32x32x16_bf16(kf[kk], bq, S[tq], 0, 0, 0); }
        }
#pragma unroll
        for (int tq = 0; tq < 4; ++tq) {
            const int t = 32 * tq + r; float ps = 0.f;
#pragma unroll
            for (int i = 0; i < 16; ++i) {
                float sv = S[tq][i];
                if (OWN) { const int key = 32 * wave + (i & 3) + 8 * (i >> 2) + 4 * hh, lim = (qi & 1) * 128 + t; if (key > lim) sv = -INFINITY; }
                const float p = __builtin_amdgcn_exp2f(sv); S[tq][i] = p; ps += p; }
            ps += sh_xor(ps, 32, lane);
            if (hh == 0) PSUM[wave * 128 + t] = ps;
#pragma unroll
            for (int g = 0; g < 4; ++g) { pg8::u32x2 w2; w2.x = pg8::cvt_pk_bf16(S[tq][4 * g], S[tq][4 * g + 1]); w2.y = pg8::cvt_pk_bf16(S[tq][4 * g + 2], S[tq][4 * g + 3]);
                *(LAS pg8::u32x2*)(L + AP_PS + t * 528 + (32 * wave + 8 * g + 4 * hh) * 2) = w2; }
        }
        if (!OWN && tid < 128) ENTn[tid] = e_n;
        LDS_WAIT(); __syncthreads();
        v4u qn[4];
        if (nxt.valid) {
#pragma unroll
            for (int j = 0; j < 4; ++j) { const int i = tid + 512 * j, rl = i >> 4, ch = i & 15; int t;
                if (OWN) t = nxt.row0 + rl; else { const int e = ENTn[rl]; t = e >= 0 ? (e >> 2) : 0; if (probe & 4) t = rl; }
                qn[j] = *(const GAS v4u*)(AQ + (size_t)t * 1024 + nxt.h * 128 + ch * 8); }
        }
        f32x16 O[2];
#pragma unroll
        for (int i = 0; i < 16; ++i) { O[0][i] = 0.f; O[1][i] = 0.f; }
#pragma unroll
        for (int kk = 0; kk < 16; ++kk) {
            const bf16x8 a0 = *(const LAS bf16x8*)(L + AP_PS + (64 * tp + r) * 528 + (16 * kk + 8 * hh) * 2), a1 = *(const LAS bf16x8*)(L + AP_PS + (64 * tp + 32 + r) * 528 + (16 * kk + 8 * hh) * 2);
            O[0] = __builtin_amdgcn_mfma_f32_32x32x16_bf16(a0, vf[kk], O[0], 0, 0, 0); O[1] = __builtin_amdgcn_mfma_f32_32x32x16_bf16(a1, vf[kk], O[1], 0, 0, 0);
        }
        const int curb = qi >> 1, nsel = curb < 3 ? curb : 3;
        if (OWN) {
            if (tid < 128) { const int t = row0 + tid; float Lo = 0.f;
#pragma unroll
                for (int w8 = 0; w8 < 8; ++w8) Lo += PSUM[w8 * 128 + tid];
                float den = Lo;
#pragma unroll
                for (int j = 0; j < 3; ++j) if (j < nsel) den += ML[((size_t)(t * 8 + h) * 3 + j) * 2 + 1];
                const float inv = 1.0f / den;
                W[tid * 4 + 0] = inv; W[tid * 4 + 1] = nsel > 0 ? inv : 0.f; W[tid * 4 + 2] = nsel > 1 ? inv : 0.f; W[tid * 4 + 3] = nsel > 2 ? inv : 0.f; }
        }
        LDS_WAIT(); __syncthreads();
        {   LAS float* OS = (LAS float*)(L + AP_PS);
#pragma unroll
            for (int q = 0; q < 2; ++q)
#pragma unroll
                for (int i = 0; i < 16; ++i) OS[(64 * tp + 32 * q + (i & 3) + 8 * (i >> 2) + 4 * hh) * 132 + 32 * dt + r] = O[q][i];
        }
        LDS_WAIT(); __syncthreads();
        {   const LAS float* OS = (const LAS float*)(L + AP_PS);
            const int rl = tid >> 2, c4 = tid & 3;
            if (!OWN) {
                const int e = (probe & 1) ? -1 : ENT[rl];
                if (e >= 0) {
                    const int te = e >> 2; bf16* dst = (te < PO_SPLIT ? PO : PO + (WS_PO2 - WS_PO) / 2 - (size_t)PO_SPLIT * 3072) + ((size_t)(te * 8 + h) * 3 + (e & 3)) * 128;
#pragma unroll
                    for (int kq = 0; kq < 4; ++kq) { const int ch = c4 + 4 * kq; const f32x4 a = *(const LAS f32x4*)(OS + rl * 132 + ch * 8), b2 = *(const LAS f32x4*)(OS + rl * 132 + ch * 8 + 4);
                        v4u w; w.x = pg8::cvt_pk_bf16(a[0], a[1]); w.y = pg8::cvt_pk_bf16(a[2], a[3]); w.z = pg8::cvt_pk_bf16(b2[0], b2[1]); w.w = pg8::cvt_pk_bf16(b2[2], b2[3]);
                        *(GAS v4u*)(dst + ch * 8) = w; }
                    if (c4 == 0) { float Ls = 0.f;
#pragma unroll
                        for (int w8 = 0; w8 < 8; ++w8) Ls += PSUM[w8 * 128 + rl];
                        float* ml = ML + ((size_t)((e >> 2) * 8 + h) * 3 + (e & 3)) * 2; ml[0] = 0.f; ml[1] = Ls; }
                }
            } else {
                const int t = row0 + rl; const f32x4 w4 = *(const LAS f32x4*)(W + rl * 4);
                const bf16* po = (t < PO_SPLIT ? PO : PO + (WS_PO2 - WS_PO) / 2 - (size_t)PO_SPLIT * 3072) + ((size_t)(t * 8 + h) * 3) * 128;
                const unsigned m0 = nsel > 0 ? 0xffffffffu : 0u, m1 = nsel > 1 ? 0xffffffffu : 0u, m2 = nsel > 2 ? 0xffffffffu : 0u;
#pragma unroll
                for (int kq = 0; kq < 4; ++kq) { const int ch = c4 + 4 * kq;
                    const f32x4 a = *(const LAS f32x4*)(OS + rl * 132 + ch * 8), b2 = *(const LAS f32x4*)(OS + rl * 132 + ch * 8 + 4);
                    v4u p0 = *(const GAS v4u*)(po + ch * 8), p1 = *(const GAS v4u*)(po + 128 + ch * 8), p2 = *(const GAS v4u*)(po + 256 + ch * 8);
                    p0 = p0 & m0; p1 = p1 & m1; p2 = p2 & m2;
                    float o8[8] = {a[0] * w4[0], a[1] * w4[0], a[2] * w4[0], a[3] * w4[0], b2[0] * w4[0], b2[1] * w4[0], b2[2] * w4[0], b2[3] * w4[0]};
#pragma unroll
                    for (int x2 = 0; x2 < 4; ++x2) {
                        o8[2 * x2] += w4[1] * __builtin_bit_cast(float, p0[x2] << 16) + w4[2] * __builtin_bit_cast(float, p1[x2] << 16) + w4[3] * __builtin_bit_cast(float, p2[x2] << 16);
                        o8[2 * x2 + 1] += w4[1] * __builtin_bit_cast(float, p0[x2] & 0xffff0000u) + w4[2] * __builtin_bit_cast(float, p1[x2] & 0xffff0000u) + w4[3] * __builtin_bit_cast(float, p2[x2] & 0xffff0000u); }
                    v4u w; w.x = pg8::cvt_pk_bf16(o8[0], o8[1]); w.y = pg8::cvt_pk_bf16(o8[2], o8[3]); w.z = pg8::cvt_pk_bf16(o8[4], o8[5]); w.w = pg8::cvt_pk_bf16(o8[6], o8[7]);
                    *(GAS v4u*)(AOUT + (size_t)(t & tmask) * 1024 + h * 128 + ch * 8) = w; }
            }
        }
        if (nxt.valid) {
#pragma unroll
            for (int j = 0; j < 4; ++j) { const int i = tid + 512 * j, rl = i >> 4, ch = i & 15; *(LAS v4u*)(Qn + rl * 272 + ch * 16) = qn[j]; }
        }
        LDS_WAIT(); __syncthreads();
        if (!nxt.valid) break;
        cur = nxt; pb ^= 1;
    }
}


struct Args { const float* in[18]; float* out; unsigned char* ws; unsigned long long ws_size; };

typedef const __attribute__((address_space(4))) Args* KArgsP;
#define KA() ({ KArgsP p_ = (KArgsP)__builtin_amdgcn_kernarg_segment_ptr(); asm volatile("" : "+s"(p_)); p_; })
#define AIN(i) ((const float*)KA()->in[i])
#define WSB ((unsigned char*)KA()->ws)
#define XIN AIN(0)
#define OUTP ((float*)KA()->out)
#define SS ((float*)(WSB + WS_SS))
#define HBP ((bf16*)(WSB + WS_HB))
#define HB ((bf16*)(WSB + WS_HB + HB_ROW0))
#define ACT ((bf16*)(WSB + WS_ACT))
constexpr int H2_BYTES = 69632, H2_QS = 0  , H2_PS = 17408  , H2_OS = 51200  ;
constexpr int H2_PSUM = 139264  , H2_ENT = 143360  , H2_PRE = 144896  , H2_WT = 146976;
#define H2_BAR() do { asm volatile("s_waitcnt lgkmcnt(0)" ::: "memory"); __builtin_amdgcn_s_barrier(); asm volatile("" ::: "memory"); } while (0)
template <bool OWN>
__device__ __forceinline__ void attn_store_rows(LAS unsigned char* L, int hf, int ht, int par, int eslot, const AItem& it, bf16* PO, float* ML, bf16* AOUT, int tmask) {
    const int rl = ht >> 2, c4 = ht & 3, h = it.h;
    const LAS float* PSUM = (const LAS float*)(L + H2_PSUM) + (par * 2 + hf) * 256; const LAS int* ENT = (const LAS int*)(L + H2_ENT) + eslot * 128;
    const LAS unsigned char* OSb = L + hf * H2_BYTES + H2_OS + rl * 272;
    const float Ls = (PSUM[rl] + PSUM[64 + rl]) + (PSUM[128 + rl] + PSUM[192 + rl]);
    if (!OWN) {
        const int e = ENT[64 * hf + rl];
        if (e >= 0) {
            const int te = e >> 2; bf16* dst = (te < PO_SPLIT ? PO : PO + (WS_PO2 - WS_PO) / 2 - (size_t)PO_SPLIT * 3072) + ((size_t)(te * 8 + h) * 3 + (e & 3)) * 128;
#pragma unroll
            for (int kq = 0; kq < 4; ++kq) { const int ch = c4 + 4 * kq; *(GAS v4u*)(dst + ch * 8) = *(const LAS v4u*)(OSb + ch * 16); }
            if (c4 == 0) { float* ml = ML + ((size_t)(te * 8 + h) * 3 + (e & 3)) * 2; ml[0] = 0.f; ml[1] = Ls; }
        }
    } else {
        const int t = it.row0 + 64 * hf + rl, curb = it.qi >> 1, nsel = curb < 3 ? curb : 3;
        float den = Ls;
#pragma unroll
        for (int j = 0; j < 3; ++j) if (j < nsel) den += ML[((size_t)(t * 8 + h) * 3 + j) * 2 + 1];
        const float inv = 1.0f / den;
        const bf16* po = (t < PO_SPLIT ? PO : PO + (WS_PO2 - WS_PO) / 2 - (size_t)PO_SPLIT * 3072) + ((size_t)(t * 8 + h) * 3) * 128;
        const unsigned m0 = nsel > 0 ? 0xffffffffu : 0u, m1 = nsel > 1 ? 0xffffffffu : 0u, m2 = nsel > 2 ? 0xffffffffu : 0u;
#pragma unroll
        for (int kq = 0; kq < 4; ++kq) { const int ch = c4 + 4 * kq;
            const v4u a = *(const LAS v4u*)(OSb + ch * 16);
            v4u p0 = *(const GAS v4u*)(po + ch * 8), p1 = *(const GAS v4u*)(po + 128 + ch * 8), p2 = *(const GAS v4u*)(po + 256 + ch * 8);
            p0 = p0 & m0; p1 = p1 & m1; p2 = p2 & m2;
            float o8[8];
#pragma unroll
            for (int x2 = 0; x2 < 4; ++x2) {
                o8[2 * x2] = (__builtin_bit_cast(float, a[x2] << 16) + __builtin_bit_cast(float, p0[x2] << 16) + __builtin_bit_cast(float, p1[x2] << 16) + __builtin_bit_cast(float, p2[x2] << 16)) * inv;
                o8[2 * x2 + 1] = (__builtin_bit_cast(float, a[x2] & 0xffff0000u) + __builtin_bit_cast(float, p0[x2] & 0xffff0000u) + __builtin_bit_cast(float, p1[x2] & 0xffff0000u) + __builtin_bit_cast(float, p2[x2] & 0xffff0000u)) * inv; }
            v4u w; w.x = pg8::cvt_pk_bf16n(o8[0], o8[1]); w.y = pg8::cvt_pk_bf16n(o8[2], o8[3]); w.z = pg8::cvt_pk_bf16n(o8[4], o8[5]); w.w = pg8::cvt_pk_bf16n(o8[6], o8[7]);
            *(GAS v4u*)(AOUT + (size_t)(t & tmask) * 1024 + h * 128 + ch * 8) = w; }
    }
}
template <bool OWN>
__device__ __forceinline__ void attn_phase2(LAS unsigned char* L, int G, const int* gcnt, const int* LIST, const bf16* AQ, const bf16* XK, const bf16* XVT, bf16* PO, float* ML, bf16* AOUT, int tmask) {
    int tid_ = threadIdx.x; asm volatile("" : "+v"(tid_)); int tid = tid_, lane = tid & 63; const int wave = __builtin_amdgcn_readfirstlane(tid >> 6);
    int r = lane & 31, hh = lane >> 5, ht = tid & 255; const int hw = wave & 3, hf = wave >> 2;
    LAS int* PRE = (LAS int*)(L + H2_PRE); LAS int* WT = (LAS int*)(L + H2_WT);
    LAS unsigned char* HB_ = L + hf * H2_BYTES;
    int total = 0;
    if (!OWN) {
        int v = (gcnt[tid] + 127) >> 7;
#pragma unroll
        for (int o = 1; o < 64; o <<= 1) { const int u = __builtin_amdgcn_ds_bpermute((lane - o) << 2, v); if (lane >= o) v += u; }
        if (lane == 63) WT[wave] = v;
        LDS_WAIT(); __syncthreads();
        int add = 0;
#pragma unroll
        for (int w8 = 0; w8 < 8; ++w8) if (w8 < wave) add += WT[w8];
        PRE[tid + 1] = v + add; if (tid == 0) PRE[0] = 0;
        LDS_WAIT(); __syncthreads();
        total = PRE[512];
    }
    AItem cur = attn_get<OWN>(0, G, PRE, total, gcnt, LIST);
    if (!cur.valid) return;
    {   LAS int* ENT = (LAS int*)(L + H2_ENT);
        if (!OWN) { if (tid < 128) ENT[tid] = (tid < cur.nrows) ? cur.list[cur.row0 + tid] : -1; LDS_WAIT(); __syncthreads(); }
#pragma unroll
        for (int j = 0; j < 4; ++j) { const int i = ht + 256 * j, rl = i >> 4, ch = i & 15; int t;
            if (OWN) t = cur.row0 + 64 * hf + rl; else { const int e = ENT[64 * hf + rl]; t = e >= 0 ? (e >> 2) : 0; }
            *(LAS v4u*)(HB_ + H2_QS + rl * 272 + ch * 16) = *(const GAS v4u*)(AQ + (size_t)t * 1024 + cur.h * 128 + ch * 8); }
        LDS_WAIT(); __syncthreads();
    }
    bf16x8 kf[2][8], vf[16]; v4u qn[4]; int e_n = -1;
#define H2_LD_K(IT) do { const bf16* kp_ = XK + (((size_t)((IT).b * 8 + (IT).h) * 8 + 2 * hw) * 8) * 512 + lane * 8; _Pragma("unroll") for (int kt = 0; kt < 2; ++kt) _Pragma("unroll") for (int kk = 0; kk < 8; ++kk) kf[kt][kk] = *(const bf16x8*)(kp_ + (size_t)(kt * 8 + kk) * 512); } while (0)
#define H2_LD_V(IT) do { const bf16* vp_ = XVT + (((size_t)((IT).b * 8 + (IT).h) * 4 + hw) * 16) * 512 + lane * 8; _Pragma("unroll") for (int kk = 0; kk < 16; ++kk) vf[kk] = *(const bf16x8*)(vp_ + (size_t)kk * 512); } while (0)
    H2_LD_K(cur);
    if (hf == 1) H2_BAR();
    AItem prv = cur; bool have_prev = false; int par = 0, es = 0;
    for (int k = 0; ; ++k) {
        { int t2_ = threadIdx.x; asm volatile("" : "+v"(t2_)); tid = t2_; lane = tid & 63; r = lane & 31; hh = lane >> 5; ht = tid & 255; }
        const AItem nxt = attn_get<OWN>(k + 1, G, PRE, total, gcnt, LIST);
        LAS float* PSUM = (LAS float*)(L + H2_PSUM) + (par * 2 + hf) * 256; LAS int* ENTn = (LAS int*)(L + H2_ENT) + (es == 2 ? 0 : es + 1) * 128;
        if (!OWN && nxt.valid && hf == 0 && tid < 128) e_n = (tid < nxt.nrows) ? nxt.list[nxt.row0 + tid] : -1;
        f32x16 S[2][2];
#pragma unroll
        for (int kt = 0; kt < 2; ++kt)
#pragma unroll
            for (int tq = 0; tq < 2; ++tq) {
#pragma unroll
                for (int i = 0; i < 16; ++i) S[kt][tq][i] = 0.f;
#pragma unroll
                for (int kk = 0; kk < 8; ++kk) { const bf16x8 bq = *(const LAS bf16x8*)(HB_ + H2_QS + (32 * tq + r) * 272 + (16 * kk + 8 * hh) * 2);
                    S[kt][tq] = __builtin_amdgcn_mfma_f32_32x32x16_bf16(kf[kt][kk], bq, S[kt][tq], 0, 0, 0); }
            }
        H2_LD_V(cur);
        H2_BAR();
        if (!OWN && nxt.valid && hf == 0 && tid < 128) ENTn[tid] = e_n;
#pragma unroll
        for (int tq = 0; tq < 2; ++tq) {
            const int t = 32 * tq + r; float ps = 0.f;
#pragma unroll
            for (int kt = 0; kt < 2; ++kt) {
#pragma unroll
                for (int i = 0; i < 16; ++i) {
                    float sv = S[kt][tq][i];
                    if (OWN) { const int key = 64 * hw + 32 * kt + (i & 3) + 8 * (i >> 2) + 4 * hh, lim = (cur.qi & 1) * 128 + 64 * hf + t; if (key > lim) sv = -INFINITY; }
                    const float p = __builtin_amdgcn_exp2f(sv); S[kt][tq][i] = p; ps += p; }
#pragma unroll
                for (int g = 0; g < 4; ++g) { pg8::u32x2 w2; w2.x = pg8::cvt_pk_bf16n(S[kt][tq][4 * g], S[kt][tq][4 * g + 1]); w2.y = pg8::cvt_pk_bf16n(S[kt][tq][4 * g + 2], S[kt][tq][4 * g + 3]);
                    *(LAS pg8::u32x2*)(HB_ + H2_PS + t * 528 + (64 * hw + 32 * kt + 8 * g + 4 * hh) * 2) = w2; }
            }
            ps += sh_xor(ps, 32, lane);
            if (hh == 0) PSUM[hw * 64 + t] = ps;
        }
        if (have_prev) attn_store_rows<OWN>(L, hf, ht, par ^ 1, es == 0 ? 2 : es - 1, prv, PO, ML, AOUT, tmask);
        H2_BAR();
        if (nxt.valid) {
#pragma unroll
            for (int j = 0; j < 4; ++j) { const int i = ht + 256 * j, rl = i >> 4, ch = i & 15; int t;
                if (OWN) t = nxt.row0 + 64 * hf + rl; else { const int e = ENTn[64 * hf + rl]; t = e >= 0 ? (e >> 2) : 0; }
                qn[j] = *(const GAS v4u*)(AQ + (size_t)t * 1024 + nxt.h * 128 + ch * 8); }
        }
        f32x16 O[2];
#pragma unroll
        for (int i = 0; i < 16; ++i) { O[0][i] = 0.f; O[1][i] = 0.f; }
#pragma unroll
        for (int kk = 0; kk < 16; ++kk) {
            const bf16x8 a0 = *(const LAS bf16x8*)(HB_ + H2_PS + r * 528 + (16 * kk + 8 * hh) * 2), a1 = *(const LAS bf16x8*)(HB_ + H2_PS + (32 + r) * 528 + (16 * kk + 8 * hh) * 2);
            O[0] = __builtin_amdgcn_mfma_f32_32x32x16_bf16(a0, vf[kk], O[0], 0, 0, 0); O[1] = __builtin_amdgcn_mfma_f32_32x32x16_bf16(a1, vf[kk], O[1], 0, 0, 0);
        }
        H2_BAR();
#pragma unroll
        for (int tq = 0; tq < 2; ++tq)
#pragma unroll
            for (int i = 0; i < 16; ++i) *(LAS unsigned short*)(HB_ + H2_OS + (32 * tq + (i & 3) + 8 * (i >> 2) + 4 * hh) * 272 + (32 * hw + r) * 2) = (unsigned short)f2bf(O[tq][i]);
        if (nxt.valid) {
#pragma unroll
            for (int j = 0; j < 4; ++j) { const int i = ht + 256 * j, rl = i >> 4, ch = i & 15; *(LAS v4u*)(HB_ + H2_QS + rl * 272 + ch * 16) = qn[j]; }
            H2_LD_K(nxt);
        }
        H2_BAR();
        prv = cur; have_prev = true; par ^= 1; es = (es == 2) ? 0 : es + 1;
        if (!nxt.valid) break;
        cur = nxt;
    }
    if (hf == 0) H2_BAR();
    { int t2_ = threadIdx.x; asm volatile("" : "+v"(t2_)); ht = t2_ & 255; }
    attn_store_rows<OWN>(L, hf, ht, par ^ 1, es == 0 ? 2 : es - 1, prv, PO, ML, AOUT, tmask);
    LDS_WAIT(); __syncthreads();
#undef H2_LD_K
#undef H2_LD_V
}

enum { WK_IN = 0, WK_OUT, WK_KV, WK_Q, WK_O, WK_UP, WK_DN };
constexpr int I_IN = 16 * 96, I_SQ = 16 * 32, I_KV = 16 * 64, I_UP = 16 * 176, I_DN = 44 * 32;
#define AIN2(i) AIN(i)
#define WSB2 WSB
__device__ __forceinline__ void weight_item(int kind, int l, int r, LAS float* scr, int lane) {
    if (kind == WK_IN) { const int kb = r / 96, nb = r % 96, c0 = nb * 32;
        const float* W = AIN2(2) + (size_t)l * D * MIN_; const float* g = AIN2(1) + l * D;
        bf16* WR = (bf16*)(WSB2 + WS_WINR) + (size_t)l * 1536 * D; bf16* WTt = (bf16*)(WSB2 + WS_WINT) + (size_t)l * 1536 * D;
        if (c0 < 512) transpose_item(W, MIN_, kb * 64, c0, g, WR, D, c0, nullptr, 0, scr, lane);
        else if (c0 < 1024) transpose_item(W, MIN_, kb * 64, c0, g, WTt, D, c0 - 512, nullptr, 0, scr, lane);
        else if (c0 < 2048) transpose_item(W, MIN_, kb * 64, c0, g, WTt, D, 512 + c0 - 1024, nullptr, 0, scr, lane);
        else transpose_item(W, MIN_, kb * 64, c0, g, WR, D, 512 + c0 - 2048, nullptr, 0, scr, lane);
    } else if (kind == WK_OUT) { const int kb = r / 32, nb = r % 32;
        transpose_item(AIN2(5) + (size_t)l * D * D, D, kb * 64, nb * 32, nullptr, (bf16*)(WSB2 + WS_WOUT) + (size_t)l * D * D, D, nb * 32, nullptr, 0, scr, lane);
    } else if (kind == WK_KV) { const int kb = r / 64, nb = r % 64, c0 = nb * 32;
        if (c0 < 1024) transpose_item(AIN2(7), 2048, kb * 64, c0, AIN2(6), (bf16*)(WSB2 + WS_WK), D, c0, nullptr, 0, scr, lane);
        else transpose_item(AIN2(7), 2048, kb * 64, c0, AIN2(6), (bf16*)(WSB2 + WS_WV), D, c0 - 1024, nullptr, 0, scr, lane);
    } else if (kind == WK_Q) { const int kb = r / 32, nb = r % 32;
        transpose_item(AIN2(10) + (size_t)l * D * D, D, kb * 64, nb * 32, AIN2(9) + l * D, (bf16*)(WSB2 + WS_WQ) + (size_t)l * D * D, D, nb * 32, nullptr, 0, scr, lane);
    } else if (kind == WK_O) { const int kb = r / 32, nb = r % 32;
        transpose_item(AIN2(12) + (size_t)l * D * D, D, kb * 64, nb * 32, nullptr, (bf16*)(WSB2 + WS_WO) + (size_t)l * D * D, D, nb * 32, nullptr, 0, scr, lane);
    } else if (kind == WK_UP) { const int kb = r / 176, nb = r % 176, c0 = nb * 32;
        const int bj = c0 >= FF, cp = c0 - bj * FF, d0 = (cp / 128) * 256 + bj * 128 + (cp % 128);
        transpose_item(AIN2(14) + (size_t)l * D * FF2, FF2, kb * 64, c0, AIN2(13) + l * D, (bf16*)(WSB2 + WS_WUP) + (size_t)l * FF2 * D, D, d0, nullptr, 0, scr, lane);
    } else { const int kb = r / 32, nb = r % 32;
        transpose_item(AIN2(17) + (size_t)l * FF * D, D, kb * 64, nb * 32, nullptr, (bf16*)(WSB2 + WS_WDN) + (size_t)l * D * FF, FF, nb * 32, nullptr, 0, scr, lane); }
}
__device__ __forceinline__ void weight_set(int set, int widx, int nw, LAS float* scr, int lane) {
    if (set == 0) {
        for (int it = widx; it < I_IN; it += nw) weight_item(WK_IN, 0, it, scr, lane);
    } else if (set == 1) {
        constexpr int N = (I_SQ + I_UP + I_DN) + (I_IN + I_SQ + I_UP + I_DN);
        for (int it = widx; it < N; it += nw) { int r = it;
            if (r < I_SQ) { weight_item(WK_OUT, 0, r, scr, lane); continue; } r -= I_SQ;
            if (r < I_UP) { weight_item(WK_UP, 0, r, scr, lane); continue; } r -= I_UP;
            if (r < I_DN) { weight_item(WK_DN, 0, r, scr, lane); continue; } r -= I_DN;
            if (r < I_IN) { weight_item(WK_IN, 1, r, scr, lane); continue; } r -= I_IN;
            if (r < I_SQ) { weight_item(WK_OUT, 1, r, scr, lane); continue; } r -= I_SQ;
            if (r < I_UP) { weight_item(WK_UP, 1, r, scr, lane); continue; } r -= I_UP;
            weight_item(WK_DN, 1, r, scr, lane); }
    } else {
        constexpr int N = I_KV + 4 * I_SQ + 2 * I_UP + 2 * I_DN;
        for (int it = widx; it < N; it += nw) { int r = it;
            if (r < I_KV) { weight_item(WK_KV, 0, r, scr, lane); continue; } r -= I_KV;
            if (r < 2 * I_SQ) { weight_item(WK_Q, r / I_SQ, r % I_SQ, scr, lane); continue; } r -= 2 * I_SQ;
            if (r < 2 * I_SQ) { weight_item(WK_O, r / I_SQ, r % I_SQ, scr, lane); continue; } r -= 2 * I_SQ;
            if (r < 2 * I_UP) { weight_item(WK_UP, 2 + r / I_UP, r % I_UP, scr, lane); continue; } r -= 2 * I_UP;
            weight_item(WK_DN, 2 + r / I_DN, r % I_DN, scr, lane); }
    }
}

__global__ void __launch_bounds__(NWAVES * 64, 2) yoco_fwd(Args args) {
    extern __shared__ __attribute__((aligned(16))) unsigned char lds[];
    LAS unsigned char* L = (LAS unsigned char*)lds;
    volatile LAS unsigned* MISC = (volatile LAS unsigned*)(L + MISC_OFF);
    const int tid = threadIdx.x, lane = tid & 63, wave = __builtin_amdgcn_readfirstlane(tid >> 6);
    const int G = gridDim.x;
    for (int u = tid; u < (LDS_BYTES - RING_BYTES) / 4; u += NWAVES * 64) ((LAS unsigned*)(L + RING_BYTES))[u] = 0u;
    __syncthreads();
    (void)xcd_barrier_post((unsigned*)(WSB + WS_CTL) + CW_BAR, MISC + 8);
#define GRID_BAR() do { XcdBarrier b_; b_.bar = (unsigned*)(WSB + WS_CTL) + CW_BAR; b_.x = xb_xcc_id(); b_.st = (volatile LAS unsigned*)(L + MISC_OFF) + 8; xcd_barrier(b_); } while (0)

    for (int rp_ = 0; rp_ < REPS(1); ++rp_) {
        LAS float* scr = (LAS float*)(L + wave * 16384);
        const int gw = blockIdx.x * NWAVES + wave, NGW = G * NWAVES;
        weight_set(0, gw, NGW, scr, lane);
        { const int gt = blockIdx.x * (NWAVES * 64) + tid, NTH = G * NWAVES * 64;
          for (int i = gt; i < 2 * D * 8; i += NTH) { const int l = i / (D * 8), k = (i / 8) % D, j = i & 7;
              ((float*)(WSB + WS_WG))[i] = AIN(2)[(size_t)l * D * MIN_ + (size_t)k * MIN_ + 3072 + j] * AIN(1)[l * D + k]; } }
        { const int gt = blockIdx.x * (NWAVES * 64) + tid, NTH = G * NWAVES * 64; bf16* ON = (bf16*)(WSB + WS_ONES);
          for (int i = gt; i < 128; i += NTH) ON[128 * 1024 + i] = (bf16)0; }
        { const int gt = blockIdx.x * (NWAVES * 64) + tid, NTH = G * NWAVES * 64; float* RP = (float*)(WSB + WS_ROPE);
          for (int i = gt; i < T * 16; i += NTH) { const int pos = i >> 4, k = i & 15; const double inv = pow(500000.0, -(double)(2 * k) / 32.0), ang = (double)pos * inv;
              RP[i] = (float)cos(ang); RP[T * 16 + i] = (float)sin(ang); } }
        for (int m = gw; m < T; m += NGW) {
            const GAS f32x4* xr = (const GAS f32x4*)(XIN + (size_t)m * D) + lane; f32x4 v[4]; float s = 0.f;
#pragma unroll
            for (int j = 0; j < 4; ++j) { v[j] = xr[64 * j]; s += (v[j].x * v[j].x + v[j].y * v[j].y) + (v[j].z * v[j].z + v[j].w * v[j].w); }
            s = wave_sum(s, lane);
            GAS unsigned long long* o8 = (GAS unsigned long long*)(HB + (size_t)m * D) + lane;
#pragma unroll
            for (int j = 0; j < 4; ++j) o8[64 * j] = (unsigned long long)pk2(v[j].x, v[j].y) | ((unsigned long long)pk2(v[j].z, v[j].w) << 32);
            if (lane == 0) *(f32x4*)(SS + (size_t)m * 4) = (f32x4){s, 0.f, 0.f, 0.f};
        }
        { const int gt = blockIdx.x * (NWAVES * 64) + tid, NTH = G * NWAVES * 64;
          for (int i = gt; i < 2 * 1024 / 8; i += NTH) ((GAS v4u*)HBP)[i] = (v4u){0u, 0u, 0u, 0u};
          for (int i = gt; i < 128 * 1024 / 8; i += NTH) ((GAS v4u*)(HB + (size_t)T * D))[i] = (v4u){0u, 0u, 0u, 0u}; }
    GRID_BAR();
    }
    if (DUP == 8) { for (int rp_ = 0; rp_ < 8; ++rp_) GRID_BAR(); }

#define GRIDN() ({ int g_ = gridDim.x; asm volatile("" : "+s"(g_)); g_; })
#define BLK() ({ int b_ = blockIdx.x; asm volatile("" : "+s"(b_)); b_; })
    LAS unsigned char* ring = L; LAS unsigned char* el = L + EPI_OFF;
#pragma unroll
    for (int l = 0; l < 4; ++l) {
#if MIXERS
        if (l < 2) {
            bf16* MQ = (bf16*)(WSB + WS_MQ); bf16* MK = (bf16*)(WSB + WS_MK); bf16* OGB = (bf16*)(WSB + WS_OG); bf16* KVT = (bf16*)(WSB + WS_KVT);
            bf16* CT = (bf16*)(WSB + WS_CT); bf16* HG = (bf16*)(WSB + WS_HG);
            float* BCUM = (float*)(WSB + WS_BCUM); float* IG = (float*)(WSB + WS_IG); float* WGT = (float*)(WSB + WS_WGT); float* DECAY = (float*)(WSB + WS_DECAY); bf16* NCT = (bf16*)(WSB + WS_NCT); bf16* WROW = (bf16*)(WSB + WS_ONES); const bf16* ZROW = (const bf16*)(WSB + WS_ONES + 256 * 1024);
            const float* ssm = SS + (size_t)((2 * l) & 3) * T * 4;
            for (int rp_ = 0; rp_ < REPS(2); ++rp_) {
            for (int c = BLK(); c < 256; c += GRIDN())
                mlstm_gates_item(L, c, HB, (const float*)(WSB + WS_WG) + (size_t)l * D * 8, ssm, AIN(3) + l * 8, BCUM, IG, WGT, DECAY, WROW);
            GRID_BAR();
            {
                pg8::Gemm g{HB, (const bf16*)(WSB + WS_WINR) + (size_t)l * 1536 * D, T, 1536, D, 256};
                pg8::StaticOrder S; S.init(T, 1536, GRIDN(), BLK());
                pg8::EpiIn E{MQ, MK, OGB, ssm};
                pg8::gemm_phase<pg8::EpiIn, pg8::StaticOrder, true, true>(ring, el, g, S, E);
            }
            {
                pg8::Gemm g{(const bf16*)(WSB + WS_WINT) + (size_t)l * 1536 * D, HB, 1536, T, D, 256};
                pg8::StaticOrder S; S.init(1536, T, GRIDN(), BLK());
                pg8::EpiInT E{KVT, ssm, 1536, 64, WGT};
                pg8::gemm_phase<pg8::EpiInT, pg8::StaticOrder, true, true>(ring, el, g, S, E);
            }
            GRID_BAR();
            }
            for (int rp_ = 0; rp_ < REPS(3); ++rp_) {
            { int t4 = threadIdx.x; asm volatile("" : "+v"(t4)); const int wv4 = __builtin_amdgcn_readfirstlane(t4 >> 6);
              if (wv4 >= 3 && rp_ == 0) weight_set(l + 1, BLK() * 5 + (wv4 - 3), GRIDN() * 5, (LAS float*)(L + (wv4 - 3) * 16384), t4 & 63); }
            mlstm_scan(KVT, DECAY, CT, NCT, WROW, ZROW, GRIDN());
            GRID_BAR();
            }
            if (DUP == 13) { mlstm_scan(KVT, DECAY, HG, HG, WROW, ZROW, GRIDN(), true); GRID_BAR(); }
            for (int rp_ = 0; rp_ < REPS(4); ++rp_) {
            mlstm_out_phase(L, GRIDN(), MQ, MK, KVT, CT, NCT, BCUM, WGT, OGB, AIN(4) + l * D, HG);
            GRID_BAR();
            }
            for (int rp_ = 0; rp_ < REPS(10); ++rp_) {
                const bool dummy = (DUP == 10) && rp_ == 0;
                pg8::Gemm g{HG, (const bf16*)(WSB + WS_WOUT) + (size_t)l * D * D, T, D, D, 256};
                pg8::StaticOrder S; S.init(T, D, GRIDN(), BLK());
                pg8::EpiRes E{HB, SS + (size_t)((2 * l + 1) & 3) * T * 4, nullptr}; (void)dummy;
                pg8::gemm_phase<pg8::EpiRes, pg8::StaticOrder, true, true>(ring, el, g, S, E);
                if (dummy) GRID_BAR();
            }
            if (0) {
                pg8::Gemm g{HG, (const bf16*)(WSB + WS_WOUT) + (size_t)l * D * D, T, D, D, 256};
                pg8::StaticOrder S; S.init(T, D, GRIDN(), BLK());
                pg8::EpiRes E{HB, SS + (size_t)((2 * l + 1) & 3) * T * 4, nullptr};
                pg8::gemm_phase<pg8::EpiRes, pg8::StaticOrder, true, true>(ring, el, g, S, E);
            }
            GRID_BAR();
        }
#if MIXERS >= 2
        else {
            const int j = l - 2;
            bf16* XK = (bf16*)(WSB + WS_XK); bf16* XVT = (bf16*)(WSB + WS_XVT); bf16* AQ = (bf16*)(WSB + WS_AQ); bf16* PO = (bf16*)(WSB + WS_PO);
            float* KMEAN = (float*)(WSB + WS_KMEAN); float* ML = (float*)(WSB + WS_ML); int* LIST = (int*)(WSB + WS_LIST); int* gcnt = (int*)(WSB + WS_GCNT) + j * 512;
            const float* ssm = SS + (size_t)((2 * l) & 3) * T * 4; const float* RP = (const float*)(WSB + WS_ROPE);
            for (int rp_ = 0; rp_ < REPS(5); ++rp_) {
            if (l == 2) {
                { pg8::Gemm g{HB, (const bf16*)(WSB + WS_WK), T, D, D, 256}; pg8::StaticOrder S; S.init(T, D, GRIDN(), BLK());
                  pg8::EpiQK E{XK, ssm, AIN(8), RP, KMEAN, 1.0f, 1};
                  pg8::gemm_phase<pg8::EpiQK, pg8::StaticOrder, true, true>(ring, el, g, S, E); }
                { pg8::Gemm g{(const bf16*)(WSB + WS_WV), HB, D, T, D, 256}; pg8::StaticOrder S; S.init(D, T, GRIDN(), BLK());
                  pg8::EpiInT E{XVT, ssm, 1024, 0, nullptr};
                  pg8::gemm_phase<pg8::EpiInT, pg8::StaticOrder, true, true>(ring, el, g, S, E); }
            }
            { pg8::Gemm g{HB, (const bf16*)(WSB + WS_WQ) + (size_t)j * D * D, T, D, D, 256}; pg8::StaticOrder S; S.init(T, D, GRIDN(), BLK());
              pg8::EpiQK E{AQ, ssm, AIN(11) + j * 128, RP, nullptr, 0.08838834764831845f * 1.4426950408889634f, 0};
              pg8::gemm_phase<pg8::EpiQK, pg8::StaticOrder, true, true>(ring, el, g, S, E); }
            GRID_BAR();
            }
            for (int rp_ = 0; rp_ < REPS(11); ++rp_) {
            const bool dummy = (DUP == 11) && rp_ == 0;
            moba_gate_phase(L, GRIDN(), AQ, KMEAN, dummy ? gcnt + 2048 : gcnt, dummy ? (int*)(WSB + WS_WINR) : LIST);
            GRID_BAR();
            }
            for (int rp_ = 0; rp_ < REPS(6); ++rp_) {
            attn_phase2<false>(L, GRIDN(), gcnt, LIST, AQ, XK, XVT, PO, ML, nullptr, 0);
            GRID_BAR();
            }
            for (int rp_ = 0; rp_ < REPS(12); ++rp_) {
            const bool dummy = (DUP == 12) && rp_ == 0;
            attn_phase2<true>(L, GRIDN(), gcnt, LIST, AQ, XK, XVT, PO, ML, dummy ? HB : AQ, dummy ? 8191 : 0x7fffffff);
            GRID_BAR();
            }
            { int t2 = threadIdx.x; asm volatile("" : "+v"(t2)); const int gt = BLK() * (NWAVES * 64) + t2, NTH = GRIDN() * NWAVES * 64;
              unsigned zu = 0u; asm volatile("" : "+v"(zu));
              for (int i = gt; i < 128 * 1024 / 8; i += NTH) ((GAS v4u*)(HB + (size_t)T * D))[i] = (v4u){zu, zu, zu, zu}; }
            { pg8::Gemm g{AQ, (const bf16*)(WSB + WS_WO) + (size_t)j * D * D, T, D, D, 256}; pg8::StaticOrder S; S.init(T, D, GRIDN(), BLK());
              pg8::EpiRes E{HB, SS + (size_t)((2 * l + 1) & 3) * T * 4, nullptr};
              pg8::gemm_phase<pg8::EpiRes, pg8::StaticOrder, true, true>(ring, el, g, S, E); }
            GRID_BAR();
        }
#endif
#endif
        const bool mix_on = (MIXERS >= 2) || (MIXERS == 1 && l < 2);
        const int ssf = mix_on ? 2 * l + 1 : 2 * l;
#ifndef SKIP_UP
        for (int rp_ = 0; rp_ < REPS(7); ++rp_) {
            pg8::Gemm g{HBP, (const bf16*)(WSB + WS_WUP) + (size_t)l * FF2 * D, 65 * 256, FF2, D, 254};
            pg8::StaticOrder S; S.init(65 * 256, FF2, GRIDN(), BLK());
            pg8::EpiConv E{ACT, SS + (size_t)(ssf & 3) * T * 4, AIN(15) + (size_t)l * 3 * FF2, AIN(16) + (size_t)l * FF2};
            pg8::gemm_phase<pg8::EpiConv, pg8::StaticOrder, true, true>(ring, el, g, S, E);
            GRID_BAR();
        }
#endif
#ifndef SKIP_DN
        for (int rp_ = 0; rp_ < REPS(9); ++rp_) {
            const bool dummy = (DUP == 9) && rp_ == 0;
            pg8::Gemm g{ACT, (const bf16*)(WSB + WS_WDN) + (size_t)l * D * FF, T, D, FF, 256};
            pg8::StaticOrder S; S.init(T, D, GRIDN(), BLK());
            pg8::EpiRes E{HB, (l < 3) ? SS + (size_t)((2 * l + 2) & 3) * T * 4 : nullptr, (l == 3) ? OUTP : nullptr}; (void)dummy;
            pg8::gemm_phase<pg8::EpiRes, pg8::StaticOrder, true, true>(ring, el, g, S, E);
            GRID_BAR();
        }
#endif
    }
    { int t3 = threadIdx.x; asm volatile("" : "+v"(t3)); if (BLK() == 0 && t3 == 0) if (xb_ld((unsigned*)(WSB + WS_CTL) + CW_BAR + XB_TMO)) OUTP[0] = 1.0e6f; }
}

#undef WSB
#undef XIN
#undef OUTP
#undef SS
#undef HBP
#undef HB
#undef ACT
extern "C" void kernel_launch(void* const* d_in, const int* in_sizes, int n_in, void* d_out, int out_size, void* d_ws, size_t ws_size, hipStream_t stream) {
    static int grid = 0;
    if (grid == 0) {
        int dev = 0, cus = 0;
        if (n_in != 18 || out_size != T * D || ws_size < WS_END) { fprintf(stderr, "kernel_launch: unexpected problem geometry (n_in %d out %d ws %zu)\n", n_in, out_size, ws_size); grid = -1; return; }
        if (hipGetDevice(&dev) != hipSuccess || hipDeviceGetAttribute(&cus, hipDeviceAttributeMultiprocessorCount, dev) != hipSuccess) { grid = -1; return; }
        if (hipFuncSetAttribute((const void*)yoco_fwd, hipFuncAttributeMaxDynamicSharedMemorySize, LDS_BYTES) != hipSuccess) { fprintf(stderr, "hipFuncSetAttribute failed\n"); grid = -1; return; }
        (void)hipGetLastError();
        grid = cus;
    }
    if (grid < 0) return;
    (void)hipMemsetAsync((char*)d_ws + WS_CTL, 0, CTL_ZERO_BYTES, stream);
    Args a{};
    for (int i = 0; i < 18; ++i) a.in[i] = (const float*)d_in[i];
    a.out = (float*)d_out; a.ws = (unsigned char*)d_ws; a.ws_size = (unsigned long long)ws_size;
    hipLaunchKernelGGL(yoco_fwd, dim3(grid), dim3(NWAVES * 64), LDS_BYTES, stream, a);
}
```

```cpp
#include <hip/hip_runtime.h>
#include <cstdio>
#include <cstdint>

#define MIXERS 2
#define DUP 0
#define REPS(k) ((DUP) == (k) ? 2 : 1)
#ifndef PROBE
#define PROBE 0
#endif

namespace pg8 {
#define PG8_LAS __attribute__((address_space(3)))
typedef unsigned short bf16_t;
typedef short bf16x8 __attribute__((ext_vector_type(8)));
typedef float f32x4 __attribute__((ext_vector_type(4)));
typedef unsigned u32x4 __attribute__((ext_vector_type(4)));
typedef unsigned u32x2 __attribute__((ext_vector_type(2)));
constexpr int BM = 256, BK = 64, HALF = 128, HTB = HALF * BK * 2, STAGE_BYTES = 8 * HTB, NXCD = 8, WGM = 8;

__host__ __device__ __forceinline__ int lds_byte(int r, int c) { const int st = (r >> 4) * 2 + (c >> 5), rr = r & 15, cc = c & 31, ob = rr * 64 + cc * 2; return st * 1024 + (ob ^ (((ob >> 9) & 1) << 5)); }
__host__ __device__ __forceinline__ void stage_rc(int b, int& R, int& C) { const int st = b / 1024, sb = b % 1024, swz = sb ^ (((sb >> 9) & 1) << 5); R = (st >> 1) * 16 + swz / 64; C = (st & 1) * 32 + (swz % 64) / 2; }
__host__ __device__ __forceinline__ int perm32(int rho) { const int n = rho >> 4, i = rho & 15; return 8 * (i >> 2) + 4 * n + (i & 3); }

struct Unit { int pm, pn; };
struct Gemm { const bf16_t* A; const bf16_t* Bt; int M, N, K, a_rows; };

struct StaticOrder {
    int nM, nN, nwg, G, c;
    __host__ __device__ void init(int M, int N, int G_, int c_) { nM = M / BM; nN = N / BM; nwg = nM * nN; G = G_; c = c_; }
    __host__ __device__ bool next(int i, Unit& u) const {
        const long L = (long)i * G + c; if (L >= nwg) return false;
        int wgid = (int)L; { const int q = nwg / NXCD, r = nwg % NXCD, xcd = wgid % NXCD, off = wgid / NXCD; wgid = (xcd < r ? xcd * (q + 1) : r * (q + 1) + (xcd - r) * q) + off; }
        const int nig = WGM * nN, gid = wgid / nig, fm = gid * WGM, gsz = (nM - fm) < WGM ? (nM - fm) : WGM;
        u.pm = fm + ((wgid % nig) % gsz); u.pn = (wgid % nig) / gsz; return true;
    }
    __device__ __forceinline__ void a_ready(const Unit&) const {}
    __device__ __forceinline__ void done(const Unit&) const {}
};

__device__ __forceinline__ float sh_idx(float v, int src) { return __builtin_bit_cast(float, __builtin_amdgcn_ds_bpermute(src << 2, __builtin_bit_cast(int, v))); }
__device__ __forceinline__ float sh_xor(float v, int o, int lane) { return sh_idx(v, lane ^ o); }
template <int CTRL, int ROWMASK = 0xf> __device__ __forceinline__ float dpp_add(float v) { return v + __builtin_bit_cast(float, __builtin_amdgcn_update_dpp(0, __builtin_bit_cast(int, v), CTRL, ROWMASK, 0xf, true)); }
__device__ __forceinline__ float half_sum_hi(float v) { v = dpp_add<0xB1>(v); v = dpp_add<0x4E>(v); v = dpp_add<0x141>(v); v = dpp_add<0x140>(v); return dpp_add<0x142, 0xA>(v); }
__device__ __forceinline__ float oct_sum(float v) { v = dpp_add<0xB1>(v); v = dpp_add<0x4E>(v); return dpp_add<0x141>(v); }
typedef float f32x2n __attribute__((ext_vector_type(2)));
typedef __bf16 bf16x2n __attribute__((ext_vector_type(2)));
__device__ __forceinline__ unsigned cvt_pk_bf16n(float lo, float hi) { unsigned r; asm volatile("s_nop 0\n\tv_cvt_pk_bf16_f32 %0, %1, %2" : "=v"(r) : "v"(lo), "v"(hi)); return r; }
__device__ __forceinline__ unsigned cvt_pk_bf16(float lo, float hi) { unsigned r; asm volatile("v_cvt_pk_bf16_f32 %0, %1, %2" : "=v"(r) : "v"(lo), "v"(hi)); return r; }
__device__ __forceinline__ float rstd4(const float* ss4, int row) { const f32x4 p = *(const f32x4*)(ss4 + (size_t)row * 4); return rsqrtf(((p[0] + p[1]) + (p[2] + p[3])) * (1.0f / 1024.0f) + 1e-6f); }
#define EPI_BAR() do { asm volatile("s_waitcnt lgkmcnt(0)" ::: "memory"); __builtin_amdgcn_s_barrier(); asm volatile("" ::: "memory"); } while (0)

constexpr int TT = 16384, DD = 1024;
constexpr float NEPS = 1e-6f;

struct EpiRes {
    static constexpr bool PERM = true; static constexpr int RSMODE = 0;
    bf16_t* hb; float* ss; float* fout;
    __device__ __forceinline__ void operator()(f32x4 (&acc)[2][2][4][2], const Unit& u, int wr, int wc, int fr_, int fq_, PG8_LAS unsigned char* el, int wid, int lane_, const PG8_LAS float* rsu) const {
        int ln_ = lane_; asm volatile("" : "+v"(ln_)); const int lane = ln_, fr = ln_ & 15, fq = ln_ >> 4; (void)fr_; (void)fq_;
        u32x4 pre[2][4][2];
#pragma unroll
        for (int ai = 0; ai < 2; ++ai)
#pragma unroll
            for (int m = 0; m < 4; ++m)
#pragma unroll
                for (int bj = 0; bj < 2; ++bj) pre[ai][m][bj] = *(const u32x4*)(hb + (size_t)(u.pm * BM + ai * HALF + wr * 64 + m * 16 + fr) * DD + u.pn * BM + bj * HALF + wc * 32 + 8 * fq);
#pragma unroll
        for (int ai = 0; ai < 2; ++ai)
#pragma unroll
            for (int m = 0; m < 4; ++m) {
                const int row = u.pm * BM + ai * HALF + wr * 64 + m * 16 + fr; float s = 0.f;
#pragma unroll
                for (int bj = 0; bj < 2; ++bj) {
                    const size_t off = (size_t)row * DD + u.pn * BM + bj * HALF + wc * 32 + 8 * fq;
                    const u32x4 p = pre[ai][m][bj];
                    f32x4 v0 = acc[ai][bj][m][0], v1 = acc[ai][bj][m][1];
                    v0[0] += __builtin_bit_cast(float, p[0] << 16); v0[1] += __builtin_bit_cast(float, p[0] & 0xffff0000u); v0[2] += __builtin_bit_cast(float, p[1] << 16); v0[3] += __builtin_bit_cast(float, p[1] & 0xffff0000u);
                    v1[0] += __builtin_bit_cast(float, p[2] << 16); v1[1] += __builtin_bit_cast(float, p[2] & 0xffff0000u); v1[2] += __builtin_bit_cast(float, p[3] << 16); v1[3] += __builtin_bit_cast(float, p[3] & 0xffff0000u);
                    if (fout) { *(f32x4*)(fout + off) = v0; *(f32x4*)(fout + off + 4) = v1; }
                    u32x4 w; w.x = cvt_pk_bf16(v0[0], v0[1]); w.y = cvt_pk_bf16(v0[2], v0[3]); w.z = cvt_pk_bf16(v1[0], v1[1]); w.w = cvt_pk_bf16(v1[2], v1[3]);
                    *(u32x4*)(hb + off) = w;
                    s += (v0[0] * v0[0] + v0[1] * v0[1]) + (v0[2] * v0[2] + v0[3] * v0[3]) + (v1[0] * v1[0] + v1[1] * v1[1]) + (v1[2] * v1[2] + v1[3] * v1[3]);
                }
                s += sh_xor(s, 16, lane); s += sh_xor(s, 32, lane);
                if (fq == 0) ((PG8_LAS float*)el)[(ai * HALF + wr * 64 + m * 16 + fr) * 4 + wc] = s;
            }
        EPI_BAR();
        { const int tid2 = wid * 64 + lane;
          if (ss && tid2 < 256) { const f32x4 p = *(const PG8_LAS f32x4*)((PG8_LAS float*)el + tid2 * 4); ss[(size_t)(u.pm * BM + tid2) * 4 + u.pn] = (p[0] + p[1]) + (p[2] + p[3]); } }
        EPI_BAR();
    }
};

struct EpiConv {
    static constexpr bool PERM = true; static constexpr int RSMODE = 1; static constexpr int tmax = 16384; __device__ __forceinline__ int tok0(const Unit& u) const { return u.pm * 254 - 2; }
    bf16_t* act; const float* ss; const float* cw; const float* cb;
    static __device__ __forceinline__ float ror1(float v) { return __builtin_bit_cast(float, __builtin_amdgcn_update_dpp(0, __builtin_bit_cast(int, v), 0x121, 0xf, 0xf, false)); }
    static __device__ __forceinline__ float ror2(float v) { return __builtin_bit_cast(float, __builtin_amdgcn_update_dpp(0, __builtin_bit_cast(int, v), 0x122, 0xf, 0xf, false)); }
    __device__ __forceinline__ void operator()(f32x4 (&acc)[2][2][4][2], const Unit& u, int wr, int wc, int fr_, int fq_, PG8_LAS unsigned char* el, int wid, int lane_, const PG8_LAS float* rsu) const {
        int ln_ = lane_; asm volatile("" : "+v"(ln_)); const int lane = ln_, fr = ln_ & 15, fq = ln_ >> 4; (void)lane; (void)fr_; (void)fq_;
        const int t0 = u.pm * 254 - 2;
        const int cl = wc * 32 + 8 * fq;
        float rs[2][4]; f32x4 cp[2][2][4];
#pragma unroll
        for (int ai = 0; ai < 2; ++ai)
#pragma unroll
            for (int m = 0; m < 4; ++m) rs[ai][m] = rsu[ai * HALF + wr * 64 + m * 16 + fr];
#pragma unroll
        for (int n = 0; n < 2; ++n)
#pragma unroll
            for (int bj = 0; bj < 2; ++bj) { const int scol = (bj ? 2816 : 0) + u.pn * HALF + cl + 4 * n;
                cp[n][bj][0] = *(const f32x4*)(cw + scol); cp[n][bj][1] = *(const f32x4*)(cw + 5632 + scol); cp[n][bj][2] = *(const f32x4*)(cw + 2 * 5632 + scol); cp[n][bj][3] = *(const f32x4*)(cb + scol); }
#pragma unroll
        for (int ai = 0; ai < 2; ++ai)
#pragma unroll
            for (int m = 0; m < 4; ++m)
#pragma unroll
                for (int bj = 0; bj < 2; ++bj)
#pragma unroll
                    for (int n = 0; n < 2; ++n) acc[ai][bj][m][n] = acc[ai][bj][m][n] * rs[ai][m];
        PG8_LAS float* X = (PG8_LAS float*)el;
#pragma unroll
        for (int ai = 0; ai < 2; ++ai) { const int B = 2 * ai + wr;
            if (B < 3 && fr >= 14) {
#pragma unroll
                for (int bj = 0; bj < 2; ++bj)
#pragma unroll
                    for (int n = 0; n < 2; ++n) *(PG8_LAS f32x4*)(X + (B * 2 + (fr - 14)) * 256 + bj * HALF + cl + 4 * n) = acc[ai][bj][3][n];
            } }
        EPI_BAR();
#pragma unroll
        for (int n = 0; n < 2; ++n) {
#pragma unroll
            for (int bj = 0; bj < 2; ++bj) {
                const f32x4 w0 = cp[n][bj][0], w1 = cp[n][bj][1], w2 = cp[n][bj][2], bb = cp[n][bj][3];
#pragma unroll
                for (int ai = 0; ai < 2; ++ai) {
                    const int B = 2 * ai + wr;
                    f32x4 p1 = (f32x4){0.f, 0.f, 0.f, 0.f}, p2 = p1;
                    if (B > 0) { const f32x4 e0 = *(const PG8_LAS f32x4*)(X + ((B - 1) * 2 + 0) * 256 + bj * HALF + cl + 4 * n), e1 = *(const PG8_LAS f32x4*)(X + ((B - 1) * 2 + 1) * 256 + bj * HALF + cl + 4 * n);
                        p1 = e1; p2 = (fr == 0) ? e0 : e1; }
#pragma unroll
                    for (int m = 0; m < 4; ++m) {
                        f32x4 cur = acc[ai][bj][m][n]; f32x4 s1, s2;
                        asm volatile("" : "+v"(cur));
#pragma unroll
                        for (int i = 0; i < 4; ++i) { s1[i] = ror1(cur[i]); s2[i] = ror2(cur[i]); }
                        const f32x4 q1 = (fr >= 1) ? s1 : p1, q2 = (fr >= 2) ? s2 : p2;
                        f32x4 res = bb + w0 * q2 + w1 * q1 + w2 * cur;
                        asm volatile("" : "+v"(res), "+v"(s1), "+v"(s2));
                        acc[ai][bj][m][n] = res;
                        p1 = s1; p2 = s2;
                    }
                }
            }
        }
#pragma unroll
        for (int ai = 0; ai < 2; ++ai)
#pragma unroll
            for (int m = 0; m < 4; ++m) {
                const int r = ai * HALF + wr * 64 + m * 16 + fr, t = t0 + r;
                u32x4 w; float a[8];
#pragma unroll
                for (int n = 0; n < 2; ++n)
#pragma unroll
                    for (int i = 0; i < 4; ++i) { const float v = acc[ai][0][m][n][i], g = acc[ai][1][m][n][i]; a[4 * n + i] = v * g * __builtin_amdgcn_rcpf(1.0f + __builtin_amdgcn_exp2f(-1.4426950408889634f * g)); }
                w.x = cvt_pk_bf16(a[0], a[1]); w.y = cvt_pk_bf16(a[2], a[3]); w.z = cvt_pk_bf16(a[4], a[5]); w.w = cvt_pk_bf16(a[6], a[7]);
                if (r >= 2 && t < TT) *(u32x4*)(act + (size_t)t * 2816 + u.pn * HALF + cl) = w;
            }
        EPI_BAR();
    }
};


struct EpiIn {
    static constexpr bool PERM = true; static constexpr int RSMODE = 1; static constexpr int tmax = 16384; __device__ __forceinline__ int tok0(const Unit& u) const { return u.pm * 256; }
    bf16_t* q; bf16_t* k; bf16_t* og; const float* ss;
    __device__ __forceinline__ void operator()(f32x4 (&acc)[2][2][4][2], const Unit& u, int wr, int wc, int fr_, int fq_, PG8_LAS unsigned char* el, int wid, int lane_, const PG8_LAS float* rsu) const {
        int ln_ = lane_; asm volatile("" : "+v"(ln_)); const int lane = ln_, fr = ln_ & 15, fq = ln_ >> 4; (void)lane; (void)fr_; (void)fq_;
        bf16_t* dst; int ldc, c0; float sc;
        if (u.pn < 2) { dst = q; ldc = 512; c0 = 256 * u.pn; sc = 0.08838834764831845f; }
        else { dst = og; ldc = 1024; c0 = 256 * (u.pn - 2); sc = 1.f; }
#pragma unroll
        for (int ai = 0; ai < 2; ++ai)
#pragma unroll
            for (int m = 0; m < 4; ++m) {
                const int row = u.pm * BM + ai * HALF + wr * 64 + m * 16 + fr;
                const float rs = rsu[ai * HALF + wr * 64 + m * 16 + fr] * sc;
#pragma unroll
                for (int bj = 0; bj < 2; ++bj) {
                    const f32x4 v0 = acc[ai][bj][m][0] * rs, v1 = acc[ai][bj][m][1] * rs;
                    u32x4 w; w.x = cvt_pk_bf16(v0[0], v0[1]); w.y = cvt_pk_bf16(v0[2], v0[3]); w.z = cvt_pk_bf16(v1[0], v1[1]); w.w = cvt_pk_bf16(v1[2], v1[3]);
                    *(u32x4*)(dst + (size_t)row * ldc + c0 + bj * HALF + wc * 32 + 8 * fq) = w;
                }
            }
    }
};
struct EpiInT {
    static constexpr bool PERM = true; static constexpr int RSMODE = 2; static constexpr int tmax = 16384; __device__ __forceinline__ int tok0(const Unit& u) const { return u.pn * 256; }
    bf16_t* o; const float* ss; int nrows, ch; const float* wgt;
    __device__ __forceinline__ void operator()(f32x4 (&acc)[2][2][4][2], const Unit& u, int wr, int wc, int fr_, int fq_, PG8_LAS unsigned char* el, int wid, int lane_, const PG8_LAS float* rsu) const {
        int ln_ = lane_; asm volatile("" : "+v"(ln_)); const int lane = ln_, fr = ln_ & 15, fq = ln_ >> 4; (void)lane; (void)fr_; (void)fq_;
#pragma unroll
        for (int bj = 0; bj < 2; ++bj) {
            const int t = u.pn * BM + bj * HALF + wc * 32 + 8 * fq;
            f32x4 r0 = *(const PG8_LAS f32x4*)(rsu + bj * HALF + wc * 32 + 8 * fq), r1 = *(const PG8_LAS f32x4*)(rsu + bj * HALF + wc * 32 + 8 * fq + 4);
            if (wgt && u.pm >= 2) { const float* wp = wgt + (size_t)(u.pm - 2) * TT + t; r0 = r0 * *(const f32x4*)wp; r1 = r1 * *(const f32x4*)(wp + 4); }
#pragma unroll
            for (int ai = 0; ai < 2; ++ai)
#pragma unroll
                for (int m = 0; m < 4; ++m) {
                    const int row = u.pm * BM + ai * HALF + wr * 64 + m * 16 + fr;
                    const f32x4 v0 = acc[ai][bj][m][0] * r0, v1 = acc[ai][bj][m][1] * r1;
                    u32x4 w; w.x = cvt_pk_bf16(v0[0], v0[1]); w.y = cvt_pk_bf16(v0[2], v0[3]); w.z = cvt_pk_bf16(v1[0], v1[1]); w.w = cvt_pk_bf16(v1[2], v1[3]);
                    if (ch) {
                        *(u32x4*)(o + ((((size_t)(t >> 6) * 96 + (row >> 4)) * 2 + ((t >> 5) & 1)) * 512 + (((t >> 3) & 3) * 16 + (row & 15)) * 8)) = w; }
                    else {
                        const int kb = t >> 8, key = t & 255;
                        *(u32x4*)(o + ((((size_t)(kb * 8 + (row >> 7)) * 4 + ((row >> 5) & 3)) * 16 + (key >> 4)) * 512 + (((key >> 3) & 1) * 32 + (row & 31)) * 8)) = w; }
                }
        }
    }
};


struct EpiQK {
    static constexpr bool PERM = false; static constexpr int RSMODE = 1; static constexpr int tmax = 16384; __device__ __forceinline__ int tok0(const Unit& u) const { return u.pm * 256; }
    bf16_t* o; const float* ss; const float* gain; const float* rope; float* kmean; float oscale; int kfrag;
    __device__ __forceinline__ void operator()(f32x4 (&acc)[2][2][4][2], const Unit& u, int wr, int wc, int fr_, int fq_, PG8_LAS unsigned char* el, int wid, int lane_, const PG8_LAS float* rsu) const {
        int ln_ = lane_; asm volatile("" : "+v"(ln_)); const int lane = ln_, fr = ln_ & 15, fq = ln_ >> 4; (void)lane; (void)fr_; (void)fq_;
        PG8_LAS float* P = (PG8_LAS float*)el;
        PG8_LAS float* KS = (PG8_LAS float*)(el + 8192);
#pragma unroll
        for (int ai = 0; ai < 2; ++ai)
#pragma unroll
            for (int m = 0; m < 4; ++m) {
                const int rl = ai * HALF + wr * 64 + m * 16 + fr;
                const float rs = rsu[rl];
#pragma unroll
                for (int bj = 0; bj < 2; ++bj) {
                    const f32x4 x0 = acc[ai][bj][m][0] * rs, x1 = acc[ai][bj][m][1] * rs;
                    acc[ai][bj][m][0] = x0; acc[ai][bj][m][1] = x1;
                    float s = (x0[0] * x0[0] + x0[1] * x0[1]) + (x0[2] * x0[2] + x0[3] * x0[3]) + (x1[0] * x1[0] + x1[1] * x1[1]) + (x1[2] * x1[2] + x1[3] * x1[3]);
                    s += sh_xor(s, 16, lane); s += sh_xor(s, 32, lane);
                    if (fq == 0) P[(rl * 2 + bj) * 4 + wc] = s;
                }
            }
        EPI_BAR();
#pragma unroll
        for (int bj = 0; bj < 2; ++bj) {
            const f32x4 g0 = *(const f32x4*)(gain + 32 * wc + 4 * fq), g1 = *(const f32x4*)(gain + 32 * wc + 16 + 4 * fq);
            f32x4 cs0 = (f32x4){0.f, 0.f, 0.f, 0.f}, cs1 = cs0;
            const int head = 2 * u.pn + bj;
#pragma unroll
            for (int ai = 0; ai < 2; ++ai)
#pragma unroll
                for (int m = 0; m < 4; ++m) {
                    const int rl = ai * HALF + wr * 64 + m * 16 + fr, row = u.pm * BM + rl;
                    const f32x4 p = *(const PG8_LAS f32x4*)(P + (rl * 2 + bj) * 4);
                    const float rn = rsqrtf(((p[0] + p[1]) + (p[2] + p[3])) * (1.0f / 128.0f) + NEPS);
                    f32x4 y0 = acc[ai][bj][m][0] * rn * g0, y1 = acc[ai][bj][m][1] * rn * g1;
                    if (wc == 0) { const f32x4 c = *(const f32x4*)(rope + (size_t)row * 16 + 4 * fq), sn = *(const f32x4*)(rope + (size_t)TT * 16 + (size_t)row * 16 + 4 * fq);
                        const f32x4 t0 = y0 * c - y1 * sn, t1 = y1 * c + y0 * sn; y0 = t0; y1 = t1; }
                    cs0 += y0; cs1 += y1;
                    y0 = y0 * oscale; y1 = y1 * oscale;
                    u32x2 w0, w1; w0.x = cvt_pk_bf16(y0[0], y0[1]); w0.y = cvt_pk_bf16(y0[2], y0[3]); w1.x = cvt_pk_bf16(y1[0], y1[1]); w1.y = cvt_pk_bf16(y1[2], y1[3]);
                    if (!kfrag) { bf16_t* op = o + (size_t)row * DD + head * 128 + 32 * wc + 4 * fq; *(u32x2*)op = w0; *(u32x2*)(op + 16) = w1; }
                    else {
                        bf16_t* op = o + ((((size_t)((row >> 8) * 8 + head) * 8 + ((row >> 5) & 7)) * 8 + 2 * wc) * 512 + ((fq >> 1) * 32 + (row & 31)) * 8 + 4 * (fq & 1));
                        *(u32x2*)op = w0; *(u32x2*)(op + 512) = w1; }
                    asm volatile("" ::: "memory");
                }
            if (kmean) {
#pragma unroll
                for (int i = 0; i < 4; ++i) {
#pragma unroll
                    for (int o2 = 1; o2 < 16; o2 <<= 1) { cs0[i] += sh_xor(cs0[i], o2, lane); cs1[i] += sh_xor(cs1[i], o2, lane); }
                }
                if (fr == 0) { *(PG8_LAS f32x4*)(KS + (wr * 2 + bj) * 128 + 32 * wc + 4 * fq) = cs0; *(PG8_LAS f32x4*)(KS + (wr * 2 + bj) * 128 + 32 * wc + 16 + 4 * fq) = cs1; }
            }
        }
        EPI_BAR();
        if (kmean) {
            const int tid2 = wid * 64 + lane;
            if (tid2 < 256) { const int bj = tid2 >> 7, d = tid2 & 127;
                kmean[((size_t)(2 * u.pn + bj) * 64 + u.pm) * 128 + d] = (KS[bj * 128 + d] + KS[(2 + bj) * 128 + d]) * (1.0f / 256.0f); }
            EPI_BAR();
        }
    }
};

template <class Epi, class Sched, bool ALIGN_EPI = false, bool SP2 = false>
__device__ __forceinline__ void gemm_phase(PG8_LAS unsigned char* lds, PG8_LAS unsigned char* elds, const Gemm g, const Sched& S, const Epi& E) {
    int tid_ = threadIdx.x; asm volatile("" : "+v"(tid_)); const int tid = tid_, wid = __builtin_amdgcn_readfirstlane(tid >> 6), lane = tid & 63, wr = wid >> 2, wc = wid & 3, fr = lane & 15, fq = lane >> 4;
    const int K = g.K, nt = K / BK;
    float zf_ = 0.f; asm volatile("" : "+v"(zf_)); const f32x4 z4_ = {zf_, zf_, zf_, zf_};
    unsigned voffA[2], voffB[2];
#pragma unroll
    for (int i = 0; i < 2; ++i) { int R, C; stage_rc(tid * 16 + i * 8192, R, C); const int Rb = Epi::PERM ? ((R & ~31) + perm32(R & 31)) : R;
        voffA[i] = (unsigned)(R * K + C) * 2u; voffB[i] = (unsigned)(Rb * K + C) * 2u; }
    const size_t kstep = (size_t)(BK * 2);
    const size_t hstep = (size_t)HALF * K * 2;
    const size_t tstep = 2 * hstep; const size_t tstepA = (size_t)g.a_rows * K * 2;
    const unsigned ldsw = (unsigned)wid * 1024u;
    const int aoff = lds_byte(wr * 64 + fr, fq * 8), boff = lds_byte(wc * 32 + fr, fq * 8);
#define PG8_SA(b, h) (((b) * 2 + (h)) * HTB)
#define PG8_SB(b, h) ((4 + (b) * 2 + (h)) * HTB)
#define PG8_STAGE(bufoff, gbase, voff) do { _Pragma("unroll") for (int _i = 0; _i < 2; ++_i) \
        __builtin_amdgcn_global_load_lds((const unsigned*)((const char*)(gbase) + (voff)[_i]), (PG8_LAS unsigned*)(lds + (bufoff) + ldsw + _i * 8192), 16, 0, 0); } while (0)
#define PG8_LDA(dst, b, h) do { _Pragma("unroll") for (int m = 0; m < 4; ++m) _Pragma("unroll") for (int k = 0; k < 2; ++k) dst[m][k] = *(const PG8_LAS bf16x8*)(lds + PG8_SA(b, h) + aoff + m * 2048 + k * 1024); } while (0)
#define PG8_LDB(dst, b, h) do { _Pragma("unroll") for (int n = 0; n < 2; ++n) _Pragma("unroll") for (int k = 0; k < 2; ++k) dst[n][k] = *(const PG8_LAS bf16x8*)(lds + PG8_SB(b, h) + boff + n * 2048 + k * 1024); } while (0)
#define PG8_MMA(ai, bj, At, Bt) do { __builtin_amdgcn_s_setprio(1); _Pragma("unroll") for (int m = 0; m < 4; ++m) _Pragma("unroll") for (int n = 0; n < 2; ++n) _Pragma("unroll") for (int k = 0; k < 2; ++k) \
        acc[ai][bj][m][n] = __builtin_amdgcn_mfma_f32_16x16x32_bf16(Bt[n][k], At[m][k], acc[ai][bj][m][n], 0, 0, 0); __builtin_amdgcn_s_setprio(0); } while (0)
#define PG8_WAIT_V(n) asm volatile("s_waitcnt vmcnt(" #n ")" ::: "memory")
#define PG8_WAIT_L(n) asm volatile("s_waitcnt lgkmcnt(" #n ")" ::: "memory")
#define PG8_BAR __builtin_amdgcn_s_barrier()
#define PG8_SCHED __builtin_amdgcn_sched_barrier(0)
    Unit cur, nxt; int ui = 0;
    if (!S.next(0, cur)) return;
    const PG8_LAS float* RSL = (const PG8_LAS float*)(elds + 22528);
    if constexpr (Epi::RSMODE != 0) {
        PG8_LAS float* RS = (PG8_LAS float*)(elds + 22528); Unit uu;
#pragma unroll 1
        for (int j = 0; j < 4; ++j) { const int i = 2 * j + (tid >> 8); if (S.next(i, uu)) { const int t = E.tok0(uu) + (tid & 255); RS[i * 256 + (tid & 255)] = (t >= 0 && t < E.tmax) ? rstd4(E.ss, t) : 0.f; } }
    }
    f32x4 acc[2][2][4][2];
#pragma unroll
    for (int a = 0; a < 2; ++a)
#pragma unroll
        for (int b = 0; b < 2; ++b)
#pragma unroll
            for (int m = 0; m < 4; ++m)
#pragma unroll
                for (int n = 0; n < 2; ++n) acc[a][b][m][n] = z4_;
    bf16x8 At[4][2], B0[2][2], B1[2][2];
    const char* cA = (const char*)g.A + (size_t)cur.pm * tstepA; const char* cB = (const char*)g.Bt + (size_t)cur.pn * tstep;
    S.a_ready(cur);
    if constexpr (SP2) {
        PG8_STAGE(PG8_SB(0, 0), cB, voffB); PG8_STAGE(PG8_SB(0, 1), cB + hstep, voffB); PG8_STAGE(PG8_SA(0, 0), cA, voffA); PG8_STAGE(PG8_SA(0, 1), cA + hstep, voffA);
        if (wr == 1) PG8_BAR;
        PG8_WAIT_V(2); PG8_BAR;
        PG8_STAGE(PG8_SB(1, 0), cB + kstep, voffB); PG8_STAGE(PG8_SA(1, 0), cA + kstep, voffA); PG8_STAGE(PG8_SB(1, 1), cB + hstep + kstep, voffB);
        PG8_WAIT_V(6); PG8_BAR;
    } else {
        PG8_STAGE(PG8_SB(0, 0), cB, voffB); PG8_STAGE(PG8_SA(0, 0), cA, voffA); PG8_STAGE(PG8_SB(0, 1), cB + hstep, voffB); PG8_STAGE(PG8_SA(0, 1), cA + hstep, voffA);
        if (wr == 1) PG8_BAR;
        PG8_WAIT_V(4); PG8_BAR;
        PG8_STAGE(PG8_SB(1, 0), cB + kstep, voffB); PG8_STAGE(PG8_SA(1, 0), cA + kstep, voffA); PG8_STAGE(PG8_SB(1, 1), cB + hstep + kstep, voffB);
        PG8_WAIT_V(6); PG8_BAR;
    }
    for (;;) {
        const bool has_next = S.next(ui + 1, nxt);
        const char* nA = has_next ? (const char*)g.A + (size_t)nxt.pm * tstepA : cA; const char* nB = has_next ? (const char*)g.Bt + (size_t)nxt.pn * tstep : cB;
        for (int t = 0; t < nt; t += 2) {
            const bool last = (t == nt - 2);
            const char* a1 = cA + (size_t)(t + 1) * kstep;
            const char* a2 = last ? nA : cA + (size_t)(t + 2) * kstep; const char* b2 = last ? nB : cB + (size_t)(t + 2) * kstep;
            const char* a3 = a2 + kstep; const char* b3 = b2 + kstep;
            if (last && has_next) S.a_ready(nxt);
            if constexpr (SP2) {
            PG8_LDB(B0, 0, 0); PG8_LDB(B1, 0, 1); PG8_SCHED; PG8_LDA(At, 0, 0); PG8_STAGE(PG8_SA(1, 1), a1 + hstep, voffA);
            PG8_WAIT_V(8); PG8_WAIT_L(0); PG8_BAR; PG8_MMA(0, 0, At, B0); PG8_MMA(0, 1, At, B1); PG8_BAR; PG8_SCHED;
            PG8_LDA(At, 0, 1); PG8_STAGE(PG8_SB(0, 0), b2, voffB); PG8_STAGE(PG8_SB(0, 1), b2 + hstep, voffB); PG8_STAGE(PG8_SA(0, 0), a2, voffA);
            PG8_WAIT_V(8); PG8_WAIT_L(0); PG8_BAR; PG8_MMA(1, 0, At, B0); PG8_MMA(1, 1, At, B1); PG8_BAR; PG8_SCHED;
            PG8_LDB(B0, 1, 0); PG8_LDB(B1, 1, 1); PG8_SCHED; PG8_LDA(At, 1, 0); PG8_STAGE(PG8_SA(0, 1), a2 + hstep, voffA);
            PG8_WAIT_V(8); PG8_WAIT_L(0); PG8_BAR; PG8_MMA(0, 0, At, B0); PG8_MMA(0, 1, At, B1); PG8_BAR; PG8_SCHED;
            PG8_LDA(At, 1, 1); PG8_STAGE(PG8_SB(1, 0), b3, voffB); PG8_STAGE(PG8_SB(1, 1), b3 + hstep, voffB); PG8_STAGE(PG8_SA(1, 0), a3, voffA);
            PG8_WAIT_V(8); PG8_WAIT_L(0); PG8_BAR; PG8_MMA(1, 0, At, B0); PG8_MMA(1, 1, At, B1); PG8_BAR; PG8_SCHED;
            } else {
            PG8_LDB(B0, 0, 0); PG8_SCHED; PG8_LDA(At, 0, 0); PG8_STAGE(PG8_SA(1, 1), a1 + hstep, voffA);
            PG8_WAIT_L(8); PG8_BAR; PG8_WAIT_L(0); PG8_MMA(0, 0, At, B0); PG8_BAR; PG8_SCHED;
            PG8_LDB(B1, 0, 1); PG8_STAGE(PG8_SB(0, 0), b2, voffB);
            PG8_BAR; PG8_WAIT_L(0); PG8_MMA(0, 1, At, B1); PG8_BAR;
            PG8_LDA(At, 0, 1); PG8_STAGE(PG8_SA(0, 0), a2, voffA);
            PG8_BAR; PG8_WAIT_L(0); PG8_MMA(1, 0, At, B0); PG8_BAR; PG8_SCHED;
            PG8_STAGE(PG8_SB(0, 1), b2 + hstep, voffB);
            PG8_WAIT_V(6); PG8_BAR; PG8_MMA(1, 1, At, B1); PG8_BAR;
            PG8_LDB(B0, 1, 0); PG8_SCHED; PG8_LDA(At, 1, 0); PG8_STAGE(PG8_SA(0, 1), a2 + hstep, voffA);
            PG8_WAIT_L(8); PG8_BAR; PG8_WAIT_L(0); PG8_MMA(0, 0, At, B0); PG8_BAR; PG8_SCHED;
            PG8_LDB(B1, 1, 1); PG8_STAGE(PG8_SB(1, 0), b3, voffB);
            PG8_BAR; PG8_WAIT_L(0); PG8_MMA(0, 1, At, B1); PG8_BAR;
            PG8_LDA(At, 1, 1); PG8_STAGE(PG8_SA(1, 0), a3, voffA);
            PG8_BAR; PG8_WAIT_L(0); PG8_MMA(1, 0, At, B0); PG8_BAR; PG8_SCHED;
            PG8_STAGE(PG8_SB(1, 1), b3 + hstep, voffB);
            PG8_WAIT_V(6); PG8_BAR; PG8_MMA(1, 1, At, B1); PG8_BAR;
            }
        }
        if constexpr (ALIGN_EPI) { if (wr == 0) PG8_BAR; }
        { E(acc, cur, wr, wc, fr, fq, elds, wid, lane, RSL + (ui & 7) * 256); S.done(cur); }
        if (!has_next) break;
#pragma unroll
        for (int a = 0; a < 2; ++a)
#pragma unroll
            for (int b = 0; b < 2; ++b)
#pragma unroll
                for (int m = 0; m < 4; ++m)
#pragma unroll
                    for (int n = 0; n < 2; ++n) acc[a][b][m][n] = z4_;
        cur = nxt; cA = nA; cB = nB; ++ui;
        if constexpr (ALIGN_EPI) { if (wr == 1) PG8_BAR; }
    }
    PG8_WAIT_V(0);
    if constexpr (!ALIGN_EPI) { if (wr == 0) PG8_BAR; }
    PG8_BAR;
#undef PG8_SA
#undef PG8_SB
#undef PG8_STAGE
#undef PG8_LDA
#undef PG8_LDB
#undef PG8_MMA
#undef PG8_WAIT_V
#undef PG8_WAIT_L
#undef PG8_BAR
#undef PG8_SCHED
}
}


#define GAS __attribute__((address_space(1)))
#define LAS __attribute__((address_space(3)))
typedef unsigned short bf16;
typedef unsigned v4u __attribute__((ext_vector_type(4)));
typedef float f32x4 __attribute__((ext_vector_type(4)));
typedef short bf16x8 __attribute__((ext_vector_type(8)));

constexpr int NWAVES = 8;
constexpr int T = 16384, D = 1024, FF = 2816, FF2 = 5632, MIN_ = 3080;
constexpr size_t MiB = 1u << 20;
constexpr size_t WS_CTL = 0, CTL_ZERO_BYTES = 2 * MiB;
constexpr size_t WS_SS = 64 * 1024;
constexpr size_t WS_WINR = 2 * MiB;
constexpr size_t WS_WINT = 10 * MiB;
constexpr size_t WS_WOUT = 16 * MiB;
constexpr size_t WS_WK = 20 * MiB, WS_WV = 22 * MiB;
constexpr size_t WS_WQ = 24 * MiB;
constexpr size_t WS_WO = 28 * MiB;
constexpr size_t WS_WUP = 32 * MiB;
constexpr size_t WS_WDN = 76 * MiB;
constexpr size_t WS_WG = 98 * MiB;
constexpr size_t WS_ROPE = 99 * MiB;
constexpr size_t WS_HB = 101 * MiB;
constexpr size_t HB_ROW0 = 2 * 2048;
constexpr size_t WS_ACT = 135 * MiB;
constexpr size_t WS_CT = 135 * MiB;
constexpr size_t WS_MQ = 199 * MiB;
constexpr size_t WS_BCUM = 215 * MiB, WS_IG = WS_BCUM + 256 * 1024, WS_WGT = WS_IG + 256 * 1024, WS_DECAY = WS_WGT + 256 * 1024;
constexpr size_t WS_NCT = 217 * MiB;
constexpr size_t WS_ONES = 221 * MiB;
constexpr size_t WS_MK = 223 * MiB;
constexpr size_t WS_OG = 239 * MiB;
constexpr size_t WS_KVT = 271 * MiB;
constexpr size_t WS_HG = 319 * MiB;
constexpr size_t WS_XK = 223 * MiB;
constexpr size_t WS_XVT = 255 * MiB;
constexpr size_t WS_KMEAN = 287 * MiB;
constexpr size_t WS_DUMP = 287 * MiB + 512 * 1024;
constexpr size_t WS_AQ = 288 * MiB;
constexpr size_t WS_LIST = 320 * MiB;
constexpr size_t WS_ML = 337 * MiB;
constexpr size_t WS_PO = 135 * MiB, WS_PO2 = 340 * MiB;
constexpr int PO_SPLIT = 14336;
constexpr int TRI = 516096;
constexpr size_t WS_GCNT = 1536 * 1024;
constexpr size_t WS_END = 352 * MiB;
constexpr int CW_BAR = 4096;
constexpr int RING_BYTES = 131072, EPI_OFF = RING_BYTES + 1024, LDS_BYTES = 163840, MISC_OFF = LDS_BYTES - 256;

#define LDS_WAIT() asm volatile("s_waitcnt lgkmcnt(0)" ::: "memory")
__device__ __forceinline__ unsigned f2bf(float f) { unsigned u = __builtin_bit_cast(unsigned, f); return (u + 0x7fffu + ((u >> 16) & 1u)) >> 16; }
__device__ __forceinline__ unsigned pk2(float lo, float hi) { return f2bf(lo) | (f2bf(hi) << 16); }

#define XB_TMO      128
#define XB_XCNT(j)  (256  + 64 * (j))
#define XB_XSUB(j)  (1280 + 64 * (j))
#define XB_XGEN(j)  (2304 + 64 * (j))
#define XB_TOP      3328
#define XB_TOPGEN   3392
#define XCD_BAR_WORDS 3456
#define XB_SPIN_CAP (1u << 18)
__device__ __forceinline__ unsigned xb_ld(unsigned* p)              { return __hip_atomic_load(p, __ATOMIC_RELAXED, __HIP_MEMORY_SCOPE_AGENT); }
__device__ __forceinline__ unsigned xb_add(unsigned* p, unsigned v) { return __hip_atomic_fetch_add(p, v, __ATOMIC_RELAXED, __HIP_MEMORY_SCOPE_AGENT); }
__device__ __forceinline__ unsigned xb_xcc_id() { return (unsigned)__builtin_amdgcn_s_getreg((3 << 11) | 20) & 0xFu; }
#define XB_SPIN(cond, bar) do { unsigned _sp = 0; while (cond) { __builtin_amdgcn_s_sleep(1); \
    if ((++_sp & 255u) == 0u) { if (xb_ld(&(bar)[XB_TMO])) break; if (_sp > XB_SPIN_CAP) { atomicAdd(&(bar)[XB_TMO], 1u); break; } } } } while (0)
struct XcdBarrier { unsigned* bar; unsigned x; volatile LAS unsigned* st; };
__device__ __forceinline__ XcdBarrier xcd_barrier_post(unsigned* bar, volatile LAS unsigned* st) {
    XcdBarrier b; b.bar = bar; b.x = xb_xcc_id(); b.st = st;
    if (threadIdx.x == 0) (void)xb_add(&bar[XB_XCNT(b.x)], 1u);
    return b;
}
__device__ __forceinline__ void xcd_barrier_complete(unsigned* bar, unsigned x, unsigned& nloc, unsigned& nx) {
    const unsigned G = gridDim.x * gridDim.y * gridDim.z;
    unsigned sum, cnt, mine, sp = 0u;
    for (;;) {
        sum = 0u; cnt = 0u; mine = 0u;
#pragma unroll
        for (unsigned j = 0; j < 16; ++j) { const unsigned c = xb_ld(&bar[XB_XCNT(j)]); sum += c; cnt += (c > 0u) ? 1u : 0u; mine = (j == x) ? c : mine; }
        if (sum == G) break;
        __builtin_amdgcn_s_sleep(1);
        if ((++sp & 255u) == 0u) { if (xb_ld(&bar[XB_TMO])) break; if (sp > XB_SPIN_CAP) { atomicAdd(&bar[XB_TMO], 1u); break; } }
    }
    nloc = mine > 0u ? mine : 1u; nx = cnt > 0u ? cnt : 1u;
}
__device__ __forceinline__ void xcd_barrier(const XcdBarrier& b) {
    asm volatile("s_waitcnt vmcnt(0)" ::: "memory");
    __syncthreads();
    if (threadIdx.x == 0) {
        unsigned* bar = b.bar;
        __builtin_amdgcn_s_waitcnt(0);
        unsigned nloc = b.st[0], nx = b.st[1];
        if (nloc == 0u) { xcd_barrier_complete(bar, b.x, nloc, nx); b.st[0] = nloc; b.st[1] = nx; }
        const unsigned old = xb_add(&bar[XB_XSUB(b.x)], 1u);
        const unsigned gen = old / nloc;
        if (old + 1u == (gen + 1u) * nloc) {
            __builtin_amdgcn_fence(__ATOMIC_RELEASE, "agent");
            asm volatile("s_waitcnt vmcnt(0)" ::: "memory");
            const unsigned og = xb_add(&bar[XB_TOP], 1u);
            const unsigned tg = og / nx;
            if (og + 1u == (tg + 1u) * nx) xb_add(&bar[XB_TOPGEN], 1u);
            else XB_SPIN(xb_ld(&bar[XB_TOPGEN]) == tg, bar);
            __builtin_amdgcn_fence(__ATOMIC_ACQUIRE, "agent");
            xb_add(&bar[XB_XGEN(b.x)], 1u);
            asm volatile("s_waitcnt vmcnt(0)" ::: "memory");
        } else {
            XB_SPIN(xb_ld(&bar[XB_XGEN(b.x)]) == gen, bar);
            __builtin_amdgcn_fence(__ATOMIC_ACQUIRE, "agent");
            asm volatile("s_waitcnt vmcnt(0)" ::: "memory");
        }
    }
    __syncthreads();
}

using pg8::sh_idx; using pg8::sh_xor; using pg8::half_sum_hi; using pg8::oct_sum;
__device__ __forceinline__ float wave_sum(float v, int lane) {
#pragma unroll
    for (int o = 1; o < 64; o <<= 1) v += sh_xor(v, o, lane);
    return v;
}
__device__ __forceinline__ void transpose_item(const float* W, int ldw, int k0, int n0, const float* gain, bf16* WT, int Kd, int d0, bf16* WT2, int d1, LAS float* scr, int lane) {
    float v_[32], g_[32];
#pragma unroll
    for (int i = 0; i < 32; ++i) { const int kk = 2 * i + (lane >> 5); v_[i] = W[(size_t)(k0 + kk) * ldw + n0 + (lane & 31)]; g_[i] = gain ? gain[k0 + kk] : 1.0f; }
#pragma unroll
    for (int i = 0; i < 32; ++i) { const int kk = 2 * i + (lane >> 5); scr[kk * 33 + (lane & 31)] = v_[i] * g_[i]; }
    LDS_WAIT(); asm volatile("" ::: "memory");
    const int c = lane & 7;
#pragma unroll
    for (int j = 0; j < 4; ++j) { const int n = (lane >> 3) + 8 * j; const LAS float* s = scr + (8 * c) * 33 + n;
        v4u o; o.x = pk2(s[0 * 33], s[1 * 33]); o.y = pk2(s[2 * 33], s[3 * 33]); o.z = pk2(s[4 * 33], s[5 * 33]); o.w = pk2(s[6 * 33], s[7 * 33]);
        *(GAS v4u*)(WT + (size_t)(d0 + n) * Kd + k0 + 8 * c) = o;
        if (WT2) *(GAS v4u*)(WT2 + (size_t)(d1 + n) * Kd + k0 + 8 * c) = o; }
    LDS_WAIT(); asm volatile("" ::: "memory");
}


typedef float f32x16 __attribute__((ext_vector_type(16)));
__device__ __forceinline__ float bf2f(unsigned short v) { return __builtin_bit_cast(float, (unsigned)v << 16); }
__device__ __forceinline__ float log_sigmoidf(float f) { return fminf(f, 0.f) - log1pf(expf(-fabsf(f))); }

__device__ __forceinline__ void mlstm_gates_item(LAS unsigned char* L, int c, const bf16* hbr, const float* wg, const float* ssn, const float* bg,
                                                 float* BCUM, float* IG, float* WGT, float* DECAY, bf16* WROW) {
    int tid_ = threadIdx.x; asm volatile("" : "+v"(tid_)); const int tid = tid_, lane = tid & 63, wave = __builtin_amdgcn_readfirstlane(tid >> 6); (void)tid; (void)lane; (void)wave;
    LAS float* Gs = (LAS float*)L;
    float w[16][8];
#pragma unroll
    for (int j = 0; j < 2; ++j)
#pragma unroll
        for (int i = 0; i < 8; ++i) { const int k = 8 * lane + 512 * j + i; const f32x4 a = *(const f32x4*)(wg + k * 8), b = *(const f32x4*)(wg + k * 8 + 4);
            w[8 * j + i][0] = a[0]; w[8 * j + i][1] = a[1]; w[8 * j + i][2] = a[2]; w[8 * j + i][3] = a[3]; w[8 * j + i][4] = b[0]; w[8 * j + i][5] = b[1]; w[8 * j + i][6] = b[2]; w[8 * j + i][7] = b[3]; }
    for (int tt = 0; tt < 8; ++tt) {
        const int tl = wave * 8 + tt, t = 64 * c + tl;
        const GAS v4u* xr = (const GAS v4u*)(hbr + (size_t)t * D) + lane;
        float a8[8] = {0.f, 0.f, 0.f, 0.f, 0.f, 0.f, 0.f, 0.f};
#pragma unroll
        for (int j = 0; j < 2; ++j) { const v4u xv = xr[64 * j];
#pragma unroll
            for (int i = 0; i < 8; ++i) { const float xf = (i & 1) ? __builtin_bit_cast(float, xv[i >> 1] & 0xffff0000u) : __builtin_bit_cast(float, xv[i >> 1] << 16);
#pragma unroll
                for (int q = 0; q < 8; ++q) a8[q] += xf * w[8 * j + i][q]; } }
        const float rs = pg8::rstd4(ssn, t);
#pragma unroll
        for (int q = 0; q < 8; ++q) { const float v = wave_sum(a8[q], lane); if (lane == 0) Gs[tl * 8 + q] = v * rs; }
    }
    LDS_WAIT(); __syncthreads();
    if (wave < 4) {
        const int h = wave, t = 64 * c + lane;
        const float gi = Gs[lane * 8 + h] + bg[h], gf = Gs[lane * 8 + 4 + h] + bg[4 + h];
        float b = log_sigmoidf(gf);
#pragma unroll
        for (int o = 1; o < 64; o <<= 1) { const float v = sh_idx(b, lane - o); if (lane >= o) b += v; }
        const float bl = sh_idx(b, 63);
        BCUM[(size_t)h * T + t] = b; IG[(size_t)h * T + t] = gi; { const float wv_ = expf(bl - b + gi); WGT[(size_t)h * T + t] = wv_; WROW[(size_t)(c * 4 + h) * 64 + lane] = (bf16)f2bf(wv_); }
        if (lane == 63) DECAY[c * 4 + h] = expf(bl);
    }
    LDS_WAIT(); __syncthreads();
}

__device__ __forceinline__ bf16x8 scale_bf16x8(bf16x8 v, bf16x8 wv) {
    typedef unsigned u4 __attribute__((ext_vector_type(4)));
    const u4 u = __builtin_bit_cast(u4, v), w = __builtin_bit_cast(u4, wv); u4 o;
#pragma unroll
    for (int i = 0; i < 4; ++i)
        o[i] = pg8::cvt_pk_bf16(__builtin_bit_cast(float, u[i] << 16) * __builtin_bit_cast(float, w[i] << 16), __builtin_bit_cast(float, u[i] & 0xffff0000u) * __builtin_bit_cast(float, w[i] & 0xffff0000u));
    return __builtin_bit_cast(bf16x8, o);
}
__device__ __forceinline__ void mlstm_scan(const bf16* KVT, const float* DECAY, bf16* CT, bf16* NCT, const bf16* WROW, const bf16* ZROW, int G, bool probe_same = false) {
    int tid_ = threadIdx.x; asm volatile("" : "+v"(tid_)); const int tid = tid_, lane = tid & 63, wave = __builtin_amdgcn_readfirstlane(tid >> 6); (void)tid;
    bool active, ntask; int h, e0, d0;
    if (G == 256) { const int x = (int)blockIdx.x & 7, cu = (int)blockIdx.x >> 3; h = x >> 1;
        if (wave < 2) { const int k = wave * 32 + cu; active = true; ntask = false; e0 = (x & 1) * 128 + (k >> 3) * 16; d0 = (k & 7) * 16; }
        else { active = (wave == 2) && ((x & 1) == 0) && (cu < 8); ntask = true; e0 = 0; d0 = (cu & 7) * 16; }
    } else { const int gw = wave * G + (int)blockIdx.x; active = gw < 544; ntask = gw >= 512;
        if (!ntask) { h = gw >> 7; e0 = ((gw >> 3) & 15) * 16; d0 = (gw & 7) * 16; } else { const int q = gw - 512; h = (q >> 3) & 3; e0 = 0; d0 = (q & 7) * 16; } }
    if (probe_same) { h = 0; e0 = 0; d0 = 0; }
    if (active) {
        const int fr = lane & 15, fq = lane >> 4;
        const bf16* arow = KVT + (size_t)((h * 8 + (d0 >> 4)) * 2) * 512 + lane * 8;
        const bf16* brow = ntask ? ((fr == 0 ? WROW + h * 64 : ZROW) + 8 * fq) : (KVT + (size_t)((32 + h * 16 + (e0 >> 4)) * 2) * 512 + lane * 8);
        bf16* crow = ntask ? (NCT + ((size_t)h * 16 + fr) * 128 + d0 + 4 * fq) : (CT + ((size_t)(h * 8 + (e0 >> 5)) * 8 + (d0 >> 4)) * 512 + ((fq >> 1) * 32 + (e0 & 16) + fr) * 8 + 4 * (fq & 1));
        const size_t cstep = probe_same ? (size_t)0 : (ntask ? (size_t)4 * 16 * 128 : (size_t)4 * 256 * 128);
        const float* drow = DECAY + h;
        const size_t bstep = ntask ? (fr == 0 ? (size_t)256 : (size_t)0) : (size_t)1536 * 64;
        constexpr int P = 8;
        bf16x8 sa[P][2], sb[P][2]; float sd[P];
        const char* pa = (const char*)arow; const char* pb = (const char*)brow; const size_t b2off = ntask ? 64 : 1024;     const char* pd = (const char*)(DECAY + h); char* pc = (char*)crow;
        const size_t astep = (size_t)1536 * 64 * 2, bstepb = bstep * 2, cstepb = cstep * 2;
#define SC_LD16(dst, ptr, OFF) asm volatile("global_load_dwordx4 %0, %1, off offset:" #OFF : "=&v"(dst) : "v"(ptr) : "memory")
#define SC_LD4(dst, ptr) asm volatile("global_load_dword %0, %1, off" : "=&v"(dst) : "v"(ptr) : "memory")
#define SC_LOADS(j) do { SC_LD16(sa[j][0], pa, 0); SC_LD16(sa[j][1], pa, 1024); { const char* pb2_ = pb + b2off; SC_LD16(sb[j][0], pb, 0); SC_LD16(sb[j][1], pb2_, 0); } SC_LD4(sd[j], pd); pa += astep; pb += bstepb; pd += 16; } while (0)
#pragma unroll
        for (int j = 0; j < P; ++j) { float dm_; SC_LD4(dm_, pd); SC_LOADS(j); }
        f32x4 acc = (f32x4){0.f, 0.f, 0.f, 0.f};
        for (int c0 = 0; c0 < 256; c0 += P) {
#pragma unroll
            for (int j = 0; j < P; ++j) {
                asm volatile("s_waitcnt vmcnt(42)" : "+v"(sa[j][0]), "+v"(sa[j][1]), "+v"(sb[j][0]), "+v"(sb[j][1]), "+v"(sd[j]) :: "memory");
                { typedef unsigned u2 __attribute__((ext_vector_type(2))); u2 o; o.x = pg8::cvt_pk_bf16(acc[0], acc[1]); o.y = pg8::cvt_pk_bf16(acc[2], acc[3]);
                  if (!probe_same) asm volatile("global_store_dwordx2 %0, %1, off" :: "v"(pc), "v"(o) : "memory"); else { float dm2_; asm volatile("global_load_dword %0, %1, off" : "=&v"(dm2_) : "v"(pd), "v"(o) : "memory"); }
                  pc += cstepb; }
                acc = acc * sd[j];
                acc = __builtin_amdgcn_mfma_f32_16x16x32_bf16(sa[j][0], sb[j][0], acc, 0, 0, 0);
                acc = __builtin_amdgcn_mfma_f32_16x16x32_bf16(sa[j][1], sb[j][1], acc, 0, 0, 0);
                asm volatile("" : "+v"(acc));
                SC_LOADS(j);
            }
        }
        asm volatile("s_waitcnt vmcnt(0)" ::: "memory");
#undef SC_LD16
#undef SC_LD4
#undef SC_LOADS
    }
}

constexpr int M3_BUF = 36864;
constexpr int M3_QS = 0, M3_KS = 17408, M3_BC = 35840, M3_IG = 36096, M3_NV = 36352;
constexpr int M3_SS = 73728, M3_DQ = 82944, M3_DSP = 83200, M3_OS = 83968  ;
__device__ __forceinline__ void mlstm_out_phase(LAS unsigned char* L, int G, const bf16* Q, const bf16* K, const bf16* KVT, const bf16* CT, const bf16* NCT,
                                                const float* BCUM, const float* WGT, const bf16* OG, const float* hn, bf16* HG) {
    int tid_ = threadIdx.x; asm volatile("" : "+v"(tid_)); const int tid = tid_, lane = tid & 63, wave = __builtin_amdgcn_readfirstlane(tid >> 6);
    const int r = lane & 31, hh = lane >> 5;
    LAS float* dq = (LAS float*)(L + M3_DQ); LAS float* dsp = (LAS float*)(L + M3_DSP); LAS float* OS = (LAS float*)(L + M3_OS);
    int it = (int)blockIdx.x; if (it >= 1024) return;
    bf16x8 ctf[8], vtf[4]; v4u ogf[4]; v4u qk[4]; float sm = 0.f;
#define M3_LD_CT(c_, h_) do { const bf16* ctp = CT + (((size_t)((c_) * 4 + (h_)) * 8 + wave) * 8) * 512 + lane * 8; _Pragma("unroll") for (int kk = 0; kk < 8; ++kk) ctf[kk] = *(const bf16x8*)(ctp + 512 * kk); } while (0)
#define M3_LD_VT(c_, h_) do { const bf16* vtp = KVT + (((size_t)(c_) * 96 + 32 + (h_) * 16 + 2 * wave + (r >> 4)) * 2) * 512 + (hh * 16 + (r & 15)) * 8; _Pragma("unroll") for (int kk = 0; kk < 4; ++kk) vtf[kk] = *(const bf16x8*)(vtp + (kk >> 1) * 512 + (kk & 1) * 256); } while (0)
#define M3_LD_OG(c_, h_) do { const bf16* ogp = OG + (size_t)(64 * (c_) + (tid >> 3)) * 1024 + (h_) * 256 + 8 * (tid & 7); _Pragma("unroll") for (int k = 0; k < 4; ++k) ogf[k] = *(const GAS v4u*)(ogp + 64 * k); } while (0)
#define M3_LD_QK(c_, h_) do { _Pragma("unroll") for (int j = 0; j < 4; ++j) { const int i = tid + 512 * j, which = i >> 10, idx = i & 1023, row = idx >> 4, ch = idx & 15; \
            qk[j] = which ? *(const GAS v4u*)(KVT + (((size_t)(c_) * 96 + (h_) * 8) * 2) * 512 + idx * 8) : *(const GAS v4u*)(Q + (size_t)(64 * (c_) + row) * 512 + (h_) * 128 + ch * 8); } \
        if (tid < 64) sm = BCUM[(size_t)(h_) * T + 64 * (c_) + tid]; else if (tid < 128) sm = WGT[(size_t)(h_) * T + 64 * (c_) + tid - 64]; else if (tid < 256) sm = bf2f(NCT[(size_t)((c_) * 4 + (h_)) * 16 * 128 + tid - 128]); } while (0)
#define M3_ST_QK(B_) do { _Pragma("unroll") for (int j = 0; j < 4; ++j) { const int i = tid + 512 * j, which = i >> 10, idx = i & 1023, row = idx >> 4, ch = idx & 15; if (which) { const int bi_ = idx >> 6, lp_ = idx & 63; *(LAS v4u*)((B_) + M3_KS + (16 * (bi_ >> 1) + (lp_ & 15)) * 144 + (32 * (bi_ & 1) + 8 * (lp_ >> 4)) * 2) = qk[j]; } \
            else *(LAS v4u*)((B_) + row * 272 + ch * 16) = qk[j]; } \
        if (tid < 256) ((LAS float*)((B_) + M3_BC))[tid] = sm; } while (0)
    { const int c = it >> 2, h = it & 3; M3_LD_CT(c, h); M3_LD_VT(c, h); M3_LD_OG(c, h); M3_LD_QK(c, h); M3_ST_QK(L); }
    LDS_WAIT(); __syncthreads();
    int pb = 0;
    for (;;) {
        const int c = it >> 2, h = it & 3, t0 = 64 * c, itn = it + G; const bool has_next = itn < 1024; const int cn = itn >> 2, hn_ = itn & 3;
        LAS unsigned char* B = L + pb * M3_BUF; LAS unsigned char* Bn = L + (pb ^ 1) * M3_BUF;
        LAS float* bc = (LAS float*)(B + M3_BC); LAS float* ig = (LAS float*)(B + M3_IG); LAS float* nv = (LAS float*)(B + M3_NV);
        if (has_next) M3_LD_QK(cn, hn_);
        f32x16 O[2];
#pragma unroll
        for (int i = 0; i < 16; ++i) { O[0][i] = 0.f; O[1][i] = 0.f; }
#pragma unroll
        for (int kk = 0; kk < 8; ++kk) {
            const bf16x8 a0 = *(const LAS bf16x8*)(B + M3_QS + r * 272 + (16 * kk + 8 * hh) * 2), a1 = *(const LAS bf16x8*)(B + M3_QS + (32 + r) * 272 + (16 * kk + 8 * hh) * 2);
            O[0] = __builtin_amdgcn_mfma_f32_32x32x16_bf16(a0, ctf[kk], O[0], 0, 0, 0); O[1] = __builtin_amdgcn_mfma_f32_32x32x16_bf16(a1, ctf[kk], O[1], 0, 0, 0);
        }
        if (has_next) M3_LD_CT(cn, hn_);
        if (wave < 4) {
            const int tt = wave >> 1, s2 = wave & 1; f32x16 S;
#pragma unroll
            for (int i = 0; i < 16; ++i) S[i] = 0.f;
#pragma unroll
            for (int kk = 0; kk < 8; ++kk) {
                const bf16x8 a = *(const LAS bf16x8*)(B + M3_QS + (32 * tt + r) * 272 + (16 * kk + 8 * hh) * 2);
                typedef short v4i16_t __attribute__((ext_vector_type(4)));
                const int i16 = lane & 15, q4 = i16 >> 2, p4 = i16 & 3, blk = (lane >> 4) & 1;
                LAS unsigned char* tb = B + M3_KS + (16 * kk + 8 * hh + q4) * 144 + (32 * s2 + 16 * blk + 4 * p4) * 2;
                const v4i16_t lo = __builtin_amdgcn_ds_read_tr16_b64_v4i16((LAS v4i16_t*)tb), hi = __builtin_amdgcn_ds_read_tr16_b64_v4i16((LAS v4i16_t*)(tb + 4 * 144));
                const bf16x8 b = __builtin_shufflevector(lo, hi, 0, 1, 2, 3, 4, 5, 6, 7);
                S = __builtin_amdgcn_mfma_f32_32x32x16_bf16(a, b, S, 0, 0, 0);
            }
            const int s = 32 * s2 + r; const float ws = ig[s], bl = bc[63];
#pragma unroll
            for (int i = 0; i < 16; ++i) {
                const int t = 32 * tt + (i & 3) + 8 * (i >> 2) + 4 * hh;
                const float v = (s <= t) ? S[i] * __expf(bc[t] - bl) : 0.f;
                const float rsum = half_sum_hi(v * ws);
                if (r == 16) dsp[s2 * 64 + t] = rsum;
                *(LAS unsigned short*)(L + M3_SS + t * 144 + s * 2) = (unsigned short)f2bf(v);
            }
        } else {
            const int th = tid - 256, t = th >> 2, part = th & 3; float sum = 0.f;
#pragma unroll 8
            for (int d = 0; d < 32; ++d) sum += bf2f(*(const LAS unsigned short*)(B + M3_QS + t * 272 + (32 * part + d) * 2)) * nv[32 * part + d];
            sum = pg8::dpp_add<0xB1>(sum); sum = pg8::dpp_add<0x4E>(sum);
            if (part == 0) dq[t] = sum;
        }
        LDS_WAIT(); __syncthreads();
#pragma unroll
        for (int tt = 0; tt < 2; ++tt)
#pragma unroll
            for (int i = 0; i < 16; ++i) O[tt][i] *= __expf(bc[32 * tt + (i & 3) + 8 * (i >> 2) + 4 * hh]);
#pragma unroll
        for (int kk = 0; kk < 4; ++kk) {
            const bf16x8 a0 = *(const LAS bf16x8*)(L + M3_SS + r * 144 + (16 * kk + 8 * hh) * 2), a1 = *(const LAS bf16x8*)(L + M3_SS + (32 + r) * 144 + (16 * kk + 8 * hh) * 2);
            O[0] = __builtin_amdgcn_mfma_f32_32x32x16_bf16(a0, vtf[kk], O[0], 0, 0, 0); O[1] = __builtin_amdgcn_mfma_f32_32x32x16_bf16(a1, vtf[kk], O[1], 0, 0, 0);
        }
        if (has_next) M3_LD_VT(cn, hn_);
#pragma unroll
        for (int tt = 0; tt < 2; ++tt)
#pragma unroll
            for (int i = 0; i < 16; ++i) OS[(32 * tt + (i & 3) + 8 * (i >> 2) + 4 * hh) * 260 + 32 * wave + r] = O[tt][i];
        LDS_WAIT(); __syncthreads();
        {
            const int t = tid >> 3, part = tid & 7;
            const float den = __expf(bc[t]) * dq[t] + dsp[t] + dsp[64 + t];
            const float inv = __builtin_amdgcn_rcpf(fmaxf(fabsf(den), 1.0f));
            f32x4 v[8]; float ssq = 0.f;
#pragma unroll
            for (int k = 0; k < 8; ++k) { v[k] = *(const LAS f32x4*)(OS + t * 260 + 64 * (k >> 1) + 8 * part + 4 * (k & 1)) * inv; ssq += (v[k][0] * v[k][0] + v[k][1] * v[k][1]) + (v[k][2] * v[k][2] + v[k][3] * v[k][3]); }
            ssq = oct_sum(ssq);
            const float rsn = rsqrtf(ssq * (1.0f / 256.0f) + 1e-6f);
            const float* gp = hn + h * 256 + 8 * part;
            bf16* op = HG + (size_t)(t0 + t) * 1024 + h * 256 + 8 * part;
#pragma unroll
            for (int k = 0; k < 4; ++k) {
                const f32x4 g0 = *(const f32x4*)(gp + 64 * k), g1 = *(const f32x4*)(gp + 64 * k + 4);
                float o8[8];
#pragma unroll
                for (int x2 = 0; x2 < 4; ++x2) {
                    const float og0 = __builtin_bit_cast(float, ogf[k][x2] << 16), og1 = __builtin_bit_cast(float, ogf[k][x2] & 0xffff0000u);
                    const float a0 = (2 * x2 < 4) ? v[2 * k][2 * x2] : v[2 * k + 1][2 * x2 - 4], a1 = (2 * x2 + 1 < 4) ? v[2 * k][2 * x2 + 1] : v[2 * k + 1][2 * x2 + 1 - 4];
                    const float gg0 = (2 * x2 < 4) ? g0[2 * x2] : g1[2 * x2 - 4], gg1 = (2 * x2 + 1 < 4) ? g0[2 * x2 + 1] : g1[2 * x2 + 1 - 4];
                    o8[2 * x2] = a0 * rsn * gg0 * __builtin_amdgcn_rcpf(1.0f + __builtin_amdgcn_exp2f(-1.4426950408889634f * og0)); o8[2 * x2 + 1] = a1 * rsn * gg1 * __builtin_amdgcn_rcpf(1.0f + __builtin_amdgcn_exp2f(-1.4426950408889634f * og1)); }
                v4u w; w.x = pg8::cvt_pk_bf16(o8[0], o8[1]); w.y = pg8::cvt_pk_bf16(o8[2], o8[3]); w.z = pg8::cvt_pk_bf16(o8[4], o8[5]); w.w = pg8::cvt_pk_bf16(o8[6], o8[7]);
                *(GAS v4u*)(op + 64 * k) = w; }
        }
        if (has_next) { M3_LD_OG(cn, hn_); M3_ST_QK(Bn); }
        LDS_WAIT(); __syncthreads();
        if (!has_next) break;
        it = itn; pb ^= 1;
    }
#undef M3_LD_CT
#undef M3_LD_VT
#undef M3_LD_OG
#undef M3_LD_QK
#undef M3_ST_QK
}

constexpr int AT_QS = 0, AT_PS = 34816, AT_PM = 102400, AT_PSUM = 106496, AT_ENT = 110592, AT_W = 111104, AT_MX = 113152, AT_PRE = 113664  , AT_WT = 115744;
constexpr int GT_KH = 34816, GT_KL = 52224, GT_SC = 69632, GT_LCNT = 102912, GT_BASE = 103168;
__device__ __forceinline__ int list_off(int h, int b) { return h * TRI + b * T - 128 * b * (b + 1); }
__device__ __forceinline__ void moba_gate_phase(LAS unsigned char* L, int G, const bf16* AQ, const float* KMEAN, int* gcnt, int* LIST) {
    int tid_ = threadIdx.x; asm volatile("" : "+v"(tid_)); const int tid = tid_, lane = tid & 63, wave = __builtin_amdgcn_readfirstlane(tid >> 6);
    const int r = lane & 31, hh = lane >> 5;
    LAS int* LCNT = (LAS int*)(L + GT_LCNT); LAS int* BASE = (LAS int*)(L + GT_BASE); LAS float* SC = (LAS float*)(L + GT_SC);
    int h_loaded = -1;
    int it = (int)blockIdx.x;
    while (it < 1024 && (it >> 4) == 0) it += G;
    if (it >= 1024) return;
    v4u qn[4];
#pragma unroll
    for (int j = 0; j < 4; ++j) { const int i = tid + 512 * j, rl = i >> 4, ch = i & 15; qn[j] = *(const GAS v4u*)(AQ + (size_t)(128 * (it >> 3) + rl) * 1024 + (it & 7) * 128 + ch * 8); }
    for (;;) {
        const int qi = it >> 3, h = it & 7, cur = qi >> 1;
        int itn = it + G; const bool has_next = itn < 1024;
        if (h != h_loaded) {
            for (int i = tid; i < 64 * 128; i += 512) { const int bb = i >> 7, d = i & 127; const float v = KMEAN[((size_t)h * 64 + bb) * 128 + d];
                const unsigned hi = f2bf(v), lo = f2bf(v - bf2f((unsigned short)hi));
                *(LAS unsigned short*)(L + GT_KH + bb * 272 + d * 2) = (unsigned short)hi; *(LAS unsigned short*)(L + GT_KL + bb * 272 + d * 2) = (unsigned short)lo; }
            h_loaded = h; }
#pragma unroll
        for (int j = 0; j < 4; ++j) { const int i = tid + 512 * j, rl = i >> 4, ch = i & 15; *(LAS v4u*)(L + AT_QS + rl * 272 + ch * 16) = qn[j]; }
        if (tid < 64) LCNT[tid] = 0;
        LDS_WAIT(); __syncthreads();
        if (has_next) {
#pragma unroll
            for (int j = 0; j < 4; ++j) { const int i = tid + 512 * j, rl = i >> 4, ch = i & 15; qn[j] = *(const GAS v4u*)(AQ + (size_t)(128 * (itn >> 3) + rl) * 1024 + (itn & 7) * 128 + ch * 8); }
        }
        {   const int tt = wave >> 1, bt = wave & 1; f32x16 S;
#pragma unroll
            for (int i = 0; i < 16; ++i) S[i] = 0.f;
#pragma unroll
            for (int kk = 0; kk < 8; ++kk) {
                const bf16x8 a = *(const LAS bf16x8*)(L + AT_QS + (32 * tt + r) * 272 + (16 * kk + 8 * hh) * 2);
                const bf16x8 bh = *(const LAS bf16x8*)(L + GT_KH + (32 * bt + r) * 272 + (16 * kk + 8 * hh) * 2), bl = *(const LAS bf16x8*)(L + GT_KL + (32 * bt + r) * 272 + (16 * kk + 8 * hh) * 2);
                S = __builtin_amdgcn_mfma_f32_32x32x16_bf16(a, bh, S, 0, 0, 0); S = __builtin_amdgcn_mfma_f32_32x32x16_bf16(a, bl, S, 0, 0, 0);
            }
#pragma unroll
            for (int i = 0; i < 16; ++i) SC[(32 * tt + (i & 3) + 8 * (i >> 2) + 4 * hh) * 65 + 32 * bt + r] = S[i];
        }
        LDS_WAIT(); __syncthreads();
        int p0 = -1, p1 = -1, p2 = -1, l0 = 0, l1 = 0, l2 = 0; const int nsel = cur < 3 ? cur : 3;
        if (tid < 128) {
            float v0 = -INFINITY, v1 = -INFINITY, v2 = -INFINITY;
            for (int b = 0; b < cur; ++b) { const float sc = SC[tid * 65 + b];
                if (sc > v0) { v2 = v1; p2 = p1; v1 = v0; p1 = p0; v0 = sc; p0 = b; }
                else if (sc > v1) { v2 = v1; p2 = p1; v1 = sc; p1 = b; }
                else if (sc > v2) { v2 = sc; p2 = b; } }
            if (nsel > 0 && p0 >= 0) l0 = __hip_atomic_fetch_add(LCNT + p0, 1, __ATOMIC_RELAXED, __HIP_MEMORY_SCOPE_WORKGROUP);
            if (nsel > 1 && p1 >= 0) l1 = __hip_atomic_fetch_add(LCNT + p1, 1, __ATOMIC_RELAXED, __HIP_MEMORY_SCOPE_WORKGROUP);
            if (nsel > 2 && p2 >= 0) l2 = __hip_atomic_fetch_add(LCNT + p2, 1, __ATOMIC_RELAXED, __HIP_MEMORY_SCOPE_WORKGROUP);
        }
        LDS_WAIT(); __syncthreads();
        if (tid < cur) { const int n = LCNT[tid]; if (n > 0) BASE[tid] = __hip_atomic_fetch_add(gcnt + h * 64 + tid, n, __ATOMIC_RELAXED, __HIP_MEMORY_SCOPE_AGENT); }
        LDS_WAIT(); __syncthreads();
        if (tid < 128) { const int tg = (128 * qi + tid) << 2;
            if (nsel > 0 && p0 >= 0) LIST[list_off(h, p0) + BASE[p0] + l0] = tg | 0;
            if (nsel > 1 && p1 >= 0) LIST[list_off(h, p1) + BASE[p1] + l1] = tg | 1;
            if (nsel > 2 && p2 >= 0) LIST[list_off(h, p2) + BASE[p2] + l2] = tg | 2; }
        LDS_WAIT(); __syncthreads();
        if (!has_next) break;
        it = itn;
    }
}

constexpr int AP_QS0 = 0, AP_QS1 = 34816, AP_PS = 69632, AP_PM = 137216, AP_PSUM = 141312, AP_ENT0 = 145408, AP_ENT1 = 145920, AP_W = 146432, AP_MX = 148480, AP_PRE = 148992  , AP_WT = 151072;
struct AItem { int h, b, row0, nrows, qi; const int* list; bool valid; };
template <bool OWN>
__device__ __forceinline__ AItem attn_get(int k, int G, const LAS int* PRE, int total, const int* gcnt, const int* LIST) {
    AItem it; const int idx = (int)blockIdx.x + k * G;
    if (OWN) { it.valid = idx < 1024; it.qi = idx >> 3; it.h = idx & 7; it.b = it.qi >> 1; it.row0 = 128 * it.qi; it.nrows = 128; it.list = nullptr; }
    else {
        it.valid = idx < total; it.qi = 0; int lo = 0, hi = 512;
        if (it.valid) { while (hi - lo > 1) { const int mid = (lo + hi) >> 1; if (PRE[mid] <= idx) lo = mid; else hi = mid; } }
        const int hb = lo; it.h = hb >> 6; it.b = hb & 63; const int i = it.valid ? idx - PRE[hb] : 0, n = it.valid ? gcnt[hb] : 0;
        it.row0 = 128 * i; it.nrows = (n - 128 * i) < 128 ? (n - 128 * i) : 128; it.list = LIST + list_off(it.h, it.b);
    }
    return it;
}
template <bool OWN>
__device__ __forceinline__ void attn_phase(LAS unsigned char* L, int G, const int* gcnt, const int* LIST, const bf16* AQ, const bf16* XK, const bf16* XVT, bf16* PO, float* ML, bf16* AOUT, int tmask, int probe = 0) {
    int tid_ = threadIdx.x; asm volatile("" : "+v"(tid_)); const int tid = tid_, lane = tid & 63, wave = __builtin_amdgcn_readfirstlane(tid >> 6);
    const int r = lane & 31, hh = lane >> 5;
    LAS int* PRE = (LAS int*)(L + AP_PRE); LAS int* WT = (LAS int*)(L + AP_WT);
    LAS float* PM = (LAS float*)(L + AP_PM); LAS float* PSUM = (LAS float*)(L + AP_PSUM); LAS float* MX = (LAS float*)(L + AP_MX); LAS float* W = (LAS float*)(L + AP_W);
    int total = 0;
    if (!OWN) {
        int v = (gcnt[tid] + 127) >> 7;
#pragma unroll
        for (int o = 1; o < 64; o <<= 1) { const int u = __builtin_amdgcn_ds_bpermute((lane - o) << 2, v); if (lane >= o) v += u; }
        if (lane == 63) WT[wave] = v;
        LDS_WAIT(); __syncthreads();
        int add = 0;
#pragma unroll
        for (int w8 = 0; w8 < 8; ++w8) if (w8 < wave) add += WT[w8];
        PRE[tid + 1] = v + add; if (tid == 0) PRE[0] = 0;
        LDS_WAIT(); __syncthreads();
        total = PRE[512];
    }
    AItem cur = attn_get<OWN>(0, G, PRE, total, gcnt, LIST);
    if (!cur.valid) return;
    int pb = 0;
    {   LAS int* ENT = (LAS int*)(L + AP_ENT0);
        if (!OWN) { if (tid < 128) ENT[tid] = (tid < cur.nrows) ? cur.list[cur.row0 + tid] : -1; LDS_WAIT(); __syncthreads(); }
        for (int i = tid; i < 2048; i += 512) { const int rl = i >> 4, ch = i & 15; int t;
            if (OWN) t = cur.row0 + rl; else { const int e = ENT[rl]; t = e >= 0 ? (e >> 2) : 0; }
            const v4u v = *(const GAS v4u*)(AQ + (size_t)t * 1024 + cur.h * 128 + ch * 8); *(LAS v4u*)(L + AP_QS0 + rl * 272 + ch * 16) = v; }
        LDS_WAIT(); __syncthreads();
    }
    for (int k = 0; ; ++k) {
        const AItem nxt = attn_get<OWN>(k + 1, G, PRE, total, gcnt, LIST);
        const int h = (probe & 2) ? 0 : cur.h, b = (probe & 2) ? 0 : cur.b, qi = cur.qi, row0 = cur.row0;
        LAS unsigned char* Qc = L + (pb ? AP_QS1 : AP_QS0); LAS unsigned char* Qn = L + (pb ? AP_QS0 : AP_QS1);
        LAS int* ENT = (LAS int*)(L + (pb ? AP_ENT1 : AP_ENT0)); LAS int* ENTn = (LAS int*)(L + (pb ? AP_ENT0 : AP_ENT1));
        const int dt = wave & 3, tp = wave >> 2;
        bf16x8 kf[8], vf[16];
        {   const bf16* kp = XK + (((size_t)(b * 8 + h) * 8 + wave) * 8) * 512 + lane * 8;
#pragma unroll
            for (int kk = 0; kk < 8; ++kk) kf[kk] = *(const bf16x8*)(kp + 512 * kk);
            const bf16* vp = XVT + (((size_t)(b * 8 + h) * 4 + dt) * 16) * 512 + lane * 8;
#pragma unroll
            for (int kk = 0; kk < 16; ++kk) vf[kk] = *(const bf16x8*)(vp + 512 * kk);
        }
        int e_n = -1;
        if (!OWN && nxt.valid && tid < 128 && tid < nxt.nrows) e_n = nxt.list[nxt.row0 + tid];
        f32x16 S[4];
#pragma unroll
        for (int tq = 0; tq < 4; ++tq) {
#pragma unroll
            for (int i = 0; i < 16; ++i) S[tq][i] = 0.f;
#pragma unroll
            for (int kk = 0; kk < 8; ++kk) { const bf16x8 bq = *(const LAS bf16x8*)(Qc + (32 * tq + r) * 272 + (16 * kk + 8 * hh) * 2);
                S[tq] = __builtin_amdgcn_mfma_f32_32x32x16_bf16(kf[kk], bq, S[tq], 0, 0, 0); }
        }
#pragma unroll
        for (int tq = 0; tq < 4; ++tq) {
            const int t = 32 * tq + r; float ps = 0.f;
#pragma unroll
            for (int i = 0; i < 16; ++i) {
                float sv = S[tq][i];
                if (OWN) { const int key = 32 * wave + (i & 3) + 8 * (i >> 2) + 4 * hh, lim = (qi & 1) * 128 + t; if (key > lim) sv = -INFINITY; }
                const float p = __builtin_amdgcn_exp2f(sv); S[tq][i] = p; ps += p; }
            ps += sh_xor(ps, 32, lane);
            if (hh == 0) PSUM[wave * 128 + t] = ps;
#pragma unroll
            for (int g = 0; g < 4; ++g) { pg8::u32x2 w2; w2.x = pg8::cvt_pk_bf16(S[tq][4 * g], S[tq][4 * g + 1]); w2.y = pg8::cvt_pk_bf16(S[tq][4 * g + 2], S[tq][4 * g + 3]);
                *(LAS pg8::u32x2*)(L + AP_PS + t * 528 + (32 * wave + 8 * g + 4 * hh) * 2) = w2; }
        }
        if (!OWN && tid < 128) ENTn[tid] = e_n;
        LDS_WAIT(); __syncthreads();
        v4u qn[4];
        if (nxt.valid) {
#pragma unroll
            for (int j = 0; j < 4; ++j) { const int i = tid + 512 * j, rl = i >> 4, ch = i & 15; int t;
                if (OWN) t = nxt.row0 + rl; else { const int e = ENTn[rl]; t = e >= 0 ? (e >> 2) : 0; if (probe & 4) t = rl; }
                qn[j] = *(const GAS v4u*)(AQ + (size_t)t * 1024 + nxt.h * 128 + ch * 8); }
        }
        f32x16 O[2];
#pragma unroll
        for (int i = 0; i < 16; ++i) { O[0][i] = 0.f; O[1][i] = 0.f; }
#pragma unroll
        for (int kk = 0; kk < 16; ++kk) {
            const bf16x8 a0 = *(const LAS bf16x8*)(L + AP_PS + (64 * tp + r) * 528 + (16 * kk + 8 * hh) * 2), a1 = *(const LAS bf16x8*)(L + AP_PS + (64 * tp + 32 + r) * 528 + (16 * kk + 8 * hh) * 2);
            O[0] = __builtin_amdgcn_mfma_f32_32x32x16_bf16(a0, vf[kk], O[0], 0, 0, 0); O[1] = __builtin_amdgcn_mfma_f32_32x32x16_bf16(a1, vf[kk], O[1], 0, 0, 0);
        }
        const int curb = qi >> 1, nsel = curb < 3 ? curb : 3;
        if (OWN) {
            if (tid < 128) { const int t = row0 + tid; float Lo = 0.f;
#pragma unroll
                for (int w8 = 0; w8 < 8; ++w8) Lo += PSUM[w8 * 128 + tid];
                float den = Lo;
#pragma unroll
                for (int j = 0; j < 3; ++j) if (j < nsel) den += ML[((size_t)(t * 8 + h) * 3 + j) * 2 + 1];
                const float inv = 1.0f / den;
                W[tid * 4 + 0] = inv; W[tid * 4 + 1] = nsel > 0 ? inv : 0.f; W[tid * 4 + 2] = nsel > 1 ? inv : 0.f; W[tid * 4 + 3] = nsel > 2 ? inv : 0.f; }
        }
        LDS_WAIT(); __syncthreads();
        {   LAS float* OS = (LAS float*)(L + AP_PS);
#pragma unroll
            for (int q = 0; q < 2; ++q)
#pragma unroll
                for (int i = 0; i < 16; ++i) OS[(64 * tp + 32 * q + (i & 3) + 8 * (i >> 2) + 4 * hh) * 132 + 32 * dt + r] = O[q][i];
        }
        LDS_WAIT(); __syncthreads();
        {   const LAS float* OS = (const LAS float*)(L + AP_PS);
            const int rl = tid >> 2, c4 = tid & 3;
            if (!OWN) {
                const int e = (probe & 1) ? -1 : ENT[rl];
                if (e >= 0) {
                    const int te = e >> 2; bf16* dst = (te < PO_SPLIT ? PO : PO + (WS_PO2 - WS_PO) / 2 - (size_t)PO_SPLIT * 3072) + ((size_t)(te * 8 + h) * 3 + (e & 3)) * 128;
#pragma unroll
                    for (int kq = 0; kq < 4; ++kq) { const int ch = c4 + 4 * kq; const f32x4 a = *(const LAS f32x4*)(OS + rl * 132 + ch * 8), b2 = *(const LAS f32x4*)(OS + rl * 132 + ch * 8 + 4);
                        v4u w; w.x = pg8::cvt_pk_bf16(a[0], a[1]); w.y = pg8::cvt_pk_bf16(a[2], a[3]); w.z = pg8::cvt_pk_bf16(b2[0], b2[1]); w.w = pg8::cvt_pk_bf16(b2[2], b2[3]);
                        *(GAS v4u*)(dst + ch * 8) = w; }
                    if (c4 == 0) { float Ls = 0.f;
#pragma unroll
                        for (int w8 = 0; w8 < 8; ++w8) Ls += PSUM[w8 * 128 + rl];
                        float* ml = ML + ((size_t)((e >> 2) * 8 + h) * 3 + (e & 3)) * 2; ml[0] = 0.f; ml[1] = Ls; }
                }
            } else {
                const int t = row0 + rl; const f32x4 w4 = *(const LAS f32x4*)(W + rl * 4);
                const bf16* po = (t < PO_SPLIT ? PO : PO + (WS_PO2 - WS_PO) / 2 - (size_t)PO_SPLIT * 3072) + ((size_t)(t * 8 + h) * 3) * 128;
                const unsigned m0 = nsel > 0 ? 0xffffffffu : 0u, m1 = nsel > 1 ? 0xffffffffu : 0u, m2 = nsel > 2 ? 0xffffffffu : 0u;
#pragma unroll
                for (int kq = 0; kq < 4; ++kq) { const int ch = c4 + 4 * kq;
                    const f32x4 a = *(const LAS f32x4*)(OS + rl * 132 + ch * 8), b2 = *(const LAS f32x4*)(OS + rl * 132 + ch * 8 + 4);
                    v4u p0 = *(const GAS v4u*)(po + ch * 8), p1 = *(const GAS v4u*)(po + 128 + ch * 8), p2 = *(const GAS v4u*)(po + 256 + ch * 8);
                    p0 = p0 & m0; p1 = p1 & m1; p2 = p2 & m2;
                    float o8[8] = {a[0] * w4[0], a[1] * w4[0], a[2] * w4[0], a[3] * w4[0], b2[0] * w4[0], b2[1] * w4[0], b2[2] * w4[0], b2[3] * w4[0]};
#pragma unroll
                    for (int x2 = 0; x2 < 4; ++x2) {
                        o8[2 * x2] += w4[1] * __builtin_bit_cast(float, p0[x2] << 16) + w4[2] * __builtin_bit_cast(float, p1[x2] << 16) + w4[3] * __builtin_bit_cast(float, p2[x2] << 16);
                        o8[2 * x2 + 1] += w4[1] * __builtin_bit_cast(float, p0[x2] & 0xffff0000u) + w4[2] * __builtin_bit_cast(float, p1[x2] & 0xffff0000u) + w4[3] * __builtin_bit_cast(float, p2[x2] & 0xffff0000u); }
                    v4u w; w.x = pg8::cvt_pk_bf16(o8[0], o8[1]); w.y = pg8::cvt_pk_bf16(o8[2], o8[3]); w.z = pg8::cvt_pk_bf16(o8[4], o8[5]); w.w = pg8::cvt_pk_bf16(o8[6], o8[7]);
                    *(GAS v4u*)(AOUT + (size_t)(t & tmask) * 1024 + h * 128 + ch * 8) = w; }
            }
        }
        if (nxt.valid) {
#pragma unroll
            for (int j = 0; j < 4; ++j) { const int i = tid + 512 * j, rl = i >> 4, ch = i & 15; *(LAS v4u*)(Qn + rl * 272 + ch * 16) = qn[j]; }
        }
        LDS_WAIT(); __syncthreads();
        if (!nxt.valid) break;
        cur = nxt; pb ^= 1;
    }
}


struct Args { const float* in[18]; float* out; unsigned char* ws; unsigned long long ws_size; };

typedef const __attribute__((address_space(4))) Args* KArgsP;
#define KA() ({ KArgsP p_ = (KArgsP)__builtin_amdgcn_kernarg_segment_ptr(); asm volatile("" : "+s"(p_)); p_; })
#define AIN(i) ((const float*)KA()->in[i])
#define WSB ((unsigned char*)KA()->ws)
#define XIN AIN(0)
#define OUTP ((float*)KA()->out)
#define SS ((float*)(WSB + WS_SS))
#define HBP ((bf16*)(WSB + WS_HB))
#define HB ((bf16*)(WSB + WS_HB + HB_ROW0))
#define ACT ((bf16*)(WSB + WS_ACT))
constexpr int H2_BYTES = 69632, H2_QS = 0  , H2_PS = 17408  , H2_OS = 51200  ;
constexpr int H2_PSUM = 139264  , H2_ENT = 143360  , H2_PRE = 144896  , H2_WT = 146976, H2_GL = 147072  ;
#define H2_BAR() do { asm volatile("s_waitcnt lgkmcnt(0)" ::: "memory"); __builtin_amdgcn_s_barrier(); asm volatile("" ::: "memory"); } while (0)
template <bool OWN>
__device__ __forceinline__ void attn_store_rows(LAS unsigned char* L, int hf, int ht, int par, int eslot, const AItem& it, bf16* PO, float* ML, bf16* AOUT, int tmask, bool live, unsigned char* dump) {
    const int rl = ht >> 2, c4 = ht & 3, h = it.h;
    const LAS float* PSUM = (const LAS float*)(L + H2_PSUM) + (par * 2 + hf) * 256; const LAS int* ENT = (const LAS int*)(L + H2_ENT) + eslot * 128;
    const LAS unsigned char* OSb = L + hf * H2_BYTES + H2_OS + rl * 272;
    const float Ls = (PSUM[rl] + PSUM[64 + rl]) + (PSUM[128 + rl] + PSUM[192 + rl]);
    if (!OWN) {
        const int e = ENT[64 * hf + rl]; const bool ok = live && e >= 0; const int es_ = e >= 0 ? e : 0;
        const int te = es_ >> 2; bf16* dst = (te < PO_SPLIT ? PO : PO + (WS_PO2 - WS_PO) / 2 - (size_t)PO_SPLIT * 3072) + ((size_t)(te * 8 + h) * 3 + (es_ & 3)) * 128;
        if (!ok) dst = (bf16*)dump;
#pragma unroll
        for (int kq = 0; kq < 4; ++kq) { const int ch = c4 + 4 * kq; *(GAS v4u*)(dst + ch * 8) = *(const LAS v4u*)(OSb + ch * 16); }
        float* ml = ML + ((size_t)(te * 8 + h) * 3 + (es_ & 3)) * 2; if (!ok || c4 != 0) ml = (float*)(dump + 512);
        ml[0] = 0.f; ml[1] = Ls;
    } else {
        const int t = it.row0 + 64 * hf + rl, curb = it.qi >> 1, nsel = curb < 3 ? curb : 3;
        float den = Ls;
#pragma unroll
        for (int j = 0; j < 3; ++j) { const float lj = ML[((size_t)(t * 8 + h) * 3 + j) * 2 + 1]; den += (j < nsel) ? lj : 0.f; }
        const float inv = 1.0f / den;
        const bf16* po = (t < PO_SPLIT ? PO : PO + (WS_PO2 - WS_PO) / 2 - (size_t)PO_SPLIT * 3072) + ((size_t)(t * 8 + h) * 3) * 128;
        const unsigned m0 = nsel > 0 ? 0xffffffffu : 0u, m1 = nsel > 1 ? 0xffffffffu : 0u, m2 = nsel > 2 ? 0xffffffffu : 0u;
        bf16* orow = live ? AOUT + (size_t)(t & tmask) * 1024 + h * 128 : (bf16*)dump;
#pragma unroll
        for (int kq = 0; kq < 4; ++kq) { const int ch = c4 + 4 * kq;
            const v4u a = *(const LAS v4u*)(OSb + ch * 16);
            v4u p0 = *(const GAS v4u*)(po + ch * 8), p1 = *(const GAS v4u*)(po + 128 + ch * 8), p2 = *(const GAS v4u*)(po + 256 + ch * 8);
            p0 = p0 & m0; p1 = p1 & m1; p2 = p2 & m2;
            float o8[8];
#pragma unroll
            for (int x2 = 0; x2 < 4; ++x2) {
                o8[2 * x2] = (__builtin_bit_cast(float, a[x2] << 16) + __builtin_bit_cast(float, p0[x2] << 16) + __builtin_bit_cast(float, p1[x2] << 16) + __builtin_bit_cast(float, p2[x2] << 16)) * inv;
                o8[2 * x2 + 1] = (__builtin_bit_cast(float, a[x2] & 0xffff0000u) + __builtin_bit_cast(float, p0[x2] & 0xffff0000u) + __builtin_bit_cast(float, p1[x2] & 0xffff0000u) + __builtin_bit_cast(float, p2[x2] & 0xffff0000u)) * inv; }
            v4u w; w.x = pg8::cvt_pk_bf16n(o8[0], o8[1]); w.y = pg8::cvt_pk_bf16n(o8[2], o8[3]); w.z = pg8::cvt_pk_bf16n(o8[4], o8[5]); w.w = pg8::cvt_pk_bf16n(o8[6], o8[7]);
            *(GAS v4u*)(orow + ch * 8) = w; }
    }
}
struct AWalk { int idx, end, hb; };
template <bool OWN>
__device__ __forceinline__ AItem attn_at(const AWalk& w, const LAS int* PRE, const LAS int* GL, const int* LIST) {
    AItem it; it.valid = w.idx < w.end;
    if (OWN) { const int ix = it.valid ? w.idx : 0; it.qi = ix >> 3; it.h = ix & 7; it.b = it.qi >> 1; it.row0 = 128 * it.qi; it.nrows = 128; it.list = nullptr; }
    else { const int hb = w.hb; it.qi = 0; it.h = hb >> 6; it.b = hb & 63; const int i = it.valid ? w.idx - PRE[hb] : 0, n = it.valid ? GL[hb] : 0;
        it.row0 = 128 * i; it.nrows = (n - 128 * i) < 128 ? (n - 128 * i) : 128; it.list = LIST + list_off(it.h, it.b); }
    return it;
}
template <bool OWN>
__device__ __forceinline__ void attn_step(AWalk& w, int G, const LAS int* PRE) {
    if (OWN) { w.idx += G; return; }
    w.idx += 1;
    if (w.idx < w.end) { while (PRE[w.hb + 1] <= w.idx) ++w.hb; }
}
template <bool OWN>
__device__ __forceinline__ void attn_phase2(LAS unsigned char* L, int G, const int* gcnt, const int* LIST, const bf16* AQ, const bf16* XK, const bf16* XVT, bf16* PO, float* ML, bf16* AOUT, int tmask, unsigned char* dump) {
    int tid_ = threadIdx.x; asm volatile("" : "+v"(tid_)); int tid = tid_, lane = tid & 63; const int wave = __builtin_amdgcn_readfirstlane(tid >> 6);
    int r = lane & 31, hh = lane >> 5, ht = tid & 255; const int hw = wave & 3, hf = wave >> 2;
    LAS int* PRE = (LAS int*)(L + H2_PRE); LAS int* WT = (LAS int*)(L + H2_WT); LAS int* GL = (LAS int*)(L + H2_GL);
    LAS unsigned char* HB_ = L + hf * H2_BYTES;
    AWalk w;
    if (!OWN) {
        const int gc = gcnt[tid]; GL[tid] = gc;
        int v = (gc + 127) >> 7;
#pragma unroll
        for (int o = 1; o < 64; o <<= 1) { const int u = __builtin_amdgcn_ds_bpermute((lane - o) << 2, v); if (lane >= o) v += u; }
        if (lane == 63) WT[wave] = v;
        LDS_WAIT(); __syncthreads();
        int add = 0;
#pragma unroll
        for (int w8 = 0; w8 < 8; ++w8) if (w8 < wave) add += WT[w8];
        PRE[tid + 1] = v + add; if (tid == 0) PRE[0] = 0;
        LDS_WAIT(); __syncthreads();
        const unsigned total = (unsigned)PRE[512];
        w.idx = (int)(((unsigned)blockIdx.x * total) / (unsigned)G); w.end = (int)((((unsigned)blockIdx.x + 1u) * total) / (unsigned)G);
        int lo = 0, hi = 512;
        if (w.idx < w.end) { while (hi - lo > 1) { const int mid = (lo + hi) >> 1; if (PRE[mid] <= w.idx) lo = mid; else hi = mid; } }
        w.hb = lo;
    } else { w.idx = (int)blockIdx.x; w.end = 1024; w.hb = 0; }
    AItem cur = attn_at<OWN>(w, PRE, GL, LIST);
    if (!cur.valid) return;
    attn_step<OWN>(w, G, PRE); AItem nxt = attn_at<OWN>(w, PRE, GL, LIST);
    {   LAS int* ENT = (LAS int*)(L + H2_ENT);
        if (!OWN) { if (tid < 128) { ENT[tid] = (tid < cur.nrows) ? cur.list[cur.row0 + tid] : -1; ENT[128 + tid] = (nxt.valid && tid < nxt.nrows) ? nxt.list[nxt.row0 + tid] : -1; } LDS_WAIT(); __syncthreads(); }
#pragma unroll
        for (int j = 0; j < 4; ++j) { const int i = ht + 256 * j, rl = i >> 4, ch = i & 15; int t;
            if (OWN) t = cur.row0 + 64 * hf + rl; else { const int e = ENT[64 * hf + rl]; t = e >= 0 ? (e >> 2) : 0; }
            *(LAS v4u*)(HB_ + H2_QS + rl * 272 + ch * 16) = *(const GAS v4u*)(AQ + (size_t)t * 1024 + cur.h * 128 + ch * 8); }
        LDS_WAIT(); __syncthreads();
    }
    bf16x8 kf[2][8], vf[16]; v4u qn[4]; int e_n = -1;
#define H2_LD_K(IT) do { const bf16* kp_ = XK + (((size_t)((IT).b * 8 + (IT).h) * 8 + 2 * hw) * 8) * 512 + lane * 8; _Pragma("unroll") for (int kt = 0; kt < 2; ++kt) _Pragma("unroll") for (int kk = 0; kk < 8; ++kk) kf[kt][kk] = *(const bf16x8*)(kp_ + (size_t)(kt * 8 + kk) * 512); } while (0)
#define H2_LD_V(IT) do { const bf16* vp_ = XVT + (((size_t)((IT).b * 8 + (IT).h) * 4 + hw) * 16) * 512 + lane * 8; _Pragma("unroll") for (int kk = 0; kk < 16; ++kk) vf[kk] = *(const bf16x8*)(vp_ + (size_t)kk * 512); } while (0)
    H2_LD_K(cur);
    if (hf == 1) H2_BAR();
    AItem prv = cur; bool have_prev = false; int par = 0, es = 0;
    for (int k = 0; ; ++k) {
        { int t2_ = threadIdx.x; asm volatile("" : "+v"(t2_)); tid = t2_; lane = tid & 63; r = lane & 31; hh = lane >> 5; ht = tid & 255; }
        attn_step<OWN>(w, G, PRE); const AItem nx2 = attn_at<OWN>(w, PRE, GL, LIST);
        const int es1 = es == 2 ? 0 : es + 1, es2 = es1 == 2 ? 0 : es1 + 1;
        LAS float* PSUM = (LAS float*)(L + H2_PSUM) + (par * 2 + hf) * 256;
        if (!OWN) { const int tl = tid & 127; const bool in = tl < nx2.nrows; const int ev = nx2.list[in ? nx2.row0 + tl : 0]; e_n = in ? ev : -1; }
        {
            const LAS int* ENT1 = (const LAS int*)(L + H2_ENT) + es1 * 128;
#pragma unroll
            for (int j = 0; j < 4; ++j) { const int i = ht + 256 * j, rl = i >> 4, ch = i & 15; int t;
                if (OWN) t = nxt.row0 + 64 * hf + rl; else { const int e = ENT1[64 * hf + rl]; t = e >= 0 ? (e >> 2) : 0; }
                qn[j] = *(const GAS v4u*)(AQ + (size_t)t * 1024 + nxt.h * 128 + ch * 8); }
        }
        f32x16 S[2][2];
#pragma unroll
        for (int kt = 0; kt < 2; ++kt)
#pragma unroll
            for (int tq = 0; tq < 2; ++tq) {
#pragma unroll
                for (int i = 0; i < 16; ++i) S[kt][tq][i] = 0.f;
#pragma unroll
                for (int kk = 0; kk < 8; ++kk) { const bf16x8 bq = *(const LAS bf16x8*)(HB_ + H2_QS + (32 * tq + r) * 272 + (16 * kk + 8 * hh) * 2);
                    S[kt][tq] = __builtin_amdgcn_mfma_f32_32x32x16_bf16(kf[kt][kk], bq, S[kt][tq], 0, 0, 0); }
            }
        H2_LD_V(cur);
        H2_BAR();
#pragma unroll
        for (int tq = 0; tq < 2; ++tq) {
            const int t = 32 * tq + r; float ps = 0.f;
#pragma unroll
            for (int kt = 0; kt < 2; ++kt) {
#pragma unroll
                for (int i = 0; i < 16; ++i) {
                    float sv = S[kt][tq][i];
                    if (OWN) { const int key = 64 * hw + 32 * kt + (i & 3) + 8 * (i >> 2) + 4 * hh, lim = (cur.qi & 1) * 128 + 64 * hf + t; if (key > lim) sv = -INFINITY; }
                    const float p = __builtin_amdgcn_exp2f(sv); S[kt][tq][i] = p; ps += p; }
#pragma unroll
                for (int g = 0; g < 4; ++g) { pg8::u32x2 w2; w2.x = pg8::cvt_pk_bf16n(S[kt][tq][4 * g], S[kt][tq][4 * g + 1]); w2.y = pg8::cvt_pk_bf16n(S[kt][tq][4 * g + 2], S[kt][tq][4 * g + 3]);
                    *(LAS pg8::u32x2*)(HB_ + H2_PS + t * 528 + (64 * hw + 32 * kt + 8 * g + 4 * hh) * 2) = w2; }
            }
            ps += sh_xor(ps, 32, lane);
            if (hh == 0) PSUM[hw * 64 + t] = ps;
        }
        attn_store_rows<OWN>(L, hf, ht, par ^ 1, have_prev ? (es == 0 ? 2 : es - 1) : es, prv, PO, ML, AOUT, tmask, have_prev, dump);
        H2_BAR();
        H2_LD_K(nxt);
        f32x16 O[2];
#pragma unroll
        for (int i = 0; i < 16; ++i) { O[0][i] = 0.f; O[1][i] = 0.f; }
#pragma unroll
        for (int kk = 0; kk < 16; ++kk) {
            const bf16x8 a0 = *(const LAS bf16x8*)(HB_ + H2_PS + r * 528 + (16 * kk + 8 * hh) * 2), a1 = *(const LAS bf16x8*)(HB_ + H2_PS + (32 + r) * 528 + (16 * kk + 8 * hh) * 2);
            O[0] = __builtin_amdgcn_mfma_f32_32x32x16_bf16(a0, vf[kk], O[0], 0, 0, 0); O[1] = __builtin_amdgcn_mfma_f32_32x32x16_bf16(a1, vf[kk], O[1], 0, 0, 0);
        }
        H2_BAR();
#pragma unroll
        for (int tq = 0; tq < 2; ++tq)
#pragma unroll
            for (int i = 0; i < 16; ++i) *(LAS unsigned short*)(HB_ + H2_OS + (32 * tq + (i & 3) + 8 * (i >> 2) + 4 * hh) * 272 + (32 * hw + r) * 2) = (unsigned short)f2bf(O[tq][i]);
#pragma unroll
        for (int j = 0; j < 4; ++j) { const int i = ht + 256 * j, rl = i >> 4, ch = i & 15; *(LAS v4u*)(HB_ + H2_QS + rl * 272 + ch * 16) = qn[j]; }
        if (!OWN && nx2.valid && hf == 0 && tid < 128) ((LAS int*)(L + H2_ENT))[es2 * 128 + tid] = e_n;
        H2_BAR();
        prv = cur; have_prev = true; par ^= 1; es = es1;
        if (!nxt.valid) break;
        cur = nxt; nxt = nx2;
    }
    if (hf == 0) H2_BAR();
    { int t2_ = threadIdx.x; asm volatile("" : "+v"(t2_)); ht = t2_ & 255; }
    attn_store_rows<OWN>(L, hf, ht, par ^ 1, es == 0 ? 2 : es - 1, prv, PO, ML, AOUT, tmask, true, dump);
    LDS_WAIT(); __syncthreads();
#undef H2_LD_K
#undef H2_LD_V
}

enum { WK_IN = 0, WK_OUT, WK_KV, WK_Q, WK_O, WK_UP, WK_DN };
constexpr int I_IN = 16 * 96, I_SQ = 16 * 32, I_KV = 16 * 64, I_UP = 16 * 176, I_DN = 44 * 32;
#define AIN2(i) AIN(i)
#define WSB2 WSB
__device__ __forceinline__ void weight_item(int kind, int l, int r, LAS float* scr, int lane) {
    if (kind == WK_IN) { const int kb = r / 96, nb = r % 96, c0 = nb * 32;
        const float* W = AIN2(2) + (size_t)l * D * MIN_; const float* g = AIN2(1) + l * D;
        bf16* WR = (bf16*)(WSB2 + WS_WINR) + (size_t)l * 1536 * D; bf16* WTt = (bf16*)(WSB2 + WS_WINT) + (size_t)l * 1536 * D;
        if (c0 < 512) transpose_item(W, MIN_, kb * 64, c0, g, WR, D, c0, nullptr, 0, scr, lane);
        else if (c0 < 1024) transpose_item(W, MIN_, kb * 64, c0, g, WTt, D, c0 - 512, nullptr, 0, scr, lane);
        else if (c0 < 2048) transpose_item(W, MIN_, kb * 64, c0, g, WTt, D, 512 + c0 - 1024, nullptr, 0, scr, lane);
        else transpose_item(W, MIN_, kb * 64, c0, g, WR, D, 512 + c0 - 2048, nullptr, 0, scr, lane);
    } else if (kind == WK_OUT) { const int kb = r / 32, nb = r % 32;
        transpose_item(AIN2(5) + (size_t)l * D * D, D, kb * 64, nb * 32, nullptr, (bf16*)(WSB2 + WS_WOUT) + (size_t)l * D * D, D, nb * 32, nullptr, 0, scr, lane);
    } else if (kind == WK_KV) { const int kb = r / 64, nb = r % 64, c0 = nb * 32;
        if (c0 < 1024) transpose_item(AIN2(7), 2048, kb * 64, c0, AIN2(6), (bf16*)(WSB2 + WS_WK), D, c0, nullptr, 0, scr, lane);
        else transpose_item(AIN2(7), 2048, kb * 64, c0, AIN2(6), (bf16*)(WSB2 + WS_WV), D, c0 - 1024, nullptr, 0, scr, lane);
    } else if (kind == WK_Q) { const int kb = r / 32, nb = r % 32;
        transpose_item(AIN2(10) + (size_t)l * D * D, D, kb * 64, nb * 32, AIN2(9) + l * D, (bf16*)(WSB2 + WS_WQ) + (size_t)l * D * D, D, nb * 32, nullptr, 0, scr, lane);
    } else if (kind == WK_O) { const int kb = r / 32, nb = r % 32;
        transpose_item(AIN2(12) + (size_t)l * D * D, D, kb * 64, nb * 32, nullptr, (bf16*)(WSB2 + WS_WO) + (size_t)l * D * D, D, nb * 32, nullptr, 0, scr, lane);
    } else if (kind == WK_UP) { const int kb = r / 176, nb = r % 176, c0 = nb * 32;
        const int bj = c0 >= FF, cp = c0 - bj * FF, d0 = (cp / 128) * 256 + bj * 128 + (cp % 128);
        transpose_item(AIN2(14) + (size_t)l * D * FF2, FF2, kb * 64, c0, AIN2(13) + l * D, (bf16*)(WSB2 + WS_WUP) + (size_t)l * FF2 * D, D, d0, nullptr, 0, scr, lane);
    } else { const int kb = r / 32, nb = r % 32;
        transpose_item(AIN2(17) + (size_t)l * FF * D, D, kb * 64, nb * 32, nullptr, (bf16*)(WSB2 + WS_WDN) + (size_t)l * D * FF, FF, nb * 32, nullptr, 0, scr, lane); }
}
__device__ __forceinline__ void weight_set(int set, int widx, int nw, LAS float* scr, int lane) {
    if (set == 0) {
        for (int it = widx; it < I_IN; it += nw) weight_item(WK_IN, 0, it, scr, lane);
    } else if (set == 1) {
        constexpr int N = (I_SQ + I_UP + I_DN) + (I_IN + I_SQ + I_UP + I_DN);
        for (int it = widx; it < N; it += nw) { int r = it;
            if (r < I_SQ) { weight_item(WK_OUT, 0, r, scr, lane); continue; } r -= I_SQ;
            if (r < I_UP) { weight_item(WK_UP, 0, r, scr, lane); continue; } r -= I_UP;
            if (r < I_DN) { weight_item(WK_DN, 0, r, scr, lane); continue; } r -= I_DN;
            if (r < I_IN) { weight_item(WK_IN, 1, r, scr, lane); continue; } r -= I_IN;
            if (r < I_SQ) { weight_item(WK_OUT, 1, r, scr, lane); continue; } r -= I_SQ;
            if (r < I_UP) { weight_item(WK_UP, 1, r, scr, lane); continue; } r -= I_UP;
            weight_item(WK_DN, 1, r, scr, lane); }
    } else {
        constexpr int N = I_KV + 4 * I_SQ + 2 * I_UP + 2 * I_DN;
        for (int it = widx; it < N; it += nw) { int r = it;
            if (r < I_KV) { weight_item(WK_KV, 0, r, scr, lane); continue; } r -= I_KV;
            if (r < 2 * I_SQ) { weight_item(WK_Q, r / I_SQ, r % I_SQ, scr, lane); continue; } r -= 2 * I_SQ;
            if (r < 2 * I_SQ) { weight_item(WK_O, r / I_SQ, r % I_SQ, scr, lane); continue; } r -= 2 * I_SQ;
            if (r < 2 * I_UP) { weight_item(WK_UP, 2 + r / I_UP, r % I_UP, scr, lane); continue; } r -= 2 * I_UP;
            weight_item(WK_DN, 2 + r / I_DN, r % I_DN, scr, lane); }
    }
}

__global__ void __launch_bounds__(NWAVES * 64, 2) yoco_fwd(Args args) {
    extern __shared__ __attribute__((aligned(16))) unsigned char lds[];
    LAS unsigned char* L = (LAS unsigned char*)lds;
    volatile LAS unsigned* MISC = (volatile LAS unsigned*)(L + MISC_OFF);
    const int tid = threadIdx.x, lane = tid & 63, wave = __builtin_amdgcn_readfirstlane(tid >> 6);
    const int G = gridDim.x;
    for (int u = tid; u < (LDS_BYTES - RING_BYTES) / 4; u += NWAVES * 64) ((LAS unsigned*)(L + RING_BYTES))[u] = 0u;
    __syncthreads();
    (void)xcd_barrier_post((unsigned*)(WSB + WS_CTL) + CW_BAR, MISC + 8);
#define GRID_BAR() do { XcdBarrier b_; b_.bar = (unsigned*)(WSB + WS_CTL) + CW_BAR; b_.x = xb_xcc_id(); b_.st = (volatile LAS unsigned*)(L + MISC_OFF) + 8; xcd_barrier(b_); } while (0)

    for (int rp_ = 0; rp_ < REPS(1); ++rp_) {
        LAS float* scr = (LAS float*)(L + wave * 16384);
        const int gw = blockIdx.x * NWAVES + wave, NGW = G * NWAVES;
        weight_set(0, gw, NGW, scr, lane);
        { const int gt = blockIdx.x * (NWAVES * 64) + tid, NTH = G * NWAVES * 64;
          for (int i = gt; i < 2 * D * 8; i += NTH) { const int l = i / (D * 8), k = (i / 8) % D, j = i & 7;
              ((float*)(WSB + WS_WG))[i] = AIN(2)[(size_t)l * D * MIN_ + (size_t)k * MIN_ + 3072 + j] * AIN(1)[l * D + k]; } }
        { const int gt = blockIdx.x * (NWAVES * 64) + tid, NTH = G * NWAVES * 64; bf16* ON = (bf16*)(WSB + WS_ONES);
          for (int i = gt; i < 128; i += NTH) ON[128 * 1024 + i] = (bf16)0; }
        { const int gt = blockIdx.x * (NWAVES * 64) + tid, NTH = G * NWAVES * 64; float* RP = (float*)(WSB + WS_ROPE);
          for (int i = gt; i < T * 16; i += NTH) { const int pos = i >> 4, k = i & 15; const double inv = pow(500000.0, -(double)(2 * k) / 32.0), ang = (double)pos * inv;
              RP[i] = (float)cos(ang); RP[T * 16 + i] = (float)sin(ang); } }
        for (int m = gw; m < T; m += NGW) {
            const GAS f32x4* xr = (const GAS f32x4*)(XIN + (size_t)m * D) + lane; f32x4 v[4]; float s = 0.f;
#pragma unroll
            for (int j = 0; j < 4; ++j) { v[j] = xr[64 * j]; s += (v[j].x * v[j].x + v[j].y * v[j].y) + (v[j].z * v[j].z + v[j].w * v[j].w); }
            s = wave_sum(s, lane);
            GAS unsigned long long* o8 = (GAS unsigned long long*)(HB + (size_t)m * D) + lane;
#pragma unroll
            for (int j = 0; j < 4; ++j) o8[64 * j] = (unsigned long long)pk2(v[j].x, v[j].y) | ((unsigned long long)pk2(v[j].z, v[j].w) << 32);
            if (lane == 0) *(f32x4*)(SS + (size_t)m * 4) = (f32x4){s, 0.f, 0.f, 0.f};
        }
        { const int gt = blockIdx.x * (NWAVES * 64) + tid, NTH = G * NWAVES * 64;
          for (int i = gt; i < 2 * 1024 / 8; i += NTH) ((GAS v4u*)HBP)[i] = (v4u){0u, 0u, 0u, 0u};
          for (int i = gt; i < 128 * 1024 / 8; i += NTH) ((GAS v4u*)(HB + (size_t)T * D))[i] = (v4u){0u, 0u, 0u, 0u}; }
    GRID_BAR();
    }
    if (DUP == 8) { for (int rp_ = 0; rp_ < 8; ++rp_) GRID_BAR(); }

#define GRIDN() ({ int g_ = gridDim.x; asm volatile("" : "+s"(g_)); g_; })
#define BLK() ({ int b_ = blockIdx.x; asm volatile("" : "+s"(b_)); b_; })
    LAS unsigned char* ring = L; LAS unsigned char* el = L + EPI_OFF;
#pragma unroll
    for (int l = 0; l < 4; ++l) {
#if MIXERS
        if (l < 2) {
            bf16* MQ = (bf16*)(WSB + WS_MQ); bf16* MK = (bf16*)(WSB + WS_MK); bf16* OGB = (bf16*)(WSB + WS_OG); bf16* KVT = (bf16*)(WSB + WS_KVT);
            bf16* CT = (bf16*)(WSB + WS_CT); bf16* HG = (bf16*)(WSB + WS_HG);
            float* BCUM = (float*)(WSB + WS_BCUM); float* IG = (float*)(WSB + WS_IG); float* WGT = (float*)(WSB + WS_WGT); float* DECAY = (float*)(WSB + WS_DECAY); bf16* NCT = (bf16*)(WSB + WS_NCT); bf16* WROW = (bf16*)(WSB + WS_ONES); const bf16* ZROW = (const bf16*)(WSB + WS_ONES + 256 * 1024);
            const float* ssm = SS + (size_t)((2 * l) & 3) * T * 4;
            for (int rp_ = 0; rp_ < REPS(2); ++rp_) {
            for (int c = BLK(); c < 256; c += GRIDN())
                mlstm_gates_item(L, c, HB, (const float*)(WSB + WS_WG) + (size_t)l * D * 8, ssm, AIN(3) + l * 8, BCUM, IG, WGT, DECAY, WROW);
            GRID_BAR();
            {
                pg8::Gemm g{HB, (const bf16*)(WSB + WS_WINR) + (size_t)l * 1536 * D, T, 1536, D, 256};
                pg8::StaticOrder S; S.init(T, 1536, GRIDN(), BLK());
                pg8::EpiIn E{MQ, MK, OGB, ssm};
                pg8::gemm_phase<pg8::EpiIn, pg8::StaticOrder, true, true>(ring, el, g, S, E);
            }
            {
                pg8::Gemm g{(const bf16*)(WSB + WS_WINT) + (size_t)l * 1536 * D, HB, 1536, T, D, 256};
                pg8::StaticOrder S; S.init(1536, T, GRIDN(), BLK());
                pg8::EpiInT E{KVT, ssm, 1536, 64, WGT};
                pg8::gemm_phase<pg8::EpiInT, pg8::StaticOrder, true, true>(ring, el, g, S, E);
            }
            GRID_BAR();
            }
            for (int rp_ = 0; rp_ < REPS(3); ++rp_) {
            { int t4 = threadIdx.x; asm volatile("" : "+v"(t4)); const int wv4 = __builtin_amdgcn_readfirstlane(t4 >> 6);
              if (wv4 >= 3 && rp_ == 0) weight_set(l + 1, BLK() * 5 + (wv4 - 3), GRIDN() * 5, (LAS float*)(L + (wv4 - 3) * 16384), t4 & 63); }
            mlstm_scan(KVT, DECAY, CT, NCT, WROW, ZROW, GRIDN());
            GRID_BAR();
            }
            if (DUP == 13) { mlstm_scan(KVT, DECAY, HG, HG, WROW, ZROW, GRIDN(), true); GRID_BAR(); }
            for (int rp_ = 0; rp_ < REPS(4); ++rp_) {
            mlstm_out_phase(L, GRIDN(), MQ, MK, KVT, CT, NCT, BCUM, WGT, OGB, AIN(4) + l * D, HG);
            GRID_BAR();
            }
            for (int rp_ = 0; rp_ < REPS(10); ++rp_) {
                const bool dummy = (DUP == 10) && rp_ == 0;
                pg8::Gemm g{HG, (const bf16*)(WSB + WS_WOUT) + (size_t)l * D * D, T, D, D, 256};
                pg8::StaticOrder S; S.init(T, D, GRIDN(), BLK());
                pg8::EpiRes E{HB, SS + (size_t)((2 * l + 1) & 3) * T * 4, nullptr}; (void)dummy;
                pg8::gemm_phase<pg8::EpiRes, pg8::StaticOrder, true, true>(ring, el, g, S, E);
                if (dummy) GRID_BAR();
            }
            if (0) {
                pg8::Gemm g{HG, (const bf16*)(WSB + WS_WOUT) + (size_t)l * D * D, T, D, D, 256};
                pg8::StaticOrder S; S.init(T, D, GRIDN(), BLK());
                pg8::EpiRes E{HB, SS + (size_t)((2 * l + 1) & 3) * T * 4, nullptr};
                pg8::gemm_phase<pg8::EpiRes, pg8::StaticOrder, true, true>(ring, el, g, S, E);
            }
            GRID_BAR();
        }
#if MIXERS >= 2
        else {
            const int j = l - 2;
            bf16* XK = (bf16*)(WSB + WS_XK); bf16* XVT = (bf16*)(WSB + WS_XVT); bf16* AQ = (bf16*)(WSB + WS_AQ); bf16* PO = (bf16*)(WSB + WS_PO);
            float* KMEAN = (float*)(WSB + WS_KMEAN); float* ML = (float*)(WSB + WS_ML); int* LIST = (int*)(WSB + WS_LIST); int* gcnt = (int*)(WSB + WS_GCNT) + j * 512;
            const float* ssm = SS + (size_t)((2 * l) & 3) * T * 4; const float* RP = (const float*)(WSB + WS_ROPE);
            for (int rp_ = 0; rp_ < REPS(5); ++rp_) {
            if (l == 2) {
                { pg8::Gemm g{HB, (const bf16*)(WSB + WS_WK), T, D, D, 256}; pg8::StaticOrder S; S.init(T, D, GRIDN(), BLK());
                  pg8::EpiQK E{XK, ssm, AIN(8), RP, KMEAN, 1.0f, 1};
                  pg8::gemm_phase<pg8::EpiQK, pg8::StaticOrder, true, true>(ring, el, g, S, E); }
                { pg8::Gemm g{(const bf16*)(WSB + WS_WV), HB, D, T, D, 256}; pg8::StaticOrder S; S.init(D, T, GRIDN(), BLK());
                  pg8::EpiInT E{XVT, ssm, 1024, 0, nullptr};
                  pg8::gemm_phase<pg8::EpiInT, pg8::StaticOrder, true, true>(ring, el, g, S, E); }
            }
            { pg8::Gemm g{HB, (const bf16*)(WSB + WS_WQ) + (size_t)j * D * D, T, D, D, 256}; pg8::StaticOrder S; S.init(T, D, GRIDN(), BLK());
              pg8::EpiQK E{AQ, ssm, AIN(11) + j * 128, RP, nullptr, 0.08838834764831845f * 1.4426950408889634f, 0};
              pg8::gemm_phase<pg8::EpiQK, pg8::StaticOrder, true, true>(ring, el, g, S, E); }
            GRID_BAR();
            }
            for (int rp_ = 0; rp_ < REPS(11); ++rp_) {
            const bool dummy = (DUP == 11) && rp_ == 0;
            moba_gate_phase(L, GRIDN(), AQ, KMEAN, dummy ? gcnt + 2048 : gcnt, dummy ? (int*)(WSB + WS_WINR) : LIST);
            GRID_BAR();
            }
            for (int rp_ = 0; rp_ < REPS(6); ++rp_) {
            attn_phase2<false>(L, GRIDN(), gcnt, LIST, AQ, XK, XVT, PO, ML, nullptr, 0, WSB + WS_DUMP);
            GRID_BAR();
            }
            for (int rp_ = 0; rp_ < REPS(12); ++rp_) {
            const bool dummy = (DUP == 12) && rp_ == 0;
            attn_phase2<true>(L, GRIDN(), gcnt, LIST, AQ, XK, XVT, PO, ML, dummy ? HB : AQ, dummy ? 8191 : 0x7fffffff, WSB + WS_DUMP);
            GRID_BAR();
            }
            { int t2 = threadIdx.x; asm volatile("" : "+v"(t2)); const int gt = BLK() * (NWAVES * 64) + t2, NTH = GRIDN() * NWAVES * 64;
              unsigned zu = 0u; asm volatile("" : "+v"(zu));
              for (int i = gt; i < 128 * 1024 / 8; i += NTH) ((GAS v4u*)(HB + (size_t)T * D))[i] = (v4u){zu, zu, zu, zu}; }
            { pg8::Gemm g{AQ, (const bf16*)(WSB + WS_WO) + (size_t)j * D * D, T, D, D, 256}; pg8::StaticOrder S; S.init(T, D, GRIDN(), BLK());
              pg8::EpiRes E{HB, SS + (size_t)((2 * l + 1) & 3) * T * 4, nullptr};
              pg8::gemm_phase<pg8::EpiRes, pg8::StaticOrder, true, true>(ring, el, g, S, E); }
            GRID_BAR();
        }
#endif
#endif
        const bool mix_on = (MIXERS >= 2) || (MIXERS == 1 && l < 2);
        const int ssf = mix_on ? 2 * l + 1 : 2 * l;
#ifndef SKIP_UP
        for (int rp_ = 0; rp_ < REPS(7); ++rp_) {
            pg8::Gemm g{HBP, (const bf16*)(WSB + WS_WUP) + (size_t)l * FF2 * D, 65 * 256, FF2, D, 254};
            pg8::StaticOrder S; S.init(65 * 256, FF2, GRIDN(), BLK());
            pg8::EpiConv E{ACT, SS + (size_t)(ssf & 3) * T * 4, AIN(15) + (size_t)l * 3 * FF2, AIN(16) + (size_t)l * FF2};
            pg8::gemm_phase<pg8::EpiConv, pg8::StaticOrder, true, true>(ring, el, g, S, E);
            GRID_BAR();
        }
#endif
#ifndef SKIP_DN
        for (int rp_ = 0; rp_ < REPS(9); ++rp_) {
            const bool dummy = (DUP == 9) && rp_ == 0;
            pg8::Gemm g{ACT, (const bf16*)(WSB + WS_WDN) + (size_t)l * D * FF, T, D, FF, 256};
            pg8::StaticOrder S; S.init(T, D, GRIDN(), BLK());
            pg8::EpiRes E{HB, (l < 3) ? SS + (size_t)((2 * l + 2) & 3) * T * 4 : nullptr, (l == 3) ? OUTP : nullptr}; (void)dummy;
            pg8::gemm_phase<pg8::EpiRes, pg8::StaticOrder, true, true>(ring, el, g, S, E);
            GRID_BAR();
        }
#endif
    }
    { int t3 = threadIdx.x; asm volatile("" : "+v"(t3)); if (BLK() == 0 && t3 == 0) if (xb_ld((unsigned*)(WSB + WS_CTL) + CW_BAR + XB_TMO)) OUTP[0] = 1.0e6f; }
}

#undef WSB
#undef XIN
#undef OUTP
#undef SS
#undef HBP
#undef HB
#undef ACT
extern "C" void kernel_launch(void* const* d_in, const int* in_sizes, int n_in, void* d_out, int out_size, void* d_ws, size_t ws_size, hipStream_t stream) {
    static int grid = 0;
    if (grid == 0) {
        int dev = 0, cus = 0;
        if (n_in != 18 || out_size != T * D || ws_size < WS_END) { fprintf(stderr, "kernel_launch: unexpected problem geometry (n_in %d out %d ws %zu)\n", n_in, out_size, ws_size); grid = -1; return; }
        if (hipGetDevice(&dev) != hipSuccess || hipDeviceGetAttribute(&cus, hipDeviceAttributeMultiprocessorCount, dev) != hipSuccess) { grid = -1; return; }
        if (hipFuncSetAttribute((const void*)yoco_fwd, hipFuncAttributeMaxDynamicSharedMemorySize, LDS_BYTES) != hipSuccess) { fprintf(stderr, "hipFuncSetAttribute failed\n"); grid = -1; return; }
        (void)hipGetLastError();
        grid = cus;
    }
    if (grid < 0) return;
    (void)hipMemsetAsync((char*)d_ws + WS_CTL, 0, CTL_ZERO_BYTES, stream);
    Args a{};
    for (int i = 0; i < 18; ++i) a.in[i] = (const float*)d_in[i];
    a.out = (float*)d_out; a.ws = (unsigned char*)d_ws; a.ws_size = (unsigned long long)ws_size;
    hipLaunchKernelGGL(yoco_fwd, dim3(grid), dim3(NWAVES * 64), LDS_BYTES, stream, a);
}
```

```cpp
#include <hip/hip_runtime.h>
#include <cstdio>
#include <cstdint>

#define MIXERS 2
#define DUP 0
#define REPS(k) ((DUP) == (k) ? 2 : 1)
#ifndef PROBE
#define PROBE 0
#endif

namespace pg8 {
#define PG8_LAS __attribute__((address_space(3)))
typedef unsigned short bf16_t;
typedef short bf16x8 __attribute__((ext_vector_type(8)));
typedef float f32x4 __attribute__((ext_vector_type(4)));
typedef unsigned u32x4 __attribute__((ext_vector_type(4)));
typedef unsigned u32x2 __attribute__((ext_vector_type(2)));
constexpr int BM = 256, BK = 64, HALF = 128, HTB = HALF * BK * 2, STAGE_BYTES = 8 * HTB, NXCD = 8, WGM = 8;

__host__ __device__ __forceinline__ int lds_byte(int r, int c) { const int st = (r >> 4) * 2 + (c >> 5), rr = r & 15, cc = c & 31, ob = rr * 64 + cc * 2; return st * 1024 + (ob ^ (((ob >> 9) & 1) << 5)); }
__host__ __device__ __forceinline__ void stage_rc(int b, int& R, int& C) { const int st = b / 1024, sb = b % 1024, swz = sb ^ (((sb >> 9) & 1) << 5); R = (st >> 1) * 16 + swz / 64; C = (st & 1) * 32 + (swz % 64) / 2; }
__host__ __device__ __forceinline__ int perm32(int rho) { const int n = rho >> 4, i = rho & 15; return 8 * (i >> 2) + 4 * n + (i & 3); }

struct Unit { int pm, pn; };
struct Gemm { const bf16_t* A; const bf16_t* Bt; int M, N, K, a_rows; };

struct StaticOrder {
    int nM, nN, nwg, G, c;
    __host__ __device__ void init(int M, int N, int G_, int c_) { nM = M / BM; nN = N / BM; nwg = nM * nN; G = G_; c = c_; }
    __host__ __device__ bool next(int i, Unit& u) const {
        const long L = (long)i * G + c; if (L >= nwg) return false;
        int wgid = (int)L; { const int q = nwg / NXCD, r = nwg % NXCD, xcd = wgid % NXCD, off = wgid / NXCD; wgid = (xcd < r ? xcd * (q + 1) : r * (q + 1) + (xcd - r) * q) + off; }
        const int nig = WGM * nN, gid = wgid / nig, fm = gid * WGM, gsz = (nM - fm) < WGM ? (nM - fm) : WGM;
        u.pm = fm + ((wgid % nig) % gsz); u.pn = (wgid % nig) / gsz; return true;
    }
    __device__ __forceinline__ void a_ready(const Unit&) const {}
    __device__ __forceinline__ void done(const Unit&) const {}
};

__device__ __forceinline__ float sh_idx(float v, int src) { return __builtin_bit_cast(float, __builtin_amdgcn_ds_bpermute(src << 2, __builtin_bit_cast(int, v))); }
__device__ __forceinline__ float sh_xor(float v, int o, int lane) { return sh_idx(v, lane ^ o); }
template <int CTRL, int ROWMASK = 0xf> __device__ __forceinline__ float dpp_add(float v) { return v + __builtin_bit_cast(float, __builtin_amdgcn_update_dpp(0, __builtin_bit_cast(int, v), CTRL, ROWMASK, 0xf, true)); }
__device__ __forceinline__ float half_sum_hi(float v) { v = dpp_add<0xB1>(v); v = dpp_add<0x4E>(v); v = dpp_add<0x141>(v); v = dpp_add<0x140>(v); return dpp_add<0x142, 0xA>(v); }
__device__ __forceinline__ float oct_sum(float v) { v = dpp_add<0xB1>(v); v = dpp_add<0x4E>(v); return dpp_add<0x141>(v); }
typedef float f32x2n __attribute__((ext_vector_type(2)));
typedef __bf16 bf16x2n __attribute__((ext_vector_type(2)));
__device__ __forceinline__ unsigned cvt_pk_bf16n(float lo, float hi) { unsigned r; asm volatile("s_nop 0\n\tv_cvt_pk_bf16_f32 %0, %1, %2" : "=v"(r) : "v"(lo), "v"(hi)); return r; }
__device__ __forceinline__ unsigned cvt_pk_bf16(float lo, float hi) { unsigned r; asm volatile("v_cvt_pk_bf16_f32 %0, %1, %2" : "=v"(r) : "v"(lo), "v"(hi)); return r; }
__device__ __forceinline__ float rstd4(const float* ss4, int row) { const f32x4 p = *(const f32x4*)(ss4 + (size_t)row * 4); return rsqrtf(((p[0] + p[1]) + (p[2] + p[3])) * (1.0f / 1024.0f) + 1e-6f); }
#define EPI_BAR() do { asm volatile("s_waitcnt lgkmcnt(0)" ::: "memory"); __builtin_amdgcn_s_barrier(); asm volatile("" ::: "memory"); } while (0)

constexpr int TT = 16384, DD = 1024;
constexpr float NEPS = 1e-6f;

struct EpiRes {
    static constexpr bool PERM = true; static constexpr int RSMODE = 0;
    bf16_t* hb; float* ss; float* fout;
    __device__ __forceinline__ void operator()(f32x4 (&acc)[2][2][4][2], const Unit& u, int wr, int wc, int fr_, int fq_, PG8_LAS unsigned char* el, int wid, int lane_, const PG8_LAS float* rsu) const {
        int ln_ = lane_; asm volatile("" : "+v"(ln_)); const int lane = ln_, fr = ln_ & 15, fq = ln_ >> 4; (void)fr_; (void)fq_;
        u32x4 pre[2][4][2];
#pragma unroll
        for (int ai = 0; ai < 2; ++ai)
#pragma unroll
            for (int m = 0; m < 4; ++m)
#pragma unroll
                for (int bj = 0; bj < 2; ++bj) pre[ai][m][bj] = *(const u32x4*)(hb + (size_t)(u.pm * BM + ai * HALF + wr * 64 + m * 16 + fr) * DD + u.pn * BM + bj * HALF + wc * 32 + 8 * fq);
#pragma unroll
        for (int ai = 0; ai < 2; ++ai)
#pragma unroll
            for (int m = 0; m < 4; ++m) {
                const int row = u.pm * BM + ai * HALF + wr * 64 + m * 16 + fr; float s = 0.f;
#pragma unroll
                for (int bj = 0; bj < 2; ++bj) {
                    const size_t off = (size_t)row * DD + u.pn * BM + bj * HALF + wc * 32 + 8 * fq;
                    const u32x4 p = pre[ai][m][bj];
                    f32x4 v0 = acc[ai][bj][m][0], v1 = acc[ai][bj][m][1];
                    v0[0] += __builtin_bit_cast(float, p[0] << 16); v0[1] += __builtin_bit_cast(float, p[0] & 0xffff0000u); v0[2] += __builtin_bit_cast(float, p[1] << 16); v0[3] += __builtin_bit_cast(float, p[1] & 0xffff0000u);
                    v1[0] += __builtin_bit_cast(float, p[2] << 16); v1[1] += __builtin_bit_cast(float, p[2] & 0xffff0000u); v1[2] += __builtin_bit_cast(float, p[3] << 16); v1[3] += __builtin_bit_cast(float, p[3] & 0xffff0000u);
                    if (fout) { *(f32x4*)(fout + off) = v0; *(f32x4*)(fout + off + 4) = v1; }
                    u32x4 w; w.x = cvt_pk_bf16(v0[0], v0[1]); w.y = cvt_pk_bf16(v0[2], v0[3]); w.z = cvt_pk_bf16(v1[0], v1[1]); w.w = cvt_pk_bf16(v1[2], v1[3]);
                    *(u32x4*)(hb + off) = w;
                    s += (v0[0] * v0[0] + v0[1] * v0[1]) + (v0[2] * v0[2] + v0[3] * v0[3]) + (v1[0] * v1[0] + v1[1] * v1[1]) + (v1[2] * v1[2] + v1[3] * v1[3]);
                }
                s += sh_xor(s, 16, lane); s += sh_xor(s, 32, lane);
                if (fq == 0) ((PG8_LAS float*)el)[(ai * HALF + wr * 64 + m * 16 + fr) * 4 + wc] = s;
            }
        EPI_BAR();
        { const int tid2 = wid * 64 + lane;
          if (ss && tid2 < 256) { const f32x4 p = *(const PG8_LAS f32x4*)((PG8_LAS float*)el + tid2 * 4); ss[(size_t)(u.pm * BM + tid2) * 4 + u.pn] = (p[0] + p[1]) + (p[2] + p[3]); } }
        EPI_BAR();
    }
};

struct EpiConv {
    static constexpr bool PERM = true; static constexpr int RSMODE = 1; static constexpr int tmax = 16384; __device__ __forceinline__ int tok0(const Unit& u) const { return u.pm * 254 - 2; }
    bf16_t* act; const float* ss; const float* cw; const float* cb;
    static __device__ __forceinline__ float ror1(float v) { return __builtin_bit_cast(float, __builtin_amdgcn_update_dpp(0, __builtin_bit_cast(int, v), 0x121, 0xf, 0xf, false)); }
    static __device__ __forceinline__ float ror2(float v) { return __builtin_bit_cast(float, __builtin_amdgcn_update_dpp(0, __builtin_bit_cast(int, v), 0x122, 0xf, 0xf, false)); }
    __device__ __forceinline__ void operator()(f32x4 (&acc)[2][2][4][2], const Unit& u, int wr, int wc, int fr_, int fq_, PG8_LAS unsigned char* el, int wid, int lane_, const PG8_LAS float* rsu) const {
        int ln_ = lane_; asm volatile("" : "+v"(ln_)); const int lane = ln_, fr = ln_ & 15, fq = ln_ >> 4; (void)lane; (void)fr_; (void)fq_;
        const int t0 = u.pm * 254 - 2;
        const int cl = wc * 32 + 8 * fq;
        float rs[2][4]; f32x4 cp[2][2][4];
#pragma unroll
        for (int ai = 0; ai < 2; ++ai)
#pragma unroll
            for (int m = 0; m < 4; ++m) rs[ai][m] = rsu[ai * HALF + wr * 64 + m * 16 + fr];
#pragma unroll
        for (int n = 0; n < 2; ++n)
#pragma unroll
            for (int bj = 0; bj < 2; ++bj) { const int scol = (bj ? 2816 : 0) + u.pn * HALF + cl + 4 * n;
                cp[n][bj][0] = *(const f32x4*)(cw + scol); cp[n][bj][1] = *(const f32x4*)(cw + 5632 + scol); cp[n][bj][2] = *(const f32x4*)(cw + 2 * 5632 + scol); cp[n][bj][3] = *(const f32x4*)(cb + scol); }
#pragma unroll
        for (int ai = 0; ai < 2; ++ai)
#pragma unroll
            for (int m = 0; m < 4; ++m)
#pragma unroll
                for (int bj = 0; bj < 2; ++bj)
#pragma unroll
                    for (int n = 0; n < 2; ++n) acc[ai][bj][m][n] = acc[ai][bj][m][n] * rs[ai][m];
        PG8_LAS float* X = (PG8_LAS float*)el;
#pragma unroll
        for (int ai = 0; ai < 2; ++ai) { const int B = 2 * ai + wr;
            if (B < 3 && fr >= 14) {
#pragma unroll
                for (int bj = 0; bj < 2; ++bj)
#pragma unroll
                    for (int n = 0; n < 2; ++n) *(PG8_LAS f32x4*)(X + (B * 2 + (fr - 14)) * 256 + bj * HALF + cl + 4 * n) = acc[ai][bj][3][n];
            } }
        EPI_BAR();
#pragma unroll
        for (int n = 0; n < 2; ++n) {
#pragma unroll
            for (int bj = 0; bj < 2; ++bj) {
                const f32x4 w0 = cp[n][bj][0], w1 = cp[n][bj][1], w2 = cp[n][bj][2], bb = cp[n][bj][3];
#pragma unroll
                for (int ai = 0; ai < 2; ++ai) {
                    const int B = 2 * ai + wr;
                    f32x4 p1 = (f32x4){0.f, 0.f, 0.f, 0.f}, p2 = p1;
                    if (B > 0) { const f32x4 e0 = *(const PG8_LAS f32x4*)(X + ((B - 1) * 2 + 0) * 256 + bj * HALF + cl + 4 * n), e1 = *(const PG8_LAS f32x4*)(X + ((B - 1) * 2 + 1) * 256 + bj * HALF + cl + 4 * n);
                        p1 = e1; p2 = (fr == 0) ? e0 : e1; }
#pragma unroll
                    for (int m = 0; m < 4; ++m) {
                        f32x4 cur = acc[ai][bj][m][n]; f32x4 s1, s2;
                        asm volatile("" : "+v"(cur));
#pragma unroll
                        for (int i = 0; i < 4; ++i) { s1[i] = ror1(cur[i]); s2[i] = ror2(cur[i]); }
                        const f32x4 q1 = (fr >= 1) ? s1 : p1, q2 = (fr >= 2) ? s2 : p2;
                        f32x4 res = bb + w0 * q2 + w1 * q1 + w2 * cur;
                        asm volatile("" : "+v"(res), "+v"(s1), "+v"(s2));
                        acc[ai][bj][m][n] = res;
                        p1 = s1; p2 = s2;
                    }
                }
            }
        }
#pragma unroll
        for (int ai = 0; ai < 2; ++ai)
#pragma unroll
            for (int m = 0; m < 4; ++m) {
                const int r = ai * HALF + wr * 64 + m * 16 + fr, t = t0 + r;
                u32x4 w; float a[8];
#pragma unroll
                for (int n = 0; n < 2; ++n)
#pragma unroll
                    for (int i = 0; i < 4; ++i) { const float v = acc[ai][0][m][n][i], g = acc[ai][1][m][n][i]; a[4 * n + i] = v * g * __builtin_amdgcn_rcpf(1.0f + __builtin_amdgcn_exp2f(-1.4426950408889634f * g)); }
                w.x = cvt_pk_bf16(a[0], a[1]); w.y = cvt_pk_bf16(a[2], a[3]); w.z = cvt_pk_bf16(a[4], a[5]); w.w = cvt_pk_bf16(a[6], a[7]);
                if (r >= 2 && t < TT) *(u32x4*)(act + (size_t)t * 2816 + u.pn * HALF + cl) = w;
            }
        EPI_BAR();
    }
};


struct EpiIn {
    static constexpr bool PERM = true; static constexpr int RSMODE = 1; static constexpr int tmax = 16384; __device__ __forceinline__ int tok0(const Unit& u) const { return u.pm * 256; }
    bf16_t* q; bf16_t* k; bf16_t* og; const float* ss;
    __device__ __forceinline__ void operator()(f32x4 (&acc)[2][2][4][2], const Unit& u, int wr, int wc, int fr_, int fq_, PG8_LAS unsigned char* el, int wid, int lane_, const PG8_LAS float* rsu) const {
        int ln_ = lane_; asm volatile("" : "+v"(ln_)); const int lane = ln_, fr = ln_ & 15, fq = ln_ >> 4; (void)lane; (void)fr_; (void)fq_;
        bf16_t* dst; int ldc, c0; float sc;
        if (u.pn < 2) { dst = q; ldc = 512; c0 = 256 * u.pn; sc = 0.08838834764831845f; }
        else { dst = og; ldc = 1024; c0 = 256 * (u.pn - 2); sc = 1.f; }
#pragma unroll
        for (int ai = 0; ai < 2; ++ai)
#pragma unroll
            for (int m = 0; m < 4; ++m) {
                const int row = u.pm * BM + ai * HALF + wr * 64 + m * 16 + fr;
                const float rs = rsu[ai * HALF + wr * 64 + m * 16 + fr] * sc;
#pragma unroll
                for (int bj = 0; bj < 2; ++bj) {
                    const f32x4 v0 = acc[ai][bj][m][0] * rs, v1 = acc[ai][bj][m][1] * rs;
                    u32x4 w; w.x = cvt_pk_bf16(v0[0], v0[1]); w.y = cvt_pk_bf16(v0[2], v0[3]); w.z = cvt_pk_bf16(v1[0], v1[1]); w.w = cvt_pk_bf16(v1[2], v1[3]);
                    *(u32x4*)(dst + (size_t)row * ldc + c0 + bj * HALF + wc * 32 + 8 * fq) = w;
                }
            }
    }
};
struct EpiInT {
    static constexpr bool PERM = true; static constexpr int RSMODE = 2; static constexpr int tmax = 16384; __device__ __forceinline__ int tok0(const Unit& u) const { return u.pn * 256; }
    bf16_t* o; const float* ss; int nrows, ch; const float* wgt;
    __device__ __forceinline__ void operator()(f32x4 (&acc)[2][2][4][2], const Unit& u, int wr, int wc, int fr_, int fq_, PG8_LAS unsigned char* el, int wid, int lane_, const PG8_LAS float* rsu) const {
        int ln_ = lane_; asm volatile("" : "+v"(ln_)); const int lane = ln_, fr = ln_ & 15, fq = ln_ >> 4; (void)lane; (void)fr_; (void)fq_;
#pragma unroll
        for (int bj = 0; bj < 2; ++bj) {
            const int t = u.pn * BM + bj * HALF + wc * 32 + 8 * fq;
            f32x4 r0 = *(const PG8_LAS f32x4*)(rsu + bj * HALF + wc * 32 + 8 * fq), r1 = *(const PG8_LAS f32x4*)(rsu + bj * HALF + wc * 32 + 8 * fq + 4);
            if (wgt && u.pm >= 2) { const float* wp = wgt + (size_t)(u.pm - 2) * TT + t; r0 = r0 * *(const f32x4*)wp; r1 = r1 * *(const f32x4*)(wp + 4); }
#pragma unroll
            for (int ai = 0; ai < 2; ++ai)
#pragma unroll
                for (int m = 0; m < 4; ++m) {
                    const int row = u.pm * BM + ai * HALF + wr * 64 + m * 16 + fr;
                    const f32x4 v0 = acc[ai][bj][m][0] * r0, v1 = acc[ai][bj][m][1] * r1;
                    u32x4 w; w.x = cvt_pk_bf16(v0[0], v0[1]); w.y = cvt_pk_bf16(v0[2], v0[3]); w.z = cvt_pk_bf16(v1[0], v1[1]); w.w = cvt_pk_bf16(v1[2], v1[3]);
                    if (ch) {
                        *(u32x4*)(o + ((((size_t)(t >> 6) * 96 + (row >> 4)) * 2 + ((t >> 5) & 1)) * 512 + (((t >> 3) & 3) * 16 + (row & 15)) * 8)) = w; }
                    else {
                        const int kb = t >> 8, key = t & 255;
                        *(u32x4*)(o + ((((size_t)(kb * 8 + (row >> 7)) * 4 + ((row >> 5) & 3)) * 16 + (key >> 4)) * 512 + (((key >> 3) & 1) * 32 + (row & 31)) * 8)) = w; }
                }
        }
    }
};


struct EpiQK {
    static constexpr bool PERM = false; static constexpr int RSMODE = 1; static constexpr int tmax = 16384; __device__ __forceinline__ int tok0(const Unit& u) const { return u.pm * 256; }
    bf16_t* o; const float* ss; const float* gain; const float* rope; float* kmean; float oscale; int kfrag;
    __device__ __forceinline__ void operator()(f32x4 (&acc)[2][2][4][2], const Unit& u, int wr, int wc, int fr_, int fq_, PG8_LAS unsigned char* el, int wid, int lane_, const PG8_LAS float* rsu) const {
        int ln_ = lane_; asm volatile("" : "+v"(ln_)); const int lane = ln_, fr = ln_ & 15, fq = ln_ >> 4; (void)lane; (void)fr_; (void)fq_;
        PG8_LAS float* P = (PG8_LAS float*)el;
        PG8_LAS float* KS = (PG8_LAS float*)(el + 8192);
#pragma unroll
        for (int ai = 0; ai < 2; ++ai)
#pragma unroll
            for (int m = 0; m < 4; ++m) {
                const int rl = ai * HALF + wr * 64 + m * 16 + fr;
                const float rs = rsu[rl];
#pragma unroll
                for (int bj = 0; bj < 2; ++bj) {
                    const f32x4 x0 = acc[ai][bj][m][0] * rs, x1 = acc[ai][bj][m][1] * rs;
                    acc[ai][bj][m][0] = x0; acc[ai][bj][m][1] = x1;
                    float s = (x0[0] * x0[0] + x0[1] * x0[1]) + (x0[2] * x0[2] + x0[3] * x0[3]) + (x1[0] * x1[0] + x1[1] * x1[1]) + (x1[2] * x1[2] + x1[3] * x1[3]);
                    s += sh_xor(s, 16, lane); s += sh_xor(s, 32, lane);
                    if (fq == 0) P[(rl * 2 + bj) * 4 + wc] = s;
                }
            }
        EPI_BAR();
#pragma unroll
        for (int bj = 0; bj < 2; ++bj) {
            const f32x4 g0 = *(const f32x4*)(gain + 32 * wc + 4 * fq), g1 = *(const f32x4*)(gain + 32 * wc + 16 + 4 * fq);
            f32x4 cs0 = (f32x4){0.f, 0.f, 0.f, 0.f}, cs1 = cs0;
            const int head = 2 * u.pn + bj;
#pragma unroll
            for (int ai = 0; ai < 2; ++ai)
#pragma unroll
                for (int m = 0; m < 4; ++m) {
                    const int rl = ai * HALF + wr * 64 + m * 16 + fr, row = u.pm * BM + rl;
                    const f32x4 p = *(const PG8_LAS f32x4*)(P + (rl * 2 + bj) * 4);
                    const float rn = rsqrtf(((p[0] + p[1]) + (p[2] + p[3])) * (1.0f / 128.0f) + NEPS);
                    f32x4 y0 = acc[ai][bj][m][0] * rn * g0, y1 = acc[ai][bj][m][1] * rn * g1;
                    if (wc == 0) { const f32x4 c = *(const f32x4*)(rope + (size_t)row * 16 + 4 * fq), sn = *(const f32x4*)(rope + (size_t)TT * 16 + (size_t)row * 16 + 4 * fq);
                        const f32x4 t0 = y0 * c - y1 * sn, t1 = y1 * c + y0 * sn; y0 = t0; y1 = t1; }
                    cs0 += y0; cs1 += y1;
                    y0 = y0 * oscale; y1 = y1 * oscale;
                    u32x2 w0, w1; w0.x = cvt_pk_bf16(y0[0], y0[1]); w0.y = cvt_pk_bf16(y0[2], y0[3]); w1.x = cvt_pk_bf16(y1[0], y1[1]); w1.y = cvt_pk_bf16(y1[2], y1[3]);
                    if (!kfrag) { bf16_t* op = o + (size_t)row * DD + head * 128 + 32 * wc + 4 * fq; *(u32x2*)op = w0; *(u32x2*)(op + 16) = w1; }
                    else {
                        bf16_t* op = o + ((((size_t)((row >> 8) * 8 + head) * 8 + ((row >> 5) & 7)) * 8 + 2 * wc) * 512 + ((fq >> 1) * 32 + (row & 31)) * 8 + 4 * (fq & 1));
                        *(u32x2*)op = w0; *(u32x2*)(op + 512) = w1; }
                    asm volatile("" ::: "memory");
                }
            if (kmean) {
#pragma unroll
                for (int i = 0; i < 4; ++i) {
#pragma unroll
                    for (int o2 = 1; o2 < 16; o2 <<= 1) { cs0[i] += sh_xor(cs0[i], o2, lane); cs1[i] += sh_xor(cs1[i], o2, lane); }
                }
                if (fr == 0) { *(PG8_LAS f32x4*)(KS + (wr * 2 + bj) * 128 + 32 * wc + 4 * fq) = cs0; *(PG8_LAS f32x4*)(KS + (wr * 2 + bj) * 128 + 32 * wc + 16 + 4 * fq) = cs1; }
            }
        }
        EPI_BAR();
        if (kmean) {
            const int tid2 = wid * 64 + lane;
            if (tid2 < 256) { const int bj = tid2 >> 7, d = tid2 & 127;
                kmean[((size_t)(2 * u.pn + bj) * 64 + u.pm) * 128 + d] = (KS[bj * 128 + d] + KS[(2 + bj) * 128 + d]) * (1.0f / 256.0f); }
            EPI_BAR();
        }
    }
};

template <class Epi, class Sched, bool ALIGN_EPI = false, bool SP2 = false>
__device__ __forceinline__ void gemm_phase(PG8_LAS unsigned char* lds, PG8_LAS unsigned char* elds, const Gemm g, const Sched& S, const Epi& E) {
    int tid_ = threadIdx.x; asm volatile("" : "+v"(tid_)); const int tid = tid_, wid = __builtin_amdgcn_readfirstlane(tid >> 6), lane = tid & 63, wr = wid >> 2, wc = wid & 3, fr = lane & 15, fq = lane >> 4;
    const int K = g.K, nt = K / BK;
    float zf_ = 0.f; asm volatile("" : "+v"(zf_)); const f32x4 z4_ = {zf_, zf_, zf_, zf_};
    unsigned voffA[2], voffB[2];
#pragma unroll
    for (int i = 0; i < 2; ++i) { int R, C; stage_rc(tid * 16 + i * 8192, R, C); const int Rb = Epi::PERM ? ((R & ~31) + perm32(R & 31)) : R;
        voffA[i] = (unsigned)(R * K + C) * 2u; voffB[i] = (unsigned)(Rb * K + C) * 2u; }
    const size_t kstep = (size_t)(BK * 2);
    const size_t hstep = (size_t)HALF * K * 2;
    const size_t tstep = 2 * hstep; const size_t tstepA = (size_t)g.a_rows * K * 2;
    const unsigned ldsw = (unsigned)wid * 1024u;
    const int aoff = lds_byte(wr * 64 + fr, fq * 8), boff = lds_byte(wc * 32 + fr, fq * 8);
#define PG8_SA(b, h) (((b) * 2 + (h)) * HTB)
#define PG8_SB(b, h) ((4 + (b) * 2 + (h)) * HTB)
#define PG8_STAGE(bufoff, gbase, voff) do { _Pragma("unroll") for (int _i = 0; _i < 2; ++_i) \
        __builtin_amdgcn_global_load_lds((const unsigned*)((const char*)(gbase) + (voff)[_i]), (PG8_LAS unsigned*)(lds + (bufoff) + ldsw + _i * 8192), 16, 0, 0); } while (0)
#define PG8_LDA(dst, b, h) do { _Pragma("unroll") for (int m = 0; m < 4; ++m) _Pragma("unroll") for (int k = 0; k < 2; ++k) dst[m][k] = *(const PG8_LAS bf16x8*)(lds + PG8_SA(b, h) + aoff + m * 2048 + k * 1024); } while (0)
#define PG8_LDB(dst, b, h) do { _Pragma("unroll") for (int n = 0; n < 2; ++n) _Pragma("unroll") for (int k = 0; k < 2; ++k) dst[n][k] = *(const PG8_LAS bf16x8*)(lds + PG8_SB(b, h) + boff + n * 2048 + k * 1024); } while (0)
#define PG8_MMA(ai, bj, At, Bt) do { __builtin_amdgcn_s_setprio(1); _Pragma("unroll") for (int m = 0; m < 4; ++m) _Pragma("unroll") for (int n = 0; n < 2; ++n) _Pragma("unroll") for (int k = 0; k < 2; ++k) \
        acc[ai][bj][m][n] = __builtin_amdgcn_mfma_f32_16x16x32_bf16(Bt[n][k], At[m][k], acc[ai][bj][m][n], 0, 0, 0); __builtin_amdgcn_s_setprio(0); } while (0)
#define PG8_WAIT_V(n) asm volatile("s_waitcnt vmcnt(" #n ")" ::: "memory")
#define PG8_WAIT_L(n) asm volatile("s_waitcnt lgkmcnt(" #n ")" ::: "memory")
#define PG8_BAR __builtin_amdgcn_s_barrier()
#define PG8_SCHED __builtin_amdgcn_sched_barrier(0)
    Unit cur, nxt; int ui = 0;
    if (!S.next(0, cur)) return;
    const PG8_LAS float* RSL = (const PG8_LAS float*)(elds + 22528);
    if constexpr (Epi::RSMODE != 0) {
        PG8_LAS float* RS = (PG8_LAS float*)(elds + 22528); Unit uu;
        const int nun_ = (S.nwg - 1 - S.c) / S.G + 1, nj_ = (nun_ + 1) >> 1;
#pragma unroll 1
        for (int j = 0; j < nj_ && j < 4; ++j) { const int i = 2 * j + (tid >> 8); if (S.next(i, uu)) { const int t = E.tok0(uu) + (tid & 255); RS[i * 256 + (tid & 255)] = (t >= 0 && t < E.tmax) ? rstd4(E.ss, t) : 0.f; } }
    }
    f32x4 acc[2][2][4][2];
#pragma unroll
    for (int a = 0; a < 2; ++a)
#pragma unroll
        for (int b = 0; b < 2; ++b)
#pragma unroll
            for (int m = 0; m < 4; ++m)
#pragma unroll
                for (int n = 0; n < 2; ++n) acc[a][b][m][n] = z4_;
    bf16x8 At[4][2], B0[2][2], B1[2][2];
    const char* cA = (const char*)g.A + (size_t)cur.pm * tstepA; const char* cB = (const char*)g.Bt + (size_t)cur.pn * tstep;
    S.a_ready(cur);
    if constexpr (SP2) {
        PG8_STAGE(PG8_SB(0, 0), cB, voffB); PG8_STAGE(PG8_SB(0, 1), cB + hstep, voffB); PG8_STAGE(PG8_SA(0, 0), cA, voffA); PG8_STAGE(PG8_SA(0, 1), cA + hstep, voffA);
        if (wr == 1) PG8_BAR;
        PG8_WAIT_V(2); PG8_BAR;
        PG8_STAGE(PG8_SB(1, 0), cB + kstep, voffB); PG8_STAGE(PG8_SA(1, 0), cA + kstep, voffA); PG8_STAGE(PG8_SB(1, 1), cB + hstep + kstep, voffB);
        PG8_WAIT_V(6); PG8_BAR;
    } else {
        PG8_STAGE(PG8_SB(0, 0), cB, voffB); PG8_STAGE(PG8_SA(0, 0), cA, voffA); PG8_STAGE(PG8_SB(0, 1), cB + hstep, voffB); PG8_STAGE(PG8_SA(0, 1), cA + hstep, voffA);
        if (wr == 1) PG8_BAR;
        PG8_WAIT_V(4); PG8_BAR;
        PG8_STAGE(PG8_SB(1, 0), cB + kstep, voffB); PG8_STAGE(PG8_SA(1, 0), cA + kstep, voffA); PG8_STAGE(PG8_SB(1, 1), cB + hstep + kstep, voffB);
        PG8_WAIT_V(6); PG8_BAR;
    }
    for (;;) {
        const bool has_next = S.next(ui + 1, nxt);
        const char* nA = has_next ? (const char*)g.A + (size_t)nxt.pm * tstepA : cA; const char* nB = has_next ? (const char*)g.Bt + (size_t)nxt.pn * tstep : cB;
        for (int t = 0; t < nt; t += 2) {
            const bool last = (t == nt - 2);
            const char* a1 = cA + (size_t)(t + 1) * kstep;
            const char* a2 = last ? nA : cA + (size_t)(t + 2) * kstep; const char* b2 = last ? nB : cB + (size_t)(t + 2) * kstep;
            const char* a3 = a2 + kstep; const char* b3 = b2 + kstep;
            if (last && has_next) S.a_ready(nxt);
            if constexpr (SP2) {
            PG8_LDB(B0, 0, 0); PG8_LDB(B1, 0, 1); PG8_SCHED; PG8_LDA(At, 0, 0); PG8_STAGE(PG8_SA(1, 1), a1 + hstep, voffA);
            PG8_WAIT_V(8); PG8_WAIT_L(0); PG8_BAR; PG8_MMA(0, 0, At, B0); PG8_MMA(0, 1, At, B1); PG8_BAR; PG8_SCHED;
            PG8_LDA(At, 0, 1); PG8_STAGE(PG8_SB(0, 0), b2, voffB); PG8_STAGE(PG8_SB(0, 1), b2 + hstep, voffB); PG8_STAGE(PG8_SA(0, 0), a2, voffA);
            PG8_WAIT_V(8); PG8_WAIT_L(0); PG8_BAR; PG8_MMA(1, 0, At, B0); PG8_MMA(1, 1, At, B1); PG8_BAR; PG8_SCHED;
            PG8_LDB(B0, 1, 0); PG8_LDB(B1, 1, 1); PG8_SCHED; PG8_LDA(At, 1, 0); PG8_STAGE(PG8_SA(0, 1), a2 + hstep, voffA);
            PG8_WAIT_V(8); PG8_WAIT_L(0); PG8_BAR; PG8_MMA(0, 0, At, B0); PG8_MMA(0, 1, At, B1); PG8_BAR; PG8_SCHED;
            PG8_LDA(At, 1, 1); PG8_STAGE(PG8_SB(1, 0), b3, voffB); PG8_STAGE(PG8_SB(1, 1), b3 + hstep, voffB); PG8_STAGE(PG8_SA(1, 0), a3, voffA);
            PG8_WAIT_V(8); PG8_WAIT_L(0); PG8_BAR; PG8_MMA(1, 0, At, B0); PG8_MMA(1, 1, At, B1); PG8_BAR; PG8_SCHED;
            } else {
            PG8_LDB(B0, 0, 0); PG8_SCHED; PG8_LDA(At, 0, 0); PG8_STAGE(PG8_SA(1, 1), a1 + hstep, voffA);
            PG8_WAIT_L(8); PG8_BAR; PG8_WAIT_L(0); PG8_MMA(0, 0, At, B0); PG8_BAR; PG8_SCHED;
            PG8_LDB(B1, 0, 1); PG8_STAGE(PG8_SB(0, 0), b2, voffB);
            PG8_BAR; PG8_WAIT_L(0); PG8_MMA(0, 1, At, B1); PG8_BAR;
            PG8_LDA(At, 0, 1); PG8_STAGE(PG8_SA(0, 0), a2, voffA);
            PG8_BAR; PG8_WAIT_L(0); PG8_MMA(1, 0, At, B0); PG8_BAR; PG8_SCHED;
            PG8_STAGE(PG8_SB(0, 1), b2 + hstep, voffB);
            PG8_WAIT_V(6); PG8_BAR; PG8_MMA(1, 1, At, B1); PG8_BAR;
            PG8_LDB(B0, 1, 0); PG8_SCHED; PG8_LDA(At, 1, 0); PG8_STAGE(PG8_SA(0, 1), a2 + hstep, voffA);
            PG8_WAIT_L(8); PG8_BAR; PG8_WAIT_L(0); PG8_MMA(0, 0, At, B0); PG8_BAR; PG8_SCHED;
            PG8_LDB(B1, 1, 1); PG8_STAGE(PG8_SB(1, 0), b3, voffB);
            PG8_BAR; PG8_WAIT_L(0); PG8_MMA(0, 1, At, B1); PG8_BAR;
            PG8_LDA(At, 1, 1); PG8_STAGE(PG8_SA(1, 0), a3, voffA);
            PG8_BAR; PG8_WAIT_L(0); PG8_MMA(1, 0, At, B0); PG8_BAR; PG8_SCHED;
            PG8_STAGE(PG8_SB(1, 1), b3 + hstep, voffB);
            PG8_WAIT_V(6); PG8_BAR; PG8_MMA(1, 1, At, B1); PG8_BAR;
            }
        }
        if constexpr (ALIGN_EPI) { if (wr == 0) PG8_BAR; }
        { E(acc, cur, wr, wc, fr, fq, elds, wid, lane, RSL + (ui & 7) * 256); S.done(cur); }
        if (!has_next) break;
#pragma unroll
        for (int a = 0; a < 2; ++a)
#pragma unroll
            for (int b = 0; b < 2; ++b)
#pragma unroll
                for (int m = 0; m < 4; ++m)
#pragma unroll
                    for (int n = 0; n < 2; ++n) acc[a][b][m][n] = z4_;
        cur = nxt; cA = nA; cB = nB; ++ui;
        if constexpr (ALIGN_EPI) { if (wr == 1) PG8_BAR; }
    }
    PG8_WAIT_V(0);
    if constexpr (!ALIGN_EPI) { if (wr == 0) PG8_BAR; }
    PG8_BAR;
#undef PG8_SA
#undef PG8_SB
#undef PG8_STAGE
#undef PG8_LDA
#undef PG8_LDB
#undef PG8_MMA
#undef PG8_WAIT_V
#undef PG8_WAIT_L
#undef PG8_BAR
#undef PG8_SCHED
}
}


#define GAS __attribute__((address_space(1)))
#define LAS __attribute__((address_space(3)))
typedef unsigned short bf16;
typedef unsigned v4u __attribute__((ext_vector_type(4)));
typedef float f32x4 __attribute__((ext_vector_type(4)));
typedef short bf16x8 __attribute__((ext_vector_type(8)));

constexpr int NWAVES = 8;
constexpr int T = 16384, D = 1024, FF = 2816, FF2 = 5632, MIN_ = 3080;
constexpr size_t MiB = 1u << 20;
constexpr size_t WS_CTL = 0, CTL_ZERO_BYTES = 2 * MiB;
constexpr size_t WS_SS = 64 * 1024;
constexpr size_t WS_WINR = 2 * MiB;
constexpr size_t WS_WINT = 10 * MiB;
constexpr size_t WS_WOUT = 16 * MiB;
constexpr size_t WS_WK = 20 * MiB, WS_WV = 22 * MiB;
constexpr size_t WS_WQ = 24 * MiB;
constexpr size_t WS_WO = 28 * MiB;
constexpr size_t WS_WUP = 32 * MiB;
constexpr size_t WS_WDN = 76 * MiB;
constexpr size_t WS_WG = 98 * MiB;
constexpr size_t WS_ROPE = 99 * MiB;
constexpr size_t WS_HB = 101 * MiB;
constexpr size_t HB_ROW0 = 2 * 2048;
constexpr size_t WS_ACT = 135 * MiB;
constexpr size_t WS_CT = 135 * MiB;
constexpr size_t WS_MQ = 199 * MiB;
constexpr size_t WS_BCUM = 215 * MiB, WS_IG = WS_BCUM + 256 * 1024, WS_WGT = WS_IG + 256 * 1024, WS_DECAY = WS_WGT + 256 * 1024;
constexpr size_t WS_NCT = 217 * MiB;
constexpr size_t WS_ONES = 221 * MiB;
constexpr size_t WS_MK = 223 * MiB;
constexpr size_t WS_OG = 239 * MiB;
constexpr size_t WS_KVT = 271 * MiB;
constexpr size_t WS_HG = 319 * MiB;
constexpr size_t WS_XK = 223 * MiB;
constexpr size_t WS_XVT = 255 * MiB;
constexpr size_t WS_KMEAN = 287 * MiB;
constexpr size_t WS_DUMP = 287 * MiB + 512 * 1024;
constexpr size_t WS_AQ = 288 * MiB;
constexpr size_t WS_LIST = 320 * MiB;
constexpr size_t WS_ML = 337 * MiB;
constexpr size_t WS_PO = 135 * MiB, WS_PO2 = 340 * MiB;
constexpr int PO_SPLIT = 14336;
constexpr int TRI = 516096;
constexpr size_t WS_GCNT = 1536 * 1024;
constexpr size_t WS_END = 352 * MiB;
constexpr int CW_BAR = 4096;
constexpr int RING_BYTES = 131072, EPI_OFF = RING_BYTES + 1024, LDS_BYTES = 163840, MISC_OFF = LDS_BYTES - 256;

#define LDS_WAIT() asm volatile("s_waitcnt lgkmcnt(0)" ::: "memory")
__device__ __forceinline__ unsigned f2bf(float f) { unsigned u = __builtin_bit_cast(unsigned, f); return (u + 0x7fffu + ((u >> 16) & 1u)) >> 16; }
__device__ __forceinline__ unsigned pk2(float lo, float hi) { return f2bf(lo) | (f2bf(hi) << 16); }

#define XB_TMO      128
#define XB_XCNT(j)  (256  + 64 * (j))
#define XB_XSUB(j)  (1280 + 64 * (j))
#define XB_XGEN(j)  (2304 + 64 * (j))
#define XB_TOP      3328
#define XB_TOPGEN   3392
#define XCD_BAR_WORDS 3456
#define XB_SPIN_CAP (1u << 18)
__device__ __forceinline__ unsigned xb_ld(unsigned* p)              { return __hip_atomic_load(p, __ATOMIC_RELAXED, __HIP_MEMORY_SCOPE_AGENT); }
__device__ __forceinline__ unsigned xb_add(unsigned* p, unsigned v) { return __hip_atomic_fetch_add(p, v, __ATOMIC_RELAXED, __HIP_MEMORY_SCOPE_AGENT); }
__device__ __forceinline__ unsigned xb_xcc_id() { return (unsigned)__builtin_amdgcn_s_getreg((3 << 11) | 20) & 0xFu; }
#define XB_SPIN(cond, bar) do { unsigned _sp = 0; while (cond) { __builtin_amdgcn_s_sleep(1); \
    if ((++_sp & 255u) == 0u) { if (xb_ld(&(bar)[XB_TMO])) break; if (_sp > XB_SPIN_CAP) { atomicAdd(&(bar)[XB_TMO], 1u); break; } } } } while (0)
struct XcdBarrier { unsigned* bar; unsigned x; volatile LAS unsigned* st; };
__device__ __forceinline__ XcdBarrier xcd_barrier_post(unsigned* bar, volatile LAS unsigned* st) {
    XcdBarrier b; b.bar = bar; b.x = xb_xcc_id(); b.st = st;
    if (threadIdx.x == 0) (void)xb_add(&bar[XB_XCNT(b.x)], 1u);
    return b;
}
__device__ __forceinline__ void xcd_barrier_complete(unsigned* bar, unsigned x, unsigned& nloc, unsigned& nx) {
    const unsigned G = gridDim.x * gridDim.y * gridDim.z;
    unsigned sum, cnt, mine, sp = 0u;
    for (;;) {
        sum = 0u; cnt = 0u; mine = 0u;
#pragma unroll
        for (unsigned j = 0; j < 16; ++j) { const unsigned c = xb_ld(&bar[XB_XCNT(j)]); sum += c; cnt += (c > 0u) ? 1u : 0u; mine = (j == x) ? c : mine; }
        if (sum == G) break;
        __builtin_amdgcn_s_sleep(1);
        if ((++sp & 255u) == 0u) { if (xb_ld(&bar[XB_TMO])) break; if (sp > XB_SPIN_CAP) { atomicAdd(&bar[XB_TMO], 1u); break; } }
    }
    nloc = mine > 0u ? mine : 1u; nx = cnt > 0u ? cnt : 1u;
}
__device__ __forceinline__ void xcd_barrier(const XcdBarrier& b) {
    asm volatile("s_waitcnt vmcnt(0)" ::: "memory");
    __syncthreads();
    if (threadIdx.x == 0) {
        unsigned* bar = b.bar;
        __builtin_amdgcn_s_waitcnt(0);
        unsigned nloc = b.st[0], nx = b.st[1];
        if (nloc == 0u) { xcd_barrier_complete(bar, b.x, nloc, nx); b.st[0] = nloc; b.st[1] = nx; }
        const unsigned old = xb_add(&bar[XB_XSUB(b.x)], 1u);
        const unsigned gen = old / nloc;
        if (old + 1u == (gen + 1u) * nloc) {
            __builtin_amdgcn_fence(__ATOMIC_RELEASE, "agent");
            asm volatile("s_waitcnt vmcnt(0)" ::: "memory");
            const unsigned og = xb_add(&bar[XB_TOP], 1u);
            const unsigned tg = og / nx;
            if (og + 1u == (tg + 1u) * nx) xb_add(&bar[XB_TOPGEN], 1u);
            else XB_SPIN(xb_ld(&bar[XB_TOPGEN]) == tg, bar);
            __builtin_amdgcn_fence(__ATOMIC_ACQUIRE, "agent");
            xb_add(&bar[XB_XGEN(b.x)], 1u);
            asm volatile("s_waitcnt vmcnt(0)" ::: "memory");
        } else {
            XB_SPIN(xb_ld(&bar[XB_XGEN(b.x)]) == gen, bar);
            __builtin_amdgcn_fence(__ATOMIC_ACQUIRE, "agent");
            asm volatile("s_waitcnt vmcnt(0)" ::: "memory");
        }
    }
    __syncthreads();
}

using pg8::sh_idx; using pg8::sh_xor; using pg8::half_sum_hi; using pg8::oct_sum;
__device__ __forceinline__ float wave_sum(float v, int lane) {
#pragma unroll
    for (int o = 1; o < 64; o <<= 1) v += sh_xor(v, o, lane);
    return v;
}
__device__ __forceinline__ void transpose_item(const float* W, int ldw, int k0, int n0, const float* gain, bf16* WT, int Kd, int d0, bf16* WT2, int d1, LAS float* scr, int lane) {
    float v_[32], g_[32];
#pragma unroll
    for (int i = 0; i < 32; ++i) { const int kk = 2 * i + (lane >> 5); v_[i] = W[(size_t)(k0 + kk) * ldw + n0 + (lane & 31)]; g_[i] = gain ? gain[k0 + kk] : 1.0f; }
#pragma unroll
    for (int i = 0; i < 32; ++i) { const int kk = 2 * i + (lane >> 5); scr[kk * 33 + (lane & 31)] = v_[i] * g_[i]; }
    LDS_WAIT(); asm volatile("" ::: "memory");
    const int c = lane & 7;
#pragma unroll
    for (int j = 0; j < 4; ++j) { const int n = (lane >> 3) + 8 * j; const LAS float* s = scr + (8 * c) * 33 + n;
        v4u o; o.x = pk2(s[0 * 33], s[1 * 33]); o.y = pk2(s[2 * 33], s[3 * 33]); o.z = pk2(s[4 * 33], s[5 * 33]); o.w = pk2(s[6 * 33], s[7 * 33]);
        *(GAS v4u*)(WT + (size_t)(d0 + n) * Kd + k0 + 8 * c) = o;
        if (WT2) *(GAS v4u*)(WT2 + (size_t)(d1 + n) * Kd + k0 + 8 * c) = o; }
    LDS_WAIT(); asm volatile("" ::: "memory");
}


typedef float f32x16 __attribute__((ext_vector_type(16)));
__device__ __forceinline__ float bf2f(unsigned short v) { return __builtin_bit_cast(float, (unsigned)v << 16); }
__device__ __forceinline__ float log_sigmoidf(float f) { return fminf(f, 0.f) - log1pf(expf(-fabsf(f))); }

__device__ __forceinline__ void mlstm_gates_item(LAS unsigned char* L, int c, const bf16* hbr, const float* wg, const float* ssn, const float* bg,
                                                 float* BCUM, float* IG, float* WGT, float* DECAY, bf16* WROW) {
    int tid_ = threadIdx.x; asm volatile("" : "+v"(tid_)); const int tid = tid_, lane = tid & 63, wave = __builtin_amdgcn_readfirstlane(tid >> 6); (void)tid; (void)lane; (void)wave;
    LAS float* Gs = (LAS float*)L;
    float w[16][8];
#pragma unroll
    for (int j = 0; j < 2; ++j)
#pragma unroll
        for (int i = 0; i < 8; ++i) { const int k = 8 * lane + 512 * j + i; const f32x4 a = *(const f32x4*)(wg + k * 8), b = *(const f32x4*)(wg + k * 8 + 4);
            w[8 * j + i][0] = a[0]; w[8 * j + i][1] = a[1]; w[8 * j + i][2] = a[2]; w[8 * j + i][3] = a[3]; w[8 * j + i][4] = b[0]; w[8 * j + i][5] = b[1]; w[8 * j + i][6] = b[2]; w[8 * j + i][7] = b[3]; }
    for (int tt = 0; tt < 8; ++tt) {
        const int tl = wave * 8 + tt, t = 64 * c + tl;
        const GAS v4u* xr = (const GAS v4u*)(hbr + (size_t)t * D) + lane;
        float a8[8] = {0.f, 0.f, 0.f, 0.f, 0.f, 0.f, 0.f, 0.f};
#pragma unroll
        for (int j = 0; j < 2; ++j) { const v4u xv = xr[64 * j];
#pragma unroll
            for (int i = 0; i < 8; ++i) { const float xf = (i & 1) ? __builtin_bit_cast(float, xv[i >> 1] & 0xffff0000u) : __builtin_bit_cast(float, xv[i >> 1] << 16);
#pragma unroll
                for (int q = 0; q < 8; ++q) a8[q] += xf * w[8 * j + i][q]; } }
        const float rs = pg8::rstd4(ssn, t);
#pragma unroll
        for (int q = 0; q < 8; ++q) { const float v = wave_sum(a8[q], lane); if (lane == 0) Gs[tl * 8 + q] = v * rs; }
    }
    LDS_WAIT(); __syncthreads();
    if (wave < 4) {
        const int h = wave, t = 64 * c + lane;
        const float gi = Gs[lane * 8 + h] + bg[h], gf = Gs[lane * 8 + 4 + h] + bg[4 + h];
        float b = log_sigmoidf(gf);
#pragma unroll
        for (int o = 1; o < 64; o <<= 1) { const float v = sh_idx(b, lane - o); if (lane >= o) b += v; }
        const float bl = sh_idx(b, 63);
        BCUM[(size_t)h * T + t] = b; IG[(size_t)h * T + t] = gi; { const float wv_ = expf(bl - b + gi); WGT[(size_t)h * T + t] = wv_; WROW[(size_t)(c * 4 + h) * 64 + lane] = (bf16)f2bf(wv_); }
        if (lane == 63) DECAY[c * 4 + h] = expf(bl);
    }
    LDS_WAIT(); __syncthreads();
}

__device__ __forceinline__ bf16x8 scale_bf16x8(bf16x8 v, bf16x8 wv) {
    typedef unsigned u4 __attribute__((ext_vector_type(4)));
    const u4 u = __builtin_bit_cast(u4, v), w = __builtin_bit_cast(u4, wv); u4 o;
#pragma unroll
    for (int i = 0; i < 4; ++i)
        o[i] = pg8::cvt_pk_bf16(__builtin_bit_cast(float, u[i] << 16) * __builtin_bit_cast(float, w[i] << 16), __builtin_bit_cast(float, u[i] & 0xffff0000u) * __builtin_bit_cast(float, w[i] & 0xffff0000u));
    return __builtin_bit_cast(bf16x8, o);
}
__device__ __forceinline__ void mlstm_scan(const bf16* KVT, const float* DECAY, bf16* CT, bf16* NCT, const bf16* WROW, const bf16* ZROW, int G, bool probe_same = false) {
    int tid_ = threadIdx.x; asm volatile("" : "+v"(tid_)); const int tid = tid_, lane = tid & 63, wave = __builtin_amdgcn_readfirstlane(tid >> 6); (void)tid;
    bool active, ntask; int h, e0, d0;
    if (G == 256) { const int x = (int)blockIdx.x & 7, cu = (int)blockIdx.x >> 3; h = x >> 1;
        if (wave < 2) { const int k = wave * 32 + cu; active = true; ntask = false; e0 = (x & 1) * 128 + (k >> 3) * 16; d0 = (k & 7) * 16; }
        else { active = (wave == 2) && ((x & 1) == 0) && (cu < 8); ntask = true; e0 = 0; d0 = (cu & 7) * 16; }
    } else { const int gw = wave * G + (int)blockIdx.x; active = gw < 544; ntask = gw >= 512;
        if (!ntask) { h = gw >> 7; e0 = ((gw >> 3) & 15) * 16; d0 = (gw & 7) * 16; } else { const int q = gw - 512; h = (q >> 3) & 3; e0 = 0; d0 = (q & 7) * 16; } }
    if (probe_same) { h = 0; e0 = 0; d0 = 0; }
    if (active) {
        const int fr = lane & 15, fq = lane >> 4;
        const bf16* arow = KVT + (size_t)((h * 8 + (d0 >> 4)) * 2) * 512 + lane * 8;
        const bf16* brow = ntask ? ((fr == 0 ? WROW + h * 64 : ZROW) + 8 * fq) : (KVT + (size_t)((32 + h * 16 + (e0 >> 4)) * 2) * 512 + lane * 8);
        bf16* crow = ntask ? (NCT + ((size_t)h * 16 + fr) * 128 + d0 + 4 * fq) : (CT + ((size_t)(h * 8 + (e0 >> 5)) * 8 + (d0 >> 4)) * 512 + ((fq >> 1) * 32 + (e0 & 16) + fr) * 8 + 4 * (fq & 1));
        const size_t cstep = probe_same ? (size_t)0 : (ntask ? (size_t)4 * 16 * 128 : (size_t)4 * 256 * 128);
        const float* drow = DECAY + h;
        const size_t bstep = ntask ? (fr == 0 ? (size_t)256 : (size_t)0) : (size_t)1536 * 64;
        constexpr int P = 8;
        bf16x8 sa[P][2], sb[P][2]; float sd[P];
        const char* pa = (const char*)arow; const char* pb = (const char*)brow; const size_t b2off = ntask ? 64 : 1024;     const char* pd = (const char*)(DECAY + h); char* pc = (char*)crow;
        const size_t astep = (size_t)1536 * 64 * 2, bstepb = bstep * 2, cstepb = cstep * 2;
#define SC_LD16(dst, ptr, OFF) asm volatile("global_load_dwordx4 %0, %1, off offset:" #OFF : "=&v"(dst) : "v"(ptr) : "memory")
#define SC_LD4(dst, ptr) asm volatile("global_load_dword %0, %1, off" : "=&v"(dst) : "v"(ptr) : "memory")
#define SC_LOADS(j) do { SC_LD16(sa[j][0], pa, 0); SC_LD16(sa[j][1], pa, 1024); { const char* pb2_ = pb + b2off; SC_LD16(sb[j][0], pb, 0); SC_LD16(sb[j][1], pb2_, 0); } SC_LD4(sd[j], pd); pa += astep; pb += bstepb; pd += 16; } while (0)
#pragma unroll
        for (int j = 0; j < P; ++j) { float dm_; SC_LD4(dm_, pd); SC_LOADS(j); }
        f32x4 acc = (f32x4){0.f, 0.f, 0.f, 0.f};
        for (int c0 = 0; c0 < 256; c0 += P) {
#pragma unroll
            for (int j = 0; j < P; ++j) {
                asm volatile("s_waitcnt vmcnt(42)" : "+v"(sa[j][0]), "+v"(sa[j][1]), "+v"(sb[j][0]), "+v"(sb[j][1]), "+v"(sd[j]) :: "memory");
                { typedef unsigned u2 __attribute__((ext_vector_type(2))); u2 o; o.x = pg8::cvt_pk_bf16(acc[0], acc[1]); o.y = pg8::cvt_pk_bf16(acc[2], acc[3]);
                  if (!probe_same) asm volatile("global_store_dwordx2 %0, %1, off" :: "v"(pc), "v"(o) : "memory"); else { float dm2_; asm volatile("global_load_dword %0, %1, off" : "=&v"(dm2_) : "v"(pd), "v"(o) : "memory"); }
                  pc += cstepb; }
                acc = acc * sd[j];
                acc = __builtin_amdgcn_mfma_f32_16x16x32_bf16(sa[j][0], sb[j][0], acc, 0, 0, 0);
                acc = __builtin_amdgcn_mfma_f32_16x16x32_bf16(sa[j][1], sb[j][1], acc, 0, 0, 0);
                asm volatile("" : "+v"(acc));
                SC_LOADS(j);
            }
        }
        asm volatile("s_waitcnt vmcnt(0)" ::: "memory");
#undef SC_LD16
#undef SC_LD4
#undef SC_LOADS
    }
}

constexpr int M3_BUF = 36864;
constexpr int M3_QS = 0, M3_KS = 17408, M3_BC = 35840, M3_IG = 36096, M3_NV = 36352;
constexpr int M3_SS = 73728, M3_DQ = 82944, M3_DSP = 83200, M3_OS = 83968  ;
__device__ __forceinline__ void mlstm_out_phase(LAS unsigned char* L, int G, const bf16* Q, const bf16* K, const bf16* KVT, const bf16* CT, const bf16* NCT,
                                                const float* BCUM, const float* WGT, const bf16* OG, const float* hn, bf16* HG) {
    int tid_ = threadIdx.x; asm volatile("" : "+v"(tid_)); const int tid = tid_, lane = tid & 63, wave = __builtin_amdgcn_readfirstlane(tid >> 6);
    const int r = lane & 31, hh = lane >> 5;
    LAS float* dq = (LAS float*)(L + M3_DQ); LAS float* dsp = (LAS float*)(L + M3_DSP); LAS float* OS = (LAS float*)(L + M3_OS);
    int it = (int)blockIdx.x; if (it >= 1024) return;
    bf16x8 ctf[8], vtf[4]; v4u ogf[4]; v4u qk[4]; float sm = 0.f;
#define M3_LD_CT(c_, h_) do { const bf16* ctp = CT + (((size_t)((c_) * 4 + (h_)) * 8 + wave) * 8) * 512 + lane * 8; _Pragma("unroll") for (int kk = 0; kk < 8; ++kk) ctf[kk] = *(const bf16x8*)(ctp + 512 * kk); } while (0)
#define M3_LD_VT(c_, h_) do { const bf16* vtp = KVT + (((size_t)(c_) * 96 + 32 + (h_) * 16 + 2 * wave + (r >> 4)) * 2) * 512 + (hh * 16 + (r & 15)) * 8; _Pragma("unroll") for (int kk = 0; kk < 4; ++kk) vtf[kk] = *(const bf16x8*)(vtp + (kk >> 1) * 512 + (kk & 1) * 256); } while (0)
#define M3_LD_OG(c_, h_) do { const bf16* ogp = OG + (size_t)(64 * (c_) + (tid >> 3)) * 1024 + (h_) * 256 + 8 * (tid & 7); _Pragma("unroll") for (int k = 0; k < 4; ++k) ogf[k] = *(const GAS v4u*)(ogp + 64 * k); } while (0)
#define M3_LD_QK(c_, h_) do { _Pragma("unroll") for (int j = 0; j < 4; ++j) { const int i = tid + 512 * j, which = i >> 10, idx = i & 1023, row = idx >> 4, ch = idx & 15; \
            qk[j] = which ? *(const GAS v4u*)(KVT + (((size_t)(c_) * 96 + (h_) * 8) * 2) * 512 + idx * 8) : *(const GAS v4u*)(Q + (size_t)(64 * (c_) + row) * 512 + (h_) * 128 + ch * 8); } \
        if (tid < 64) sm = BCUM[(size_t)(h_) * T + 64 * (c_) + tid]; else if (tid < 128) sm = WGT[(size_t)(h_) * T + 64 * (c_) + tid - 64]; else if (tid < 256) sm = bf2f(NCT[(size_t)((c_) * 4 + (h_)) * 16 * 128 + tid - 128]); } while (0)
#define M3_ST_QK(B_) do { _Pragma("unroll") for (int j = 0; j < 4; ++j) { const int i = tid + 512 * j, which = i >> 10, idx = i & 1023, row = idx >> 4, ch = idx & 15; if (which) { const int bi_ = idx >> 6, lp_ = idx & 63; *(LAS v4u*)((B_) + M3_KS + (16 * (bi_ >> 1) + (lp_ & 15)) * 144 + (32 * (bi_ & 1) + 8 * (lp_ >> 4)) * 2) = qk[j]; } \
            else *(LAS v4u*)((B_) + row * 272 + ch * 16) = qk[j]; } \
        if (tid < 256) ((LAS float*)((B_) + M3_BC))[tid] = sm; } while (0)
    { const int c = it >> 2, h = it & 3; M3_LD_CT(c, h); M3_LD_VT(c, h); M3_LD_OG(c, h); M3_LD_QK(c, h); M3_ST_QK(L); }
    LDS_WAIT(); __syncthreads();
    int pb = 0;
    for (;;) {
        const int c = it >> 2, h = it & 3, t0 = 64 * c, itn = it + G; const bool has_next = itn < 1024; const int cn = itn >> 2, hn_ = itn & 3;
        LAS unsigned char* B = L + pb * M3_BUF; LAS unsigned char* Bn = L + (pb ^ 1) * M3_BUF;
        LAS float* bc = (LAS float*)(B + M3_BC); LAS float* ig = (LAS float*)(B + M3_IG); LAS float* nv = (LAS float*)(B + M3_NV);
        if (has_next) M3_LD_QK(cn, hn_);
        f32x16 O[2];
#pragma unroll
        for (int i = 0; i < 16; ++i) { O[0][i] = 0.f; O[1][i] = 0.f; }
#pragma unroll
        for (int kk = 0; kk < 8; ++kk) {
            const bf16x8 a0 = *(const LAS bf16x8*)(B + M3_QS + r * 272 + (16 * kk + 8 * hh) * 2), a1 = *(const LAS bf16x8*)(B + M3_QS + (32 + r) * 272 + (16 * kk + 8 * hh) * 2);
            O[0] = __builtin_amdgcn_mfma_f32_32x32x16_bf16(a0, ctf[kk], O[0], 0, 0, 0); O[1] = __builtin_amdgcn_mfma_f32_32x32x16_bf16(a1, ctf[kk], O[1], 0, 0, 0);
        }
        if (has_next) M3_LD_CT(cn, hn_);
        if (wave < 4) {
            const int tt = wave >> 1, s2 = wave & 1; f32x16 S;
#pragma unroll
            for (int i = 0; i < 16; ++i) S[i] = 0.f;
#pragma unroll
            for (int kk = 0; kk < 8; ++kk) {
                const bf16x8 a = *(const LAS bf16x8*)(B + M3_QS + (32 * tt + r) * 272 + (16 * kk + 8 * hh) * 2);
                typedef short v4i16_t __attribute__((ext_vector_type(4)));
                const int i16 = lane & 15, q4 = i16 >> 2, p4 = i16 & 3, blk = (lane >> 4) & 1;
                LAS unsigned char* tb = B + M3_KS + (16 * kk + 8 * hh + q4) * 144 + (32 * s2 + 16 * blk + 4 * p4) * 2;
                const v4i16_t lo = __builtin_amdgcn_ds_read_tr16_b64_v4i16((LAS v4i16_t*)tb), hi = __builtin_amdgcn_ds_read_tr16_b64_v4i16((LAS v4i16_t*)(tb + 4 * 144));
                const bf16x8 b = __builtin_shufflevector(lo, hi, 0, 1, 2, 3, 4, 5, 6, 7);
                S = __builtin_amdgcn_mfma_f32_32x32x16_bf16(a, b, S, 0, 0, 0);
            }
            const int s = 32 * s2 + r; const float ws = ig[s], bl = bc[63];
#pragma unroll
            for (int i = 0; i < 16; ++i) {
                const int t = 32 * tt + (i & 3) + 8 * (i >> 2) + 4 * hh;
                const float v = (s <= t) ? S[i] * __expf(bc[t] - bl) : 0.f;
                const float rsum = half_sum_hi(v * ws);
                if (r == 16) dsp[s2 * 64 + t] = rsum;
                *(LAS unsigned short*)(L + M3_SS + t * 144 + s * 2) = (unsigned short)f2bf(v);
            }
        } else {
            const int th = tid - 256, t = th >> 2, part = th & 3; float sum = 0.f;
#pragma unroll 8
            for (int d = 0; d < 32; ++d) sum += bf2f(*(const LAS unsigned short*)(B + M3_QS + t * 272 + (32 * part + d) * 2)) * nv[32 * part + d];
            sum = pg8::dpp_add<0xB1>(sum); sum = pg8::dpp_add<0x4E>(sum);
            if (part == 0) dq[t] = sum;
        }
        LDS_WAIT(); __syncthreads();
#pragma unroll
        for (int tt = 0; tt < 2; ++tt)
#pragma unroll
            for (int i = 0; i < 16; ++i) O[tt][i] *= __expf(bc[32 * tt + (i & 3) + 8 * (i >> 2) + 4 * hh]);
#pragma unroll
        for (int kk = 0; kk < 4; ++kk) {
            const bf16x8 a0 = *(const LAS bf16x8*)(L + M3_SS + r * 144 + (16 * kk + 8 * hh) * 2), a1 = *(const LAS bf16x8*)(L + M3_SS + (32 + r) * 144 + (16 * kk + 8 * hh) * 2);
            O[0] = __builtin_amdgcn_mfma_f32_32x32x16_bf16(a0, vtf[kk], O[0], 0, 0, 0); O[1] = __builtin_amdgcn_mfma_f32_32x32x16_bf16(a1, vtf[kk], O[1], 0, 0, 0);
        }
        if (has_next) M3_LD_VT(cn, hn_);
#pragma unroll
        for (int tt = 0; tt < 2; ++tt)
#pragma unroll
            for (int i = 0; i < 16; ++i) OS[(32 * tt + (i & 3) + 8 * (i >> 2) + 4 * hh) * 260 + 32 * wave + r] = O[tt][i];
        LDS_WAIT(); __syncthreads();
        {
            const int t = tid >> 3, part = tid & 7;
            const float den = __expf(bc[t]) * dq[t] + dsp[t] + dsp[64 + t];
            const float inv = __builtin_amdgcn_rcpf(fmaxf(fabsf(den), 1.0f));
            f32x4 v[8]; float ssq = 0.f;
#pragma unroll
            for (int k = 0; k < 8; ++k) { v[k] = *(const LAS f32x4*)(OS + t * 260 + 64 * (k >> 1) + 8 * part + 4 * (k & 1)) * inv; ssq += (v[k][0] * v[k][0] + v[k][1] * v[k][1]) + (v[k][2] * v[k][2] + v[k][3] * v[k][3]); }
            ssq = oct_sum(ssq);
            const float rsn = rsqrtf(ssq * (1.0f / 256.0f) + 1e-6f);
            const float* gp = hn + h * 256 + 8 * part;
            bf16* op = HG + (size_t)(t0 + t) * 1024 + h * 256 + 8 * part;
#pragma unroll
            for (int k = 0; k < 4; ++k) {
                const f32x4 g0 = *(const f32x4*)(gp + 64 * k), g1 = *(const f32x4*)(gp + 64 * k + 4);
                float o8[8];
#pragma unroll
                for (int x2 = 0; x2 < 4; ++x2) {
                    const float og0 = __builtin_bit_cast(float, ogf[k][x2] << 16), og1 = __builtin_bit_cast(float, ogf[k][x2] & 0xffff0000u);
                    const float a0 = (2 * x2 < 4) ? v[2 * k][2 * x2] : v[2 * k + 1][2 * x2 - 4], a1 = (2 * x2 + 1 < 4) ? v[2 * k][2 * x2 + 1] : v[2 * k + 1][2 * x2 + 1 - 4];
                    const float gg0 = (2 * x2 < 4) ? g0[2 * x2] : g1[2 * x2 - 4], gg1 = (2 * x2 + 1 < 4) ? g0[2 * x2 + 1] : g1[2 * x2 + 1 - 4];
                    o8[2 * x2] = a0 * rsn * gg0 * __builtin_amdgcn_rcpf(1.0f + __builtin_amdgcn_exp2f(-1.4426950408889634f * og0)); o8[2 * x2 + 1] = a1 * rsn * gg1 * __builtin_amdgcn_rcpf(1.0f + __builtin_amdgcn_exp2f(-1.4426950408889634f * og1)); }
                v4u w; w.x = pg8::cvt_pk_bf16(o8[0], o8[1]); w.y = pg8::cvt_pk_bf16(o8[2], o8[3]); w.z = pg8::cvt_pk_bf16(o8[4], o8[5]); w.w = pg8::cvt_pk_bf16(o8[6], o8[7]);
                *(GAS v4u*)(op + 64 * k) = w; }
        }
        if (has_next) { M3_LD_OG(cn, hn_); M3_ST_QK(Bn); }
        LDS_WAIT(); __syncthreads();
        if (!has_next) break;
        it = itn; pb ^= 1;
    }
#undef M3_LD_CT
#undef M3_LD_VT
#undef M3_LD_OG
#undef M3_LD_QK
#undef M3_ST_QK
}

constexpr int AT_QS = 0, AT_PS = 34816, AT_PM = 102400, AT_PSUM = 106496, AT_ENT = 110592, AT_W = 111104, AT_MX = 113152, AT_PRE = 113664  , AT_WT = 115744;
constexpr int GT_KH = 34816, GT_KL = 52224, GT_SC = 69632, GT_LCNT = 102912, GT_BASE = 103168;
__device__ __forceinline__ int list_off(int h, int b) { return h * TRI + b * T - 128 * b * (b + 1); }
__device__ __forceinline__ void moba_gate_phase(LAS unsigned char* L, int G, const bf16* AQ, const float* KMEAN, int* gcnt, int* LIST) {
    int tid_ = threadIdx.x; asm volatile("" : "+v"(tid_)); const int tid = tid_, lane = tid & 63, wave = __builtin_amdgcn_readfirstlane(tid >> 6);
    const int r = lane & 31, hh = lane >> 5;
    LAS int* LCNT = (LAS int*)(L + GT_LCNT); LAS int* BASE = (LAS int*)(L + GT_BASE); LAS float* SC = (LAS float*)(L + GT_SC);
    int h_loaded = -1;
    int it = (int)blockIdx.x;
    while (it < 1024 && (it >> 4) == 0) it += G;
    if (it >= 1024) return;
    v4u qn[4];
#pragma unroll
    for (int j = 0; j < 4; ++j) { const int i = tid + 512 * j, rl = i >> 4, ch = i & 15; qn[j] = *(const GAS v4u*)(AQ + (size_t)(128 * (it >> 3) + rl) * 1024 + (it & 7) * 128 + ch * 8); }
    for (;;) {
        const int qi = it >> 3, h = it & 7, cur = qi >> 1;
        int itn = it + G; const bool has_next = itn < 1024;
        if (h != h_loaded) {
            for (int i = tid; i < 64 * 128; i += 512) { const int bb = i >> 7, d = i & 127; const float v = KMEAN[((size_t)h * 64 + bb) * 128 + d];
                const unsigned hi = f2bf(v), lo = f2bf(v - bf2f((unsigned short)hi));
                *(LAS unsigned short*)(L + GT_KH + bb * 272 + d * 2) = (unsigned short)hi; *(LAS unsigned short*)(L + GT_KL + bb * 272 + d * 2) = (unsigned short)lo; }
            h_loaded = h; }
#pragma unroll
        for (int j = 0; j < 4; ++j) { const int i = tid + 512 * j, rl = i >> 4, ch = i & 15; *(LAS v4u*)(L + AT_QS + rl * 272 + ch * 16) = qn[j]; }
        if (tid < 64) LCNT[tid] = 0;
        LDS_WAIT(); __syncthreads();
        if (has_next) {
#pragma unroll
            for (int j = 0; j < 4; ++j) { const int i = tid + 512 * j, rl = i >> 4, ch = i & 15; qn[j] = *(const GAS v4u*)(AQ + (size_t)(128 * (itn >> 3) + rl) * 1024 + (itn & 7) * 128 + ch * 8); }
        }
        {   const int tt = wave >> 1, bt = wave & 1; f32x16 S;
#pragma unroll
            for (int i = 0; i < 16; ++i) S[i] = 0.f;
#pragma unroll
            for (int kk = 0; kk < 8; ++kk) {
                const bf16x8 a = *(const LAS bf16x8*)(L + AT_QS + (32 * tt + r) * 272 + (16 * kk + 8 * hh) * 2);
                const bf16x8 bh = *(const LAS bf16x8*)(L + GT_KH + (32 * bt + r) * 272 + (16 * kk + 8 * hh) * 2), bl = *(const LAS bf16x8*)(L + GT_KL + (32 * bt + r) * 272 + (16 * kk + 8 * hh) * 2);
                S = __builtin_amdgcn_mfma_f32_32x32x16_bf16(a, bh, S, 0, 0, 0); S = __builtin_amdgcn_mfma_f32_32x32x16_bf16(a, bl, S, 0, 0, 0);
            }
#pragma unroll
            for (int i = 0; i < 16; ++i) SC[(32 * tt + (i & 3) + 8 * (i >> 2) + 4 * hh) * 65 + 32 * bt + r] = S[i];
        }
        LDS_WAIT(); __syncthreads();
        int p0 = -1, p1 = -1, p2 = -1, l0 = 0, l1 = 0, l2 = 0; const int nsel = cur < 3 ? cur : 3;
        if (tid < 128) {
            float v0 = -INFINITY, v1 = -INFINITY, v2 = -INFINITY;
            for (int b = 0; b < cur; ++b) { const float sc = SC[tid * 65 + b];
                if (sc > v0) { v2 = v1; p2 = p1; v1 = v0; p1 = p0; v0 = sc; p0 = b; }
                else if (sc > v1) { v2 = v1; p2 = p1; v1 = sc; p1 = b; }
                else if (sc > v2) { v2 = sc; p2 = b; } }
            if (nsel > 0 && p0 >= 0) l0 = __hip_atomic_fetch_add(LCNT + p0, 1, __ATOMIC_RELAXED, __HIP_MEMORY_SCOPE_WORKGROUP);
            if (nsel > 1 && p1 >= 0) l1 = __hip_atomic_fetch_add(LCNT + p1, 1, __ATOMIC_RELAXED, __HIP_MEMORY_SCOPE_WORKGROUP);
            if (nsel > 2 && p2 >= 0) l2 = __hip_atomic_fetch_add(LCNT + p2, 1, __ATOMIC_RELAXED, __HIP_MEMORY_SCOPE_WORKGROUP);
        }
        LDS_WAIT(); __syncthreads();
        if (tid < cur) { const int n = LCNT[tid]; if (n > 0) BASE[tid] = __hip_atomic_fetch_add(gcnt + h * 64 + tid, n, __ATOMIC_RELAXED, __HIP_MEMORY_SCOPE_AGENT); }
        LDS_WAIT(); __syncthreads();
        if (tid < 128) { const int tg = (128 * qi + tid) << 2;
            if (nsel > 0 && p0 >= 0) LIST[list_off(h, p0) + BASE[p0] + l0] = tg | 0;
            if (nsel > 1 && p1 >= 0) LIST[list_off(h, p1) + BASE[p1] + l1] = tg | 1;
            if (nsel > 2 && p2 >= 0) LIST[list_off(h, p2) + BASE[p2] + l2] = tg | 2; }
        LDS_WAIT(); __syncthreads();
        if (!has_next) break;
        it = itn;
    }
}

constexpr int AP_QS0 = 0, AP_QS1 = 34816, AP_PS = 69632, AP_PM = 137216, AP_PSUM = 141312, AP_ENT0 = 145408, AP_ENT1 = 145920, AP_W = 146432, AP_MX = 148480, AP_PRE = 148992  , AP_WT = 151072;
struct AItem { int h, b, row0, nrows, qi; const int* list; bool valid; };
template <bool OWN>
__device__ __forceinline__ AItem attn_get(int k, int G, const LAS int* PRE, int total, const int* gcnt, const int* LIST) {
    AItem it; const int idx = (int)blockIdx.x + k * G;
    if (OWN) { it.valid = idx < 1024; it.qi = idx >> 3; it.h = idx & 7; it.b = it.qi >> 1; it.row0 = 128 * it.qi; it.nrows = 128; it.list = nullptr; }
    else {
        it.valid = idx < total; it.qi = 0; int lo = 0, hi = 512;
        if (it.valid) { while (hi - lo > 1) { const int mid = (lo + hi) >> 1; if (PRE[mid] <= idx) lo = mid; else hi = mid; } }
        const int hb = lo; it.h = hb >> 6; it.b = hb & 63; const int i = it.valid ? idx - PRE[hb] : 0, n = it.valid ? gcnt[hb] : 0;
        it.row0 = 128 * i; it.nrows = (n - 128 * i) < 128 ? (n - 128 * i) : 128; it.list = LIST + list_off(it.h, it.b);
    }
    return it;
}
template <bool OWN>
__device__ __forceinline__ void attn_phase(LAS unsigned char* L, int G, const int* gcnt, const int* LIST, const bf16* AQ, const bf16* XK, const bf16* XVT, bf16* PO, float* ML, bf16* AOUT, int tmask, int probe = 0) {
    int tid_ = threadIdx.x; asm volatile("" : "+v"(tid_)); const int tid = tid_, lane = tid & 63, wave = __builtin_amdgcn_readfirstlane(tid >> 6);
    const int r = lane & 31, hh = lane >> 5;
    LAS int* PRE = (LAS int*)(L + AP_PRE); LAS int* WT = (LAS int*)(L + AP_WT);
    LAS float* PM = (LAS float*)(L + AP_PM); LAS float* PSUM = (LAS float*)(L + AP_PSUM); LAS float* MX = (LAS float*)(L + AP_MX); LAS float* W = (LAS float*)(L + AP_W);
    int total = 0;
    if (!OWN) {
        int v = (gcnt[tid] + 127) >> 7;
#pragma unroll
        for (int o = 1; o < 64; o <<= 1) { const int u = __builtin_amdgcn_ds_bpermute((lane - o) << 2, v); if (lane >= o) v += u; }
        if (lane == 63) WT[wave] = v;
        LDS_WAIT(); __syncthreads();
        int add = 0;
#pragma unroll
        for (int w8 = 0; w8 < 8; ++w8) if (w8 < wave) add += WT[w8];
        PRE[tid + 1] = v + add; if (tid == 0) PRE[0] = 0;
        LDS_WAIT(); __syncthreads();
        total = PRE[512];
    }
    AItem cur = attn_get<OWN>(0, G, PRE, total, gcnt, LIST);
    if (!cur.valid) return;
    int pb = 0;
    {   LAS int* ENT = (LAS int*)(L + AP_ENT0);
        if (!OWN) { if (tid < 128) ENT[tid] = (tid < cur.nrows) ? cur.list[cur.row0 + tid] : -1; LDS_WAIT(); __syncthreads(); }
        for (int i = tid; i < 2048; i += 512) { const int rl = i >> 4, ch = i & 15; int t;
            if (OWN) t = cur.row0 + rl; else { const int e = ENT[rl]; t = e >= 0 ? (e >> 2) : 0; }
            const v4u v = *(const GAS v4u*)(AQ + (size_t)t * 1024 + cur.h * 128 + ch * 8); *(LAS v4u*)(L + AP_QS0 + rl * 272 + ch * 16) = v; }
        LDS_WAIT(); __syncthreads();
    }
    for (int k = 0; ; ++k) {
        const AItem nxt = attn_get<OWN>(k + 1, G, PRE, total, gcnt, LIST);
        const int h = (probe & 2) ? 0 : cur.h, b = (probe & 2) ? 0 : cur.b, qi = cur.qi, row0 = cur.row0;
        LAS unsigned char* Qc = L + (pb ? AP_QS1 : AP_QS0); LAS unsigned char* Qn = L + (pb ? AP_QS0 : AP_QS1);
        LAS int* ENT = (LAS int*)(L + (pb ? AP_ENT1 : AP_ENT0)); LAS int* ENTn = (LAS int*)(L + (pb ? AP_ENT0 : AP_ENT1));
        const int dt = wave & 3, tp = wave >> 2;
        bf16x8 kf[8], vf[16];
        {   const bf16* kp = XK + (((size_t)(b * 8 + h) * 8 + wave) * 8) * 512 + lane * 8;
#pragma unroll
            for (int kk = 0; kk < 8; ++kk) kf[kk] = *(const bf16x8*)(kp + 512 * kk);
            const bf16* vp = XVT + (((size_t)(b * 8 + h) * 4 + dt) * 16) * 512 + lane * 8;
#pragma unroll
            for (int kk = 0; kk < 16; ++kk) vf[kk] = *(const bf16x8*)(vp + 512 * kk);
        }
        int e_n = -1;
        if (!OWN && nxt.valid && tid < 128 && tid < nxt.nrows) e_n = nxt.list[nxt.row0 + tid];
        f32x16 S[4];
#pragma unroll
        for (int tq = 0; tq < 4; ++tq) {
#pragma unroll
            for (int i = 0; i < 16; ++i) S[tq][i] = 0.f;
#pragma unroll
            for (int kk = 0; kk < 8; ++kk) { const bf16x8 bq = *(const LAS bf16x8*)(Qc + (32 * tq + r) * 272 + (16 * kk + 8 * hh) * 2);
                S[tq] = __builtin_amdgcn_mfma_f32_32x32x16_bf16(kf[kk], bq, S[tq], 0, 0, 0); }
        }
#pragma unroll
        for (int tq = 0; tq < 4; ++tq) {
            const int t = 32 * tq + r; float ps = 0.f;
#pragma unroll
            for (int i = 0; i < 16; ++i) {
                float sv = S[tq][i];
                if (OWN) { const int key = 32 * wave + (i & 3) + 8 * (i >> 2) + 4 * hh, lim = (qi & 1) * 128 + t; if (key > lim) sv = -INFINITY; }
                const float p = __builtin_amdgcn_exp2f(sv); S[tq][i] = p; ps += p; }
            ps += sh_xor(ps, 32, lane);
            if (hh == 0) PSUM[wave * 128 + t] = ps;
#pragma unroll
            for (int g = 0; g < 4; ++g) { pg8::u32x2 w2; w2.x = pg8::cvt_pk_bf16(S[tq][4 * g], S[tq][4 * g + 1]); w2.y = pg8::cvt_pk_bf16(S[tq][4 * g + 2], S[tq][4 * g + 3]);
                *(LAS pg8::u32x2*)(L + AP_PS + t * 528 + (32 * wave + 8 * g + 4 * hh) * 2) = w2; }
        }
        if (!OWN && tid < 128) ENTn[tid] = e_n;
        LDS_WAIT(); __syncthreads();
        v4u qn[4];
        if (nxt.valid) {
#pragma unroll
            for (int j = 0; j < 4; ++j) { const int i = tid + 512 * j, rl = i >> 4, ch = i & 15; int t;
                if (OWN) t = nxt.row0 + rl; else { const int e = ENTn[rl]; t = e >= 0 ? (e >> 2) : 0; if (probe & 4) t = rl; }
                qn[j] = *(const GAS v4u*)(AQ + (size_t)t * 1024 + nxt.h * 128 + ch * 8); }
        }
        f32x16 O[2];
#pragma unroll
        for (int i = 0; i < 16; ++i) { O[0][i] = 0.f; O[1][i] = 0.f; }
#pragma unroll
        for (int kk = 0; kk < 16; ++kk) {
            const bf16x8 a0 = *(const LAS bf16x8*)(L + AP_PS + (64 * tp + r) * 528 + (16 * kk + 8 * hh) * 2), a1 = *(const LAS bf16x8*)(L + AP_PS + (64 * tp + 32 + r) * 528 + (16 * kk + 8 * hh) * 2);
            O[0] = __builtin_amdgcn_mfma_f32_32x32x16_bf16(a0, vf[kk], O[0], 0, 0, 0); O[1] = __builtin_amdgcn_mfma_f32_32x32x16_bf16(a1, vf[kk], O[1], 0, 0, 0);
        }
        const int curb = qi >> 1, nsel = curb < 3 ? curb : 3;
        if (OWN) {
            if (tid < 128) { const int t = row0 + tid; float Lo = 0.f;
#pragma unroll
                for (int w8 = 0; w8 < 8; ++w8) Lo += PSUM[w8 * 128 + tid];
                float den = Lo;
#pragma unroll
                for (int j = 0; j < 3; ++j) if (j < nsel) den += ML[((size_t)(t * 8 + h) * 3 + j) * 2 + 1];
                const float inv = 1.0f / den;
                W[tid * 4 + 0] = inv; W[tid * 4 + 1] = nsel > 0 ? inv : 0.f; W[tid * 4 + 2] = nsel > 1 ? inv : 0.f; W[tid * 4 + 3] = nsel > 2 ? inv : 0.f; }
        }
        LDS_WAIT(); __syncthreads();
        {   LAS float* OS = (LAS float*)(L + AP_PS);
#pragma unroll
            for (int q = 0; q < 2; ++q)
#pragma unroll
                for (int i = 0; i < 16; ++i) OS[(64 * tp + 32 * q + (i & 3) + 8 * (i >> 2) + 4 * hh) * 132 + 32 * dt + r] = O[q][i];
        }
        LDS_WAIT(); __syncthreads();
        {   const LAS float* OS = (const LAS float*)(L + AP_PS);
            const int rl = tid >> 2, c4 = tid & 3;
            if (!OWN) {
                const int e = (probe & 1) ? -1 : ENT[rl];
                if (e >= 0) {
                    const int te = e >> 2; bf16* dst = (te < PO_SPLIT ? PO : PO + (WS_PO2 - WS_PO) / 2 - (size_t)PO_SPLIT * 3072) + ((size_t)(te * 8 + h) * 3 + (e & 3)) * 128;
#pragma unroll
                    for (int kq = 0; kq < 4; ++kq) { const int ch = c4 + 4 * kq; const f32x4 a = *(const LAS f32x4*)(OS + rl * 132 + ch * 8), b2 = *(const LAS f32x4*)(OS + rl * 132 + ch * 8 + 4);
                        v4u w; w.x = pg8::cvt_pk_bf16(a[0], a[1]); w.y = pg8::cvt_pk_bf16(a[2], a[3]); w.z = pg8::cvt_pk_bf16(b2[0], b2[1]); w.w = pg8::cvt_pk_bf16(b2[2], b2[3]);
                        *(GAS v4u*)(dst + ch * 8) = w; }
                    if (c4 == 0) { float Ls = 0.f;
#pragma unroll
                        for (int w8 = 0; w8 < 8; ++w8) Ls += PSUM[w8 * 128 + rl];
                        float* ml = ML + ((size_t)((e >> 2) * 8 + h) * 3 + (e & 3)) * 2; ml[0] = 0.f; ml[1] = Ls; }
                }
            } else {
                const int t = row0 + rl; const f32x4 w4 = *(const LAS f32x4*)(W + rl * 4);
                const bf16* po = (t < PO_SPLIT ? PO : PO + (WS_PO2 - WS_PO) / 2 - (size_t)PO_SPLIT * 3072) + ((size_t)(t * 8 + h) * 3) * 128;
                const unsigned m0 = nsel > 0 ? 0xffffffffu : 0u, m1 = nsel > 1 ? 0xffffffffu : 0u, m2 = nsel > 2 ? 0xffffffffu : 0u;
#pragma unroll
                for (int kq = 0; kq < 4; ++kq) { const int ch = c4 + 4 * kq;
                    const f32x4 a = *(const LAS f32x4*)(OS + rl * 132 + ch * 8), b2 = *(const LAS f32x4*)(OS + rl * 132 + ch * 8 + 4);
                    v4u p0 = *(const GAS v4u*)(po + ch * 8), p1 = *(const GAS v4u*)(po + 128 + ch * 8), p2 = *(const GAS v4u*)(po + 256 + ch * 8);
                    p0 = p0 & m0; p1 = p1 & m1; p2 = p2 & m2;
                    float o8[8] = {a[0] * w4[0], a[1] * w4[0], a[2] * w4[0], a[3] * w4[0], b2[0] * w4[0], b2[1] * w4[0], b2[2] * w4[0], b2[3] * w4[0]};
#pragma unroll
                    for (int x2 = 0; x2 < 4; ++x2) {
                        o8[2 * x2] += w4[1] * __builtin_bit_cast(float, p0[x2] << 16) + w4[2] * __builtin_bit_cast(float, p1[x2] << 16) + w4[3] * __builtin_bit_cast(float, p2[x2] << 16);
                        o8[2 * x2 + 1] += w4[1] * __builtin_bit_cast(float, p0[x2] & 0xffff0000u) + w4[2] * __builtin_bit_cast(float, p1[x2] & 0xffff0000u) + w4[3] * __builtin_bit_cast(float, p2[x2] & 0xffff0000u); }
                    v4u w; w.x = pg8::cvt_pk_bf16(o8[0], o8[1]); w.y = pg8::cvt_pk_bf16(o8[2], o8[3]); w.z = pg8::cvt_pk_bf16(o8[4], o8[5]); w.w = pg8::cvt_pk_bf16(o8[6], o8[7]);
                    *(GAS v4u*)(AOUT + (size_t)(t & tmask) * 1024 + h * 128 + ch * 8) = w; }
            }
        }
        if (nxt.valid) {
#pragma unroll
            for (int j = 0; j < 4; ++j) { const int i = tid + 512 * j, rl = i >> 4, ch = i & 15; *(LAS v4u*)(Qn + rl * 272 + ch * 16) = qn[j]; }
        }
        LDS_WAIT(); __syncthreads();
        if (!nxt.valid) break;
        cur = nxt; pb ^= 1;
    }
}


struct Args { const float* in[18]; float* out; unsigned char* ws; unsigned long long ws_size; };

typedef const __attribute__((address_space(4))) Args* KArgsP;
#define KA() ({ KArgsP p_ = (KArgsP)__builtin_amdgcn_kernarg_segment_ptr(); asm volatile("" : "+s"(p_)); p_; })
#define AIN(i) ((const float*)KA()->in[i])
#define WSB ((unsigned char*)KA()->ws)
#define XIN AIN(0)
#define OUTP ((float*)KA()->out)
#define SS ((float*)(WSB + WS_SS))
#define HBP ((bf16*)(WSB + WS_HB))
#define HB ((bf16*)(WSB + WS_HB + HB_ROW0))
#define ACT ((bf16*)(WSB + WS_ACT))
constexpr int H2_BYTES = 69632, H2_QS = 0  , H2_PS = 17408  , H2_OS = 51200  ;
constexpr int H2_PSUM = 139264  , H2_ENT = 143360  , H2_PRE = 144896  , H2_WT = 146976, H2_GL = 147072  ;
#define H2_BAR() do { asm volatile("s_waitcnt lgkmcnt(0)" ::: "memory"); __builtin_amdgcn_s_barrier(); asm volatile("" ::: "memory"); } while (0)
template <bool OWN>
__device__ __forceinline__ void attn_store_rows(LAS unsigned char* L, int hf, int ht, int par, int eslot, const AItem& it, bf16* PO, float* ML, bf16* AOUT, int tmask, bool live, unsigned char* dump) {
    const int rl = ht >> 2, c4 = ht & 3, h = it.h;
    const LAS float* PSUM = (const LAS float*)(L + H2_PSUM) + (par * 2 + hf) * 256; const LAS int* ENT = (const LAS int*)(L + H2_ENT) + eslot * 128;
    const LAS unsigned char* OSb = L + hf * H2_BYTES + H2_OS + rl * 272;
    const float Ls = (PSUM[rl] + PSUM[64 + rl]) + (PSUM[128 + rl] + PSUM[192 + rl]);
    if (!OWN) {
        const int e = ENT[64 * hf + rl]; const bool ok = live && e >= 0; const int es_ = e >= 0 ? e : 0;
        const int te = es_ >> 2; bf16* dst = (te < PO_SPLIT ? PO : PO + (WS_PO2 - WS_PO) / 2 - (size_t)PO_SPLIT * 3072) + ((size_t)(te * 8 + h) * 3 + (es_ & 3)) * 128;
        if (!ok) dst = (bf16*)dump;
#pragma unroll
        for (int kq = 0; kq < 4; ++kq) { const int ch = c4 + 4 * kq; *(GAS v4u*)(dst + ch * 8) = *(const LAS v4u*)(OSb + ch * 16); }
        float* ml = ML + ((size_t)(te * 8 + h) * 3 + (es_ & 3)) * 2; if (!ok || c4 != 0) ml = (float*)(dump + 512);
        ml[0] = 0.f; ml[1] = Ls;
    } else {
        const int t = it.row0 + 64 * hf + rl, curb = it.qi >> 1, nsel = curb < 3 ? curb : 3;
        float den = Ls;
#pragma unroll
        for (int j = 0; j < 3; ++j) { const float lj = ML[((size_t)(t * 8 + h) * 3 + j) * 2 + 1]; den += (j < nsel) ? lj : 0.f; }
        const float inv = 1.0f / den;
        const bf16* po = (t < PO_SPLIT ? PO : PO + (WS_PO2 - WS_PO) / 2 - (size_t)PO_SPLIT * 3072) + ((size_t)(t * 8 + h) * 3) * 128;
        const unsigned m0 = nsel > 0 ? 0xffffffffu : 0u, m1 = nsel > 1 ? 0xffffffffu : 0u, m2 = nsel > 2 ? 0xffffffffu : 0u;
        bf16* orow = live ? AOUT + (size_t)(t & tmask) * 1024 + h * 128 : (bf16*)dump;
#pragma unroll
        for (int kq = 0; kq < 4; ++kq) { const int ch = c4 + 4 * kq;
            const v4u a = *(const LAS v4u*)(OSb + ch * 16);
            v4u p0 = *(const GAS v4u*)(po + ch * 8), p1 = *(const GAS v4u*)(po + 128 + ch * 8), p2 = *(const GAS v4u*)(po + 256 + ch * 8);
            p0 = p0 & m0; p1 = p1 & m1; p2 = p2 & m2;
            float o8[8];
#pragma unroll
            for (int x2 = 0; x2 < 4; ++x2) {
                o8[2 * x2] = (__builtin_bit_cast(float, a[x2] << 16) + __builtin_bit_cast(float, p0[x2] << 16) + __builtin_bit_cast(float, p1[x2] << 16) + __builtin_bit_cast(float, p2[x2] << 16)) * inv;
                o8[2 * x2 + 1] = (__builtin_bit_cast(float, a[x2] & 0xffff0000u) + __builtin_bit_cast(float, p0[x2] & 0xffff0000u) + __builtin_bit_cast(float, p1[x2] & 0xffff0000u) + __builtin_bit_cast(float, p2[x2] & 0xffff0000u)) * inv; }
            v4u w; w.x = pg8::cvt_pk_bf16n(o8[0], o8[1]); w.y = pg8::cvt_pk_bf16n(o8[2], o8[3]); w.z = pg8::cvt_pk_bf16n(o8[4], o8[5]); w.w = pg8::cvt_pk_bf16n(o8[6], o8[7]);
            *(GAS v4u*)(orow + ch * 8) = w; }
    }
}
struct AWalk { int idx, end, hb; };
template <bool OWN>
__device__ __forceinline__ AItem attn_at(const AWalk& w, const LAS int* PRE, const LAS int* GL, const int* LIST) {
    AItem it; it.valid = w.idx < w.end;
    if (OWN) { const int ix = it.valid ? w.idx : 0; it.qi = ix >> 3; it.h = ix & 7; it.b = it.qi >> 1; it.row0 = 128 * it.qi; it.nrows = 128; it.list = nullptr; }
    else { const int hb = w.hb; it.qi = 0; it.h = hb >> 6; it.b = hb & 63; const int i = it.valid ? w.idx - PRE[hb] : 0, n = it.valid ? GL[hb] : 0;
        it.row0 = 128 * i; it.nrows = (n - 128 * i) < 128 ? (n - 128 * i) : 128; it.list = LIST + list_off(it.h, it.b); }
    return it;
}
template <bool OWN>
__device__ __forceinline__ void attn_step(AWalk& w, int G, const LAS int* PRE) {
    if (OWN) { w.idx += G; return; }
    w.idx += 1;
    if (w.idx < w.end) { while (PRE[w.hb + 1] <= w.idx) ++w.hb; }
}
template <bool OWN>
__device__ __forceinline__ void attn_phase2(LAS unsigned char* L, int G, const int* gcnt, const int* LIST, const bf16* AQ, const bf16* XK, const bf16* XVT, bf16* PO, float* ML, bf16* AOUT, int tmask, unsigned char* dump) {
    int tid_ = threadIdx.x; asm volatile("" : "+v"(tid_)); int tid = tid_, lane = tid & 63; const int wave = __builtin_amdgcn_readfirstlane(tid >> 6);
    int r = lane & 31, hh = lane >> 5, ht = tid & 255; const int hw = wave & 3, hf = wave >> 2;
    LAS int* PRE = (LAS int*)(L + H2_PRE); LAS int* WT = (LAS int*)(L + H2_WT); LAS int* GL = (LAS int*)(L + H2_GL);
    LAS unsigned char* HB_ = L + hf * H2_BYTES;
    AWalk w;
    if (!OWN) {
        const int gc = gcnt[tid]; GL[tid] = gc;
        int v = (gc + 127) >> 7;
#pragma unroll
        for (int o = 1; o < 64; o <<= 1) { const int u = __builtin_amdgcn_ds_bpermute((lane - o) << 2, v); if (lane >= o) v += u; }
        if (lane == 63) WT[wave] = v;
        LDS_WAIT(); __syncthreads();
        int add = 0;
#pragma unroll
        for (int w8 = 0; w8 < 8; ++w8) if (w8 < wave) add += WT[w8];
        PRE[tid + 1] = v + add; if (tid == 0) PRE[0] = 0;
        LDS_WAIT(); __syncthreads();
        const unsigned total = (unsigned)PRE[512];
        w.idx = (int)(((unsigned)blockIdx.x * total) / (unsigned)G); w.end = (int)((((unsigned)blockIdx.x + 1u) * total) / (unsigned)G);
        int lo = 0, hi = 512;
        if (w.idx < w.end) { while (hi - lo > 1) { const int mid = (lo + hi) >> 1; if (PRE[mid] <= w.idx) lo = mid; else hi = mid; } }
        w.hb = lo;
    } else { w.idx = (int)blockIdx.x; w.end = 1024; w.hb = 0; }
    AItem cur = attn_at<OWN>(w, PRE, GL, LIST);
    if (!cur.valid) return;
    attn_step<OWN>(w, G, PRE); AItem nxt = attn_at<OWN>(w, PRE, GL, LIST);
    {   LAS int* ENT = (LAS int*)(L + H2_ENT);
        if (!OWN) { if (tid < 128) { ENT[tid] = (tid < cur.nrows) ? cur.list[cur.row0 + tid] : -1; ENT[128 + tid] = (nxt.valid && tid < nxt.nrows) ? nxt.list[nxt.row0 + tid] : -1; } LDS_WAIT(); __syncthreads(); }
#pragma unroll
        for (int j = 0; j < 4; ++j) { const int i = ht + 256 * j, rl = i >> 4, ch = i & 15; int t;
            if (OWN) t = cur.row0 + 64 * hf + rl; else { const int e = ENT[64 * hf + rl]; t = e >= 0 ? (e >> 2) : 0; }
            *(LAS v4u*)(HB_ + H2_QS + rl * 272 + ch * 16) = *(const GAS v4u*)(AQ + (size_t)t * 1024 + cur.h * 128 + ch * 8); }
        LDS_WAIT(); __syncthreads();
    }
    bf16x8 kf[2][8], vf[16]; v4u qn[4]; int e_n = -1;
#define H2_LD_K(IT) do { const bf16* kp_ = XK + (((size_t)((IT).b * 8 + (IT).h) * 8 + 2 * hw) * 8) * 512 + lane * 8; _Pragma("unroll") for (int kt = 0; kt < 2; ++kt) _Pragma("unroll") for (int kk = 0; kk < 8; ++kk) kf[kt][kk] = *(const bf16x8*)(kp_ + (size_t)(kt * 8 + kk) * 512); } while (0)
#define H2_LD_V(IT) do { const bf16* vp_ = XVT + (((size_t)((IT).b * 8 + (IT).h) * 4 + hw) * 16) * 512 + lane * 8; _Pragma("unroll") for (int kk = 0; kk < 16; ++kk) vf[kk] = *(const bf16x8*)(vp_ + (size_t)kk * 512); } while (0)
    H2_LD_K(cur);
    if (hf == 1) H2_BAR();
    AItem prv = cur; bool have_prev = false; int par = 0, es = 0;
    for (int k = 0; ; ++k) {
        { int t2_ = threadIdx.x; asm volatile("" : "+v"(t2_)); tid = t2_; lane = tid & 63; r = lane & 31; hh = lane >> 5; ht = tid & 255; }
        attn_step<OWN>(w, G, PRE); const AItem nx2 = attn_at<OWN>(w, PRE, GL, LIST);
        const int es1 = es == 2 ? 0 : es + 1, es2 = es1 == 2 ? 0 : es1 + 1;
        LAS float* PSUM = (LAS float*)(L + H2_PSUM) + (par * 2 + hf) * 256;
        if (!OWN) { const int tl = tid & 127; const bool in = tl < nx2.nrows; const int ev = nx2.list[in ? nx2.row0 + tl : 0]; e_n = in ? ev : -1; }
        {
            const LAS int* ENT1 = (const LAS int*)(L + H2_ENT) + es1 * 128;
#pragma unroll
            for (int j = 0; j < 4; ++j) { const int i = ht + 256 * j, rl = i >> 4, ch = i & 15; int t;
                if (OWN) t = nxt.row0 + 64 * hf + rl; else { const int e = ENT1[64 * hf + rl]; t = e >= 0 ? (e >> 2) : 0; }
                qn[j] = *(const GAS v4u*)(AQ + (size_t)t * 1024 + nxt.h * 128 + ch * 8); }
        }
        f32x16 S[2][2];
#pragma unroll
        for (int kt = 0; kt < 2; ++kt)
#pragma unroll
            for (int tq = 0; tq < 2; ++tq) {
#pragma unroll
                for (int i = 0; i < 16; ++i) S[kt][tq][i] = 0.f;
#pragma unroll
                for (int kk = 0; kk < 8; ++kk) { const bf16x8 bq = *(const LAS bf16x8*)(HB_ + H2_QS + (32 * tq + r) * 272 + (16 * kk + 8 * hh) * 2);
                    S[kt][tq] = __builtin_amdgcn_mfma_f32_32x32x16_bf16(kf[kt][kk], bq, S[kt][tq], 0, 0, 0); }
            }
        H2_LD_V(cur);
        H2_BAR();
#pragma unroll
        for (int tq = 0; tq < 2; ++tq) {
            const int t = 32 * tq + r; float ps = 0.f;
#pragma unroll
            for (int kt = 0; kt < 2; ++kt) {
#pragma unroll
                for (int i = 0; i < 16; ++i) {
                    float sv = S[kt][tq][i];
                    if (OWN) { const int key = 64 * hw + 32 * kt + (i & 3) + 8 * (i >> 2) + 4 * hh, lim = (cur.qi & 1) * 128 + 64 * hf + t; if (key > lim) sv = -INFINITY; }
                    const float p = __builtin_amdgcn_exp2f(sv); S[kt][tq][i] = p; ps += p; }
#pragma unroll
                for (int g = 0; g < 4; ++g) { pg8::u32x2 w2; w2.x = pg8::cvt_pk_bf16n(S[kt][tq][4 * g], S[kt][tq][4 * g + 1]); w2.y = pg8::cvt_pk_bf16n(S[kt][tq][4 * g + 2], S[kt][tq][4 * g + 3]);
                    *(LAS pg8::u32x2*)(HB_ + H2_PS + t * 528 + (64 * hw + 32 * kt + 8 * g + 4 * hh) * 2) = w2; }
            }
            ps += sh_xor(ps, 32, lane);
            if (hh == 0) PSUM[hw * 64 + t] = ps;
        }
        attn_store_rows<OWN>(L, hf, ht, par ^ 1, have_prev ? (es == 0 ? 2 : es - 1) : es, prv, PO, ML, AOUT, tmask, have_prev, dump);
        H2_BAR();
        H2_LD_K(nxt);
        f32x16 O[2];
#pragma unroll
        for (int i = 0; i < 16; ++i) { O[0][i] = 0.f; O[1][i] = 0.f; }
#pragma unroll
        for (int kk = 0; kk < 16; ++kk) {
            const bf16x8 a0 = *(const LAS bf16x8*)(HB_ + H2_PS + r * 528 + (16 * kk + 8 * hh) * 2), a1 = *(const LAS bf16x8*)(HB_ + H2_PS + (32 + r) * 528 + (16 * kk + 8 * hh) * 2);
            O[0] = __builtin_amdgcn_mfma_f32_32x32x16_bf16(a0, vf[kk], O[0], 0, 0, 0); O[1] = __builtin_amdgcn_mfma_f32_32x32x16_bf16(a1, vf[kk], O[1], 0, 0, 0);
        }
        H2_BAR();
#pragma unroll
        for (int tq = 0; tq < 2; ++tq)
#pragma unroll
            for (int i = 0; i < 16; ++i) *(LAS unsigned short*)(HB_ + H2_OS + (32 * tq + (i & 3) + 8 * (i >> 2) + 4 * hh) * 272 + (32 * hw + r) * 2) = (unsigned short)f2bf(O[tq][i]);
#pragma unroll
        for (int j = 0; j < 4; ++j) { const int i = ht + 256 * j, rl = i >> 4, ch = i & 15; *(LAS v4u*)(HB_ + H2_QS + rl * 272 + ch * 16) = qn[j]; }
        if (!OWN && nx2.valid && hf == 0 && tid < 128) ((LAS int*)(L + H2_ENT))[es2 * 128 + tid] = e_n;
        H2_BAR();
        prv = cur; have_prev = true; par ^= 1; es = es1;
        if (!nxt.valid) break;
        cur = nxt; nxt = nx2;
    }
    if (hf == 0) H2_BAR();
    { int t2_ = threadIdx.x; asm volatile("" : "+v"(t2_)); ht = t2_ & 255; }
    attn_store_rows<OWN>(L, hf, ht, par ^ 1, es == 0 ? 2 : es - 1, prv, PO, ML, AOUT, tmask, true, dump);
    LDS_WAIT(); __syncthreads();
#undef H2_LD_K
#undef H2_LD_V
}

enum { WK_IN = 0, WK_OUT, WK_KV, WK_Q, WK_O, WK_UP, WK_DN };
constexpr int I_IN = 16 * 96, I_SQ = 16 * 32, I_KV = 16 * 64, I_UP = 16 * 176, I_DN = 44 * 32;
#define AIN2(i) AIN(i)
#define WSB2 WSB
__device__ __forceinline__ void weight_item(int kind, int l, int r, LAS float* scr, int lane) {
    if (kind == WK_IN) { const int kb = r / 96, nb = r % 96, c0 = nb * 32;
        const float* W = AIN2(2) + (size_t)l * D * MIN_; const float* g = AIN2(1) + l * D;
        bf16* WR = (bf16*)(WSB2 + WS_WINR) + (size_t)l * 1536 * D; bf16* WTt = (bf16*)(WSB2 + WS_WINT) + (size_t)l * 1536 * D;
        if (c0 < 512) transpose_item(W, MIN_, kb * 64, c0, g, WR, D, c0, nullptr, 0, scr, lane);
        else if (c0 < 1024) transpose_item(W, MIN_, kb * 64, c0, g, WTt, D, c0 - 512, nullptr, 0, scr, lane);
        else if (c0 < 2048) transpose_item(W, MIN_, kb * 64, c0, g, WTt, D, 512 + c0 - 1024, nullptr, 0, scr, lane);
        else transpose_item(W, MIN_, kb * 64, c0, g, WR, D, 512 + c0 - 2048, nullptr, 0, scr, lane);
    } else if (kind == WK_OUT) { const int kb = r / 32, nb = r % 32;
        transpose_item(AIN2(5) + (size_t)l * D * D, D, kb * 64, nb * 32, nullptr, (bf16*)(WSB2 + WS_WOUT) + (size_t)l * D * D, D, nb * 32, nullptr, 0, scr, lane);
    } else if (kind == WK_KV) { const int kb = r / 64, nb = r % 64, c0 = nb * 32;
        if (c0 < 1024) transpose_item(AIN2(7), 2048, kb * 64, c0, AIN2(6), (bf16*)(WSB2 + WS_WK), D, c0, nullptr, 0, scr, lane);
        else transpose_item(AIN2(7), 2048, kb * 64, c0, AIN2(6), (bf16*)(WSB2 + WS_WV), D, c0 - 1024, nullptr, 0, scr, lane);
    } else if (kind == WK_Q) { const int kb = r / 32, nb = r % 32;
        transpose_item(AIN2(10) + (size_t)l * D * D, D, kb * 64, nb * 32, AIN2(9) + l * D, (bf16*)(WSB2 + WS_WQ) + (size_t)l * D * D, D, nb * 32, nullptr, 0, scr, lane);
    } else if (kind == WK_O) { const int kb = r / 32, nb = r % 32;
        transpose_item(AIN2(12) + (size_t)l * D * D, D, kb * 64, nb * 32, nullptr, (bf16*)(WSB2 + WS_WO) + (size_t)l * D * D, D, nb * 32, nullptr, 0, scr, lane);
    } else if (kind == WK_UP) { const int kb = r / 176, nb = r % 176, c0 = nb * 32;
        const int bj = c0 >= FF, cp = c0 - bj * FF, d0 = (cp / 128) * 256 + bj * 128 + (cp % 128);
        transpose_item(AIN2(14) + (size_t)l * D * FF2, FF2, kb * 64, c0, AIN2(13) + l * D, (bf16*)(WSB2 + WS_WUP) + (size_t)l * FF2 * D, D, d0, nullptr, 0, scr, lane);
    } else { const int kb = r / 32, nb = r % 32;
        transpose_item(AIN2(17) + (size_t)l * FF * D, D, kb * 64, nb * 32, nullptr, (bf16*)(WSB2 + WS_WDN) + (size_t)l * D * FF, FF, nb * 32, nullptr, 0, scr, lane); }
}
__device__ __forceinline__ void weight_set(int set, int widx, int nw, LAS float* scr, int lane) {
    if (set == 0) {
        for (int it = widx; it < I_IN; it += nw) weight_item(WK_IN, 0, it, scr, lane);
    } else if (set == 1) {
        constexpr int N = (I_SQ + I_UP + I_DN) + (I_IN + I_SQ + I_UP + I_DN);
        for (int it = widx; it < N; it += nw) { int r = it;
            if (r < I_SQ) { weight_item(WK_OUT, 0, r, scr, lane); continue; } r -= I_SQ;
            if (r < I_UP) { weight_item(WK_UP, 0, r, scr, lane); continue; } r -= I_UP;
            if (r < I_DN) { weight_item(WK_DN, 0, r, scr, lane); continue; } r -= I_DN;
            if (r < I_IN) { weight_item(WK_IN, 1, r, scr, lane); continue; } r -= I_IN;
            if (r < I_SQ) { weight_item(WK_OUT, 1, r, scr, lane); continue; } r -= I_SQ;
            if (r < I_UP) { weight_item(WK_UP, 1, r, scr, lane); continue; } r -= I_UP;
            weight_item(WK_DN, 1, r, scr, lane); }
    } else {
        constexpr int N = I_KV + 4 * I_SQ + 2 * I_UP + 2 * I_DN;
        for (int it = widx; it < N; it += nw) { int r = it;
            if (r < I_KV) { weight_item(WK_KV, 0, r, scr, lane); continue; } r -= I_KV;
            if (r < 2 * I_SQ) { weight_item(WK_Q, r / I_SQ, r % I_SQ, scr, lane); continue; } r -= 2 * I_SQ;
            if (r < 2 * I_SQ) { weight_item(WK_O, r / I_SQ, r % I_SQ, scr, lane); continue; } r -= 2 * I_SQ;
            if (r < 2 * I_UP) { weight_item(WK_UP, 2 + r / I_UP, r % I_UP, scr, lane); continue; } r -= 2 * I_UP;
            weight_item(WK_DN, 2 + r / I_DN, r % I_DN, scr, lane); }
    }
}

__global__ void __launch_bounds__(NWAVES * 64, 2) yoco_fwd(Args args) {
    extern __shared__ __attribute__((aligned(16))) unsigned char lds[];
    LAS unsigned char* L = (LAS unsigned char*)lds;
    volatile LAS unsigned* MISC = (volatile LAS unsigned*)(L + MISC_OFF);
    const int tid = threadIdx.x, lane = tid & 63, wave = __builtin_amdgcn_readfirstlane(tid >> 6);
    const int G = gridDim.x;
    for (int u = tid; u < (LDS_BYTES - RING_BYTES) / 4; u += NWAVES * 64) ((LAS unsigned*)(L + RING_BYTES))[u] = 0u;
    __syncthreads();
    (void)xcd_barrier_post((unsigned*)(WSB + WS_CTL) + CW_BAR, MISC + 8);
#define GRID_BAR() do { XcdBarrier b_; b_.bar = (unsigned*)(WSB + WS_CTL) + CW_BAR; b_.x = xb_xcc_id(); b_.st = (volatile LAS unsigned*)(L + MISC_OFF) + 8; xcd_barrier(b_); } while (0)

    for (int rp_ = 0; rp_ < REPS(1); ++rp_) {
        LAS float* scr = (LAS float*)(L + wave * 16384);
        const int gw = blockIdx.x * NWAVES + wave, NGW = G * NWAVES;
        weight_set(0, gw, NGW, scr, lane);
        { const int gt = blockIdx.x * (NWAVES * 64) + tid, NTH = G * NWAVES * 64;
          for (int i = gt; i < 2 * D * 8; i += NTH) { const int l = i / (D * 8), k = (i / 8) % D, j = i & 7;
              ((float*)(WSB + WS_WG))[i] = AIN(2)[(size_t)l * D * MIN_ + (size_t)k * MIN_ + 3072 + j] * AIN(1)[l * D + k]; } }
        { const int gt = blockIdx.x * (NWAVES * 64) + tid, NTH = G * NWAVES * 64; bf16* ON = (bf16*)(WSB + WS_ONES);
          for (int i = gt; i < 128; i += NTH) ON[128 * 1024 + i] = (bf16)0; }
        { const int gt = blockIdx.x * (NWAVES * 64) + tid, NTH = G * NWAVES * 64; float* RP = (float*)(WSB + WS_ROPE);
          for (int i = gt; i < T * 16; i += NTH) { const int pos = i >> 4, k = i & 15; const double inv = pow(500000.0, -(double)(2 * k) / 32.0), ang = (double)pos * inv;
              RP[i] = (float)cos(ang); RP[T * 16 + i] = (float)sin(ang); } }
        for (int m = gw; m < T; m += NGW) {
            const GAS f32x4* xr = (const GAS f32x4*)(XIN + (size_t)m * D) + lane; f32x4 v[4]; float s = 0.f;
#pragma unroll
            for (int j = 0; j < 4; ++j) { v[j] = xr[64 * j]; s += (v[j].x * v[j].x + v[j].y * v[j].y) + (v[j].z * v[j].z + v[j].w * v[j].w); }
            s = wave_sum(s, lane);
            GAS unsigned long long* o8 = (GAS unsigned long long*)(HB + (size_t)m * D) + lane;
#pragma unroll
            for (int j = 0; j < 4; ++j) o8[64 * j] = (unsigned long long)pk2(v[j].x, v[j].y) | ((unsigned long long)pk2(v[j].z, v[j].w) << 32);
            if (lane == 0) *(f32x4*)(SS + (size_t)m * 4) = (f32x4){s, 0.f, 0.f, 0.f};
        }
        { const int gt = blockIdx.x * (NWAVES * 64) + tid, NTH = G * NWAVES * 64;
          for (int i = gt; i < 2 * 1024 / 8; i += NTH) ((GAS v4u*)HBP)[i] = (v4u){0u, 0u, 0u, 0u};
          for (int i = gt; i < 128 * 1024 / 8; i += NTH) ((GAS v4u*)(HB + (size_t)T * D))[i] = (v4u){0u, 0u, 0u, 0u}; }
    GRID_BAR();
    }
    if (DUP == 8) { for (int rp_ = 0; rp_ < 8; ++rp_) GRID_BAR(); }

#define GRIDN() ({ int g_ = gridDim.x; asm volatile("" : "+s"(g_)); g_; })
#define BLK() ({ int b_ = blockIdx.x; asm volatile("" : "+s"(b_)); b_; })
    LAS unsigned char* ring = L; LAS unsigned char* el = L + EPI_OFF;
#pragma unroll
    for (int l = 0; l < 4; ++l) {
#if MIXERS
        if (l < 2) {
            bf16* MQ = (bf16*)(WSB + WS_MQ); bf16* MK = (bf16*)(WSB + WS_MK); bf16* OGB = (bf16*)(WSB + WS_OG); bf16* KVT = (bf16*)(WSB + WS_KVT);
            bf16* CT = (bf16*)(WSB + WS_CT); bf16* HG = (bf16*)(WSB + WS_HG);
            float* BCUM = (float*)(WSB + WS_BCUM); float* IG = (float*)(WSB + WS_IG); float* WGT = (float*)(WSB + WS_WGT); float* DECAY = (float*)(WSB + WS_DECAY); bf16* NCT = (bf16*)(WSB + WS_NCT); bf16* WROW = (bf16*)(WSB + WS_ONES); const bf16* ZROW = (const bf16*)(WSB + WS_ONES + 256 * 1024);
            const float* ssm = SS + (size_t)((2 * l) & 3) * T * 4;
            for (int rp_ = 0; rp_ < REPS(2); ++rp_) {
            for (int c = BLK(); c < 256; c += GRIDN())
                mlstm_gates_item(L, c, HB, (const float*)(WSB + WS_WG) + (size_t)l * D * 8, ssm, AIN(3) + l * 8, BCUM, IG, WGT, DECAY, WROW);
            GRID_BAR();
            {
                pg8::Gemm g{HB, (const bf16*)(WSB + WS_WINR) + (size_t)l * 1536 * D, T, 1536, D, 256};
                pg8::StaticOrder S; S.init(T, 1536, GRIDN(), BLK());
                pg8::EpiIn E{MQ, MK, OGB, ssm};
                pg8::gemm_phase<pg8::EpiIn, pg8::StaticOrder, true, true>(ring, el, g, S, E);
            }
            {
                pg8::Gemm g{(const bf16*)(WSB + WS_WINT) + (size_t)l * 1536 * D, HB, 1536, T, D, 256};
                pg8::StaticOrder S; S.init(1536, T, GRIDN(), BLK());
                pg8::EpiInT E{KVT, ssm, 1536, 64, WGT};
                pg8::gemm_phase<pg8::EpiInT, pg8::StaticOrder, true, true>(ring, el, g, S, E);
            }
            GRID_BAR();
            }
            for (int rp_ = 0; rp_ < REPS(3); ++rp_) {
            { int t4 = threadIdx.x; asm volatile("" : "+v"(t4)); const int wv4 = __builtin_amdgcn_readfirstlane(t4 >> 6);
              if (wv4 >= 3 && rp_ == 0) weight_set(l + 1, BLK() * 5 + (wv4 - 3), GRIDN() * 5, (LAS float*)(L + (wv4 - 3) * 16384), t4 & 63); }
            mlstm_scan(KVT, DECAY, CT, NCT, WROW, ZROW, GRIDN());
            GRID_BAR();
            }
            if (DUP == 13) { mlstm_scan(KVT, DECAY, HG, HG, WROW, ZROW, GRIDN(), true); GRID_BAR(); }
            for (int rp_ = 0; rp_ < REPS(4); ++rp_) {
            mlstm_out_phase(L, GRIDN(), MQ, MK, KVT, CT, NCT, BCUM, WGT, OGB, AIN(4) + l * D, HG);
            GRID_BAR();
            }
            for (int rp_ = 0; rp_ < REPS(10); ++rp_) {
                const bool dummy = (DUP == 10) && rp_ == 0;
                pg8::Gemm g{HG, (const bf16*)(WSB + WS_WOUT) + (size_t)l * D * D, T, D, D, 256};
                pg8::StaticOrder S; S.init(T, D, GRIDN(), BLK());
                pg8::EpiRes E{HB, SS + (size_t)((2 * l + 1) & 3) * T * 4, nullptr}; (void)dummy;
                pg8::gemm_phase<pg8::EpiRes, pg8::StaticOrder, true, true>(ring, el, g, S, E);
                if (dummy) GRID_BAR();
            }
            if (0) {
                pg8::Gemm g{HG, (const bf16*)(WSB + WS_WOUT) + (size_t)l * D * D, T, D, D, 256};
                pg8::StaticOrder S; S.init(T, D, GRIDN(), BLK());
                pg8::EpiRes E{HB, SS + (size_t)((2 * l + 1) & 3) * T * 4, nullptr};
                pg8::gemm_phase<pg8::EpiRes, pg8::StaticOrder, true, true>(ring, el, g, S, E);
            }
            GRID_BAR();
        }
#if MIXERS >= 2
        else {
            const int j = l - 2;
            bf16* XK = (bf16*)(WSB + WS_XK); bf16* XVT = (bf16*)(WSB + WS_XVT); bf16* AQ = (bf16*)(WSB + WS_AQ); bf16* PO = (bf16*)(WSB + WS_PO);
            float* KMEAN = (float*)(WSB + WS_KMEAN); float* ML = (float*)(WSB + WS_ML); int* LIST = (int*)(WSB + WS_LIST); int* gcnt = (int*)(WSB + WS_GCNT) + j * 512;
            const float* ssm = SS + (size_t)((2 * l) & 3) * T * 4; const float* RP = (const float*)(WSB + WS_ROPE);
            for (int rp_ = 0; rp_ < REPS(5); ++rp_) {
            if (l == 2) {
                { pg8::Gemm g{HB, (const bf16*)(WSB + WS_WK), T, D, D, 256}; pg8::StaticOrder S; S.init(T, D, GRIDN(), BLK());
                  pg8::EpiQK E{XK, ssm, AIN(8), RP, KMEAN, 1.0f, 1};
                  pg8::gemm_phase<pg8::EpiQK, pg8::StaticOrder, true, true>(ring, el, g, S, E); }
                { pg8::Gemm g{(const bf16*)(WSB + WS_WV), HB, D, T, D, 256}; pg8::StaticOrder S; S.init(D, T, GRIDN(), BLK());
                  pg8::EpiInT E{XVT, ssm, 1024, 0, nullptr};
                  pg8::gemm_phase<pg8::EpiInT, pg8::StaticOrder, true, true>(ring, el, g, S, E); }
            }
            { pg8::Gemm g{HB, (const bf16*)(WSB + WS_WQ) + (size_t)j * D * D, T, D, D, 256}; pg8::StaticOrder S; S.init(T, D, GRIDN(), BLK());
              pg8::EpiQK E{AQ, ssm, AIN(11) + j * 128, RP, nullptr, 0.08838834764831845f * 1.4426950408889634f, 0};
              pg8::gemm_phase<pg8::EpiQK, pg8::StaticOrder, true, true>(ring, el, g, S, E); }
            GRID_BAR();
            }
            for (int rp_ = 0; rp_ < REPS(11); ++rp_) {
            const bool dummy = (DUP == 11) && rp_ == 0;
            moba_gate_phase(L, GRIDN(), AQ, KMEAN, dummy ? gcnt + 2048 : gcnt, dummy ? (int*)(WSB + WS_WINR) : LIST);
            GRID_BAR();
            }
            for (int rp_ = 0; rp_ < REPS(6); ++rp_) {
            attn_phase2<false>(L, GRIDN(), gcnt, LIST, AQ, XK, XVT, PO, ML, nullptr, 0, WSB + WS_DUMP);
            GRID_BAR();
            }
            for (int rp_ = 0; rp_ < REPS(12); ++rp_) {
            const bool dummy = (DUP == 12) && rp_ == 0;
            attn_phase2<true>(L, GRIDN(), gcnt, LIST, AQ, XK, XVT, PO, ML, dummy ? HB : AQ, dummy ? 8191 : 0x7fffffff, WSB + WS_DUMP);
            GRID_BAR();
            }
            { int t2 = threadIdx.x; asm volatile("" : "+v"(t2)); const int gt = BLK() * (NWAVES * 64) + t2, NTH = GRIDN() * NWAVES * 64;
              unsigned zu = 0u; asm volatile("" : "+v"(zu));
              for (int i = gt; i < 128 * 1024 / 8; i += NTH) ((GAS v4u*)(HB + (size_t)T * D))[i] = (v4u){zu, zu, zu, zu}; }
            { pg8::Gemm g{AQ, (const bf16*)(WSB + WS_WO) + (size_t)j * D * D, T, D, D, 256}; pg8::StaticOrder S; S.init(T, D, GRIDN(), BLK());
              pg8::EpiRes E{HB, SS + (size_t)((2 * l + 1) & 3) * T * 4, nullptr};
              pg8::gemm_phase<pg8::EpiRes, pg8::StaticOrder, true, true>(ring, el, g, S, E); }
            GRID_BAR();
        }
#endif
#endif
        const bool mix_on = (MIXERS >= 2) || (MIXERS == 1 && l < 2);
        const int ssf = mix_on ? 2 * l + 1 : 2 * l;
#ifndef SKIP_UP
        for (int rp_ = 0; rp_ < REPS(7); ++rp_) {
            pg8::Gemm g{HBP, (const bf16*)(WSB + WS_WUP) + (size_t)l * FF2 * D, 65 * 256, FF2, D, 254};
            pg8::StaticOrder S; S.init(65 * 256, FF2, GRIDN(), BLK());
            pg8::EpiConv E{ACT, SS + (size_t)(ssf & 3) * T * 4, AIN(15) + (size_t)l * 3 * FF2, AIN(16) + (size_t)l * FF2};
            pg8::gemm_phase<pg8::EpiConv, pg8::StaticOrder, true, true>(ring, el, g, S, E);
            GRID_BAR();
        }
#endif
#ifndef SKIP_DN
        for (int rp_ = 0; rp_ < REPS(9); ++rp_) {
            const bool dummy = (DUP == 9) && rp_ == 0;
            pg8::Gemm g{ACT, (const bf16*)(WSB + WS_WDN) + (size_t)l * D * FF, T, D, FF, 256};
            pg8::StaticOrder S; S.init(T, D, GRIDN(), BLK());
            pg8::EpiRes E{HB, (l < 3) ? SS + (size_t)((2 * l + 2) & 3) * T * 4 : nullptr, (l == 3) ? OUTP : nullptr}; (void)dummy;
            pg8::gemm_phase<pg8::EpiRes, pg8::StaticOrder, true, true>(ring, el, g, S, E);
            GRID_BAR();
        }
#endif
    }
    { int t3 = threadIdx.x; asm volatile("" : "+v"(t3)); if (BLK() == 0 && t3 == 0) if (xb_ld((unsigned*)(WSB + WS_CTL) + CW_BAR + XB_TMO)) OUTP[0] = 1.0e6f; }
}

#undef WSB
#undef XIN
#undef OUTP
#undef SS
#undef HBP
#undef HB
#undef ACT
extern "C" void kernel_launch(void* const* d_in, const int* in_sizes, int n_in, void* d_out, int out_size, void* d_ws, size_t ws_size, hipStream_t stream) {
    static int grid = 0;
    if (grid == 0) {
        int dev = 0, cus = 0;
        if (n_in != 18 || out_size != T * D || ws_size < WS_END) { fprintf(stderr, "kernel_launch: unexpected problem geometry (n_in %d out %d ws %zu)\n", n_in, out_size, ws_size); grid = -1; return; }
        if (hipGetDevice(&dev) != hipSuccess || hipDeviceGetAttribute(&cus, hipDeviceAttributeMultiprocessorCount, dev) != hipSuccess) { grid = -1; return; }
        if (hipFuncSetAttribute((const void*)yoco_fwd, hipFuncAttributeMaxDynamicSharedMemorySize, LDS_BYTES) != hipSuccess) { fprintf(stderr, "hipFuncSetAttribute failed\n"); grid = -1; return; }
        (void)hipGetLastError();
        grid = cus;
    }
    if (grid < 0) return;
    (void)hipMemsetAsync((char*)d_ws + WS_CTL, 0, CTL_ZERO_BYTES, stream);
    Args a{};
    for (int i = 0; i < 18; ++i) a.in[i] = (const float*)d_in[i];
    a.out = (float*)d_out; a.ws = (unsigned char*)d_ws; a.ws_size = (unsigned long long)ws_size;
    hipLaunchKernelGGL(yoco_fwd, dim3(grid), dim3(NWAVES * 64), LDS_BYTES, stream, a);
}
```

```cpp
#include <hip/hip_runtime.h>
#include <cstdio>
#include <cstdint>

#define MIXERS 2
#define DUP 0
#define REPS(k) ((DUP) == (k) ? 2 : 1)
#ifndef PROBE
#define PROBE 0
#endif
#ifndef TIMEX
#define TIMEX 0
#endif
#ifndef TBLK
#define TBLK 0
#endif
#ifndef TSEL
#define TSEL 0
#endif
#ifndef TW
#define TW 0
#endif
#if TIMEX
#define TSTAMP(v) unsigned v; { unsigned long long t64_; asm volatile("s_memtime %0\n\ts_waitcnt lgkmcnt(0)" : "=s"(t64_) :: "memory"); v = (unsigned)t64_; }
#define TACC(i, a, b) do { if ((i) == TSEL) tacc_ += (b) - (a); } while (0)
__device__ unsigned g_dbg;
#else
#define TSTAMP(v)
#define TACC(i, a, b)
#endif

namespace pg8 {
#define PG8_LAS __attribute__((address_space(3)))
typedef unsigned short bf16_t;
typedef short bf16x8 __attribute__((ext_vector_type(8)));
typedef float f32x4 __attribute__((ext_vector_type(4)));
typedef unsigned u32x4 __attribute__((ext_vector_type(4)));
typedef unsigned u32x2 __attribute__((ext_vector_type(2)));
constexpr int BM = 256, BK = 64, HALF = 128, HTB = HALF * BK * 2, STAGE_BYTES = 8 * HTB, NXCD = 8, WGM = 8;

__host__ __device__ __forceinline__ int lds_byte(int r, int c) { const int st = (r >> 4) * 2 + (c >> 5), rr = r & 15, cc = c & 31, ob = rr * 64 + cc * 2; return st * 1024 + (ob ^ (((ob >> 9) & 1) << 5)); }
__host__ __device__ __forceinline__ void stage_rc(int b, int& R, int& C) { const int st = b / 1024, sb = b % 1024, swz = sb ^ (((sb >> 9) & 1) << 5); R = (st >> 1) * 16 + swz / 64; C = (st & 1) * 32 + (swz % 64) / 2; }
__host__ __device__ __forceinline__ int perm32(int rho) { const int n = rho >> 4, i = rho & 15; return 8 * (i >> 2) + 4 * n + (i & 3); }

struct Unit { int pm, pn; };
struct Gemm { const bf16_t* A; const bf16_t* Bt; int M, N, K, a_rows; };

struct StaticOrder {
    int nM, nN, nwg, G, c;
    __host__ __device__ void init(int M, int N, int G_, int c_) { nM = M / BM; nN = N / BM; nwg = nM * nN; G = G_; c = c_; }
    __host__ __device__ bool next(int i, Unit& u) const {
        const long L = (long)i * G + c; if (L >= nwg) return false;
        int wgid = (int)L; { const int q = nwg / NXCD, r = nwg % NXCD, xcd = wgid % NXCD, off = wgid / NXCD; wgid = (xcd < r ? xcd * (q + 1) : r * (q + 1) + (xcd - r) * q) + off; }
        const int nig = WGM * nN, gid = wgid / nig, fm = gid * WGM, gsz = (nM - fm) < WGM ? (nM - fm) : WGM;
        u.pm = fm + ((wgid % nig) % gsz); u.pn = (wgid % nig) / gsz; return true;
    }
    __device__ __forceinline__ void a_ready(const Unit&) const {}
    __device__ __forceinline__ void done(const Unit&) const {}
};

__device__ __forceinline__ float sh_idx(float v, int src) { return __builtin_bit_cast(float, __builtin_amdgcn_ds_bpermute(src << 2, __builtin_bit_cast(int, v))); }
__device__ __forceinline__ float sh_xor(float v, int o, int lane) { return sh_idx(v, lane ^ o); }
template <int CTRL, int ROWMASK = 0xf> __device__ __forceinline__ float dpp_add(float v) { return v + __builtin_bit_cast(float, __builtin_amdgcn_update_dpp(0, __builtin_bit_cast(int, v), CTRL, ROWMASK, 0xf, true)); }
__device__ __forceinline__ float half_sum_hi(float v) { v = dpp_add<0xB1>(v); v = dpp_add<0x4E>(v); v = dpp_add<0x141>(v); v = dpp_add<0x140>(v); return dpp_add<0x142, 0xA>(v); }
__device__ __forceinline__ float oct_sum(float v) { v = dpp_add<0xB1>(v); v = dpp_add<0x4E>(v); return dpp_add<0x141>(v); }
typedef float f32x2n __attribute__((ext_vector_type(2)));
typedef __bf16 bf16x2n __attribute__((ext_vector_type(2)));
__device__ __forceinline__ unsigned cvt_pk_bf16n(float lo, float hi) { unsigned r; asm volatile("s_nop 0\n\tv_cvt_pk_bf16_f32 %0, %1, %2" : "=v"(r) : "v"(lo), "v"(hi)); return r; }
__device__ __forceinline__ float rows_sum(float v) {
    float x = v, y = v; asm volatile("s_nop 1\n\tv_permlane16_swap_b32 %0, %1" : "+v"(x), "+v"(y));
    const float s = x + y; float x2 = s, y2 = s; asm volatile("s_nop 1\n\tv_permlane32_swap_b32 %0, %1" : "+v"(x2), "+v"(y2));
    return x2 + y2;
}
__device__ __forceinline__ unsigned cvt_pk_bf16(float lo, float hi) { unsigned r; asm volatile("v_cvt_pk_bf16_f32 %0, %1, %2" : "=v"(r) : "v"(lo), "v"(hi)); return r; }
__device__ __forceinline__ float rstd4(const float* ss4, int row) { const f32x4 p = *(const f32x4*)(ss4 + (size_t)row * 4); return rsqrtf(((p[0] + p[1]) + (p[2] + p[3])) * (1.0f / 1024.0f) + 1e-6f); }
#define EPI_BAR() do { asm volatile("s_waitcnt lgkmcnt(0)" ::: "memory"); __builtin_amdgcn_s_barrier(); asm volatile("" ::: "memory"); } while (0)

constexpr int TT = 16384, DD = 1024;
constexpr float NEPS = 1e-6f;

struct EpiRes {
    static constexpr bool PERM = true; static constexpr int RSMODE = 0;
    bf16_t* hb; float* ss; float* fout;
    __device__ __forceinline__ void operator()(f32x4 (&acc)[2][2][4][2], const Unit& u, int wr, int wc, int fr_, int fq_, PG8_LAS unsigned char* el, int wid, int lane_, const PG8_LAS float* rsu) const {
        int ln_ = lane_; asm volatile("" : "+v"(ln_)); const int lane = ln_, fr = ln_ & 15, fq = ln_ >> 4; (void)fr_; (void)fq_;
        u32x4 pre[2][4][2];
#pragma unroll
        for (int ai = 0; ai < 2; ++ai)
#pragma unroll
            for (int m = 0; m < 4; ++m)
#pragma unroll
                for (int bj = 0; bj < 2; ++bj) pre[ai][m][bj] = *(const u32x4*)(hb + (size_t)(u.pm * BM + ai * HALF + wr * 64 + m * 16 + fr) * DD + u.pn * BM + bj * HALF + wc * 32 + 8 * fq);
#pragma unroll
        for (int ai = 0; ai < 2; ++ai)
#pragma unroll
            for (int m = 0; m < 4; ++m) {
                const int row = u.pm * BM + ai * HALF + wr * 64 + m * 16 + fr; float s = 0.f;
#pragma unroll
                for (int bj = 0; bj < 2; ++bj) {
                    const size_t off = (size_t)row * DD + u.pn * BM + bj * HALF + wc * 32 + 8 * fq;
                    const u32x4 p = pre[ai][m][bj];
                    f32x4 v0 = acc[ai][bj][m][0], v1 = acc[ai][bj][m][1];
                    v0[0] += __builtin_bit_cast(float, p[0] << 16); v0[1] += __builtin_bit_cast(float, p[0] & 0xffff0000u); v0[2] += __builtin_bit_cast(float, p[1] << 16); v0[3] += __builtin_bit_cast(float, p[1] & 0xffff0000u);
                    v1[0] += __builtin_bit_cast(float, p[2] << 16); v1[1] += __builtin_bit_cast(float, p[2] & 0xffff0000u); v1[2] += __builtin_bit_cast(float, p[3] << 16); v1[3] += __builtin_bit_cast(float, p[3] & 0xffff0000u);
                    if (fout) { *(f32x4*)(fout + off) = v0; *(f32x4*)(fout + off + 4) = v1; }
                    u32x4 w; w.x = cvt_pk_bf16(v0[0], v0[1]); w.y = cvt_pk_bf16(v0[2], v0[3]); w.z = cvt_pk_bf16(v1[0], v1[1]); w.w = cvt_pk_bf16(v1[2], v1[3]);
                    if (!fout) *(u32x4*)(hb + off) = w;
                    s += (v0[0] * v0[0] + v0[1] * v0[1]) + (v0[2] * v0[2] + v0[3] * v0[3]) + (v1[0] * v1[0] + v1[1] * v1[1]) + (v1[2] * v1[2] + v1[3] * v1[3]);
                }
                s = rows_sum(s);
                if (fq == 0) ((PG8_LAS float*)el)[(ai * HALF + wr * 64 + m * 16 + fr) * 4 + wc] = s;
            }
        EPI_BAR();
        { const int tid2 = wid * 64 + lane;
          if (ss && tid2 < 256) { const f32x4 p = *(const PG8_LAS f32x4*)((PG8_LAS float*)el + tid2 * 4); ss[(size_t)(u.pm * BM + tid2) * 4 + u.pn] = (p[0] + p[1]) + (p[2] + p[3]); } }
    }
};

struct EpiConv {
    static constexpr bool PERM = true; static constexpr int RSMODE = 1; static constexpr int tmax = 16384; __device__ __forceinline__ int tok0(const Unit& u) const { return u.pm * 254 - 2; }
    bf16_t* act; const float* ss; const float* cw; const float* cb;
    static __device__ __forceinline__ float ror1(float v) { return __builtin_bit_cast(float, __builtin_amdgcn_update_dpp(0, __builtin_bit_cast(int, v), 0x121, 0xf, 0xf, false)); }
    static __device__ __forceinline__ float ror2(float v) { return __builtin_bit_cast(float, __builtin_amdgcn_update_dpp(0, __builtin_bit_cast(int, v), 0x122, 0xf, 0xf, false)); }
    __device__ __forceinline__ void operator()(f32x4 (&acc)[2][2][4][2], const Unit& u, int wr, int wc, int fr_, int fq_, PG8_LAS unsigned char* el, int wid, int lane_, const PG8_LAS float* rsu) const {
        int ln_ = lane_; asm volatile("" : "+v"(ln_)); const int lane = ln_, fr = ln_ & 15, fq = ln_ >> 4; (void)lane; (void)fr_; (void)fq_;
        const int t0 = u.pm * 254 - 2;
        const int cl = wc * 32 + 8 * fq;
        float rs[2][4]; f32x4 cp[2][2][4];
#pragma unroll
        for (int ai = 0; ai < 2; ++ai)
#pragma unroll
            for (int m = 0; m < 4; ++m) rs[ai][m] = rsu[ai * HALF + wr * 64 + m * 16 + fr];
#pragma unroll
        for (int n = 0; n < 2; ++n)
#pragma unroll
            for (int bj = 0; bj < 2; ++bj) { const int scol = (bj ? 2816 : 0) + u.pn * HALF + cl + 4 * n;
                cp[n][bj][0] = *(const f32x4*)(cw + scol); cp[n][bj][1] = *(const f32x4*)(cw + 5632 + scol); cp[n][bj][2] = *(const f32x4*)(cw + 2 * 5632 + scol); cp[n][bj][3] = *(const f32x4*)(cb + scol); }
#pragma unroll
        for (int ai = 0; ai < 2; ++ai)
#pragma unroll
            for (int m = 0; m < 4; ++m)
#pragma unroll
                for (int bj = 0; bj < 2; ++bj)
#pragma unroll
                    for (int n = 0; n < 2; ++n) acc[ai][bj][m][n] = acc[ai][bj][m][n] * rs[ai][m];
        PG8_LAS float* X = (PG8_LAS float*)el;
#pragma unroll
        for (int ai = 0; ai < 2; ++ai) { const int B = 2 * ai + wr;
            if (B < 3 && fr >= 14) {
#pragma unroll
                for (int bj = 0; bj < 2; ++bj)
#pragma unroll
                    for (int n = 0; n < 2; ++n) *(PG8_LAS f32x4*)(X + (B * 2 + (fr - 14)) * 256 + bj * HALF + cl + 4 * n) = acc[ai][bj][3][n];
            } }
#pragma unroll
        for (int n = 0; n < 2; ++n) {
#pragma unroll
            for (int bj = 0; bj < 2; ++bj) {
                const f32x4 w0 = cp[n][bj][0], w1 = cp[n][bj][1], w2 = cp[n][bj][2], bb = cp[n][bj][3];
#pragma unroll
                for (int ai = 0; ai < 2; ++ai) {
#pragma unroll
                    for (int m = 3; m >= 1; --m) {
                        const f32x4 cur = acc[ai][bj][m][n], pv = acc[ai][bj][m - 1][n]; f32x4 res = bb + w2 * cur;
                        {
                            float r0 = res[0], r1 = res[1], r2 = res[2], r3 = res[3];
                            asm volatile("s_nop 1\n\tv_fmac_f32_dpp %0, %4, %12 row_shr:1 row_mask:0xf bank_mask:0xf bound_ctrl:1\n\tv_fmac_f32_dpp %0, %8, %12 row_shl:15 row_mask:0xf bank_mask:0xf bound_ctrl:1\n\tv_fmac_f32_dpp %0, %4, %16 row_shr:2 row_mask:0xf bank_mask:0xf bound_ctrl:1\n\tv_fmac_f32_dpp %0, %8, %16 row_shl:14 row_mask:0xf bank_mask:0xf bound_ctrl:1\n\tv_fmac_f32_dpp %1, %5, %13 row_shr:1 row_mask:0xf bank_mask:0xf bound_ctrl:1\n\tv_fmac_f32_dpp %1, %9, %13 row_shl:15 row_mask:0xf bank_mask:0xf bound_ctrl:1\n\tv_fmac_f32_dpp %1, %5, %17 row_shr:2 row_mask:0xf bank_mask:0xf bound_ctrl:1\n\tv_fmac_f32_dpp %1, %9, %17 row_shl:14 row_mask:0xf bank_mask:0xf bound_ctrl:1\n\tv_fmac_f32_dpp %2, %6, %14 row_shr:1 row_mask:0xf bank_mask:0xf bound_ctrl:1\n\tv_fmac_f32_dpp %2, %10, %14 row_shl:15 row_mask:0xf bank_mask:0xf bound_ctrl:1\n\tv_fmac_f32_dpp %2, %6, %18 row_shr:2 row_mask:0xf bank_mask:0xf bound_ctrl:1\n\tv_fmac_f32_dpp %2, %10, %18 row_shl:14 row_mask:0xf bank_mask:0xf bound_ctrl:1\n\tv_fmac_f32_dpp %3, %7, %15 row_shr:1 row_mask:0xf bank_mask:0xf bound_ctrl:1\n\tv_fmac_f32_dpp %3, %11, %15 row_shl:15 row_mask:0xf bank_mask:0xf bound_ctrl:1\n\tv_fmac_f32_dpp %3, %7, %19 row_shr:2 row_mask:0xf bank_mask:0xf bound_ctrl:1\n\tv_fmac_f32_dpp %3, %11, %19 row_shl:14 row_mask:0xf bank_mask:0xf bound_ctrl:1"
                                : "+v"(r0), "+v"(r1), "+v"(r2), "+v"(r3)
                                : "v"(cur[0]), "v"(cur[1]), "v"(cur[2]), "v"(cur[3]), "v"(pv[0]), "v"(pv[1]), "v"(pv[2]), "v"(pv[3]),
                                  "v"(w1[0]), "v"(w1[1]), "v"(w1[2]), "v"(w1[3]), "v"(w0[0]), "v"(w0[1]), "v"(w0[2]), "v"(w0[3]));
                            res[0] = r0; res[1] = r1; res[2] = r2; res[3] = r3; }
                        acc[ai][bj][m][n] = res;
                    }
                }
            }
        }
        EPI_BAR();
#pragma unroll
        for (int n = 0; n < 2; ++n) {
#pragma unroll
            for (int bj = 0; bj < 2; ++bj) {
                const f32x4 w0 = cp[n][bj][0], w1 = cp[n][bj][1], w2 = cp[n][bj][2], bb = cp[n][bj][3];
#pragma unroll
                for (int ai = 0; ai < 2; ++ai) {
                    const int B = 2 * ai + wr;
                    f32x4 pv = (f32x4){0.f, 0.f, 0.f, 0.f};
                    if (B > 0) { const f32x4 e0 = *(const PG8_LAS f32x4*)(X + ((B - 1) * 2 + 0) * 256 + bj * HALF + cl + 4 * n), e1 = *(const PG8_LAS f32x4*)(X + ((B - 1) * 2 + 1) * 256 + bj * HALF + cl + 4 * n);
                        pv = (fr == 14) ? e0 : e1; }
                    { const int m = 0; const f32x4 cur = acc[ai][bj][m][n]; f32x4 res = bb + w2 * cur;
                        {
                            float r0 = res[0], r1 = res[1], r2 = res[2], r3 = res[3];
                            asm volatile("s_nop 1\n\tv_fmac_f32_dpp %0, %4, %12 row_shr:1 row_mask:0xf bank_mask:0xf bound_ctrl:1\n\tv_fmac_f32_dpp %0, %8, %12 row_shl:15 row_mask:0xf bank_mask:0xf bound_ctrl:1\n\tv_fmac_f32_dpp %0, %4, %16 row_shr:2 row_mask:0xf bank_mask:0xf bound_ctrl:1\n\tv_fmac_f32_dpp %0, %8, %16 row_shl:14 row_mask:0xf bank_mask:0xf bound_ctrl:1\n\tv_fmac_f32_dpp %1, %5, %13 row_shr:1 row_mask:0xf bank_mask:0xf bound_ctrl:1\n\tv_fmac_f32_dpp %1, %9, %13 row_shl:15 row_mask:0xf bank_mask:0xf bound_ctrl:1\n\tv_fmac_f32_dpp %1, %5, %17 row_shr:2 row_mask:0xf bank_mask:0xf bound_ctrl:1\n\tv_fmac_f32_dpp %1, %9, %17 row_shl:14 row_mask:0xf bank_mask:0xf bound_ctrl:1\n\tv_fmac_f32_dpp %2, %6, %14 row_shr:1 row_mask:0xf bank_mask:0xf bound_ctrl:1\n\tv_fmac_f32_dpp %2, %10, %14 row_shl:15 row_mask:0xf bank_mask:0xf bound_ctrl:1\n\tv_fmac_f32_dpp %2, %6, %18 row_shr:2 row_mask:0xf bank_mask:0xf bound_ctrl:1\n\tv_fmac_f32_dpp %2, %10, %18 row_shl:14 row_mask:0xf bank_mask:0xf bound_ctrl:1\n\tv_fmac_f32_dpp %3, %7, %15 row_shr:1 row_mask:0xf bank_mask:0xf bound_ctrl:1\n\tv_fmac_f32_dpp %3, %11, %15 row_shl:15 row_mask:0xf bank_mask:0xf bound_ctrl:1\n\tv_fmac_f32_dpp %3, %7, %19 row_shr:2 row_mask:0xf bank_mask:0xf bound_ctrl:1\n\tv_fmac_f32_dpp %3, %11, %19 row_shl:14 row_mask:0xf bank_mask:0xf bound_ctrl:1"
                                : "+v"(r0), "+v"(r1), "+v"(r2), "+v"(r3)
                                : "v"(cur[0]), "v"(cur[1]), "v"(cur[2]), "v"(cur[3]), "v"(pv[0]), "v"(pv[1]), "v"(pv[2]), "v"(pv[3]),
                                  "v"(w1[0]), "v"(w1[1]), "v"(w1[2]), "v"(w1[3]), "v"(w0[0]), "v"(w0[1]), "v"(w0[2]), "v"(w0[3]));
                            res[0] = r0; res[1] = r1; res[2] = r2; res[3] = r3; }
                        acc[ai][bj][m][n] = res; }
                }
            }
        }
#pragma unroll
        for (int ai = 0; ai < 2; ++ai)
#pragma unroll
            for (int m = 0; m < 4; ++m) {
                const int r = ai * HALF + wr * 64 + m * 16 + fr, t = t0 + r;
                u32x4 w; float a[8];
#pragma unroll
                for (int n = 0; n < 2; ++n)
#pragma unroll
                    for (int i = 0; i < 4; ++i) { const float v = acc[ai][0][m][n][i], g = acc[ai][1][m][n][i]; a[4 * n + i] = v * g * __builtin_amdgcn_rcpf(1.0f + __builtin_amdgcn_exp2f(-1.4426950408889634f * g)); }
                w.x = cvt_pk_bf16(a[0], a[1]); w.y = cvt_pk_bf16(a[2], a[3]); w.z = cvt_pk_bf16(a[4], a[5]); w.w = cvt_pk_bf16(a[6], a[7]);
                if (r >= 2 && t < TT) *(u32x4*)(act + (size_t)t * 2816 + u.pn * HALF + cl) = w;
            }
    }
};


struct EpiIn {
    static constexpr bool PERM = true; static constexpr int RSMODE = 1; static constexpr int tmax = 16384; __device__ __forceinline__ int tok0(const Unit& u) const { return u.pm * 256; }
    bf16_t* q; bf16_t* k; bf16_t* og; const float* ss;
    __device__ __forceinline__ void operator()(f32x4 (&acc)[2][2][4][2], const Unit& u, int wr, int wc, int fr_, int fq_, PG8_LAS unsigned char* el, int wid, int lane_, const PG8_LAS float* rsu) const {
        int ln_ = lane_; asm volatile("" : "+v"(ln_)); const int lane = ln_, fr = ln_ & 15, fq = ln_ >> 4; (void)lane; (void)fr_; (void)fq_;
        bf16_t* dst; int ldc, c0; float sc;
        if (u.pn < 2) { dst = q; ldc = 512; c0 = 256 * u.pn; sc = 0.08838834764831845f; }
        else { dst = og; ldc = 1024; c0 = 256 * (u.pn - 2); sc = 1.f; }
#pragma unroll
        for (int ai = 0; ai < 2; ++ai)
#pragma unroll
            for (int m = 0; m < 4; ++m) {
                const int row = u.pm * BM + ai * HALF + wr * 64 + m * 16 + fr;
                const float rs = rsu[ai * HALF + wr * 64 + m * 16 + fr] * sc;
#pragma unroll
                for (int bj = 0; bj < 2; ++bj) {
                    const f32x4 v0 = acc[ai][bj][m][0] * rs, v1 = acc[ai][bj][m][1] * rs;
                    u32x4 w; w.x = cvt_pk_bf16(v0[0], v0[1]); w.y = cvt_pk_bf16(v0[2], v0[3]); w.z = cvt_pk_bf16(v1[0], v1[1]); w.w = cvt_pk_bf16(v1[2], v1[3]);
                    *(u32x4*)(dst + (size_t)row * ldc + c0 + bj * HALF + wc * 32 + 8 * fq) = w;
                }
            }
    }
};
struct EpiInT {
    static constexpr bool PERM = true; static constexpr int RSMODE = 2; static constexpr int tmax = 16384; __device__ __forceinline__ int tok0(const Unit& u) const { return u.pn * 256; }
    bf16_t* o; const float* ss; int nrows, ch; const float* wgt;
    __device__ __forceinline__ void operator()(f32x4 (&acc)[2][2][4][2], const Unit& u, int wr, int wc, int fr_, int fq_, PG8_LAS unsigned char* el, int wid, int lane_, const PG8_LAS float* rsu) const {
        int ln_ = lane_; asm volatile("" : "+v"(ln_)); const int lane = ln_, fr = ln_ & 15, fq = ln_ >> 4; (void)lane; (void)fr_; (void)fq_;
#pragma unroll
        for (int bj = 0; bj < 2; ++bj) {
            const int t = u.pn * BM + bj * HALF + wc * 32 + 8 * fq;
            f32x4 r0 = *(const PG8_LAS f32x4*)(rsu + bj * HALF + wc * 32 + 8 * fq), r1 = *(const PG8_LAS f32x4*)(rsu + bj * HALF + wc * 32 + 8 * fq + 4);
            if (wgt && u.pm >= 2) { const float* wp = wgt + (size_t)(u.pm - 2) * TT + t; r0 = r0 * *(const f32x4*)wp; r1 = r1 * *(const f32x4*)(wp + 4); }
#pragma unroll
            for (int ai = 0; ai < 2; ++ai)
#pragma unroll
                for (int m = 0; m < 4; ++m) {
                    const int row = u.pm * BM + ai * HALF + wr * 64 + m * 16 + fr;
                    const f32x4 v0 = acc[ai][bj][m][0] * r0, v1 = acc[ai][bj][m][1] * r1;
                    u32x4 w; w.x = cvt_pk_bf16(v0[0], v0[1]); w.y = cvt_pk_bf16(v0[2], v0[3]); w.z = cvt_pk_bf16(v1[0], v1[1]); w.w = cvt_pk_bf16(v1[2], v1[3]);
                    if (ch) {
                        *(u32x4*)(o + ((((size_t)(t >> 6) * 96 + (row >> 4)) * 2 + ((t >> 5) & 1)) * 512 + (((t >> 3) & 3) * 16 + (row & 15)) * 8)) = w; }
                    else {
                        const int kb = t >> 8, key = t & 255, b8 = (key >> 3) & 1;
                        bf16_t* vp = o + ((((size_t)(kb * 8 + (row >> 7)) * 4 + ((row >> 5) & 3)) * 16 + (key >> 4)) * 512 + (row & 31) * 8 + 4 * b8);
                        u32x2 lo2, hi2; lo2.x = w.x; lo2.y = w.y; hi2.x = w.z; hi2.y = w.w;
                        *(u32x2*)vp = lo2; *(u32x2*)(vp + 256) = hi2; }
                }
        }
    }
};


struct EpiQK {
    static constexpr bool PERM = false; static constexpr int RSMODE = 1; static constexpr int tmax = 16384; __device__ __forceinline__ int tok0(const Unit& u) const { return u.pm * 256; }
    bf16_t* o; const float* ss; const float* gain; const float* rope; float* kmean; float oscale; int kfrag;
    __device__ __forceinline__ void operator()(f32x4 (&acc)[2][2][4][2], const Unit& u, int wr, int wc, int fr_, int fq_, PG8_LAS unsigned char* el, int wid, int lane_, const PG8_LAS float* rsu) const {
        int ln_ = lane_; asm volatile("" : "+v"(ln_)); const int lane = ln_, fr = ln_ & 15, fq = ln_ >> 4; (void)lane; (void)fr_; (void)fq_;
        PG8_LAS float* P = (PG8_LAS float*)el;
        PG8_LAS float* KS = (PG8_LAS float*)(el + 8192);
#pragma unroll
        for (int ai = 0; ai < 2; ++ai)
#pragma unroll
            for (int m = 0; m < 4; ++m) {
                const int rl = ai * HALF + wr * 64 + m * 16 + fr;
                const float rs = rsu[rl];
#pragma unroll
                for (int bj = 0; bj < 2; ++bj) {
                    const f32x4 x0 = acc[ai][bj][m][0] * rs, x1 = acc[ai][bj][m][1] * rs;
                    acc[ai][bj][m][0] = x0; acc[ai][bj][m][1] = x1;
                    float s = (x0[0] * x0[0] + x0[1] * x0[1]) + (x0[2] * x0[2] + x0[3] * x0[3]) + (x1[0] * x1[0] + x1[1] * x1[1]) + (x1[2] * x1[2] + x1[3] * x1[3]);
                    s = rows_sum(s);
                    if (fq == 0) P[(rl * 2 + bj) * 4 + wc] = s;
                }
            }
        EPI_BAR();
#pragma unroll
        for (int bj = 0; bj < 2; ++bj) {
            const f32x4 g0 = *(const f32x4*)(gain + 32 * wc + 4 * fq), g1 = *(const f32x4*)(gain + 32 * wc + 16 + 4 * fq);
            f32x4 cs0 = (f32x4){0.f, 0.f, 0.f, 0.f}, cs1 = cs0;
            const int head = 2 * u.pn + bj;
            f32x4 rc_ = *(const f32x4*)(rope + (size_t)(u.pm * BM + wr * 64 + fr) * 16 + 4 * fq), rs_ = *(const f32x4*)(rope + (size_t)TT * 16 + (size_t)(u.pm * BM + wr * 64 + fr) * 16 + 4 * fq);
#pragma unroll
            for (int ai = 0; ai < 2; ++ai)
#pragma unroll
                for (int m = 0; m < 4; ++m) {
                    const int rl = ai * HALF + wr * 64 + m * 16 + fr, row = u.pm * BM + rl;
                    const int jn_ = (ai * 4 + m + 1) & 7, rown_ = u.pm * BM + (jn_ >> 2) * HALF + wr * 64 + (jn_ & 3) * 16 + fr;
                    const f32x4 rcn_ = *(const f32x4*)(rope + (size_t)rown_ * 16 + 4 * fq), rsn_ = *(const f32x4*)(rope + (size_t)TT * 16 + (size_t)rown_ * 16 + 4 * fq);
                    const f32x4 p = *(const PG8_LAS f32x4*)(P + (rl * 2 + bj) * 4);
                    const float rn = rsqrtf(((p[0] + p[1]) + (p[2] + p[3])) * (1.0f / 128.0f) + NEPS);
                    f32x4 y0 = acc[ai][bj][m][0] * rn * g0, y1 = acc[ai][bj][m][1] * rn * g1;
                    if (wc == 0) { const f32x4 c = rc_, sn = rs_;
                        const f32x4 t0 = y0 * c - y1 * sn, t1 = y1 * c + y0 * sn; y0 = t0; y1 = t1; }
                    rc_ = rcn_; rs_ = rsn_;
                    cs0 += y0; cs1 += y1;
                    y0 = y0 * oscale; y1 = y1 * oscale;
                    u32x2 w0, w1; w0.x = cvt_pk_bf16(y0[0], y0[1]); w0.y = cvt_pk_bf16(y0[2], y0[3]); w1.x = cvt_pk_bf16(y1[0], y1[1]); w1.y = cvt_pk_bf16(y1[2], y1[3]);
                    if (!kfrag) { bf16_t* op = o + (size_t)row * DD + head * 128 + 32 * wc + 4 * fq; *(u32x2*)op = w0; *(u32x2*)(op + 16) = w1; }
                    else {
                        bf16_t* op = o + ((((size_t)((row >> 8) * 8 + head) * 8 + ((row >> 5) & 7)) * 8 + 2 * wc) * 512 + ((fq >> 1) * 32 + (row & 31)) * 8 + 4 * (fq & 1));
                        *(u32x2*)op = w0; *(u32x2*)(op + 512) = w1; }
                    asm volatile("" ::: "memory");
                }
            if (kmean) {
#pragma unroll
                for (int i = 0; i < 4; ++i) {
                    { cs0[i] = dpp_add<0x140>(dpp_add<0x141>(dpp_add<0x4E>(dpp_add<0xB1>(cs0[i])))); cs1[i] = dpp_add<0x140>(dpp_add<0x141>(dpp_add<0x4E>(dpp_add<0xB1>(cs1[i])))); }
                }
                if (fr == 0) { *(PG8_LAS f32x4*)(KS + (wr * 2 + bj) * 128 + 32 * wc + 4 * fq) = cs0; *(PG8_LAS f32x4*)(KS + (wr * 2 + bj) * 128 + 32 * wc + 16 + 4 * fq) = cs1; }
            }
        }
        if (kmean) {
            EPI_BAR();
            const int tid2 = wid * 64 + lane;
            if (tid2 < 256) { const int bj = tid2 >> 7, d = tid2 & 127;
                kmean[((size_t)(2 * u.pn + bj) * 64 + u.pm) * 128 + d] = (KS[bj * 128 + d] + KS[(2 + bj) * 128 + d]) * (1.0f / 256.0f); }
        }
    }
};

template <class Epi, class Sched, bool ALIGN_EPI = false, bool SP2 = false>
__device__ __forceinline__ void gemm_phase(PG8_LAS unsigned char* lds, PG8_LAS unsigned char* elds, const Gemm g, const Sched& S, const Epi& E) {
    int tid_ = threadIdx.x; asm volatile("" : "+v"(tid_)); const int tid = tid_, wid = __builtin_amdgcn_readfirstlane(tid >> 6), lane = tid & 63, wr = wid >> 2, wc = wid & 3, fr = lane & 15, fq = lane >> 4;
    const int K = g.K, nt = K / BK;
    float zf_ = 0.f; asm volatile("" : "+v"(zf_)); const f32x4 z4_ = {zf_, zf_, zf_, zf_};
    unsigned voffA[2], voffB[2];
#pragma unroll
    for (int i = 0; i < 2; ++i) { int R, C; stage_rc(tid * 16 + i * 8192, R, C); const int Rb = Epi::PERM ? ((R & ~31) + perm32(R & 31)) : R;
        voffA[i] = (unsigned)(R * K + C) * 2u; voffB[i] = (unsigned)(Rb * K + C) * 2u; }
    const size_t kstep = (size_t)(BK * 2);
    const size_t hstep = (size_t)HALF * K * 2;
    const size_t tstep = 2 * hstep; const size_t tstepA = (size_t)g.a_rows * K * 2;
    const unsigned ldsw = (unsigned)wid * 1024u;
    const int aoff = lds_byte(wr * 64 + fr, fq * 8), boff = lds_byte(wc * 32 + fr, fq * 8);
#define PG8_SA(b, h) (((b) * 2 + (h)) * HTB)
#define PG8_SB(b, h) ((4 + (b) * 2 + (h)) * HTB)
#define PG8_STAGE(bufoff, gbase, voff) do { _Pragma("unroll") for (int _i = 0; _i < 2; ++_i) \
        __builtin_amdgcn_global_load_lds((const unsigned*)((const char*)(gbase) + (voff)[_i]), (PG8_LAS unsigned*)(lds + (bufoff) + ldsw + _i * 8192), 16, 0, 0); } while (0)
#define PG8_LDA(dst, b, h) do { _Pragma("unroll") for (int m = 0; m < 4; ++m) _Pragma("unroll") for (int k = 0; k < 2; ++k) dst[m][k] = *(const PG8_LAS bf16x8*)(lds + PG8_SA(b, h) + aoff + m * 2048 + k * 1024); } while (0)
#define PG8_LDB(dst, b, h) do { _Pragma("unroll") for (int n = 0; n < 2; ++n) _Pragma("unroll") for (int k = 0; k < 2; ++k) dst[n][k] = *(const PG8_LAS bf16x8*)(lds + PG8_SB(b, h) + boff + n * 2048 + k * 1024); } while (0)
#define PG8_MMA(ai, bj, At, Bt) do { __builtin_amdgcn_s_setprio(1); _Pragma("unroll") for (int m = 0; m < 4; ++m) _Pragma("unroll") for (int n = 0; n < 2; ++n) _Pragma("unroll") for (int k = 0; k < 2; ++k) \
        acc[ai][bj][m][n] = __builtin_amdgcn_mfma_f32_16x16x32_bf16(Bt[n][k], At[m][k], acc[ai][bj][m][n], 0, 0, 0); __builtin_amdgcn_s_setprio(0); } while (0)
#define PG8_WAIT_V(n) asm volatile("s_waitcnt vmcnt(" #n ")" ::: "memory")
#define PG8_WAIT_L(n) asm volatile("s_waitcnt lgkmcnt(" #n ")" ::: "memory")
#define PG8_BAR __builtin_amdgcn_s_barrier()
#define PG8_SCHED __builtin_amdgcn_sched_barrier(0)
    Unit cur, nxt; int ui = 0;
    if (!S.next(0, cur)) return;
    const PG8_LAS float* RSL = (const PG8_LAS float*)(elds + 22528);
    if constexpr (Epi::RSMODE != 0) {
        PG8_LAS float* RS = (PG8_LAS float*)(elds + 22528); Unit uu;
        const int nun_ = (S.nwg - 1 - S.c) / S.G + 1, nj_ = (nun_ + 1) >> 1;
#pragma unroll 1
        for (int j = 0; j < nj_ && j < 4; ++j) { const int i = 2 * j + (tid >> 8); if (S.next(i, uu)) { const int t = E.tok0(uu) + (tid & 255); RS[i * 256 + (tid & 255)] = (t >= 0 && t < E.tmax) ? rstd4(E.ss, t) : 0.f; } }
    }
    f32x4 acc[2][2][4][2];
#pragma unroll
    for (int a = 0; a < 2; ++a)
#pragma unroll
        for (int b = 0; b < 2; ++b)
#pragma unroll
            for (int m = 0; m < 4; ++m)
#pragma unroll
                for (int n = 0; n < 2; ++n) acc[a][b][m][n] = z4_;
    bf16x8 At[4][2], B0[2][2], B1[2][2];
    const char* cA = (const char*)g.A + (size_t)cur.pm * tstepA; const char* cB = (const char*)g.Bt + (size_t)cur.pn * tstep;
    S.a_ready(cur);
    if constexpr (SP2) {
        PG8_STAGE(PG8_SB(0, 0), cB, voffB); PG8_STAGE(PG8_SB(0, 1), cB + hstep, voffB); PG8_STAGE(PG8_SA(0, 0), cA, voffA); PG8_STAGE(PG8_SA(0, 1), cA + hstep, voffA);
        if (wr == 1) PG8_BAR;
        PG8_WAIT_V(2); PG8_BAR;
        PG8_STAGE(PG8_SB(1, 0), cB + kstep, voffB); PG8_STAGE(PG8_SA(1, 0), cA + kstep, voffA); PG8_STAGE(PG8_SB(1, 1), cB + hstep + kstep, voffB);
        PG8_WAIT_V(6); PG8_BAR;
    } else {
        PG8_STAGE(PG8_SB(0, 0), cB, voffB); PG8_STAGE(PG8_SA(0, 0), cA, voffA); PG8_STAGE(PG8_SB(0, 1), cB + hstep, voffB); PG8_STAGE(PG8_SA(0, 1), cA + hstep, voffA);
        if (wr == 1) PG8_BAR;
        PG8_WAIT_V(4); PG8_BAR;
        PG8_STAGE(PG8_SB(1, 0), cB + kstep, voffB); PG8_STAGE(PG8_SA(1, 0), cA + kstep, voffA); PG8_STAGE(PG8_SB(1, 1), cB + hstep + kstep, voffB);
        PG8_WAIT_V(6); PG8_BAR;
    }
    for (;;) {
        const bool has_next = S.next(ui + 1, nxt);
        const char* nA = has_next ? (const char*)g.A + (size_t)nxt.pm * tstepA : cA; const char* nB = has_next ? (const char*)g.Bt + (size_t)nxt.pn * tstep : cB;
        for (int t = 0; t < nt; t += 2) {
            const bool last = (t == nt - 2);
            const char* a1 = cA + (size_t)(t + 1) * kstep;
            const char* a2 = last ? nA : cA + (size_t)(t + 2) * kstep; const char* b2 = last ? nB : cB + (size_t)(t + 2) * kstep;
            const char* a3 = a2 + kstep; const char* b3 = b2 + kstep;
            if (last && has_next) S.a_ready(nxt);
            if constexpr (SP2) {
            PG8_LDB(B0, 0, 0); PG8_LDB(B1, 0, 1); PG8_SCHED; PG8_LDA(At, 0, 0); PG8_STAGE(PG8_SA(1, 1), a1 + hstep, voffA);
            PG8_WAIT_V(8); PG8_WAIT_L(0); PG8_BAR; PG8_MMA(0, 0, At, B0); PG8_MMA(0, 1, At, B1); PG8_BAR; PG8_SCHED;
            PG8_LDA(At, 0, 1); PG8_STAGE(PG8_SB(0, 0), b2, voffB); PG8_STAGE(PG8_SB(0, 1), b2 + hstep, voffB); PG8_STAGE(PG8_SA(0, 0), a2, voffA);
            PG8_WAIT_V(8); PG8_WAIT_L(0); PG8_BAR; PG8_MMA(1, 0, At, B0); PG8_MMA(1, 1, At, B1); PG8_BAR; PG8_SCHED;
            PG8_LDB(B0, 1, 0); PG8_LDB(B1, 1, 1); PG8_SCHED; PG8_LDA(At, 1, 0); PG8_STAGE(PG8_SA(0, 1), a2 + hstep, voffA);
            PG8_WAIT_V(8); PG8_WAIT_L(0); PG8_BAR; PG8_MMA(0, 0, At, B0); PG8_MMA(0, 1, At, B1); PG8_BAR; PG8_SCHED;
            PG8_LDA(At, 1, 1); PG8_STAGE(PG8_SB(1, 0), b3, voffB); PG8_STAGE(PG8_SB(1, 1), b3 + hstep, voffB); PG8_STAGE(PG8_SA(1, 0), a3, voffA);
            PG8_WAIT_V(8); PG8_WAIT_L(0); PG8_BAR; PG8_MMA(1, 0, At, B0); PG8_MMA(1, 1, At, B1); PG8_BAR; PG8_SCHED;
            } else {
            PG8_LDB(B0, 0, 0); PG8_SCHED; PG8_LDA(At, 0, 0); PG8_STAGE(PG8_SA(1, 1), a1 + hstep, voffA);
            PG8_WAIT_L(8); PG8_BAR; PG8_WAIT_L(0); PG8_MMA(0, 0, At, B0); PG8_BAR; PG8_SCHED;
            PG8_LDB(B1, 0, 1); PG8_STAGE(PG8_SB(0, 0), b2, voffB);
            PG8_BAR; PG8_WAIT_L(0); PG8_MMA(0, 1, At, B1); PG8_BAR;
            PG8_LDA(At, 0, 1); PG8_STAGE(PG8_SA(0, 0), a2, voffA);
            PG8_BAR; PG8_WAIT_L(0); PG8_MMA(1, 0, At, B0); PG8_BAR; PG8_SCHED;
            PG8_STAGE(PG8_SB(0, 1), b2 + hstep, voffB);
            PG8_WAIT_V(6); PG8_BAR; PG8_MMA(1, 1, At, B1); PG8_BAR;
            PG8_LDB(B0, 1, 0); PG8_SCHED; PG8_LDA(At, 1, 0); PG8_STAGE(PG8_SA(0, 1), a2 + hstep, voffA);
            PG8_WAIT_L(8); PG8_BAR; PG8_WAIT_L(0); PG8_MMA(0, 0, At, B0); PG8_BAR; PG8_SCHED;
            PG8_LDB(B1, 1, 1); PG8_STAGE(PG8_SB(1, 0), b3, voffB);
            PG8_BAR; PG8_WAIT_L(0); PG8_MMA(0, 1, At, B1); PG8_BAR;
            PG8_LDA(At, 1, 1); PG8_STAGE(PG8_SA(1, 0), a3, voffA);
            PG8_BAR; PG8_WAIT_L(0); PG8_MMA(1, 0, At, B0); PG8_BAR; PG8_SCHED;
            PG8_STAGE(PG8_SB(1, 1), b3 + hstep, voffB);
            PG8_WAIT_V(6); PG8_BAR; PG8_MMA(1, 1, At, B1); PG8_BAR;
            }
        }
        if constexpr (ALIGN_EPI) { if (wr == 0) PG8_BAR; }
        { E(acc, cur, wr, wc, fr, fq, elds, wid, lane, RSL + (ui & 7) * 256); S.done(cur); }
        if (!has_next) break;
#pragma unroll
        for (int a = 0; a < 2; ++a)
#pragma unroll
            for (int b = 0; b < 2; ++b)
#pragma unroll
                for (int m = 0; m < 4; ++m)
#pragma unroll
                    for (int n = 0; n < 2; ++n) acc[a][b][m][n] = z4_;
        cur = nxt; cA = nA; cB = nB; ++ui;
        if constexpr (ALIGN_EPI) { if (wr == 1) PG8_BAR; }
    }
    PG8_WAIT_V(0);
    if constexpr (!ALIGN_EPI) { if (wr == 0) PG8_BAR; }
    PG8_BAR;
#undef PG8_SA
#undef PG8_SB
#undef PG8_STAGE
#undef PG8_LDA
#undef PG8_LDB
#undef PG8_MMA
#undef PG8_WAIT_V
#undef PG8_WAIT_L
#undef PG8_BAR
#undef PG8_SCHED
}
}


#define GAS __attribute__((address_space(1)))
#define LAS __attribute__((address_space(3)))
typedef unsigned short bf16;
typedef unsigned v4u __attribute__((ext_vector_type(4)));
typedef float f32x4 __attribute__((ext_vector_type(4)));
typedef short bf16x8 __attribute__((ext_vector_type(8)));

constexpr int NWAVES = 8;
constexpr int T = 16384, D = 1024, FF = 2816, FF2 = 5632, MIN_ = 3080;
constexpr size_t MiB = 1u << 20;
constexpr size_t WS_CTL = 0, CTL_ZERO_BYTES = 2 * MiB;
constexpr size_t WS_SS = 64 * 1024;
constexpr size_t WS_WINR = 2 * MiB;
constexpr size_t WS_WINT = 10 * MiB;
constexpr size_t WS_WOUT = 16 * MiB;
constexpr size_t WS_WK = 20 * MiB, WS_WV = 22 * MiB;
constexpr size_t WS_WQ = 24 * MiB;
constexpr size_t WS_WO = 28 * MiB;
constexpr size_t WS_WUP = 32 * MiB;
constexpr size_t WS_WDN = 76 * MiB;
constexpr size_t WS_WG = 98 * MiB;
constexpr size_t WS_ROPE = 99 * MiB;
constexpr size_t WS_HB = 101 * MiB;
constexpr size_t HB_ROW0 = 2 * 2048;
constexpr size_t WS_ACT = 135 * MiB;
constexpr size_t WS_CT = 135 * MiB;
constexpr size_t WS_MQ = 199 * MiB;
constexpr size_t WS_BCUM = 215 * MiB, WS_IG = WS_BCUM + 256 * 1024, WS_WGT = WS_IG + 256 * 1024, WS_DECAY = WS_WGT + 256 * 1024;
constexpr size_t WS_NCT = 217 * MiB;
constexpr size_t WS_ONES = 221 * MiB;
constexpr size_t WS_MK = 223 * MiB;
constexpr size_t WS_OG = 239 * MiB;
constexpr size_t WS_KVT = 271 * MiB;
constexpr size_t WS_HG = 319 * MiB;
constexpr size_t WS_XK = 223 * MiB;
constexpr size_t WS_XVT = 255 * MiB;
constexpr size_t WS_KMEAN = 287 * MiB;
constexpr size_t WS_DUMP = 287 * MiB + 512 * 1024;
constexpr size_t WS_AQ = 288 * MiB;
constexpr size_t WS_LIST = 320 * MiB;
constexpr size_t WS_ML = 337 * MiB;
constexpr size_t WS_PO = 135 * MiB, WS_PO2 = 340 * MiB;
constexpr int PO_SPLIT = 14336;
constexpr int TRI = 516096;
constexpr size_t WS_GCNT = 1536 * 1024;
constexpr size_t WS_END = 352 * MiB;
constexpr int CW_BAR = 4096;
constexpr int RING_BYTES = 131072, EPI_OFF = RING_BYTES + 1024, LDS_BYTES = 163840, MISC_OFF = LDS_BYTES - 256;

#define LDS_WAIT() asm volatile("s_waitcnt lgkmcnt(0)" ::: "memory")
__device__ __forceinline__ unsigned f2bf(float f) { unsigned u = __builtin_bit_cast(unsigned, f); return (u + 0x7fffu + ((u >> 16) & 1u)) >> 16; }
__device__ __forceinline__ unsigned pk2(float lo, float hi) { return f2bf(lo) | (f2bf(hi) << 16); }

#define XB_TMO      128
#define XB_XCNT(j)  (256  + 64 * (j))
#define XB_XSUB(j)  (1280 + 64 * (j))
#define XB_XGEN(j)  (2304 + 64 * (j))
#define XB_TOP      3328
#define XB_TOPGEN   3392
#define XCD_BAR_WORDS 3456
#define XB_SPIN_CAP (1u << 18)
__device__ __forceinline__ unsigned xb_ld(unsigned* p)              { return __hip_atomic_load(p, __ATOMIC_RELAXED, __HIP_MEMORY_SCOPE_AGENT); }
__device__ __forceinline__ unsigned xb_add(unsigned* p, unsigned v) { return __hip_atomic_fetch_add(p, v, __ATOMIC_RELAXED, __HIP_MEMORY_SCOPE_AGENT); }
__device__ __forceinline__ unsigned xb_xcc_id() { return (unsigned)__builtin_amdgcn_s_getreg((3 << 11) | 20) & 0xFu; }
#define XB_SPIN(cond, bar) do { unsigned _sp = 0; while (cond) { __builtin_amdgcn_s_sleep(1); \
    if ((++_sp & 255u) == 0u) { if (xb_ld(&(bar)[XB_TMO])) break; if (_sp > XB_SPIN_CAP) { atomicAdd(&(bar)[XB_TMO], 1u); break; } } } } while (0)
struct XcdBarrier { unsigned* bar; unsigned x; volatile LAS unsigned* st; };
__device__ __forceinline__ XcdBarrier xcd_barrier_post(unsigned* bar, volatile LAS unsigned* st) {
    XcdBarrier b; b.bar = bar; b.x = xb_xcc_id(); b.st = st;
    if (threadIdx.x == 0) (void)xb_add(&bar[XB_XCNT(b.x)], 1u);
    return b;
}
__device__ __forceinline__ void xcd_barrier_complete(unsigned* bar, unsigned x, unsigned& nloc, unsigned& nx) {
    const unsigned G = gridDim.x * gridDim.y * gridDim.z;
    unsigned sum, cnt, mine, sp = 0u;
    for (;;) {
        sum = 0u; cnt = 0u; mine = 0u;
#pragma unroll
        for (unsigned j = 0; j < 16; ++j) { const unsigned c = xb_ld(&bar[XB_XCNT(j)]); sum += c; cnt += (c > 0u) ? 1u : 0u; mine = (j == x) ? c : mine; }
        if (sum == G) break;
        __builtin_amdgcn_s_sleep(1);
        if ((++sp & 255u) == 0u) { if (xb_ld(&bar[XB_TMO])) break; if (sp > XB_SPIN_CAP) { atomicAdd(&bar[XB_TMO], 1u); break; } }
    }
    nloc = mine > 0u ? mine : 1u; nx = cnt > 0u ? cnt : 1u;
}
__device__ __forceinline__ void xcd_barrier(const XcdBarrier& b) {
    asm volatile("s_waitcnt vmcnt(0)" ::: "memory");
    __syncthreads();
    if (threadIdx.x == 0) {
        unsigned* bar = b.bar;
        __builtin_amdgcn_s_waitcnt(0);
        unsigned nloc = b.st[0], nx = b.st[1];
        if (nloc == 0u) { xcd_barrier_complete(bar, b.x, nloc, nx); b.st[0] = nloc; b.st[1] = nx; }
        const unsigned old = xb_add(&bar[XB_XSUB(b.x)], 1u);
        const unsigned gen = old / nloc;
        if (old + 1u == (gen + 1u) * nloc) {
            __builtin_amdgcn_fence(__ATOMIC_RELEASE, "agent");
            asm volatile("s_waitcnt vmcnt(0)" ::: "memory");
            const unsigned og = xb_add(&bar[XB_TOP], 1u);
            const unsigned tg = og / nx;
            if (og + 1u == (tg + 1u) * nx) xb_add(&bar[XB_TOPGEN], 1u);
            else XB_SPIN(xb_ld(&bar[XB_TOPGEN]) == tg, bar);
            __builtin_amdgcn_fence(__ATOMIC_ACQUIRE, "agent");
            xb_add(&bar[XB_XGEN(b.x)], 1u);
            asm volatile("s_waitcnt vmcnt(0)" ::: "memory");
        } else {
            XB_SPIN(xb_ld(&bar[XB_XGEN(b.x)]) == gen, bar);
            __builtin_amdgcn_fence(__ATOMIC_ACQUIRE, "agent");
            asm volatile("s_waitcnt vmcnt(0)" ::: "memory");
        }
    }
    __syncthreads();
}

using pg8::sh_idx; using pg8::sh_xor; using pg8::half_sum_hi; using pg8::oct_sum;
__device__ __forceinline__ float wave_sum_hi(float v) { v = pg8::half_sum_hi(v); return pg8::dpp_add<0x143, 0xC>(v); }
__device__ __forceinline__ float wave_sum(float v, int lane) {
#pragma unroll
    for (int o = 1; o < 64; o <<= 1) v += sh_xor(v, o, lane);
    return v;
}
__device__ __forceinline__ void transpose_item(const float* W, int ldw, int k0, int n0, const float* gain, bf16* WT, int Kd, int d0, bf16* WT2, int d1, LAS float* scr, int lane) {
    float v_[32], g_[32];
#pragma unroll
    for (int i = 0; i < 32; ++i) { const int kk = 2 * i + (lane >> 5); v_[i] = W[(size_t)(k0 + kk) * ldw + n0 + (lane & 31)]; g_[i] = gain ? gain[k0 + kk] : 1.0f; }
#pragma unroll
    for (int i = 0; i < 32; ++i) { const int kk = 2 * i + (lane >> 5); scr[kk * 33 + (lane & 31)] = v_[i] * g_[i]; }
    LDS_WAIT(); asm volatile("" ::: "memory");
    const int c = lane & 7;
#pragma unroll
    for (int j = 0; j < 4; ++j) { const int n = (lane >> 3) + 8 * j; const LAS float* s = scr + (8 * c) * 33 + n;
        v4u o; o.x = pk2(s[0 * 33], s[1 * 33]); o.y = pk2(s[2 * 33], s[3 * 33]); o.z = pk2(s[4 * 33], s[5 * 33]); o.w = pk2(s[6 * 33], s[7 * 33]);
        *(GAS v4u*)(WT + (size_t)(d0 + n) * Kd + k0 + 8 * c) = o;
        if (WT2) *(GAS v4u*)(WT2 + (size_t)(d1 + n) * Kd + k0 + 8 * c) = o; }
    LDS_WAIT(); asm volatile("" ::: "memory");
}


typedef float f32x16 __attribute__((ext_vector_type(16)));
__device__ __forceinline__ float bf2f(unsigned short v) { return __builtin_bit_cast(float, (unsigned)v << 16); }
__device__ __forceinline__ float log_sigmoidf(float f) { return fminf(f, 0.f) - log1pf(expf(-fabsf(f))); }

__device__ __forceinline__ void mlstm_gates_item(LAS unsigned char* L, int c, const bf16* hbr, const float* wg, const float* ssn, const float* bg,
                                                 float* BCUM, float* IG, float* WGT, float* DECAY, bf16* WROW) {
    int tid_ = threadIdx.x; asm volatile("" : "+v"(tid_)); const int tid = tid_, lane = tid & 63, wave = __builtin_amdgcn_readfirstlane(tid >> 6); (void)tid; (void)lane; (void)wave;
    LAS float* Gs = (LAS float*)L;
    LAS float* WL = (LAS float*)(L + 4096);
    {   f32x4 wv[4];
#pragma unroll
        for (int q = 0; q < 4; ++q) wv[q] = ((const GAS f32x4*)wg)[tid + 512 * q];
#pragma unroll
        for (int q = 0; q < 4; ++q) { const int m = tid + 512 * q, k = m >> 1; *(LAS f32x4*)(WL + (((k >> 9) * 64 + ((k & 511) >> 3)) * 68 + (k & 7) * 8 + (m & 1) * 4)) = wv[q]; }
    }
    LDS_WAIT(); __syncthreads();
    float w[16][8];
#pragma unroll
    for (int j = 0; j < 2; ++j)
#pragma unroll
        for (int i = 0; i < 8; ++i) { const LAS float* wp = WL + ((j * 64 + lane) * 68 + i * 8); const f32x4 a = *(const LAS f32x4*)wp, b = *(const LAS f32x4*)(wp + 4);
            w[8 * j + i][0] = a[0]; w[8 * j + i][1] = a[1]; w[8 * j + i][2] = a[2]; w[8 * j + i][3] = a[3]; w[8 * j + i][4] = b[0]; w[8 * j + i][5] = b[1]; w[8 * j + i][6] = b[2]; w[8 * j + i][7] = b[3]; }
    for (int tt = 0; tt < 8; ++tt) {
        const int tl = wave * 8 + tt, t = 64 * c + tl;
        const GAS v4u* xr = (const GAS v4u*)(hbr + (size_t)t * D) + lane;
        float a8[8] = {0.f, 0.f, 0.f, 0.f, 0.f, 0.f, 0.f, 0.f};
#pragma unroll
        for (int j = 0; j < 2; ++j) { const v4u xv = xr[64 * j];
#pragma unroll
            for (int i = 0; i < 8; ++i) { const float xf = (i & 1) ? __builtin_bit_cast(float, xv[i >> 1] & 0xffff0000u) : __builtin_bit_cast(float, xv[i >> 1] << 16);
#pragma unroll
                for (int q = 0; q < 8; ++q) a8[q] += xf * w[8 * j + i][q]; } }
        const float rs = pg8::rstd4(ssn, t);
#pragma unroll
        for (int q = 0; q < 8; ++q) { const float v = wave_sum_hi(a8[q]); if (lane == 63) Gs[tl * 8 + q] = v * rs; }
    }
    LDS_WAIT(); __syncthreads();
    if (wave < 4) {
        const int h = wave, t = 64 * c + lane;
        const float gi = Gs[lane * 8 + h] + bg[h], gf = Gs[lane * 8 + 4 + h] + bg[4 + h];
        float b = log_sigmoidf(gf);
#pragma unroll
        for (int o = 1; o < 64; o <<= 1) { const float v = sh_idx(b, lane - o); if (lane >= o) b += v; }
        const float bl = sh_idx(b, 63);
        BCUM[(size_t)h * T + t] = b; IG[(size_t)h * T + t] = gi; { const float wv_ = expf(bl - b + gi); WGT[(size_t)h * T + t] = wv_; WROW[(size_t)(c * 4 + h) * 64 + lane] = (bf16)f2bf(wv_); }
        if (lane == 63) DECAY[c * 4 + h] = expf(bl);
    }
    LDS_WAIT(); __syncthreads();
}

__device__ __forceinline__ bf16x8 scale_bf16x8(bf16x8 v, bf16x8 wv) {
    typedef unsigned u4 __attribute__((ext_vector_type(4)));
    const u4 u = __builtin_bit_cast(u4, v), w = __builtin_bit_cast(u4, wv); u4 o;
#pragma unroll
    for (int i = 0; i < 4; ++i)
        o[i] = pg8::cvt_pk_bf16(__builtin_bit_cast(float, u[i] << 16) * __builtin_bit_cast(float, w[i] << 16), __builtin_bit_cast(float, u[i] & 0xffff0000u) * __builtin_bit_cast(float, w[i] & 0xffff0000u));
    return __builtin_bit_cast(bf16x8, o);
}
__device__ __forceinline__ void mlstm_scan(const bf16* KVT, const float* DECAY, bf16* CT, bf16* NCT, const bf16* WROW, const bf16* ZROW, int G, bool probe_same = false) {
    int tid_ = threadIdx.x; asm volatile("" : "+v"(tid_)); const int tid = tid_, lane = tid & 63, wave = __builtin_amdgcn_readfirstlane(tid >> 6); (void)tid;
    bool active, ntask; int h, e0, d0;
    if (G == 256) { const int x = (int)blockIdx.x & 7, cu = (int)blockIdx.x >> 3; h = x >> 1;
        if (wave < 2) { const int k = wave * 32 + cu; active = true; ntask = false; e0 = (x & 1) * 128 + (k >> 3) * 16; d0 = (k & 7) * 16; }
        else { active = (wave == 2) && ((x & 1) == 0) && (cu < 8); ntask = true; e0 = 0; d0 = (cu & 7) * 16; }
    } else { const int gw = wave * G + (int)blockIdx.x; active = gw < 544; ntask = gw >= 512;
        if (!ntask) { h = gw >> 7; e0 = ((gw >> 3) & 15) * 16; d0 = (gw & 7) * 16; } else { const int q = gw - 512; h = (q >> 3) & 3; e0 = 0; d0 = (q & 7) * 16; } }
    if (probe_same) { h = 0; e0 = 0; d0 = 0; }
    if (active) {
        const int fr = lane & 15, fq = lane >> 4;
        const bf16* arow = KVT + (size_t)((h * 8 + (d0 >> 4)) * 2) * 512 + lane * 8;
        const bf16* brow = ntask ? ((fr == 0 ? WROW + h * 64 : ZROW) + 8 * fq) : (KVT + (size_t)((32 + h * 16 + (e0 >> 4)) * 2) * 512 + lane * 8);
        bf16* crow = ntask ? (NCT + ((size_t)h * 16 + fr) * 128 + d0 + 4 * fq) : (CT + ((size_t)(h * 8 + (e0 >> 5)) * 8 + (d0 >> 4)) * 512 + ((fq >> 1) * 32 + (e0 & 16) + fr) * 8 + 4 * (fq & 1));
        const size_t cstep = probe_same ? (size_t)0 : (ntask ? (size_t)4 * 16 * 128 : (size_t)4 * 256 * 128);
        const float* drow = DECAY + h;
        const size_t bstep = ntask ? (fr == 0 ? (size_t)256 : (size_t)0) : (size_t)1536 * 64;
        constexpr int P = 8;
        bf16x8 sa[P][2], sb[P][2]; float sd[P];
        const char* pa = (const char*)arow; const char* pb = (const char*)brow; const size_t b2off = ntask ? 64 : 1024;     const char* pd = (const char*)(DECAY + h); char* pc = (char*)crow;
        const size_t astep = (size_t)1536 * 64 * 2, bstepb = bstep * 2, cstepb = cstep * 2;
#define SC_LD16(dst, ptr, OFF) asm volatile("global_load_dwordx4 %0, %1, off offset:" #OFF : "=&v"(dst) : "v"(ptr) : "memory")
#define SC_LD4(dst, ptr) asm volatile("global_load_dword %0, %1, off" : "=&v"(dst) : "v"(ptr) : "memory")
#define SC_LOADS(j) do { SC_LD16(sa[j][0], pa, 0); SC_LD16(sa[j][1], pa, 1024); { const char* pb2_ = pb + b2off; SC_LD16(sb[j][0], pb, 0); SC_LD16(sb[j][1], pb2_, 0); } SC_LD4(sd[j], pd); pa += astep; pb += bstepb; pd += 16; } while (0)
#pragma unroll
        for (int j = 0; j < P; ++j) { float dm_; SC_LD4(dm_, pd); SC_LOADS(j); }
        f32x4 acc = (f32x4){0.f, 0.f, 0.f, 0.f};
        for (int c0 = 0; c0 < 256; c0 += P) {
#pragma unroll
            for (int j = 0; j < P; ++j) {
                asm volatile("s_waitcnt vmcnt(42)" : "+v"(sa[j][0]), "+v"(sa[j][1]), "+v"(sb[j][0]), "+v"(sb[j][1]), "+v"(sd[j]) :: "memory");
                { typedef unsigned u2 __attribute__((ext_vector_type(2))); u2 o; o.x = pg8::cvt_pk_bf16(acc[0], acc[1]); o.y = pg8::cvt_pk_bf16(acc[2], acc[3]);
                  if (!probe_same) asm volatile("global_store_dwordx2 %0, %1, off" :: "v"(pc), "v"(o) : "memory"); else { float dm2_; asm volatile("global_load_dword %0, %1, off" : "=&v"(dm2_) : "v"(pd), "v"(o) : "memory"); }
                  pc += cstepb; }
                acc = acc * sd[j];
                acc = __builtin_amdgcn_mfma_f32_16x16x32_bf16(sa[j][0], sb[j][0], acc, 0, 0, 0);
                acc = __builtin_amdgcn_mfma_f32_16x16x32_bf16(sa[j][1], sb[j][1], acc, 0, 0, 0);
                asm volatile("" : "+v"(acc));
                SC_LOADS(j);
            }
        }
        asm volatile("s_waitcnt vmcnt(0)" ::: "memory");
#undef SC_LD16
#undef SC_LD4
#undef SC_LOADS
    }
}

constexpr int M3_BUF = 36864;
constexpr int M3_QS = 0, M3_KS = 17408, M3_BC = 35840, M3_IG = 36096, M3_NV = 36352;
constexpr int M3_SS = 73728, M3_DQ = 82944, M3_DSP = 83200, M3_OS = 83968  , M3_GN = 150528  ;
__device__ __forceinline__ void mlstm_out_phase(LAS unsigned char* L, int G, const bf16* Q, const bf16* K, const bf16* KVT, const bf16* CT, const bf16* NCT,
                                                const float* BCUM, const float* WGT, const bf16* OG, const float* hn, bf16* HG) {
    int tid_ = threadIdx.x; asm volatile("" : "+v"(tid_)); const int tid = tid_, lane = tid & 63, wave = __builtin_amdgcn_readfirstlane(tid >> 6);
    const int r = lane & 31, hh = lane >> 5;
    LAS float* dq = (LAS float*)(L + M3_DQ); LAS float* dsp = (LAS float*)(L + M3_DSP); LAS float* OS = (LAS float*)(L + M3_OS);
    int it = (int)blockIdx.x; if (it >= 1024) return;
#if TIMEX == 3
    unsigned tacc_ = 0; TSTAMP(tp0_);
#endif
    bf16x8 ctf[8], vtf[4]; v4u ogf[4]; v4u qk[4]; float sm = 0.f;
#define M3_LD_CT(c_, h_) do { const bf16* ctp = CT + (((size_t)((c_) * 4 + (h_)) * 8 + wave) * 8) * 512 + lane * 8; _Pragma("unroll") for (int kk = 0; kk < 8; ++kk) ctf[kk] = *(const bf16x8*)(ctp + 512 * kk); } while (0)
#define M3_LD_VT(c_, h_) do { const bf16* vtp = KVT + (((size_t)(c_) * 96 + 32 + (h_) * 16 + 2 * wave + (r >> 4)) * 2) * 512 + (hh * 16 + (r & 15)) * 8; _Pragma("unroll") for (int kk = 0; kk < 4; ++kk) vtf[kk] = *(const bf16x8*)(vtp + (kk >> 1) * 512 + (kk & 1) * 256); } while (0)
#define M3_LD_OG(c_, h_) do { const bf16* ogp = OG + (size_t)(64 * (c_) + (tid >> 3)) * 1024 + (h_) * 256 + 8 * (tid & 7); _Pragma("unroll") for (int k = 0; k < 4; ++k) ogf[k] = *(const GAS v4u*)(ogp + 64 * k); } while (0)
#define M3_LD_QK(c_, h_) do { _Pragma("unroll") for (int j = 0; j < 4; ++j) { const int idx = tid + 512 * (j & 1), row = idx >> 4, ch = idx & 15; \
            if (j >> 1) qk[j] = *(const GAS v4u*)(KVT + (((size_t)(c_) * 96 + (h_) * 8) * 2) * 512 + idx * 8); else qk[j] = *(const GAS v4u*)(Q + (size_t)(64 * (c_) + row) * 512 + (h_) * 128 + ch * 8); } \
        { const float s0_ = BCUM[(size_t)(h_) * T + 64 * (c_) + (tid & 63)], s1_ = WGT[(size_t)(h_) * T + 64 * (c_) + (tid & 63)]; const float s2_ = bf2f(NCT[(size_t)((c_) * 4 + (h_)) * 16 * 128 + (tid & 127)]); \
          sm = tid < 64 ? s0_ : (tid < 128 ? s1_ : s2_); } } while (0)
#define M3_ST_QK(B_) do { _Pragma("unroll") for (int j = 0; j < 4; ++j) { const int i = tid + 512 * j, which = i >> 10, idx = i & 1023, row = idx >> 4, ch = idx & 15; if (which) { const int bi_ = idx >> 6, lp_ = idx & 63; *(LAS v4u*)((B_) + M3_KS + (16 * (bi_ >> 1) + (lp_ & 15)) * 144 + (32 * (bi_ & 1) + 8 * (lp_ >> 4)) * 2) = qk[j]; } \
            else *(LAS v4u*)((B_) + row * 272 + ch * 16) = qk[j]; } \
        if (tid < 256) ((LAS float*)((B_) + M3_BC))[tid] = sm; } while (0)
    { LAS float* GN = (LAS float*)(L + M3_GN); GN[tid] = hn[tid]; GN[512 + tid] = hn[512 + tid]; }
    { const int c = it >> 2, h = it & 3; M3_LD_CT(c, h); M3_LD_VT(c, h); M3_LD_OG(c, h); M3_LD_QK(c, h); M3_ST_QK(L); }
    LDS_WAIT(); __syncthreads();
    int pb = 0;
    for (;;) {
        const int c = it >> 2, h = it & 3, t0 = 64 * c, itn = it + G; const bool has_next = itn < 1024; const int itc = has_next ? itn : it, cn = itc >> 2, hn_ = itc & 3;
        LAS unsigned char* B = L + pb * M3_BUF; LAS unsigned char* Bn = L + (pb ^ 1) * M3_BUF;
        LAS float* bc = (LAS float*)(B + M3_BC); LAS float* ig = (LAS float*)(B + M3_IG); LAS float* nv = (LAS float*)(B + M3_NV);
#if TIMEX == 3
        TSTAMP(t0_); if (it == (int)blockIdx.x) TACC(5, tp0_, t0_);
#endif
        M3_LD_QK(cn, hn_);
        f32x16 O[2];
#pragma unroll
        for (int i = 0; i < 16; ++i) { O[0][i] = 0.f; O[1][i] = 0.f; }
#pragma unroll
        for (int kk = 0; kk < 8; ++kk) {
            const bf16x8 a0 = *(const LAS bf16x8*)(B + M3_QS + r * 272 + (16 * kk + 8 * hh) * 2), a1 = *(const LAS bf16x8*)(B + M3_QS + (32 + r) * 272 + (16 * kk + 8 * hh) * 2);
            O[0] = __builtin_amdgcn_mfma_f32_32x32x16_bf16(a0, ctf[kk], O[0], 0, 0, 0); O[1] = __builtin_amdgcn_mfma_f32_32x32x16_bf16(a1, ctf[kk], O[1], 0, 0, 0);
        }
        M3_LD_CT(cn, hn_);
        if (wave < 4) {
            const int tt = wave >> 1, s2 = wave & 1; f32x16 S;
#pragma unroll
            for (int i = 0; i < 16; ++i) S[i] = 0.f;
#pragma unroll
            for (int kk = 0; kk < 8; ++kk) {
                const bf16x8 a = *(const LAS bf16x8*)(B + M3_QS + (32 * tt + r) * 272 + (16 * kk + 8 * hh) * 2);
                typedef short v4i16_t __attribute__((ext_vector_type(4)));
                const int i16 = lane & 15, q4 = i16 >> 2, p4 = i16 & 3, blk = (lane >> 4) & 1;
                LAS unsigned char* tb = B + M3_KS + (16 * kk + 8 * hh + q4) * 144 + (32 * s2 + 16 * blk + 4 * p4) * 2;
                const v4i16_t lo = __builtin_amdgcn_ds_read_tr16_b64_v4i16((LAS v4i16_t*)tb), hi = __builtin_amdgcn_ds_read_tr16_b64_v4i16((LAS v4i16_t*)(tb + 4 * 144));
                const bf16x8 b = __builtin_shufflevector(lo, hi, 0, 1, 2, 3, 4, 5, 6, 7);
                S = __builtin_amdgcn_mfma_f32_32x32x16_bf16(a, b, S, 0, 0, 0);
            }
            const int s = 32 * s2 + r; const float ws = ig[s], bl = bc[63];
#pragma unroll
            for (int i = 0; i < 16; ++i) {
                const int t = 32 * tt + (i & 3) + 8 * (i >> 2) + 4 * hh;
                const float v = (s <= t) ? S[i] * __expf(bc[t] - bl) : 0.f;
                const float rsum = half_sum_hi(v * ws);
                if (r == 16) dsp[s2 * 64 + t] = rsum;
                *(LAS unsigned short*)(L + M3_SS + t * 144 + s * 2) = (unsigned short)f2bf(v);
            }
        } else {
            const int th = tid - 256, t = th >> 2, part = th & 3; float sum = 0.f;
#pragma unroll 8
            for (int d = 0; d < 32; ++d) sum += bf2f(*(const LAS unsigned short*)(B + M3_QS + t * 272 + (32 * part + d) * 2)) * nv[32 * part + d];
            sum = pg8::dpp_add<0xB1>(sum); sum = pg8::dpp_add<0x4E>(sum);
            if (part == 0) dq[t] = sum;
        }
#if TIMEX == 3
        TSTAMP(t1_); TACC(0, t0_, t1_);
#endif
        LDS_WAIT(); __syncthreads();
#if TIMEX == 3
        TSTAMP(t2_); TACC(1, t1_, t2_);
#endif
#pragma unroll
        for (int tt = 0; tt < 2; ++tt)
#pragma unroll
            for (int i = 0; i < 16; ++i) O[tt][i] *= __expf(bc[32 * tt + (i & 3) + 8 * (i >> 2) + 4 * hh]);
#pragma unroll
        for (int kk = 0; kk < 4; ++kk) {
            const bf16x8 a0 = *(const LAS bf16x8*)(L + M3_SS + r * 144 + (16 * kk + 8 * hh) * 2), a1 = *(const LAS bf16x8*)(L + M3_SS + (32 + r) * 144 + (16 * kk + 8 * hh) * 2);
            O[0] = __builtin_amdgcn_mfma_f32_32x32x16_bf16(a0, vtf[kk], O[0], 0, 0, 0); O[1] = __builtin_amdgcn_mfma_f32_32x32x16_bf16(a1, vtf[kk], O[1], 0, 0, 0);
        }
        M3_LD_VT(cn, hn_);
#pragma unroll
        for (int tt = 0; tt < 2; ++tt)
#pragma unroll
            for (int i = 0; i < 16; ++i) OS[(32 * tt + (i & 3) + 8 * (i >> 2) + 4 * hh) * 260 + 32 * wave + r] = O[tt][i];
#if TIMEX == 3
        TSTAMP(t3_); TACC(2, t2_, t3_);
#endif
        LDS_WAIT(); __syncthreads();
#if TIMEX == 3
        TSTAMP(t4_); TACC(3, t3_, t4_);
#endif
        {
            const int t = tid >> 3, part = tid & 7;
            const float den = __expf(bc[t]) * dq[t] + dsp[t] + dsp[64 + t];
            const float inv = __builtin_amdgcn_rcpf(fmaxf(fabsf(den), 1.0f));
            f32x4 v[8]; float ssq = 0.f;
#pragma unroll
            for (int k = 0; k < 8; ++k) { v[k] = *(const LAS f32x4*)(OS + t * 260 + 64 * (k >> 1) + 8 * part + 4 * (k & 1)) * inv; ssq += (v[k][0] * v[k][0] + v[k][1] * v[k][1]) + (v[k][2] * v[k][2] + v[k][3] * v[k][3]); }
            ssq = oct_sum(ssq);
            const float rsn = rsqrtf(ssq * (1.0f / 256.0f) + 1e-6f);
            const LAS float* gp = (const LAS float*)(L + M3_GN) + h * 256 + 8 * part;
            bf16* op = HG + (size_t)(t0 + t) * 1024 + h * 256 + 8 * part;
#pragma unroll
            for (int k = 0; k < 4; ++k) {
                const f32x4 g0 = *(const LAS f32x4*)(gp + 64 * k), g1 = *(const LAS f32x4*)(gp + 64 * k + 4);
                float o8[8];
#pragma unroll
                for (int x2 = 0; x2 < 4; ++x2) {
                    const float og0 = __builtin_bit_cast(float, ogf[k][x2] << 16), og1 = __builtin_bit_cast(float, ogf[k][x2] & 0xffff0000u);
                    const float a0 = (2 * x2 < 4) ? v[2 * k][2 * x2] : v[2 * k + 1][2 * x2 - 4], a1 = (2 * x2 + 1 < 4) ? v[2 * k][2 * x2 + 1] : v[2 * k + 1][2 * x2 + 1 - 4];
                    const float gg0 = (2 * x2 < 4) ? g0[2 * x2] : g1[2 * x2 - 4], gg1 = (2 * x2 + 1 < 4) ? g0[2 * x2 + 1] : g1[2 * x2 + 1 - 4];
                    o8[2 * x2] = a0 * rsn * gg0 * __builtin_amdgcn_rcpf(1.0f + __builtin_amdgcn_exp2f(-1.4426950408889634f * og0)); o8[2 * x2 + 1] = a1 * rsn * gg1 * __builtin_amdgcn_rcpf(1.0f + __builtin_amdgcn_exp2f(-1.4426950408889634f * og1)); }
                v4u w; w.x = pg8::cvt_pk_bf16(o8[0], o8[1]); w.y = pg8::cvt_pk_bf16(o8[2], o8[3]); w.z = pg8::cvt_pk_bf16(o8[4], o8[5]); w.w = pg8::cvt_pk_bf16(o8[6], o8[7]);
                *(GAS v4u*)(op + 64 * k) = w; }
        }
        M3_LD_OG(cn, hn_); M3_ST_QK(Bn);
#if TIMEX == 3
        TSTAMP(t5_); TACC(4, t4_, t5_);
#endif
        LDS_WAIT(); __syncthreads();
#if TIMEX == 3
        { TSTAMP(t6_); TACC(6, t5_, t6_); TACC(7, t0_, t6_); }
#endif
        if (!has_next) break;
        it = itn; pb ^= 1;
    }
#if TIMEX == 3
    if ((int)blockIdx.x == TBLK && wave == TW && lane == 0) g_dbg = tacc_;
#endif
#undef M3_LD_CT
#undef M3_LD_VT
#undef M3_LD_OG
#undef M3_LD_QK
#undef M3_ST_QK
}

constexpr int AT_QS = 0, AT_PS = 34816, AT_PM = 102400, AT_PSUM = 106496, AT_ENT = 110592, AT_W = 111104, AT_MX = 113152, AT_PRE = 113664  , AT_WT = 115744;
constexpr int GT_KH = 34816, GT_KL = 52224, GT_SC = 69632, GT_LCNT = 102912, GT_BASE = 103168;
__device__ __forceinline__ int list_off(int h, int b) { return h * TRI + b * T - 128 * b * (b + 1); }
__device__ __forceinline__ void moba_gate_phase(LAS unsigned char* L, int G, const bf16* AQ, const float* KMEAN, int* gcnt, int* LIST) {
    int tid_ = threadIdx.x; asm volatile("" : "+v"(tid_)); const int tid = tid_, lane = tid & 63, wave = __builtin_amdgcn_readfirstlane(tid >> 6);
    const int r = lane & 31, hh = lane >> 5;
    LAS int* LCNT = (LAS int*)(L + GT_LCNT); LAS int* BASE = (LAS int*)(L + GT_BASE); LAS float* SC = (LAS float*)(L + GT_SC);
    int h_loaded = -1;
    int it = (int)blockIdx.x;
    while (it < 1024 && (it >> 4) == 0) it += G;
    if (it >= 1024) return;
    v4u qn[4];
#pragma unroll
    for (int j = 0; j < 4; ++j) { const int i = tid + 512 * j, rl = i >> 4, ch = i & 15; qn[j] = *(const GAS v4u*)(AQ + (size_t)(128 * (it >> 3) + rl) * 1024 + (it & 7) * 128 + ch * 8); }
    for (;;) {
        const int qi = it >> 3, h = it & 7, cur = qi >> 1;
        int itn = it + G; const bool has_next = itn < 1024;
        if (h != h_loaded) {
            float kmv[16];
#pragma unroll
            for (int q = 0; q < 16; ++q) kmv[q] = KMEAN[(size_t)h * 8192 + tid + 512 * q];
#pragma unroll
            for (int q = 0; q < 16; ++q) { const int i = tid + 512 * q; const int bb = i >> 7, d = i & 127; const float v = kmv[q];
                const unsigned hi = f2bf(v), lo = f2bf(v - bf2f((unsigned short)hi));
                *(LAS unsigned short*)(L + GT_KH + bb * 272 + d * 2) = (unsigned short)hi; *(LAS unsigned short*)(L + GT_KL + bb * 272 + d * 2) = (unsigned short)lo; }
            h_loaded = h; }
#pragma unroll
        for (int j = 0; j < 4; ++j) { const int i = tid + 512 * j, rl = i >> 4, ch = i & 15; *(LAS v4u*)(L + AT_QS + rl * 272 + ch * 16) = qn[j]; }
        if (tid < 64) LCNT[tid] = 0;
        LDS_WAIT(); __syncthreads();
        if (has_next) {
#pragma unroll
            for (int j = 0; j < 4; ++j) { const int i = tid + 512 * j, rl = i >> 4, ch = i & 15; qn[j] = *(const GAS v4u*)(AQ + (size_t)(128 * (itn >> 3) + rl) * 1024 + (itn & 7) * 128 + ch * 8); }
        }
        {   const int tt = wave >> 1, bt = wave & 1; f32x16 S;
#pragma unroll
            for (int i = 0; i < 16; ++i) S[i] = 0.f;
#pragma unroll
            for (int kk = 0; kk < 8; ++kk) {
                const bf16x8 a = *(const LAS bf16x8*)(L + AT_QS + (32 * tt + r) * 272 + (16 * kk + 8 * hh) * 2);
                const bf16x8 bh = *(const LAS bf16x8*)(L + GT_KH + (32 * bt + r) * 272 + (16 * kk + 8 * hh) * 2), bl = *(const LAS bf16x8*)(L + GT_KL + (32 * bt + r) * 272 + (16 * kk + 8 * hh) * 2);
                S = __builtin_amdgcn_mfma_f32_32x32x16_bf16(a, bh, S, 0, 0, 0); S = __builtin_amdgcn_mfma_f32_32x32x16_bf16(a, bl, S, 0, 0, 0);
            }
#pragma unroll
            for (int i = 0; i < 16; ++i) SC[(32 * tt + (i & 3) + 8 * (i >> 2) + 4 * hh) * 65 + 32 * bt + r] = S[i];
        }
        LDS_WAIT(); __syncthreads();
        int p0 = -1, p1 = -1, p2 = -1, l0 = 0, l1 = 0, l2 = 0; const int nsel = cur < 3 ? cur : 3;
        const int grow = tid >> 2, gq = tid & 3;
        {
            float v0 = -INFINITY, v1 = -INFINITY, v2 = -INFINITY;
#define GT_INS(SC_, B_) do { const float sc_ = (SC_); const int b_ = (B_); \
                if (sc_ > v0) { v2 = v1; p2 = p1; v1 = v0; p1 = p0; v0 = sc_; p0 = b_; } else if (sc_ > v1) { v2 = v1; p2 = p1; v1 = sc_; p1 = b_; } else if (sc_ > v2) { v2 = sc_; p2 = b_; } } while (0)
#pragma unroll
            for (int hb8 = 0; hb8 < 2; ++hb8) {
                const int b0 = 16 * gq + 8 * hb8; float sc8[8];
#pragma unroll
                for (int j = 0; j < 8; ++j) { const int b = b0 + j; const float x = SC[grow * 65 + (b < cur ? b : 0)]; sc8[j] = b < cur ? x : -INFINITY; }
#pragma unroll
                for (int j = 0; j < 8; ++j) GT_INS(sc8[j], b0 + j); }
#pragma unroll
            for (int st = 0; st < 2; ++st) {
                const float w0 = st ? __builtin_bit_cast(float, __builtin_amdgcn_update_dpp(0, __builtin_bit_cast(int, v0), 0x4E, 0xf, 0xf, true)) : __builtin_bit_cast(float, __builtin_amdgcn_update_dpp(0, __builtin_bit_cast(int, v0), 0xB1, 0xf, 0xf, true));
                const float w1 = st ? __builtin_bit_cast(float, __builtin_amdgcn_update_dpp(0, __builtin_bit_cast(int, v1), 0x4E, 0xf, 0xf, true)) : __builtin_bit_cast(float, __builtin_amdgcn_update_dpp(0, __builtin_bit_cast(int, v1), 0xB1, 0xf, 0xf, true));
                const float w2 = st ? __builtin_bit_cast(float, __builtin_amdgcn_update_dpp(0, __builtin_bit_cast(int, v2), 0x4E, 0xf, 0xf, true)) : __builtin_bit_cast(float, __builtin_amdgcn_update_dpp(0, __builtin_bit_cast(int, v2), 0xB1, 0xf, 0xf, true));
                const int q0 = st ? __builtin_amdgcn_update_dpp(0, p0, 0x4E, 0xf, 0xf, true) : __builtin_amdgcn_update_dpp(0, p0, 0xB1, 0xf, 0xf, true);
                const int q1 = st ? __builtin_amdgcn_update_dpp(0, p1, 0x4E, 0xf, 0xf, true) : __builtin_amdgcn_update_dpp(0, p1, 0xB1, 0xf, 0xf, true);
                const int q2 = st ? __builtin_amdgcn_update_dpp(0, p2, 0x4E, 0xf, 0xf, true) : __builtin_amdgcn_update_dpp(0, p2, 0xB1, 0xf, 0xf, true);
                GT_INS(w0, q0); GT_INS(w1, q1); GT_INS(w2, q2);
            }
#undef GT_INS
        }
        if (gq != 0) { p0 = -1; p1 = -1; p2 = -1; }
        if (gq == 0) {
            if (nsel > 0 && p0 >= 0) l0 = __hip_atomic_fetch_add(LCNT + p0, 1, __ATOMIC_RELAXED, __HIP_MEMORY_SCOPE_WORKGROUP);
            if (nsel > 1 && p1 >= 0) l1 = __hip_atomic_fetch_add(LCNT + p1, 1, __ATOMIC_RELAXED, __HIP_MEMORY_SCOPE_WORKGROUP);
            if (nsel > 2 && p2 >= 0) l2 = __hip_atomic_fetch_add(LCNT + p2, 1, __ATOMIC_RELAXED, __HIP_MEMORY_SCOPE_WORKGROUP);
        }
        LDS_WAIT(); __syncthreads();
        if (tid < cur) { const int n = LCNT[tid]; if (n > 0) BASE[tid] = __hip_atomic_fetch_add(gcnt + h * 64 + tid, n, __ATOMIC_RELAXED, __HIP_MEMORY_SCOPE_AGENT); }
        LDS_WAIT(); __syncthreads();
        if (gq == 0) { const int tg = (128 * qi + grow) << 2;
            if (nsel > 0 && p0 >= 0) LIST[list_off(h, p0) + BASE[p0] + l0] = tg | 0;
            if (nsel > 1 && p1 >= 0) LIST[list_off(h, p1) + BASE[p1] + l1] = tg | 1;
            if (nsel > 2 && p2 >= 0) LIST[list_off(h, p2) + BASE[p2] + l2] = tg | 2; }
        if (!has_next) break;
        it = itn;
    }
}

constexpr int AP_QS0 = 0, AP_QS1 = 34816, AP_PS = 69632, AP_PM = 137216, AP_PSUM = 141312, AP_ENT0 = 145408, AP_ENT1 = 145920, AP_W = 146432, AP_MX = 148480, AP_PRE = 148992  , AP_WT = 151072;
struct AItem { int h, b, row0, nrows, qi; const int* list; bool valid; };
template <bool OWN>
__device__ __forceinline__ AItem attn_get(int k, int G, const LAS int* PRE, int total, const int* gcnt, const int* LIST) {
    AItem it; const int idx = (int)blockIdx.x + k * G;
    if (OWN) { it.valid = idx < 1024; it.qi = idx >> 3; it.h = idx & 7; it.b = it.qi >> 1; it.row0 = 128 * it.qi; it.nrows = 128; it.list = nullptr; }
    else {
        it.valid = idx < total; it.qi = 0; int lo = 0, hi = 512;
        if (it.valid) { while (hi - lo > 1) { const int mid = (lo + hi) >> 1; if (PRE[mid] <= idx) lo = mid; else hi = mid; } }
        const int hb = lo; it.h = hb >> 6; it.b = hb & 63; const int i = it.valid ? idx - PRE[hb] : 0, n = it.valid ? gcnt[hb] : 0;
        it.row0 = 128 * i; it.nrows = (n - 128 * i) < 128 ? (n - 128 * i) : 128; it.list = LIST + list_off(it.h, it.b);
    }
    return it;
}
template <bool OWN>
__device__ __forceinline__ void attn_phase(LAS unsigned char* L, int G, const int* gcnt, const int* LIST, const bf16* AQ, const bf16* XK, const bf16* XVT, bf16* PO, float* ML, bf16* AOUT, int tmask, int probe = 0) {
    int tid_ = threadIdx.x; asm volatile("" : "+v"(tid_)); const int tid = tid_, lane = tid & 63, wave = __builtin_amdgcn_readfirstlane(tid >> 6);
    const int r = lane & 31, hh = lane >> 5;
    LAS int* PRE = (LAS int*)(L + AP_PRE); LAS int* WT = (LAS int*)(L + AP_WT);
    LAS float* PM = (LAS float*)(L + AP_PM); LAS float* PSUM = (LAS float*)(L + AP_PSUM); LAS float* MX = (LAS float*)(L + AP_MX); LAS float* W = (LAS float*)(L + AP_W);
    int total = 0;
    if (!OWN) {
        int v = (gcnt[tid] + 127) >> 7;
#pragma unroll
        for (int o = 1; o < 64; o <<= 1) { const int u = __builtin_amdgcn_ds_bpermute((lane - o) << 2, v); if (lane >= o) v += u; }
        if (lane == 63) WT[wave] = v;
        LDS_WAIT(); __syncthreads();
        int add = 0;
#pragma unroll
        for (int w8 = 0; w8 < 8; ++w8) if (w8 < wave) add += WT[w8];
        PRE[tid + 1] = v + add; if (tid == 0) PRE[0] = 0;
        LDS_WAIT(); __syncthreads();
        total = PRE[512];
    }
    AItem cur = attn_get<OWN>(0, G, PRE, total, gcnt, LIST);
    if (!cur.valid) return;
    int pb = 0;
    {   LAS int* ENT = (LAS int*)(L + AP_ENT0);
        if (!OWN) { if (tid < 128) ENT[tid] = (tid < cur.nrows) ? cur.list[cur.row0 + tid] : -1; LDS_WAIT(); __syncthreads(); }
        for (int i = tid; i < 2048; i += 512) { const int rl = i >> 4, ch = i & 15; int t;
            if (OWN) t = cur.row0 + rl; else { const int e = ENT[rl]; t = e >= 0 ? (e >> 2) : 0; }
            const v4u v = *(const GAS v4u*)(AQ + (size_t)t * 1024 + cur.h * 128 + ch * 8); *(LAS v4u*)(L + AP_QS0 + rl * 272 + ch * 16) = v; }
        LDS_WAIT(); __syncthreads();
    }
    for (int k = 0; ; ++k) {
        const AItem nxt = attn_get<OWN>(k + 1, G, PRE, total, gcnt, LIST);
        const int h = (probe & 2) ? 0 : cur.h, b = (probe & 2) ? 0 : cur.b, qi = cur.qi, row0 = cur.row0;
        LAS unsigned char* Qc = L + (pb ? AP_QS1 : AP_QS0); LAS unsigned char* Qn = L + (pb ? AP_QS0 : AP_QS1);
        LAS int* ENT = (LAS int*)(L + (pb ? AP_ENT1 : AP_ENT0)); LAS int* ENTn = (LAS int*)(L + (pb ? AP_ENT0 : AP_ENT1));
        const int dt = wave & 3, tp = wave >> 2;
        bf16x8 kf[8], vf[16];
        {   const bf16* kp = XK + (((size_t)(b * 8 + h) * 8 + wave) * 8) * 512 + lane * 8;
#pragma unroll
            for (int kk = 0; kk < 8; ++kk) kf[kk] = *(const bf16x8*)(kp + 512 * kk);
            const bf16* vp = XVT + (((size_t)(b * 8 + h) * 4 + dt) * 16) * 512 + lane * 8;
#pragma unroll
            for (int kk = 0; kk < 16; ++kk) vf[kk] = *(const bf16x8*)(vp + 512 * kk);
        }
        int e_n = -1;
        if (!OWN && nxt.valid && tid < 128 && tid < nxt.nrows) e_n = nxt.list[nxt.row0 + tid];
        f32x16 S[4];
#pragma unroll
        for (int tq = 0; tq < 4; ++tq) {
#pragma unroll
            for (int i = 0; i < 16; ++i) S[tq][i] = 0.f;
#pragma unroll
            for (int kk = 0; kk < 8; ++kk) { const bf16x8 bq = *(const LAS bf16x8*)(Qc + (32 * tq + r) * 272 + (16 * kk + 8 * hh) * 2);
                S[tq] = __builtin_amdgcn_mfma_f32_32x32x16_bf16(kf[kk], bq, S[tq], 0, 0, 0); }
        }
#pragma unroll
        for (int tq = 0; tq < 4; ++tq) {
            const int t = 32 * tq + r; float ps = 0.f;
#pragma unroll
            for (int i = 0; i < 16; ++i) {
                float sv = S[tq][i];
                if (OWN) { const int key = 32 * wave + (i & 3) + 8 * (i >> 2) + 4 * hh, lim = (qi & 1) * 128 + t; if (key > lim) sv = -INFINITY; }
                const float p = __builtin_amdgcn_exp2f(sv); S[tq][i] = p; ps += p; }
            ps += sh_xor(ps, 32, lane);
            if (hh == 0) PSUM[wave * 128 + t] = ps;
#pragma unroll
            for (int g = 0; g < 4; ++g) { pg8::u32x2 w2; w2.x = pg8::cvt_pk_bf16(S[tq][4 * g], S[tq][4 * g + 1]); w2.y = pg8::cvt_pk_bf16(S[tq][4 * g + 2], S[tq][4 * g + 3]);
                *(LAS pg8::u32x2*)(L + AP_PS + t * 528 + (32 * wave + 8 * g + 4 * hh) * 2) = w2; }
        }
        if (!OWN && tid < 128) ENTn[tid] = e_n;
        LDS_WAIT(); __syncthreads();
        v4u qn[4];
        if (nxt.valid) {
#pragma unroll
            for (int j = 0; j < 4; ++j) { const int i = tid + 512 * j, rl = i >> 4, ch = i & 15; int t;
                if (OWN) t = nxt.row0 + rl; else { const int e = ENTn[rl]; t = e >= 0 ? (e >> 2) : 0; if (probe & 4) t = rl; }
                qn[j] = *(const GAS v4u*)(AQ + (size_t)t * 1024 + nxt.h * 128 + ch * 8); }
        }
        f32x16 O[2];
#pragma unroll
        for (int i = 0; i < 16; ++i) { O[0][i] = 0.f; O[1][i] = 0.f; }
#pragma unroll
        for (int kk = 0; kk < 16; ++kk) {
            const bf16x8 a0 = *(const LAS bf16x8*)(L + AP_PS + (64 * tp + r) * 528 + (16 * kk + 8 * hh) * 2), a1 = *(const LAS bf16x8*)(L + AP_PS + (64 * tp + 32 + r) * 528 + (16 * kk + 8 * hh) * 2);
            O[0] = __builtin_amdgcn_mfma_f32_32x32x16_bf16(a0, vf[kk], O[0], 0, 0, 0); O[1] = __builtin_amdgcn_mfma_f32_32x32x16_bf16(a1, vf[kk], O[1], 0, 0, 0);
        }
        const int curb = qi >> 1, nsel = curb < 3 ? curb : 3;
        if (OWN) {
            if (tid < 128) { const int t = row0 + tid; float Lo = 0.f;
#pragma unroll
                for (int w8 = 0; w8 < 8; ++w8) Lo += PSUM[w8 * 128 + tid];
                float den = Lo;
#pragma unroll
                for (int j = 0; j < 3; ++j) if (j < nsel) den += ML[((size_t)(t * 8 + h) * 3 + j) * 2 + 1];
                const float inv = 1.0f / den;
                W[tid * 4 + 0] = inv; W[tid * 4 + 1] = nsel > 0 ? inv : 0.f; W[tid * 4 + 2] = nsel > 1 ? inv : 0.f; W[tid * 4 + 3] = nsel > 2 ? inv : 0.f; }
        }
        LDS_WAIT(); __syncthreads();
        {   LAS float* OS = (LAS float*)(L + AP_PS);
#pragma unroll
            for (int q = 0; q < 2; ++q)
#pragma unroll
                for (int i = 0; i < 16; ++i) OS[(64 * tp + 32 * q + (i & 3) + 8 * (i >> 2) + 4 * hh) * 132 + 32 * dt + r] = O[q][i];
        }
        LDS_WAIT(); __syncthreads();
        {   const LAS float* OS = (const LAS float*)(L + AP_PS);
            const int rl = tid >> 2, c4 = tid & 3;
            if (!OWN) {
                const int e = (probe & 1) ? -1 : ENT[rl];
                if (e >= 0) {
                    const int te = e >> 2; bf16* dst = (te < PO_SPLIT ? PO : PO + (WS_PO2 - WS_PO) / 2 - (size_t)PO_SPLIT * 3072) + ((size_t)(te * 8 + h) * 3 + (e & 3)) * 128;
#pragma unroll
                    for (int kq = 0; kq < 4; ++kq) { const int ch = c4 + 4 * kq; const f32x4 a = *(const LAS f32x4*)(OS + rl * 132 + ch * 8), b2 = *(const LAS f32x4*)(OS + rl * 132 + ch * 8 + 4);
                        v4u w; w.x = pg8::cvt_pk_bf16(a[0], a[1]); w.y = pg8::cvt_pk_bf16(a[2], a[3]); w.z = pg8::cvt_pk_bf16(b2[0], b2[1]); w.w = pg8::cvt_pk_bf16(b2[2], b2[3]);
                        *(GAS v4u*)(dst + ch * 8) = w; }
                    if (c4 == 0) { float Ls = 0.f;
#pragma unroll
                        for (int w8 = 0; w8 < 8; ++w8) Ls += PSUM[w8 * 128 + rl];
                        float* ml = ML + ((size_t)((e >> 2) * 8 + h) * 3 + (e & 3)) * 2; ml[0] = 0.f; ml[1] = Ls; }
                }
            } else {
                const int t = row0 + rl; const f32x4 w4 = *(const LAS f32x4*)(W + rl * 4);
                const bf16* po = (t < PO_SPLIT ? PO : PO + (WS_PO2 - WS_PO) / 2 - (size_t)PO_SPLIT * 3072) + ((size_t)(t * 8 + h) * 3) * 128;
                const unsigned m0 = nsel > 0 ? 0xffffffffu : 0u, m1 = nsel > 1 ? 0xffffffffu : 0u, m2 = nsel > 2 ? 0xffffffffu : 0u;
#pragma unroll
                for (int kq = 0; kq < 4; ++kq) { const int ch = c4 + 4 * kq;
                    const f32x4 a = *(const LAS f32x4*)(OS + rl * 132 + ch * 8), b2 = *(const LAS f32x4*)(OS + rl * 132 + ch * 8 + 4);
                    v4u p0 = *(const GAS v4u*)(po + ch * 8), p1 = *(const GAS v4u*)(po + 128 + ch * 8), p2 = *(const GAS v4u*)(po + 256 + ch * 8);
                    p0 = p0 & m0; p1 = p1 & m1; p2 = p2 & m2;
                    float o8[8] = {a[0] * w4[0], a[1] * w4[0], a[2] * w4[0], a[3] * w4[0], b2[0] * w4[0], b2[1] * w4[0], b2[2] * w4[0], b2[3] * w4[0]};
#pragma unroll
                    for (int x2 = 0; x2 < 4; ++x2) {
                        o8[2 * x2] += w4[1] * __builtin_bit_cast(float, p0[x2] << 16) + w4[2] * __builtin_bit_cast(float, p1[x2] << 16) + w4[3] * __builtin_bit_cast(float, p2[x2] << 16);
                        o8[2 * x2 + 1] += w4[1] * __builtin_bit_cast(float, p0[x2] & 0xffff0000u) + w4[2] * __builtin_bit_cast(float, p1[x2] & 0xffff0000u) + w4[3] * __builtin_bit_cast(float, p2[x2] & 0xffff0000u); }
                    v4u w; w.x = pg8::cvt_pk_bf16(o8[0], o8[1]); w.y = pg8::cvt_pk_bf16(o8[2], o8[3]); w.z = pg8::cvt_pk_bf16(o8[4], o8[5]); w.w = pg8::cvt_pk_bf16(o8[6], o8[7]);
                    *(GAS v4u*)(AOUT + (size_t)(t & tmask) * 1024 + h * 128 + ch * 8) = w; }
            }
        }
        if (nxt.valid) {
#pragma unroll
            for (int j = 0; j < 4; ++j) { const int i = tid + 512 * j, rl = i >> 4, ch = i & 15; *(LAS v4u*)(Qn + rl * 272 + ch * 16) = qn[j]; }
        }
        LDS_WAIT(); __syncthreads();
        if (!nxt.valid) break;
        cur = nxt; pb ^= 1;
    }
}


struct Args { const float* in[18]; float* out; unsigned char* ws; unsigned long long ws_size; };

typedef const __attribute__((address_space(4))) Args* KArgsP;
#define KA() ({ KArgsP p_ = (KArgsP)__builtin_amdgcn_kernarg_segment_ptr(); asm volatile("" : "+s"(p_)); p_; })
#define AIN(i) ((const float*)KA()->in[i])
#define WSB ((unsigned char*)KA()->ws)
#define XIN AIN(0)
#define OUTP ((float*)KA()->out)
#define SS ((float*)(WSB + WS_SS))
#define HBP ((bf16*)(WSB + WS_HB))
#define HB ((bf16*)(WSB + WS_HB + HB_ROW0))
#define ACT ((bf16*)(WSB + WS_ACT))
constexpr int H2_BYTES = 69632, H2_QS = 0  , H2_PS = 17408  , H2_OS = 51200  ;
constexpr int H2_PSUM = 139264  , H2_ENT = 143360  , H2_PRE = 144896  , H2_WT = 146976, H2_GL = 147072  ;
#define H2_BAR() do { asm volatile("s_waitcnt lgkmcnt(0)" ::: "memory"); __builtin_amdgcn_s_barrier(); asm volatile("" ::: "memory"); } while (0)
template <bool OWN>
__device__ __forceinline__ void attn_store_rows(LAS unsigned char* L, int hf, int ht, int par, int eslot, const AItem& it, bf16* PO, float* ML, bf16* AOUT, int tmask, bool live, unsigned char* dump) {
    const int rl = ht >> 2, c4 = ht & 3, h = it.h;
    const LAS float* PSUM = (const LAS float*)(L + H2_PSUM) + (par * 2 + hf) * 256; const LAS int* ENT = (const LAS int*)(L + H2_ENT) + eslot * 128;
    const LAS unsigned char* OSb = L + hf * H2_BYTES + H2_OS + rl * 272;
    const float Ls = (PSUM[rl] + PSUM[64 + rl]) + (PSUM[128 + rl] + PSUM[192 + rl]);
    if (!OWN) {
        const int e = ENT[64 * hf + rl]; const bool ok = live && e >= 0; const int es_ = e >= 0 ? e : 0;
        const int te = es_ >> 2; bf16* dst = (te < PO_SPLIT ? PO : PO + (WS_PO2 - WS_PO) / 2 - (size_t)PO_SPLIT * 3072) + ((size_t)(te * 8 + h) * 3 + (es_ & 3)) * 128;
        if (!ok) dst = (bf16*)dump;
#pragma unroll
        for (int kq = 0; kq < 4; ++kq) { const int ch = c4 + 4 * kq; *(GAS v4u*)(dst + ch * 8) = *(const LAS v4u*)(OSb + ch * 16); }
        float* ml = ML + ((size_t)(te * 8 + h) * 3 + (es_ & 3)) * 2; if (!ok || c4 != 0) ml = (float*)(dump + 512);
        ml[0] = 0.f; ml[1] = Ls;
    } else {
        const int t = it.row0 + 64 * hf + rl, curb = it.qi >> 1, nsel = curb < 3 ? curb : 3;
        float den = Ls;
#pragma unroll
        for (int j = 0; j < 3; ++j) { const float lj = ML[((size_t)(t * 8 + h) * 3 + j) * 2 + 1]; den += (j < nsel) ? lj : 0.f; }
        const float inv = 1.0f / den;
        const bf16* po = (t < PO_SPLIT ? PO : PO + (WS_PO2 - WS_PO) / 2 - (size_t)PO_SPLIT * 3072) + ((size_t)(t * 8 + h) * 3) * 128;
        const unsigned m0 = nsel > 0 ? 0xffffffffu : 0u, m1 = nsel > 1 ? 0xffffffffu : 0u, m2 = nsel > 2 ? 0xffffffffu : 0u;
        bf16* orow = live ? AOUT + (size_t)(t & tmask) * 1024 + h * 128 : (bf16*)dump;
#pragma unroll
        for (int kq = 0; kq < 4; ++kq) { const int ch = c4 + 4 * kq;
            const v4u a = *(const LAS v4u*)(OSb + ch * 16);
            v4u p0 = *(const GAS v4u*)(po + ch * 8), p1 = *(const GAS v4u*)(po + 128 + ch * 8), p2 = *(const GAS v4u*)(po + 256 + ch * 8);
            p0 = p0 & m0; p1 = p1 & m1; p2 = p2 & m2;
            float o8[8];
#pragma unroll
            for (int x2 = 0; x2 < 4; ++x2) {
                o8[2 * x2] = (__builtin_bit_cast(float, a[x2] << 16) + __builtin_bit_cast(float, p0[x2] << 16) + __builtin_bit_cast(float, p1[x2] << 16) + __builtin_bit_cast(float, p2[x2] << 16)) * inv;
                o8[2 * x2 + 1] = (__builtin_bit_cast(float, a[x2] & 0xffff0000u) + __builtin_bit_cast(float, p0[x2] & 0xffff0000u) + __builtin_bit_cast(float, p1[x2] & 0xffff0000u) + __builtin_bit_cast(float, p2[x2] & 0xffff0000u)) * inv; }
            v4u w; w.x = pg8::cvt_pk_bf16n(o8[0], o8[1]); w.y = pg8::cvt_pk_bf16n(o8[2], o8[3]); w.z = pg8::cvt_pk_bf16n(o8[4], o8[5]); w.w = pg8::cvt_pk_bf16n(o8[6], o8[7]);
            *(GAS v4u*)(orow + ch * 8) = w; }
    }
}
struct AWalk { int idx, end, hb; };
template <bool OWN>
__device__ __forceinline__ AItem attn_at(const AWalk& w, const LAS int* PRE, const LAS int* GL, const int* LIST) {
    AItem it; it.valid = w.idx < w.end;
    if (OWN) { const int ix = it.valid ? w.idx : 0; it.qi = ix >> 3; it.h = ix & 7; it.b = it.qi >> 1; it.row0 = 128 * it.qi; it.nrows = 128; it.list = nullptr; }
    else { const int hb = w.hb; it.qi = 0; it.h = hb >> 6; it.b = hb & 63; const int i = it.valid ? w.idx - PRE[hb] : 0, n = it.valid ? GL[hb] : 0;
        it.row0 = 128 * i; it.nrows = (n - 128 * i) < 128 ? (n - 128 * i) : 128; it.list = LIST + list_off(it.h, it.b); }
    return it;
}
template <bool OWN>
__device__ __forceinline__ void attn_step(AWalk& w, int G, const LAS int* PRE) {
    if (OWN) { w.idx += G; return; }
    w.idx += 1;
    if (w.idx < w.end) { while (PRE[w.hb + 1] <= w.idx) ++w.hb; }
}
template <bool OWN>
__device__ __forceinline__ void attn_phase2(LAS unsigned char* L, int G, const int* gcnt, const int* LIST, const bf16* AQ, const bf16* XK, const bf16* XVT, bf16* PO, float* ML, bf16* AOUT, int tmask, unsigned char* dump) {
    int tid_ = threadIdx.x; asm volatile("" : "+v"(tid_)); int tid = tid_, lane = tid & 63; const int wave = __builtin_amdgcn_readfirstlane(tid >> 6);
    int r = lane & 31, hh = lane >> 5, ht = tid & 255; const int hw = wave & 3, hf = wave >> 2;
    LAS int* PRE = (LAS int*)(L + H2_PRE); LAS int* WT = (LAS int*)(L + H2_WT); LAS int* GL = (LAS int*)(L + H2_GL);
    LAS unsigned char* HB_ = L + hf * H2_BYTES;
    AWalk w;
    if (!OWN) {
        const int gc = gcnt[tid]; GL[tid] = gc;
        int v = (gc + 127) >> 7;
#pragma unroll
        for (int o = 1; o < 64; o <<= 1) { const int u = __builtin_amdgcn_ds_bpermute((lane - o) << 2, v); if (lane >= o) v += u; }
        if (lane == 63) WT[wave] = v;
        LDS_WAIT(); __syncthreads();
        int add = 0;
#pragma unroll
        for (int w8 = 0; w8 < 8; ++w8) if (w8 < wave) add += WT[w8];
        PRE[tid + 1] = v + add; if (tid == 0) PRE[0] = 0;
        LDS_WAIT(); __syncthreads();
        const unsigned total = (unsigned)PRE[512];
        w.idx = (int)(((unsigned)blockIdx.x * total) / (unsigned)G); w.end = (int)((((unsigned)blockIdx.x + 1u) * total) / (unsigned)G);
        int lo = 0, hi = 512;
        if (w.idx < w.end) { while (hi - lo > 1) { const int mid = (lo + hi) >> 1; if (PRE[mid] <= w.idx) lo = mid; else hi = mid; } }
        w.hb = lo;
    } else { w.idx = (int)blockIdx.x; w.end = 1024; w.hb = 0; }
    AItem cur = attn_at<OWN>(w, PRE, GL, LIST);
    if (!cur.valid) return;
    attn_step<OWN>(w, G, PRE); AItem nxt = attn_at<OWN>(w, PRE, GL, LIST);
    {   LAS int* ENT = (LAS int*)(L + H2_ENT);
        if (!OWN) { if (tid < 128) { ENT[tid] = (tid < cur.nrows) ? cur.list[cur.row0 + tid] : -1; ENT[128 + tid] = (nxt.valid && tid < nxt.nrows) ? nxt.list[nxt.row0 + tid] : -1; } LDS_WAIT(); __syncthreads(); }
#pragma unroll
        for (int j = 0; j < 4; ++j) { const int i = ht + 256 * j, rl = i >> 4, ch = i & 15; int t;
            if (OWN) t = cur.row0 + 64 * hf + rl; else { const int e = ENT[64 * hf + rl]; t = e >= 0 ? (e >> 2) : 0; }
            *(LAS v4u*)(HB_ + H2_QS + rl * 272 + ch * 16) = *(const GAS v4u*)(AQ + (size_t)t * 1024 + cur.h * 128 + ch * 8); }
        LDS_WAIT(); __syncthreads();
    }
    bf16x8 kf[2][8], vf[16]; v4u qn[4]; int e_n = -1;
#define H2_LD_K(IT) do { const bf16* kp_ = XK + (((size_t)((IT).b * 8 + (IT).h) * 8 + 2 * hw) * 8) * 512 + lane * 8; _Pragma("unroll") for (int kt = 0; kt < 2; ++kt) _Pragma("unroll") for (int kk = 0; kk < 8; ++kk) kf[kt][kk] = *(const bf16x8*)(kp_ + (size_t)(kt * 8 + kk) * 512); } while (0)
#define H2_LD_V(IT) do { const bf16* vp_ = XVT + (((size_t)((IT).b * 8 + (IT).h) * 4 + hw) * 16) * 512 + lane * 8; _Pragma("unroll") for (int kk = 0; kk < 16; ++kk) vf[kk] = *(const bf16x8*)(vp_ + (size_t)kk * 512); } while (0)
    H2_LD_K(cur);
    if (hf == 1) H2_BAR();
    AItem prv = cur; bool have_prev = false; int par = 0, es = 0;
    for (int k = 0; ; ++k) {
        { int t2_ = threadIdx.x; asm volatile("" : "+v"(t2_)); tid = t2_; lane = tid & 63; r = lane & 31; hh = lane >> 5; ht = tid & 255; }
        attn_step<OWN>(w, G, PRE); const AItem nx2 = attn_at<OWN>(w, PRE, GL, LIST);
        const int es1 = es == 2 ? 0 : es + 1, es2 = es1 == 2 ? 0 : es1 + 1;
        LAS float* PSUM = (LAS float*)(L + H2_PSUM) + (par * 2 + hf) * 256;
        if (!OWN) { const int tl = tid & 127; const bool in = tl < nx2.nrows; const int ev = nx2.list[in ? nx2.row0 + tl : 0]; e_n = in ? ev : -1; }
        {
            const LAS int* ENT1 = (const LAS int*)(L + H2_ENT) + es1 * 128;
#pragma unroll
            for (int j = 0; j < 4; ++j) { const int i = ht + 256 * j, rl = i >> 4, ch = i & 15; int t;
                if (OWN) t = nxt.row0 + 64 * hf + rl; else { const int e = ENT1[64 * hf + rl]; t = e >= 0 ? (e >> 2) : 0; }
                qn[j] = *(const GAS v4u*)(AQ + (size_t)t * 1024 + nxt.h * 128 + ch * 8); }
        }
        f32x16 S[2][2];
#pragma unroll
        for (int kt = 0; kt < 2; ++kt)
#pragma unroll
            for (int tq = 0; tq < 2; ++tq) {
#pragma unroll
                for (int i = 0; i < 16; ++i) S[kt][tq][i] = 0.f;
#pragma unroll
                for (int kk = 0; kk < 8; ++kk) { const bf16x8 bq = *(const LAS bf16x8*)(HB_ + H2_QS + (32 * tq + r) * 272 + (16 * kk + 8 * hh) * 2);
                    S[kt][tq] = __builtin_amdgcn_mfma_f32_32x32x16_bf16(kf[kt][kk], bq, S[kt][tq], 0, 0, 0); }
            }
        H2_LD_V(cur);
        H2_BAR();
#pragma unroll
        for (int tq = 0; tq < 2; ++tq) {
            const int t = 32 * tq + r; float ps = 0.f;
#pragma unroll
            for (int kt = 0; kt < 2; ++kt) {
#pragma unroll
                for (int i = 0; i < 16; ++i) {
                    float sv = S[kt][tq][i];
                    if (OWN) { const int key = 64 * hw + 32 * kt + (i & 3) + 8 * (i >> 2) + 4 * hh, lim = (cur.qi & 1) * 128 + 64 * hf + t; if (key > lim) sv = -INFINITY; }
                    const float p = __builtin_amdgcn_exp2f(sv); S[kt][tq][i] = p; ps += p; }
#pragma unroll
                for (int g = 0; g < 4; ++g) { pg8::u32x2 w2; w2.x = pg8::cvt_pk_bf16n(S[kt][tq][4 * g], S[kt][tq][4 * g + 1]); w2.y = pg8::cvt_pk_bf16n(S[kt][tq][4 * g + 2], S[kt][tq][4 * g + 3]);
                    *(LAS pg8::u32x2*)(HB_ + H2_PS + t * 528 + (64 * hw + 32 * kt + 8 * g + 4 * hh) * 2) = w2; }
            }
            ps += sh_xor(ps, 32, lane);
            if (hh == 0) PSUM[hw * 64 + t] = ps;
        }
        attn_store_rows<OWN>(L, hf, ht, par ^ 1, have_prev ? (es == 0 ? 2 : es - 1) : es, prv, PO, ML, AOUT, tmask, have_prev, dump);
        H2_BAR();
        H2_LD_K(nxt);
        f32x16 O[2];
#pragma unroll
        for (int i = 0; i < 16; ++i) { O[0][i] = 0.f; O[1][i] = 0.f; }
#pragma unroll
        for (int kk = 0; kk < 16; ++kk) {
            const bf16x8 a0 = *(const LAS bf16x8*)(HB_ + H2_PS + r * 528 + (16 * kk + 8 * hh) * 2), a1 = *(const LAS bf16x8*)(HB_ + H2_PS + (32 + r) * 528 + (16 * kk + 8 * hh) * 2);
            O[0] = __builtin_amdgcn_mfma_f32_32x32x16_bf16(a0, vf[kk], O[0], 0, 0, 0); O[1] = __builtin_amdgcn_mfma_f32_32x32x16_bf16(a1, vf[kk], O[1], 0, 0, 0);
        }
        H2_BAR();
#pragma unroll
        for (int tq = 0; tq < 2; ++tq)
#pragma unroll
            for (int i = 0; i < 16; ++i) *(LAS unsigned short*)(HB_ + H2_OS + (32 * tq + (i & 3) + 8 * (i >> 2) + 4 * hh) * 272 + (32 * hw + r) * 2) = (unsigned short)f2bf(O[tq][i]);
#pragma unroll
        for (int j = 0; j < 4; ++j) { const int i = ht + 256 * j, rl = i >> 4, ch = i & 15; *(LAS v4u*)(HB_ + H2_QS + rl * 272 + ch * 16) = qn[j]; }
        if (!OWN && nx2.valid && hf == 0 && tid < 128) ((LAS int*)(L + H2_ENT))[es2 * 128 + tid] = e_n;
        H2_BAR();
        prv = cur; have_prev = true; par ^= 1; es = es1;
        if (!nxt.valid) break;
        cur = nxt; nxt = nx2;
    }
    if (hf == 0) H2_BAR();
    { int t2_ = threadIdx.x; asm volatile("" : "+v"(t2_)); ht = t2_ & 255; }
    attn_store_rows<OWN>(L, hf, ht, par ^ 1, es == 0 ? 2 : es - 1, prv, PO, ML, AOUT, tmask, true, dump);
    LDS_WAIT(); __syncthreads();
#undef H2_LD_K
#undef H2_LD_V
}


constexpr int A3_K = 0, A3_V = 65536, A3_PRE = 131072  , A3_GL = 133248  , A3_WT = 135296;
typedef float a3f2 __attribute__((ext_vector_type(2)));
typedef __bf16 a3b2 __attribute__((ext_vector_type(2)));
__device__ __forceinline__ unsigned a3_pk(float lo, float hi) { const a3f2 v = {lo, hi}; return __builtin_bit_cast(unsigned, __builtin_convertvector(v, a3b2)); }
template <bool OWN>
__device__ __forceinline__ void attn_phase3(LAS unsigned char* L, int G, int jl) {
#define A3_AQ ((const bf16*)(WSB + WS_AQ))
#define A3_PO ((bf16*)(WSB + WS_PO))
#define A3_ML ((float*)(WSB + WS_ML))
#define A3_LIST ((const int*)(WSB + WS_LIST))
    int tid_ = threadIdx.x; asm volatile("" : "+v"(tid_)); const int tid = tid_, lane = tid & 63; const int wave = __builtin_amdgcn_readfirstlane(tid >> 6);
    const int r = lane & 31, hh = lane >> 5;
    LAS int* PRE = (LAS int*)(L + A3_PRE); LAS int* GL = (LAS int*)(L + A3_GL); LAS int* WT = (LAS int*)(L + A3_WT);
    int idx, end, hb = 0;
    if (!OWN) {
        const int gc = ((const int*)(WSB + WS_GCNT) + jl * 512)[tid]; GL[tid] = gc;
        int v = (gc + 255) >> 8;
#pragma unroll
        for (int o = 1; o < 64; o <<= 1) { const int u = __builtin_amdgcn_ds_bpermute((lane - o) << 2, v); if (lane >= o) v += u; }
        if (lane == 63) WT[wave] = v;
        LDS_WAIT(); __syncthreads();
        int add = 0;
#pragma unroll
        for (int w8 = 0; w8 < 8; ++w8) if (w8 < wave) add += WT[w8];
        PRE[tid + 1] = v + add; if (tid == 0) PRE[0] = 0;
        LDS_WAIT(); __syncthreads();
        const unsigned total = (unsigned)PRE[512];
        idx = (int)(((unsigned)blockIdx.x * total) / (unsigned)G); end = (int)((((unsigned)blockIdx.x + 1u) * total) / (unsigned)G);
        int lo = 0, hi = 512;
        if (idx < end) { while (hi - lo > 1) { const int mid = (lo + hi) >> 1; if (PRE[mid] <= idx) lo = mid; else hi = mid; } }
        hb = lo;
    } else { idx = (int)blockIdx.x; end = 512; }
    int lb = -1, lh = -1;
    const int rb = OWN ? (wave < 4 ? wave : 11 - wave) : wave;
    while (idx < end) {
        int b, h, row0 = 0, nrows = 256;
        if (OWN) { b = idx >> 3; h = idx & 7; }
        else { h = hb >> 6; b = hb & 63; row0 = 256 * (idx - PRE[hb]); const int n = GL[hb]; nrows = (n - row0) < 256 ? (n - row0) : 256; }
        int e = -1, t;
        if (OWN) t = 256 * b + 32 * rb + r;
        else { const int rr = 32 * rb + r; const bool in = rr < nrows; const int ev = (A3_LIST + list_off(h, b))[in ? row0 + rr : 0]; e = in ? ev : -1; t = e >= 0 ? (e >> 2) : 0; }
        if (b != lb || h != lh) {
            __syncthreads();
            const bf16* ks = (const bf16*)(WSB + WS_XK) + (size_t)(b * 8 + h) * 32768 + lane * 8; const bf16* vs = (const bf16*)(WSB + WS_XVT) + (size_t)(b * 8 + h) * 32768 + lane * 8;
#pragma unroll
            for (int j = 0; j < 8; ++j) { const int ch = wave + 8 * j; __builtin_amdgcn_global_load_lds((const unsigned*)(ks + ch * 512), (LAS unsigned*)(L + A3_K + ch * 1024), 16, 0, 0); }
#pragma unroll
            for (int j = 0; j < 8; ++j) { const int ch = wave + 8 * j; __builtin_amdgcn_global_load_lds((const unsigned*)(vs + ch * 512), (LAS unsigned*)(L + A3_V + ch * 1024), 16, 0, 0); }
            asm volatile("s_waitcnt vmcnt(0)" ::: "memory");
            __syncthreads();
            lb = b; lh = h;
        }
        bf16x8 qf[8];
#pragma unroll
        for (int kk = 0; kk < 8; ++kk) qf[kk] = *(const bf16x8*)(A3_AQ + (size_t)t * 1024 + h * 128 + 16 * kk + 8 * hh);
        if (OWN || 32 * rb < nrows) {
            f32x16 O[4]; float ps = 0.f;
            float lsel = 0.f;
            if (OWN) { const int nsel_ = b < 3 ? b : 3;
#pragma unroll
                for (int j = 0; j < 3; ++j) { const float lj = A3_ML[((size_t)(t * 8 + h) * 3 + j) * 2 + 1]; lsel += (j < nsel_) ? lj : 0.f; } }
#pragma unroll
            for (int dt = 0; dt < 4; ++dt)
#pragma unroll
                for (int i = 0; i < 16; ++i) O[dt][i] = 0.f;
            const int ktn = OWN ? rb + 1 : 8;
#define A3_S(ST, KT) do { _Pragma("unroll") for (int i = 0; i < 16; ++i) ST[i] = 0.f; const LAS unsigned char* kb_ = L + A3_K + (KT) * 8192 + lane * 16; \
                _Pragma("unroll") for (int kk = 0; kk < 8; ++kk) { const bf16x8 kf = *(const LAS bf16x8*)(kb_ + kk * 1024); ST = __builtin_amdgcn_mfma_f32_32x32x16_bf16(kf, qf[kk], ST, 0, 0, 0); } } while (0)
            f32x16 S; A3_S(S, 0);
#pragma unroll 1
            for (int kt = 0; kt < ktn; ++kt) {
                f32x16 Sn;
                { const int ktc = (kt + 1 < ktn) ? kt + 1 : kt; A3_S(Sn, ktc); }
                const bool diag = OWN && kt == rb;
#pragma unroll
                for (int i = 0; i < 16; ++i) { float sv = S[i]; if (diag && ((i & 3) + 8 * (i >> 2) + 4 * hh) > r) sv = -INFINITY; const float p = __builtin_amdgcn_exp2f(sv); S[i] = p; ps += p; }
                const LAS unsigned char* vb_ = L + A3_V + (2 * kt) * 1024 + lane * 16;
#pragma unroll
                for (int s2 = 0; s2 < 2; ++s2) {
                    v4u pu; pu.x = a3_pk(S[8 * s2 + 0], S[8 * s2 + 1]); pu.y = a3_pk(S[8 * s2 + 2], S[8 * s2 + 3]); pu.z = a3_pk(S[8 * s2 + 4], S[8 * s2 + 5]); pu.w = a3_pk(S[8 * s2 + 6], S[8 * s2 + 7]);
                    const bf16x8 pk = __builtin_bit_cast(bf16x8, pu);
#pragma unroll
                    for (int dt = 0; dt < 4; ++dt) { const bf16x8 vfr = *(const LAS bf16x8*)(vb_ + (dt * 16 + s2) * 1024); O[dt] = __builtin_amdgcn_mfma_f32_32x32x16_bf16(vfr, pk, O[dt], 0, 0, 0); }
                }
                S = Sn;
            }
#undef A3_S
            ps += sh_xor(ps, 32, lane);
            if (!OWN) {
                const int es_ = e >= 0 ? e : 0, te = es_ >> 2;
                bf16* dst = (te < PO_SPLIT ? A3_PO : A3_PO + (WS_PO2 - WS_PO) / 2 - (size_t)PO_SPLIT * 3072) + ((size_t)(te * 8 + h) * 3 + (es_ & 3)) * 128;
#pragma unroll
                for (int dt = 0; dt < 4; ++dt)
#pragma unroll
                    for (int gp = 0; gp < 2; ++gp) {
                        unsigned ax = a3_pk(O[dt][8 * gp + 0], O[dt][8 * gp + 1]), ay = a3_pk(O[dt][8 * gp + 2], O[dt][8 * gp + 3]), bx = a3_pk(O[dt][8 * gp + 4], O[dt][8 * gp + 5]), by = a3_pk(O[dt][8 * gp + 6], O[dt][8 * gp + 7]);
                        { const auto sw = __builtin_amdgcn_permlane32_swap(ax, bx, false, false); ax = sw[0]; bx = sw[1]; }
                        { const auto sw = __builtin_amdgcn_permlane32_swap(ay, by, false, false); ay = sw[0]; by = sw[1]; }
                        if (e >= 0) *(GAS v4u*)(dst + 32 * dt + 16 * gp + 8 * hh) = (v4u){ax, ay, bx, by};
                    }
                if (e >= 0 && hh == 0) { float* ml = A3_ML + ((size_t)(te * 8 + h) * 3 + (es_ & 3)) * 2; ml[0] = 0.f; ml[1] = ps; }
            } else {
                const int nsel = b < 3 ? b : 3;
                const float inv = 1.0f / (ps + lsel);
                const bf16* po = (t < PO_SPLIT ? A3_PO : A3_PO + (WS_PO2 - WS_PO) / 2 - (size_t)PO_SPLIT * 3072) + ((size_t)(t * 8 + h) * 3) * 128;
                const unsigned m0 = nsel > 0 ? 0xffffffffu : 0u, m1 = nsel > 1 ? 0xffffffffu : 0u, m2 = nsel > 2 ? 0xffffffffu : 0u;
                bf16* orow = (bf16*)(WSB + WS_AQ) + (size_t)t * 1024 + h * 128;
#pragma unroll
                for (int dt = 0; dt < 4; ++dt)
#pragma unroll
                    for (int gp = 0; gp < 2; ++gp) {
                        const int dof = 32 * dt + 16 * gp + 8 * hh;
                        v4u p0 = *(const GAS v4u*)(po + dof), p1 = *(const GAS v4u*)(po + 128 + dof), p2 = *(const GAS v4u*)(po + 256 + dof);
                        p0 = p0 & m0; p1 = p1 & m1; p2 = p2 & m2;
                        unsigned ax = a3_pk(O[dt][8 * gp + 0], O[dt][8 * gp + 1]), ay = a3_pk(O[dt][8 * gp + 2], O[dt][8 * gp + 3]), bx = a3_pk(O[dt][8 * gp + 4], O[dt][8 * gp + 5]), by = a3_pk(O[dt][8 * gp + 6], O[dt][8 * gp + 7]);
                        { const auto sw = __builtin_amdgcn_permlane32_swap(ax, bx, false, false); ax = sw[0]; bx = sw[1]; }
                        { const auto sw = __builtin_amdgcn_permlane32_swap(ay, by, false, false); ay = sw[0]; by = sw[1]; }
                        const v4u a = (v4u){ax, ay, bx, by};
                        float o8[8];
#pragma unroll
                        for (int x2 = 0; x2 < 4; ++x2) {
                            o8[2 * x2] = (__builtin_bit_cast(float, a[x2] << 16) + __builtin_bit_cast(float, p0[x2] << 16) + __builtin_bit_cast(float, p1[x2] << 16) + __builtin_bit_cast(float, p2[x2] << 16)) * inv;
                            o8[2 * x2 + 1] = (__builtin_bit_cast(float, a[x2] & 0xffff0000u) + __builtin_bit_cast(float, p0[x2] & 0xffff0000u) + __builtin_bit_cast(float, p1[x2] & 0xffff0000u) + __builtin_bit_cast(float, p2[x2] & 0xffff0000u)) * inv; }
                        v4u w; w.x = a3_pk(o8[0], o8[1]); w.y = a3_pk(o8[2], o8[3]); w.z = a3_pk(o8[4], o8[5]); w.w = a3_pk(o8[6], o8[7]);
                        *(GAS v4u*)(orow + dof) = w;
                    }
            }
        }
        if (OWN) idx += G; else { idx += 1; if (idx < end) { while (PRE[hb + 1] <= idx) ++hb; } }
    }
#undef A3_AQ
#undef A3_PO
#undef A3_ML
#undef A3_LIST
}

enum { WK_IN = 0, WK_OUT, WK_KV, WK_Q, WK_O, WK_UP, WK_DN };
constexpr int I_IN = 16 * 96, I_SQ = 16 * 32, I_KV = 16 * 64, I_UP = 16 * 176, I_DN = 44 * 32;
#define AIN2(i) AIN(i)
#define WSB2 WSB
__device__ __forceinline__ void weight_item(int kind, int l, int r, LAS float* scr, int lane) {
    if (kind == WK_IN) { const int kb = r / 96, nb = r % 96, c0 = nb * 32;
        const float* W = AIN2(2) + (size_t)l * D * MIN_; const float* g = AIN2(1) + l * D;
        bf16* WR = (bf16*)(WSB2 + WS_WINR) + (size_t)l * 1536 * D; bf16* WTt = (bf16*)(WSB2 + WS_WINT) + (size_t)l * 1536 * D;
        if (c0 < 512) transpose_item(W, MIN_, kb * 64, c0, g, WR, D, c0, nullptr, 0, scr, lane);
        else if (c0 < 1024) transpose_item(W, MIN_, kb * 64, c0, g, WTt, D, c0 - 512, nullptr, 0, scr, lane);
        else if (c0 < 2048) transpose_item(W, MIN_, kb * 64, c0, g, WTt, D, 512 + c0 - 1024, nullptr, 0, scr, lane);
        else transpose_item(W, MIN_, kb * 64, c0, g, WR, D, 512 + c0 - 2048, nullptr, 0, scr, lane);
    } else if (kind == WK_OUT) { const int kb = r / 32, nb = r % 32;
        transpose_item(AIN2(5) + (size_t)l * D * D, D, kb * 64, nb * 32, nullptr, (bf16*)(WSB2 + WS_WOUT) + (size_t)l * D * D, D, nb * 32, nullptr, 0, scr, lane);
    } else if (kind == WK_KV) { const int kb = r / 64, nb = r % 64, c0 = nb * 32;
        if (c0 < 1024) transpose_item(AIN2(7), 2048, kb * 64, c0, AIN2(6), (bf16*)(WSB2 + WS_WK), D, c0, nullptr, 0, scr, lane);
        else transpose_item(AIN2(7), 2048, kb * 64, c0, AIN2(6), (bf16*)(WSB2 + WS_WV), D, c0 - 1024, nullptr, 0, scr, lane);
    } else if (kind == WK_Q) { const int kb = r / 32, nb = r % 32;
        transpose_item(AIN2(10) + (size_t)l * D * D, D, kb * 64, nb * 32, AIN2(9) + l * D, (bf16*)(WSB2 + WS_WQ) + (size_t)l * D * D, D, nb * 32, nullptr, 0, scr, lane);
    } else if (kind == WK_O) { const int kb = r / 32, nb = r % 32;
        transpose_item(AIN2(12) + (size_t)l * D * D, D, kb * 64, nb * 32, nullptr, (bf16*)(WSB2 + WS_WO) + (size_t)l * D * D, D, nb * 32, nullptr, 0, scr, lane);
    } else if (kind == WK_UP) { const int kb = r / 176, nb = r % 176, c0 = nb * 32;
        const int bj = c0 >= FF, cp = c0 - bj * FF, d0 = (cp / 128) * 256 + bj * 128 + (cp % 128);
        transpose_item(AIN2(14) + (size_t)l * D * FF2, FF2, kb * 64, c0, AIN2(13) + l * D, (bf16*)(WSB2 + WS_WUP) + (size_t)l * FF2 * D, D, d0, nullptr, 0, scr, lane);
    } else { const int kb = r / 32, nb = r % 32;
        transpose_item(AIN2(17) + (size_t)l * FF * D, D, kb * 64, nb * 32, nullptr, (bf16*)(WSB2 + WS_WDN) + (size_t)l * D * FF, FF, nb * 32, nullptr, 0, scr, lane); }
}
__device__ __forceinline__ void weight_set(int set, int widx, int nw, LAS float* scr, int lane) {
    if (set == 0) {
        for (int it = widx; it < I_IN; it += nw) weight_item(WK_IN, 0, it, scr, lane);
    } else if (set == 1) {
        constexpr int N = (I_SQ + I_UP + I_DN) + (I_IN + I_SQ + I_UP + I_DN);
        for (int it = widx; it < N; it += nw) { int r = it;
            if (r < I_SQ) { weight_item(WK_OUT, 0, r, scr, lane); continue; } r -= I_SQ;
            if (r < I_UP) { weight_item(WK_UP, 0, r, scr, lane); continue; } r -= I_UP;
            if (r < I_DN) { weight_item(WK_DN, 0, r, scr, lane); continue; } r -= I_DN;
            if (r < I_IN) { weight_item(WK_IN, 1, r, scr, lane); continue; } r -= I_IN;
            if (r < I_SQ) { weight_item(WK_OUT, 1, r, scr, lane); continue; } r -= I_SQ;
            if (r < I_UP) { weight_item(WK_UP, 1, r, scr, lane); continue; } r -= I_UP;
            weight_item(WK_DN, 1, r, scr, lane); }
    } else {
        constexpr int N = I_KV + 4 * I_SQ + 2 * I_UP + 2 * I_DN;
        for (int it = widx; it < N; it += nw) { int r = it;
            if (r < I_KV) { weight_item(WK_KV, 0, r, scr, lane); continue; } r -= I_KV;
            if (r < 2 * I_SQ) { weight_item(WK_Q, r / I_SQ, r % I_SQ, scr, lane); continue; } r -= 2 * I_SQ;
            if (r < 2 * I_SQ) { weight_item(WK_O, r / I_SQ, r % I_SQ, scr, lane); continue; } r -= 2 * I_SQ;
            if (r < 2 * I_UP) { weight_item(WK_UP, 2 + r / I_UP, r % I_UP, scr, lane); continue; } r -= 2 * I_UP;
            weight_item(WK_DN, 2 + r / I_DN, r % I_DN, scr, lane); }
    }
}

__global__ void __launch_bounds__(NWAVES * 64, 2) yoco_fwd(Args args) {
    extern __shared__ __attribute__((aligned(16))) unsigned char lds[];
    LAS unsigned char* L = (LAS unsigned char*)lds;
    volatile LAS unsigned* MISC = (volatile LAS unsigned*)(L + MISC_OFF);
    const int tid = threadIdx.x, lane = tid & 63, wave = __builtin_amdgcn_readfirstlane(tid >> 6);
    const int G = gridDim.x;
    for (int u = tid; u < (LDS_BYTES - RING_BYTES) / 4; u += NWAVES * 64) ((LAS unsigned*)(L + RING_BYTES))[u] = 0u;
    __syncthreads();
    (void)xcd_barrier_post((unsigned*)(WSB + WS_CTL) + CW_BAR, MISC + 8);
#define GRID_BAR() do { XcdBarrier b_; b_.bar = (unsigned*)(WSB + WS_CTL) + CW_BAR; b_.x = xb_xcc_id(); b_.st = (volatile LAS unsigned*)(L + MISC_OFF) + 8; xcd_barrier(b_); } while (0)

    for (int rp_ = 0; rp_ < REPS(1); ++rp_) {
        LAS float* scr = (LAS float*)(L + wave * 16384);
        const int gw = blockIdx.x * NWAVES + wave, NGW = G * NWAVES;
        weight_set(0, gw, NGW, scr, lane);
        { const int gt = blockIdx.x * (NWAVES * 64) + tid, NTH = G * NWAVES * 64;
          for (int i = gt; i < 2 * D * 8; i += NTH) { const int l = i / (D * 8), k = (i / 8) % D, j = i & 7;
              ((float*)(WSB + WS_WG))[i] = AIN(2)[(size_t)l * D * MIN_ + (size_t)k * MIN_ + 3072 + j] * AIN(1)[l * D + k]; } }
        { const int gt = blockIdx.x * (NWAVES * 64) + tid, NTH = G * NWAVES * 64; bf16* ON = (bf16*)(WSB + WS_ONES);
          for (int i = gt; i < 128; i += NTH) ON[128 * 1024 + i] = (bf16)0; }
        { const int gt = blockIdx.x * (NWAVES * 64) + tid, NTH = G * NWAVES * 64; float* RP = (float*)(WSB + WS_ROPE);
          for (int i = gt; i < T * 16; i += NTH) { const int pos = i >> 4, k = i & 15;
              double inv = 1.0;
#define ROPE_INV_TABLE { 1.0, 0.44036660267178046, 0.19392274474868576, 0.08539710028576561, 0.03760603093086393, 0.016560440080994446, 0.007292664737217109, 0.003211445994752591, 0.001414213562373095, 0.000622772421914596, 0.0002742481756762073, 0.00012076973741146504, 5.318295896944988e-05, 2.341999896140934e-05, 1.031338537721246e-05, 4.5416704806078695e-06 }
              { const double tb[16] = ROPE_INV_TABLE;
#pragma unroll
                for (int q = 0; q < 16; ++q) inv = (k == q) ? tb[q] : inv; }
#undef ROPE_INV_TABLE
              const double turns = (double)pos * inv * 0.15915494309189535; const float fr = (float)(turns - __builtin_rint(turns));
              RP[i] = __builtin_amdgcn_cosf(fr); RP[T * 16 + i] = __builtin_amdgcn_sinf(fr); } }
        for (int m = gw; m < T; m += NGW) {
            const GAS f32x4* xr = (const GAS f32x4*)(XIN + (size_t)m * D) + lane; f32x4 v[4]; float s = 0.f;
#pragma unroll
            for (int j = 0; j < 4; ++j) { v[j] = xr[64 * j]; s += (v[j].x * v[j].x + v[j].y * v[j].y) + (v[j].z * v[j].z + v[j].w * v[j].w); }
            s = wave_sum_hi(s);
            GAS unsigned long long* o8 = (GAS unsigned long long*)(HB + (size_t)m * D) + lane;
#pragma unroll
            for (int j = 0; j < 4; ++j) o8[64 * j] = (unsigned long long)pk2(v[j].x, v[j].y) | ((unsigned long long)pk2(v[j].z, v[j].w) << 32);
            if (lane == 63) *(f32x4*)(SS + (size_t)m * 4) = (f32x4){s, 0.f, 0.f, 0.f};
        }
        { const int gt = blockIdx.x * (NWAVES * 64) + tid, NTH = G * NWAVES * 64;
          for (int i = gt; i < 2 * 1024 / 8; i += NTH) ((GAS v4u*)HBP)[i] = (v4u){0u, 0u, 0u, 0u};
          for (int i = gt; i < 128 * 1024 / 8; i += NTH) ((GAS v4u*)(HB + (size_t)T * D))[i] = (v4u){0u, 0u, 0u, 0u}; }
    GRID_BAR();
    }
    if (DUP == 8) { for (int rp_ = 0; rp_ < 8; ++rp_) GRID_BAR(); }

#define GRIDN() ({ int g_ = gridDim.x; asm volatile("" : "+s"(g_)); g_; })
#define BLK() ({ int b_ = blockIdx.x; asm volatile("" : "+s"(b_)); b_; })
    LAS unsigned char* ring = L; LAS unsigned char* el = L + EPI_OFF;
#pragma unroll
    for (int l = 0; l < 4; ++l) {
#if MIXERS
        if (l < 2) {
            bf16* MQ = (bf16*)(WSB + WS_MQ); bf16* MK = (bf16*)(WSB + WS_MK); bf16* OGB = (bf16*)(WSB + WS_OG); bf16* KVT = (bf16*)(WSB + WS_KVT);
            bf16* CT = (bf16*)(WSB + WS_CT); bf16* HG = (bf16*)(WSB + WS_HG);
            float* BCUM = (float*)(WSB + WS_BCUM); float* IG = (float*)(WSB + WS_IG); float* WGT = (float*)(WSB + WS_WGT); float* DECAY = (float*)(WSB + WS_DECAY); bf16* NCT = (bf16*)(WSB + WS_NCT); bf16* WROW = (bf16*)(WSB + WS_ONES); const bf16* ZROW = (const bf16*)(WSB + WS_ONES + 256 * 1024);
            const float* ssm = SS + (size_t)((2 * l) & 3) * T * 4;
            for (int rp_ = 0; rp_ < REPS(2); ++rp_) {
            for (int c = BLK(); c < 256; c += GRIDN())
                mlstm_gates_item(L, c, HB, (const float*)(WSB + WS_WG) + (size_t)l * D * 8, ssm, AIN(3) + l * 8, BCUM, IG, WGT, DECAY, WROW);
            GRID_BAR();
            {
                pg8::Gemm g{HB, (const bf16*)(WSB + WS_WINR) + (size_t)l * 1536 * D, T, 1536, D, 256};
                pg8::StaticOrder S; S.init(T, 1536, GRIDN(), BLK());
                pg8::EpiIn E{MQ, MK, OGB, ssm};
                pg8::gemm_phase<pg8::EpiIn, pg8::StaticOrder, true, true>(ring, el, g, S, E);
            }
            {
                pg8::Gemm g{(const bf16*)(WSB + WS_WINT) + (size_t)l * 1536 * D, HB, 1536, T, D, 256};
                pg8::StaticOrder S; S.init(1536, T, GRIDN(), BLK());
                pg8::EpiInT E{KVT, ssm, 1536, 64, WGT};
                pg8::gemm_phase<pg8::EpiInT, pg8::StaticOrder, true, true>(ring, el, g, S, E);
            }
            GRID_BAR();
            }
            for (int rp_ = 0; rp_ < REPS(3); ++rp_) {
            { int t4 = threadIdx.x; asm volatile("" : "+v"(t4)); const int wv4 = __builtin_amdgcn_readfirstlane(t4 >> 6);
              if (wv4 >= 3 && rp_ == 0) weight_set(l + 1, BLK() * 5 + (wv4 - 3), GRIDN() * 5, (LAS float*)(L + (wv4 - 3) * 16384), t4 & 63); }
            mlstm_scan(KVT, DECAY, CT, NCT, WROW, ZROW, GRIDN());
            GRID_BAR();
            }
            if (DUP == 13) { mlstm_scan(KVT, DECAY, HG, HG, WROW, ZROW, GRIDN(), true); GRID_BAR(); }
            for (int rp_ = 0; rp_ < REPS(4); ++rp_) {
            mlstm_out_phase(L, GRIDN(), MQ, MK, KVT, CT, NCT, BCUM, WGT, OGB, AIN(4) + l * D, HG);
            GRID_BAR();
            }
            for (int rp_ = 0; rp_ < REPS(10); ++rp_) {
                const bool dummy = (DUP == 10) && rp_ == 0;
                pg8::Gemm g{HG, (const bf16*)(WSB + WS_WOUT) + (size_t)l * D * D, T, D, D, 256};
                pg8::StaticOrder S; S.init(T, D, GRIDN(), BLK());
                pg8::EpiRes E{HB, SS + (size_t)((2 * l + 1) & 3) * T * 4, nullptr}; (void)dummy;
                pg8::gemm_phase<pg8::EpiRes, pg8::StaticOrder, true, true>(ring, el, g, S, E);
                if (dummy) GRID_BAR();
            }
            if (0) {
                pg8::Gemm g{HG, (const bf16*)(WSB + WS_WOUT) + (size_t)l * D * D, T, D, D, 256};
                pg8::StaticOrder S; S.init(T, D, GRIDN(), BLK());
                pg8::EpiRes E{HB, SS + (size_t)((2 * l + 1) & 3) * T * 4, nullptr};
                pg8::gemm_phase<pg8::EpiRes, pg8::StaticOrder, true, true>(ring, el, g, S, E);
            }
            GRID_BAR();
        }
#if MIXERS >= 2
        else {
            const int j = l - 2;
            bf16* XK = (bf16*)(WSB + WS_XK); bf16* XVT = (bf16*)(WSB + WS_XVT); bf16* AQ = (bf16*)(WSB + WS_AQ); bf16* PO = (bf16*)(WSB + WS_PO);
            float* KMEAN = (float*)(WSB + WS_KMEAN); float* ML = (float*)(WSB + WS_ML); int* LIST = (int*)(WSB + WS_LIST); int* gcnt = (int*)(WSB + WS_GCNT) + j * 512;
            const float* ssm = SS + (size_t)((2 * l) & 3) * T * 4; const float* RP = (const float*)(WSB + WS_ROPE);
            for (int rp_ = 0; rp_ < REPS(5); ++rp_) {
            if (l == 2) {
                { pg8::Gemm g{HB, (const bf16*)(WSB + WS_WK), T, D, D, 256}; pg8::StaticOrder S; S.init(T, D, GRIDN(), BLK());
                  pg8::EpiQK E{XK, ssm, AIN(8), RP, KMEAN, 1.0f, 1};
                  pg8::gemm_phase<pg8::EpiQK, pg8::StaticOrder, true, true>(ring, el, g, S, E); }
                { pg8::Gemm g{(const bf16*)(WSB + WS_WV), HB, D, T, D, 256}; pg8::StaticOrder S; S.init(D, T, GRIDN(), BLK());
                  pg8::EpiInT E{XVT, ssm, 1024, 0, nullptr};
                  pg8::gemm_phase<pg8::EpiInT, pg8::StaticOrder, true, true>(ring, el, g, S, E); }
            }
            { pg8::Gemm g{HB, (const bf16*)(WSB + WS_WQ) + (size_t)j * D * D, T, D, D, 256}; pg8::StaticOrder S; S.init(T, D, GRIDN(), BLK());
              pg8::EpiQK E{AQ, ssm, AIN(11) + j * 128, RP, nullptr, 0.08838834764831845f * 1.4426950408889634f, 0};
              pg8::gemm_phase<pg8::EpiQK, pg8::StaticOrder, true, true>(ring, el, g, S, E); }
            GRID_BAR();
            }
            for (int rp_ = 0; rp_ < REPS(11); ++rp_) {
            const bool dummy = (DUP == 11) && rp_ == 0;
            moba_gate_phase(L, GRIDN(), AQ, KMEAN, dummy ? gcnt + 2048 : gcnt, dummy ? (int*)(WSB + WS_WINR) : LIST);
            GRID_BAR();
            }
            for (int rp_ = 0; rp_ < REPS(6); ++rp_) {
            attn_phase3<false>(L, GRIDN(), j);
            GRID_BAR();
            }
            for (int rp_ = 0; rp_ < REPS(12); ++rp_) {
            const bool dummy = (DUP == 12) && rp_ == 0;
            (void)dummy; attn_phase3<true>(L, GRIDN(), j);
            GRID_BAR();
            }
            { int t2 = threadIdx.x; asm volatile("" : "+v"(t2)); const int gt = BLK() * (NWAVES * 64) + t2, NTH = GRIDN() * NWAVES * 64;
              unsigned zu = 0u; asm volatile("" : "+v"(zu));
              for (int i = gt; i < 128 * 1024 / 8; i += NTH) ((GAS v4u*)(HB + (size_t)T * D))[i] = (v4u){zu, zu, zu, zu}; }
            { pg8::Gemm g{AQ, (const bf16*)(WSB + WS_WO) + (size_t)j * D * D, T, D, D, 256}; pg8::StaticOrder S; S.init(T, D, GRIDN(), BLK());
              pg8::EpiRes E{HB, SS + (size_t)((2 * l + 1) & 3) * T * 4, nullptr};
              pg8::gemm_phase<pg8::EpiRes, pg8::StaticOrder, true, true>(ring, el, g, S, E); }
            GRID_BAR();
        }
#endif
#endif
        const bool mix_on = (MIXERS >= 2) || (MIXERS == 1 && l < 2);
        const int ssf = mix_on ? 2 * l + 1 : 2 * l;
#ifndef SKIP_UP
        for (int rp_ = 0; rp_ < REPS(7); ++rp_) {
            pg8::Gemm g{HBP, (const bf16*)(WSB + WS_WUP) + (size_t)l * FF2 * D, 65 * 256, FF2, D, 254};
            pg8::StaticOrder S; S.init(65 * 256, FF2, GRIDN(), BLK());
            pg8::EpiConv E{ACT, SS + (size_t)(ssf & 3) * T * 4, AIN(15) + (size_t)l * 3 * FF2, AIN(16) + (size_t)l * FF2};
            pg8::gemm_phase<pg8::EpiConv, pg8::StaticOrder, true, true>(ring, el, g, S, E);
            GRID_BAR();
        }
#endif
#ifndef SKIP_DN
        for (int rp_ = 0; rp_ < REPS(9); ++rp_) {
            const bool dummy = (DUP == 9) && rp_ == 0;
            pg8::Gemm g{ACT, (const bf16*)(WSB + WS_WDN) + (size_t)l * D * FF, T, D, FF, 256};
            pg8::StaticOrder S; S.init(T, D, GRIDN(), BLK());
            pg8::EpiRes E{HB, (l < 3) ? SS + (size_t)((2 * l + 2) & 3) * T * 4 : nullptr, (l == 3) ? OUTP : nullptr}; (void)dummy;
            pg8::gemm_phase<pg8::EpiRes, pg8::StaticOrder, true, true>(ring, el, g, S, E);
            if (l < 3 || REPS(9) > 1) GRID_BAR();
        }
#endif
    }
    { int t3 = threadIdx.x; asm volatile("" : "+v"(t3)); if (BLK() == 0 && t3 == 0) if (xb_ld((unsigned*)(WSB + WS_CTL) + CW_BAR + XB_TMO)) OUTP[0] = 1.0e6f; }
#if TIMEX
    if (BLK() == TBLK) { const unsigned amt = 8u * *(volatile unsigned*)&g_dbg; TSTAMP(s0_); for (;;) { TSTAMP(s1_); if (s1_ - s0_ >= amt) break; } }
#endif
}

#undef WSB
#undef XIN
#undef OUTP
#undef SS
#undef HBP
#undef HB
#undef ACT
extern "C" void kernel_launch(void* const* d_in, const int* in_sizes, int n_in, void* d_out, int out_size, void* d_ws, size_t ws_size, hipStream_t stream) {
    static int grid = 0;
    if (grid == 0) {
        int dev = 0, cus = 0;
        if (n_in != 18 || out_size != T * D || ws_size < WS_END) { fprintf(stderr, "kernel_launch: unexpected problem geometry (n_in %d out %d ws %zu)\n", n_in, out_size, ws_size); grid = -1; return; }
        if (hipGetDevice(&dev) != hipSuccess || hipDeviceGetAttribute(&cus, hipDeviceAttributeMultiprocessorCount, dev) != hipSuccess) { grid = -1; return; }
        if (hipFuncSetAttribute((const void*)yoco_fwd, hipFuncAttributeMaxDynamicSharedMemorySize, LDS_BYTES) != hipSuccess) { fprintf(stderr, "hipFuncSetAttribute failed\n"); grid = -1; return; }
        (void)hipGetLastError();
        grid = cus;
    }
    if (grid < 0) return;
    (void)hipMemsetAsync((char*)d_ws + WS_CTL, 0, CTL_ZERO_BYTES, stream);
    Args a{};
    for (int i = 0; i < 18; ++i) a.in[i] = (const float*)d_in[i];
    a.out = (float*)d_out; a.ws = (unsigned char*)d_ws; a.ws_size = (unsigned long long)ws_size;
    hipLaunchKernelGGL(yoco_fwd, dim3(grid), dim3(NWAVES * 64), LDS_BYTES, stream, a);
}
```
